# Optimizing an MI355X kernel written in HIP

```python
import math
import jax, jax.numpy as jnp
from jax import lax
import numpy as np

D_MODEL = 1024
BATCH = 32
SEQ = 256
DEPTH = 1
DEC_BATCH = 2
DEC_SEQ = 1024
PAST_LEN = 512

GRID_W = 64
HEAD_DIM_A = 64
WIDTH_A = D_MODEL
N_HEADS_A = WIDTH_A // (2 * HEAD_DIM_A)
HEAD_DIM_B = 64
WIDTH_B = D_MODEL
N_HEADS_B = WIDTH_B // HEAD_DIM_B
LORA_R = 64
D_MIX = WIDTH_A + WIDTH_B
D_SHIFT = 3 * WIDTH_B + 4 * LORA_R
D_IN = 4 * WIDTH_A + D_SHIFT + WIDTH_B
Q_BLOCK = 128
ROPE_BASE = 10000.0
NORM_EPS = 1e-6
SUBLN_EPS = 1e-5
LNX_EPS = 64e-5

kernel_name = 'hymba_diffattn_rwkv7_prefix_dit'

F32 = jnp.float32


def rmsnorm(x, g, eps):
    xf = x.astype(F32)
    y = xf * lax.rsqrt(jnp.mean(xf * xf, axis=-1, keepdims=True) + eps)
    return (y * g.astype(F32)).astype(x.dtype)


def axial_rope(x, rows):
    T = rows * GRID_W
    row = jnp.repeat(jnp.arange(rows), GRID_W)
    col = jnp.arange(T) % GRID_W
    n_freq = HEAD_DIM_A // 4
    inv = ROPE_BASE ** (-jnp.arange(n_freq, dtype=F32) / n_freq)

    def rot(seg, pos):
        ang = pos.astype(F32)[:, None] * inv[None, :]
        cos = jnp.cos(ang)[None, :, None, None, :].astype(x.dtype)
        sin = jnp.sin(ang)[None, :, None, None, :].astype(x.dtype)
        x1, x2 = jnp.split(seg, 2, axis=-1)
        return jnp.concatenate([x1 * cos - x2 * sin, x2 * cos + x1 * sin], axis=-1)

    half = HEAD_DIM_A // 2
    return jnp.concatenate([rot(x[..., :half], row), rot(x[..., half:], col)], axis=-1)


def diff_attention(q, k, v, lam, lam_init, subln_g):
    B, Tq = q.shape[0], q.shape[1]
    nq = Tq // Q_BLOCK
    qb = jnp.moveaxis(q.reshape(B, nq, Q_BLOCK, N_HEADS_A, 2, HEAD_DIM_A), 1, 0)
    scale = HEAD_DIM_A ** -0.5

    def block(qblk):
        s = jnp.einsum('bqhmd,bkhmd->bhmqk', qblk, k).astype(F32) * scale
        p = jax.nn.softmax(s, axis=-1)
        a = p[:, :, 0] - lam * p[:, :, 1]
        return jnp.einsum('bhqk,bkhv->bqhv', a.astype(v.dtype), v)

    o = lax.map(block, qb)
    o = jnp.moveaxis(o, 0, 1).reshape(B, Tq, N_HEADS_A, 2 * HEAD_DIM_A)
    o = rmsnorm(o, subln_g, SUBLN_EPS) * (1.0 - lam_init)
    return o.reshape(B, Tq, WIDTH_A)


def token_shift(u, mu_prev, mu_next):
    zeros = jnp.zeros_like(u[:, :1])
    prev = jnp.concatenate([zeros, u[:, :-1]], axis=1)
    nxt = jnp.concatenate([u[:, 1:], zeros], axis=1)
    return u + mu_prev * (prev - u) + mu_next * (nxt - u)


def rwkv_scan(r, w, k, v, kk, b, s0, reverse):
    xs = tuple(jnp.moveaxis(t.astype(F32), 1, 0) for t in (r, w, k, v, kk, b))

    def step(S, inp):
        r_t, w_t, k_t, v_t, kk_t, b_t = inp
        sa = jnp.einsum('bhvk,bhk->bhv', S, -kk_t)
        S = S * w_t[:, :, None, :] + sa[..., None] * b_t[:, :, None, :] + v_t[..., None] * k_t[:, :, None, :]
        return S, jnp.einsum('bhvk,bhk->bhv', S, r_t)

    s_final, y = lax.scan(step, s0.astype(F32), xs, reverse=reverse)
    return jnp.moveaxis(y, 0, 1), s_final


def rwkv_branch(u_b, g_b, s0, lp):
    B, T, _ = u_b.shape
    dt = u_b.dtype
    us = token_shift(u_b, lp['shift_mu'][0], lp['shift_mu'][1])
    r, k, v, lora = jnp.split(us, [WIDTH_B, 2 * WIDTH_B, 3 * WIDTH_B], axis=-1)
    lora = lora.reshape(B, T, 4, LORA_R).astype(F32)

    def heads(t):
        return t.reshape(B, T, N_HEADS_B, HEAD_DIM_B)

    rf, kf, vf = r.astype(F32), k.astype(F32), v.astype(F32)
    kk = heads(kf * lp['k_k'])
    kk = kk * lax.rsqrt(jnp.sum(kk * kk, axis=-1, keepdims=True) + 1e-12)
    ys, finals = [], []
    for d in range(2):
        w_log = -jax.nn.softplus(-(lp['decay_w0'][d] + jnp.tanh(lora[:, :, d]) @ lp['decay_w2'][d])) - 0.5
        decay = jnp.exp(-jnp.exp(w_log))
        a = jax.nn.sigmoid(lp['iclr_a0'][d] + lora[:, :, 2 + d] @ lp['iclr_a2'][d])
        k_d = kf * (1.0 + (a - 1.0) * lp['k_a'])
        y_d, s_d = rwkv_scan(heads(rf), heads(decay), heads(k_d), heads(vf), kk, kk * heads(a),
                             s0[:, d], reverse=(d == 1))
        ys.append(y_d)
        finals.append(s_d)
    y = ys[0] + ys[1]
    mu = jnp.mean(y, axis=-1, keepdims=True)
    var = jnp.mean(jnp.square(y - mu), axis=-1, keepdims=True)
    yn = ((y - mu) * lax.rsqrt(var + LNX_EPS)).reshape(B, T, WIDTH_B) * lp['lnx_g'] + lp['lnx_b']
    bonus = jnp.sum(heads(rf) * heads(kf) * lp['r_k'], axis=-1, keepdims=True) * heads(vf)
    out = (yn + bonus.reshape(B, T, WIDTH_B)).astype(dt) * jax.nn.silu(g_b)
    return out, jnp.stack(finals, axis=1)


def mixer_layer(x, mod, rows, ctx_k, ctx_v, s0, lp, lam_init):
    B, T, _ = x.shape
    shift, scale, gate = jnp.split(mod, 3, axis=-1)
    h = rmsnorm(x, lp['norm_g'], NORM_EPS) * (1.0 + scale[:, None, :]) + shift[:, None, :]
    u = h @ lp['w_in']
    q, k, v, g_a, u_b, g_b = jnp.split(
        u, [WIDTH_A, 2 * WIDTH_A, 3 * WIDTH_A, 4 * WIDTH_A, 4 * WIDTH_A + D_SHIFT], axis=-1)
    q = q.reshape(B, T, N_HEADS_A, 2, HEAD_DIM_A)
    k = k.reshape(B, T, N_HEADS_A, 2, HEAD_DIM_A)
    v = v.reshape(B, T, N_HEADS_A, 2 * HEAD_DIM_A)
    if rows is None:
        k_all, v_all = k, v
    else:
        q = axial_rope(q, rows)
        k = axial_rope(k, rows)
        k_all = jnp.concatenate([ctx_k.astype(k.dtype), k], axis=1)
        v_all = jnp.concatenate([ctx_v.astype(v.dtype), v], axis=1)
    lam = (jnp.exp(jnp.sum(lp['lam_q1'].astype(F32) * lp['lam_k1'].astype(F32)))
           - jnp.exp(jnp.sum(lp['lam_q2'].astype(F32) * lp['lam_k2'].astype(F32))) + lam_init)
    o_a = diff_attention(q, k_all, v_all, lam, lam_init, lp['subln_g']) * jax.nn.silu(g_a)
    o_b, s_final = rwkv_branch(u_b, g_b, s0, lp)
    x = x + gate[:, None, :] * (jnp.concatenate([o_a, o_b], axis=-1) @ lp['w_out'])
    return x, k, v, s_final


def setup_inputs(seed: int = 0) -> dict:
    key = jax.random.key(seed)
    ks = jax.random.split(key, 32)

    def nrm(k, shape, s):
        return jax.random.normal(k, shape, F32) * s

    return {
        'x_prompt': nrm(ks[0], (BATCH, SEQ, D_MODEL), 1.0),
        'x_sample': nrm(ks[1], (DEC_BATCH, DEC_SEQ, D_MODEL), 1.0),
        'cache_k': nrm(ks[2], (DEC_BATCH, DEPTH, PAST_LEN, N_HEADS_A, 2, HEAD_DIM_A), 1.0),
        'cache_v': nrm(ks[3], (DEC_BATCH, DEPTH, PAST_LEN, N_HEADS_A, 2 * HEAD_DIM_A), 1.0),
        'state_rwkv': nrm(ks[4], (DEC_BATCH, DEPTH, 2, N_HEADS_B, HEAD_DIM_B, HEAD_DIM_B), 0.5),
        'c': nrm(ks[5], (DEC_BATCH, D_MODEL), 1.0),
        'c_ctx': nrm(ks[6], (D_MODEL,), 1.0),
        'norm_g': 1.0 + nrm(ks[7], (DEPTH, D_MODEL), 0.02),
        'w_ada': nrm(ks[8], (DEPTH, D_MODEL, 3 * D_MODEL), 0.5 * D_MODEL ** -0.5),
        'b_ada': nrm(ks[9], (DEPTH, 3 * D_MODEL), 0.02),
        'w_in': nrm(ks[10], (DEPTH, D_MODEL, D_IN), D_MODEL ** -0.5),
        'lam_q1': nrm(ks[11], (DEPTH, HEAD_DIM_A), 0.1),
        'lam_k1': nrm(ks[12], (DEPTH, HEAD_DIM_A), 0.1),
        'lam_q2': nrm(ks[13], (DEPTH, HEAD_DIM_A), 0.1),
        'lam_k2': nrm(ks[14], (DEPTH, HEAD_DIM_A), 0.1),
        'subln_g': 1.0 + nrm(ks[15], (DEPTH, 2 * HEAD_DIM_A), 0.02),
        'shift_mu': jax.random.uniform(ks[16], (DEPTH, 2, D_SHIFT), F32, 0.0, 0.5),
        'decay_w0': jax.random.uniform(ks[17], (DEPTH, 2, WIDTH_B), F32, -5.0, 1.0),
        'decay_w2': nrm(ks[18], (DEPTH, 2, LORA_R, WIDTH_B), 0.1 * LORA_R ** -0.5),
        'iclr_a0': nrm(ks[19], (DEPTH, 2, WIDTH_B), 0.1),
        'iclr_a2': nrm(ks[20], (DEPTH, 2, LORA_R, WIDTH_B), 0.1 * LORA_R ** -0.5),
        'k_k': 0.85 + nrm(ks[21], (DEPTH, WIDTH_B), 0.02),
        'k_a': 1.0 + nrm(ks[22], (DEPTH, WIDTH_B), 0.02),
        'r_k': nrm(ks[23], (DEPTH, N_HEADS_B, HEAD_DIM_B), 0.1),
        'lnx_g': 1.0 + nrm(ks[24], (DEPTH, WIDTH_B), 0.02),
        'lnx_b': nrm(ks[25], (DEPTH, WIDTH_B), 0.02),
        'w_out': nrm(ks[26], (DEPTH, D_MIX, D_MODEL), D_MIX ** -0.5),
        'final_g': 1.0 + nrm(ks[27], (D_MODEL,), 0.02),
    }


def reference(x_prompt, x_sample, cache_k, cache_v, state_rwkv, c, c_ctx, norm_g, w_ada, b_ada,
              w_in, lam_q1, lam_k1, lam_q2, lam_k2, subln_g, shift_mu, decay_w0, decay_w2,
              iclr_a0, iclr_a2, k_k, k_a, r_k, lnx_g, lnx_b, w_out, final_g):
    rows = x_sample.shape[1] // GRID_W
    xp, xs = x_prompt, x_sample
    s0_ctx = jnp.zeros((x_prompt.shape[0], 2, N_HEADS_B, HEAD_DIM_B, HEAD_DIM_B), F32)
    new_k, new_v, new_s = [], [], []
    for l in range(DEPTH):
        lp = {
            'norm_g': norm_g[l], 'w_in': w_in[l], 'lam_q1': lam_q1[l], 'lam_k1': lam_k1[l],
            'lam_q2': lam_q2[l], 'lam_k2': lam_k2[l], 'subln_g': subln_g[l], 'shift_mu': shift_mu[l],
            'decay_w0': decay_w0[l], 'decay_w2': decay_w2[l], 'iclr_a0': iclr_a0[l],
            'iclr_a2': iclr_a2[l], 'k_k': k_k[l], 'k_a': k_a[l], 'r_k': r_k[l],
            'lnx_g': lnx_g[l], 'lnx_b': lnx_b[l], 'w_out': w_out[l],
        }
        lam_init = 0.8 - 0.6 * math.exp(-0.3 * l)
        mod_ctx = (jax.nn.silu(c_ctx) @ w_ada[l] + b_ada[l])[None]
        mod_lat = jax.nn.silu(c) @ w_ada[l] + b_ada[l]
        xp, k_l, v_l, s_l = mixer_layer(xp, mod_ctx, None, None, None, s0_ctx, lp, lam_init)
        new_k.append(k_l)
        new_v.append(v_l)
        new_s.append(s_l.astype(x_prompt.dtype))
        xs, _, _, _ = mixer_layer(xs, mod_lat, rows, cache_k[:, l], cache_v[:, l],
                                  state_rwkv[:, l], lp, lam_init)
    y_prompt = rmsnorm(xp, final_g, NORM_EPS)
    y_sample = rmsnorm(xs, final_g, NORM_EPS)
    return (y_prompt, y_sample, jnp.stack(new_k, axis=1), jnp.stack(new_v, axis=1), jnp.stack(new_s, axis=1))
```

```cpp
#include <hip/hip_runtime.h>
#include <cstdio>
#include <cstdint>

#ifndef MK_N_LAUNCHES
#define MK_N_LAUNCHES 1
#endif

namespace pg8 {
#define PG8_LAS __attribute__((address_space(3)))
typedef unsigned short bf16_t;
typedef short bf16x8 __attribute__((ext_vector_type(8)));
typedef float f32x4 __attribute__((ext_vector_type(4)));
typedef unsigned u32x4 __attribute__((ext_vector_type(4)));
constexpr int BM = 256, BK = 64, HALF = 128, HTB = HALF * BK * 2, STAGE_BYTES = 8 * HTB, NXCD = 8, WGM = 8;

__host__ __device__ __forceinline__ int lds_byte(int r, int c) { const int st = (r >> 4) * 2 + (c >> 5), rr = r & 15, cc = c & 31, ob = rr * 64 + cc * 2; return st * 1024 + (ob ^ (((ob >> 9) & 1) << 5)); }
__host__ __device__ __forceinline__ void stage_rc(int b, int& R, int& C) { const int st = b / 1024, sb = b % 1024, swz = sb ^ (((sb >> 9) & 1) << 5); R = (st >> 1) * 16 + swz / 64; C = (st & 1) * 32 + (swz % 64) / 2; }
__host__ __device__ __forceinline__ int perm32(int rho) { const int n = rho >> 4, i = rho & 15; return 8 * (i >> 2) + 4 * n + (i & 3); }

struct Unit { int pm, pn; };
struct Gemm { const bf16_t* A; const bf16_t* Bt; int M, N, K; };

struct StaticOrder {
    int nM, nN, nwg, G, c;
    __host__ __device__ void init(int M, int N, int G_, int c_) { nM = M / BM; nN = N / BM; nwg = nM * nN; G = G_; c = c_; }
    __host__ __device__ bool next(int i, Unit& u) const {
        const long L = (long)i * G + c; if (L >= nwg) return false;
        int wgid = (int)L; { const int q = nwg / NXCD, r = nwg % NXCD, xcd = wgid % NXCD, off = wgid / NXCD; wgid = (xcd < r ? xcd * (q + 1) : r * (q + 1) + (xcd - r) * q) + off; }
        const int nig = WGM * nN, gid = wgid / nig, fm = gid * WGM, gsz = (nM - fm) < WGM ? (nM - fm) : WGM;
        u.pm = fm + ((wgid % nig) % gsz); u.pn = (wgid % nig) / gsz; return true;
    }
    __device__ __forceinline__ void a_ready(const Unit&) const {}
    __device__ __forceinline__ void done(const Unit&) const {}
};

__device__ __forceinline__ unsigned cvt_pk_bf16(float lo, float hi) { unsigned r; asm volatile("v_cvt_pk_bf16_f32 %0, %1, %2" : "=v"(r) : "v"(lo), "v"(hi)); return r; }

template <class Epi, class Sched, bool ALIGN_EPI = false, bool SP2 = false>
__device__ __forceinline__ void gemm_phase(PG8_LAS unsigned char* lds, const Gemm g, const Sched& S, const Epi& E) {
    int tid = threadIdx.x; asm volatile("" : "+v"(tid));
    const int wid = __builtin_amdgcn_readfirstlane(tid >> 6), lane = tid & 63, wr = wid >> 2, wc = wid & 3, fr = lane & 15, fq = lane >> 4;
    const int K = g.K, nt = K / BK;
    unsigned voffA[2], voffB[2];
#pragma unroll
    for (int i = 0; i < 2; ++i) { int R, C; stage_rc(tid * 16 + i * 8192, R, C); const int Rb = Epi::PERM ? ((R & ~31) + perm32(R & 31)) : R;
        voffA[i] = (unsigned)(R * K + C) * 2u; voffB[i] = (unsigned)(Rb * K + C) * 2u; }
    const size_t kstep = (size_t)(BK * 2);
    const size_t hstep = (size_t)HALF * K * 2;
    const size_t tstep = 2 * hstep;
    const unsigned ldsw = (unsigned)wid * 1024u;
    const int aoff = lds_byte(wr * 64 + fr, fq * 8), boff = lds_byte(wc * 32 + fr, fq * 8);
#define PG8_SA(b, h) (((b) * 2 + (h)) * HTB)
#define PG8_SB(b, h) ((4 + (b) * 2 + (h)) * HTB)
#define PG8_STAGE(bufoff, gbase, voff) do { _Pragma("unroll") for (int _i = 0; _i < 2; ++_i) \
        __builtin_amdgcn_global_load_lds((const unsigned*)((const char*)(gbase) + (voff)[_i]), (PG8_LAS unsigned*)(lds + (bufoff) + ldsw + _i * 8192), 16, 0, 0); } while (0)
#define PG8_LDA(dst, b, h) do { _Pragma("unroll") for (int m = 0; m < 4; ++m) _Pragma("unroll") for (int k = 0; k < 2; ++k) dst[m][k] = *(const PG8_LAS bf16x8*)(lds + PG8_SA(b, h) + aoff + m * 2048 + k * 1024); } while (0)
#define PG8_LDB(dst, b, h) do { _Pragma("unroll") for (int n = 0; n < 2; ++n) _Pragma("unroll") for (int k = 0; k < 2; ++k) dst[n][k] = *(const PG8_LAS bf16x8*)(lds + PG8_SB(b, h) + boff + n * 2048 + k * 1024); } while (0)
#define PG8_MMA(ai, bj, At, Bt) do { __builtin_amdgcn_s_setprio(1); _Pragma("unroll") for (int m = 0; m < 4; ++m) _Pragma("unroll") for (int n = 0; n < 2; ++n) _Pragma("unroll") for (int k = 0; k < 2; ++k) \
        acc[ai][bj][m][n] = __builtin_amdgcn_mfma_f32_16x16x32_bf16(Bt[n][k], At[m][k], acc[ai][bj][m][n], 0, 0, 0); __builtin_amdgcn_s_setprio(0); } while (0)
#define PG8_WAIT_V(n) asm volatile("s_waitcnt vmcnt(" #n ")" ::: "memory")
#define PG8_WAIT_L(n) asm volatile("s_waitcnt lgkmcnt(" #n ")" ::: "memory")
#define PG8_BAR __builtin_amdgcn_s_barrier()
#define PG8_SCHED __builtin_amdgcn_sched_barrier(0)
    Unit cur, nxt; int ui = 0;
    if (!S.next(0, cur)) return;
    f32x4 acc[2][2][4][2];
#pragma unroll
    for (int a = 0; a < 2; ++a)
#pragma unroll
        for (int b = 0; b < 2; ++b)
#pragma unroll
            for (int m = 0; m < 4; ++m)
#pragma unroll
                for (int n = 0; n < 2; ++n) acc[a][b][m][n] = (f32x4){0.f, 0.f, 0.f, 0.f};
    bf16x8 At[4][2], B0[2][2], B1[2][2];
    const char* cA = (const char*)g.A + (size_t)cur.pm * tstep; const char* cB = (const char*)g.Bt + (size_t)cur.pn * tstep;
    S.a_ready(cur);
    if constexpr (SP2) {
        PG8_STAGE(PG8_SB(0, 0), cB, voffB); PG8_STAGE(PG8_SB(0, 1), cB + hstep, voffB); PG8_STAGE(PG8_SA(0, 0), cA, voffA); PG8_STAGE(PG8_SA(0, 1), cA + hstep, voffA);
        if (wr == 1) PG8_BAR;
        PG8_WAIT_V(2); PG8_BAR;
        PG8_STAGE(PG8_SB(1, 0), cB + kstep, voffB); PG8_STAGE(PG8_SA(1, 0), cA + kstep, voffA); PG8_STAGE(PG8_SB(1, 1), cB + hstep + kstep, voffB);
        PG8_WAIT_V(6); PG8_BAR;
    } else {
        PG8_STAGE(PG8_SB(0, 0), cB, voffB); PG8_STAGE(PG8_SA(0, 0), cA, voffA); PG8_STAGE(PG8_SB(0, 1), cB + hstep, voffB); PG8_STAGE(PG8_SA(0, 1), cA + hstep, voffA);
        if (wr == 1) PG8_BAR;
        PG8_WAIT_V(4); PG8_BAR;
        PG8_STAGE(PG8_SB(1, 0), cB + kstep, voffB); PG8_STAGE(PG8_SA(1, 0), cA + kstep, voffA); PG8_STAGE(PG8_SB(1, 1), cB + hstep + kstep, voffB);
        PG8_WAIT_V(6); PG8_BAR;
    }
    for (;;) {
        const bool has_next = S.next(ui + 1, nxt);
        const char* nA = has_next ? (const char*)g.A + (size_t)nxt.pm * tstep : cA; const char* nB = has_next ? (const char*)g.Bt + (size_t)nxt.pn * tstep : cB;
        for (int t = 0; t < nt; t += 2) {
            const bool last = (t == nt - 2);
            const char* a1 = cA + (size_t)(t + 1) * kstep;
            const char* a2 = last ? nA : cA + (size_t)(t + 2) * kstep; const char* b2 = last ? nB : cB + (size_t)(t + 2) * kstep;
            const char* a3 = a2 + kstep; const char* b3 = b2 + kstep;
            if (last && has_next) S.a_ready(nxt);
            if constexpr (SP2) {
            PG8_LDB(B0, 0, 0); PG8_LDB(B1, 0, 1); PG8_SCHED; PG8_LDA(At, 0, 0); PG8_STAGE(PG8_SA(1, 1), a1 + hstep, voffA);
            PG8_WAIT_V(8); PG8_WAIT_L(0); PG8_BAR; PG8_MMA(0, 0, At, B0); PG8_MMA(0, 1, At, B1); PG8_BAR; PG8_SCHED;
            PG8_LDA(At, 0, 1); PG8_STAGE(PG8_SB(0, 0), b2, voffB); PG8_STAGE(PG8_SB(0, 1), b2 + hstep, voffB); PG8_STAGE(PG8_SA(0, 0), a2, voffA);
            PG8_WAIT_V(8); PG8_WAIT_L(0); PG8_BAR; PG8_MMA(1, 0, At, B0); PG8_MMA(1, 1, At, B1); PG8_BAR; PG8_SCHED;
            PG8_LDB(B0, 1, 0); PG8_LDB(B1, 1, 1); PG8_SCHED; PG8_LDA(At, 1, 0); PG8_STAGE(PG8_SA(0, 1), a2 + hstep, voffA);
            PG8_WAIT_V(8); PG8_WAIT_L(0); PG8_BAR; PG8_MMA(0, 0, At, B0); PG8_MMA(0, 1, At, B1); PG8_BAR; PG8_SCHED;
            PG8_LDA(At, 1, 1); PG8_STAGE(PG8_SB(1, 0), b3, voffB); PG8_STAGE(PG8_SB(1, 1), b3 + hstep, voffB); PG8_STAGE(PG8_SA(1, 0), a3, voffA);
            PG8_WAIT_V(8); PG8_WAIT_L(0); PG8_BAR; PG8_MMA(1, 0, At, B0); PG8_MMA(1, 1, At, B1); PG8_BAR; PG8_SCHED;
            } else {
            PG8_LDB(B0, 0, 0); PG8_SCHED; PG8_LDA(At, 0, 0); PG8_STAGE(PG8_SA(1, 1), a1 + hstep, voffA);
            PG8_WAIT_L(8); PG8_BAR; PG8_WAIT_L(0); PG8_MMA(0, 0, At, B0); PG8_BAR; PG8_SCHED;
            PG8_LDB(B1, 0, 1); PG8_STAGE(PG8_SB(0, 0), b2, voffB);
            PG8_BAR; PG8_WAIT_L(0); PG8_MMA(0, 1, At, B1); PG8_BAR;
            PG8_LDA(At, 0, 1); PG8_STAGE(PG8_SA(0, 0), a2, voffA);
            PG8_BAR; PG8_WAIT_L(0); PG8_MMA(1, 0, At, B0); PG8_BAR; PG8_SCHED;
            PG8_STAGE(PG8_SB(0, 1), b2 + hstep, voffB);
            PG8_WAIT_V(6); PG8_BAR; PG8_MMA(1, 1, At, B1); PG8_BAR;
            PG8_LDB(B0, 1, 0); PG8_SCHED; PG8_LDA(At, 1, 0); PG8_STAGE(PG8_SA(0, 1), a2 + hstep, voffA);
            PG8_WAIT_L(8); PG8_BAR; PG8_WAIT_L(0); PG8_MMA(0, 0, At, B0); PG8_BAR; PG8_SCHED;
            PG8_LDB(B1, 1, 1); PG8_STAGE(PG8_SB(1, 0), b3, voffB);
            PG8_BAR; PG8_WAIT_L(0); PG8_MMA(0, 1, At, B1); PG8_BAR;
            PG8_LDA(At, 1, 1); PG8_STAGE(PG8_SA(1, 0), a3, voffA);
            PG8_BAR; PG8_WAIT_L(0); PG8_MMA(1, 0, At, B0); PG8_BAR; PG8_SCHED;
            PG8_STAGE(PG8_SB(1, 1), b3 + hstep, voffB);
            PG8_WAIT_V(6); PG8_BAR; PG8_MMA(1, 1, At, B1); PG8_BAR;
            }
        }
        if constexpr (ALIGN_EPI) { if (wr == 0) PG8_BAR; }
        if constexpr (!Epi::AFTER_DRAIN) { E(acc, cur, wr, wc, fr, fq); S.done(cur); }
        if (!has_next) break;
#pragma unroll
        for (int a = 0; a < 2; ++a)
#pragma unroll
            for (int b = 0; b < 2; ++b)
#pragma unroll
                for (int m = 0; m < 4; ++m)
#pragma unroll
                    for (int n = 0; n < 2; ++n) acc[a][b][m][n] = (f32x4){0.f, 0.f, 0.f, 0.f};
        cur = nxt; cA = nA; cB = nB; ++ui;
        if constexpr (ALIGN_EPI) { if (wr == 1) PG8_BAR; }
    }
    PG8_WAIT_V(0);
    if constexpr (!ALIGN_EPI) { if (wr == 0) PG8_BAR; }
    PG8_BAR;
    if constexpr (Epi::AFTER_DRAIN) { E.fused(acc, cur, wr, wc, fr, fq, lds, wid, lane); S.done(cur); }
#undef PG8_SA
#undef PG8_SB
#undef PG8_STAGE
#undef PG8_LDA
#undef PG8_LDB
#undef PG8_MMA
#undef PG8_WAIT_V
#undef PG8_WAIT_L
#undef PG8_BAR
#undef PG8_SCHED
}
}

constexpr int NWAVES = 8, NTHR = 512;
constexpr int N_LAUNCHES = MK_N_LAUNCHES;
constexpr int PER_PHASE = 6;
constexpr int D = 1024, NBC = 32, SEQ = 256, NBL = 2, LSEQ = 1024, PAST = 512, KLAT = PAST + LSEQ;
constexpr int MC = NBC * SEQ, ML = NBL * LSEQ, M = MC + ML;
constexpr int DIN = 8448, DMIX = 2048, DSH = 3328, NH = 8, NHB = 16;
constexpr int OUT_Y = 0, OUT_CK = M * D, OUT_CV = OUT_CK + MC * D, OUT_ST = OUT_CV + MC * D, OUT_END = OUT_ST + NBC * 2 * NHB * 64 * 64;

enum { I_XP = 0, I_XS, I_CK, I_CV, I_ST, I_C, I_CCTX, I_NG, I_WADA, I_BADA, I_WIN, I_LQ1, I_LK1, I_LQ2, I_LK2, I_SUBG, I_MU, I_W0, I_W2, I_A0, I_A2, I_KK, I_KA, I_RK, I_LNG, I_LNB, I_WOUT, I_FG, N_IN };

constexpr size_t MiB = 1u << 20;
constexpr size_t WS_CTL = 0, CTL_ZERO_BYTES = 1 * MiB;
constexpr size_t WS_MODP = 1 * MiB;
constexpr size_t WS_MODF = WS_MODP + 640 * 1024;
constexpr size_t WS_ROPE = WS_MODF + 64 * 1024;
constexpr size_t WS_SSQ = 2 * MiB;
constexpr size_t WS_WOP = 3 * MiB;
constexpr size_t WS_WIN = 4 * MiB;
constexpr size_t WS_WOUT = 21 * MiB;
constexpr size_t WS_XN = 25 * MiB;
constexpr size_t WS_Q = 45 * MiB;
constexpr size_t WS_KC = 65 * MiB;
constexpr size_t WS_KL = 81 * MiB;
constexpr size_t WS_VTC = 87 * MiB;
constexpr size_t WS_VTL = 103 * MiB;
constexpr size_t WS_GA = 109 * MiB;
constexpr size_t WS_GB = 129 * MiB;
constexpr size_t WS_UB = 149 * MiB;
constexpr size_t WS_MIX = 214 * MiB;
constexpr size_t WS_END = 254 * MiB;
constexpr int CW_BAR = 4096;
constexpr int CW_Q3 = 64;

constexpr int RING_OFF = 0, RING_BYTES = 131072;
constexpr int LDS_BYTES = 163840;
constexpr int LDSCTL_OFF = LDS_BYTES - 1024, MISC_OFF = LDSCTL_OFF + 320;

#define GAS __attribute__((address_space(1)))
#define LAS __attribute__((address_space(3)))
typedef unsigned short bf16;
typedef unsigned v4u __attribute__((ext_vector_type(4)));
typedef unsigned v2u __attribute__((ext_vector_type(2)));
typedef float f32x4 __attribute__((ext_vector_type(4)));
typedef float f32x16 __attribute__((ext_vector_type(16)));
typedef short bf16x8 __attribute__((ext_vector_type(8)));
typedef GAS unsigned gu32;
#define RLX_AGENT __ATOMIC_RELAXED, __HIP_MEMORY_SCOPE_AGENT
#define LDS_WAIT() asm volatile("s_waitcnt lgkmcnt(0)" ::: "memory")
#define VM_WAIT() asm volatile("s_waitcnt vmcnt(0)" ::: "memory")
__device__ __forceinline__ unsigned f2bf(float f) { unsigned u = __builtin_bit_cast(unsigned, f); return (u + 0x7fffu + ((u >> 16) & 1u)) >> 16; }
typedef float f32x2_t __attribute__((ext_vector_type(2)));
typedef __bf16 bf16x2_t __attribute__((ext_vector_type(2)));
__device__ __forceinline__ unsigned pk2(float lo, float hi) { const f32x2_t f = {lo, hi}; return __builtin_bit_cast(unsigned, __builtin_convertvector(f, bf16x2_t)); }
__device__ __forceinline__ unsigned f2bf_hw(float f) { return pk2(f, f); }
__device__ __forceinline__ float bf2f(unsigned b) { return __builtin_bit_cast(float, b << 16); }
__device__ __forceinline__ float bflo(unsigned w) { return __builtin_bit_cast(float, w << 16); }
__device__ __forceinline__ float bfhi(unsigned w) { return __builtin_bit_cast(float, w & 0xffff0000u); }
__device__ __forceinline__ float sigmoidf_(float x) { return __builtin_amdgcn_rcpf(1.f + __expf(-x)); }
__device__ __forceinline__ float siluf_(float x) { return x * __builtin_amdgcn_rcpf(1.f + __expf(-x)); }

#define XB_TMO      128
#define XB_XCNT(j)  (256  + 64 * (j))
#define XB_XSUB(j)  (1280 + 64 * (j))
#define XB_XGEN(j)  (2304 + 64 * (j))
#define XB_TOP      3328
#define XB_TOPGEN   3392
#define XCD_BAR_WORDS 3456
#define XB_SPIN_CAP (1u << 18)
__device__ __forceinline__ unsigned xb_ld(unsigned* p)              { return __hip_atomic_load(p, __ATOMIC_RELAXED, __HIP_MEMORY_SCOPE_AGENT); }
__device__ __forceinline__ unsigned xb_add(unsigned* p, unsigned v) { return __hip_atomic_fetch_add(p, v, __ATOMIC_RELAXED, __HIP_MEMORY_SCOPE_AGENT); }
__device__ __forceinline__ unsigned xb_xcc_id() { return (unsigned)__builtin_amdgcn_s_getreg((3 << 11) | 20) & 0xFu; }
#define XB_SPIN(cond, bar) do { unsigned _sp = 0; while (cond) { __builtin_amdgcn_s_sleep(1); \
    if ((++_sp & 255u) == 0u) { if (xb_ld(&(bar)[XB_TMO])) break; if (_sp > XB_SPIN_CAP) { atomicAdd(&(bar)[XB_TMO], 1u); break; } } } } while (0)
struct XcdBarrier { unsigned* bar; unsigned x; volatile LAS unsigned* st; };
__device__ __forceinline__ XcdBarrier xcd_barrier_post(unsigned* bar, volatile LAS unsigned* st) {
    XcdBarrier b; b.bar = bar; b.x = xb_xcc_id(); b.st = st;
    if (threadIdx.x == 0) (void)xb_add(&bar[XB_XCNT(b.x)], 1u);
    return b;
}
__device__ __forceinline__ void xcd_barrier_complete(unsigned* bar, unsigned x, unsigned& nloc, unsigned& nx) {
    const unsigned G = gridDim.x * gridDim.y * gridDim.z;
    unsigned sum, cnt, mine, sp = 0u;
    for (;;) {
        sum = 0u; cnt = 0u; mine = 0u;
#pragma unroll
        for (unsigned j = 0; j < 16; ++j) { const unsigned c = xb_ld(&bar[XB_XCNT(j)]); sum += c; cnt += (c > 0u) ? 1u : 0u; mine = (j == x) ? c : mine; }
        if (sum == G) break;
        __builtin_amdgcn_s_sleep(1);
        if ((++sp & 255u) == 0u) { if (xb_ld(&bar[XB_TMO])) break; if (sp > XB_SPIN_CAP) { atomicAdd(&bar[XB_TMO], 1u); break; } }
    }
    nloc = mine > 0u ? mine : 1u; nx = cnt > 0u ? cnt : 1u;
}
__device__ __forceinline__ void xcd_barrier(const XcdBarrier& b) {
    asm volatile("s_waitcnt vmcnt(0)" ::: "memory");
    __syncthreads();
    if (threadIdx.x == 0) {
        unsigned* bar = b.bar;
        __builtin_amdgcn_s_waitcnt(0);
        unsigned nloc = b.st[0], nx = b.st[1];
        if (nloc == 0u) { xcd_barrier_complete(bar, b.x, nloc, nx); b.st[0] = nloc; b.st[1] = nx; }
        const unsigned old = xb_add(&bar[XB_XSUB(b.x)], 1u);
        const unsigned gen = old / nloc;
        if (old + 1u == (gen + 1u) * nloc) {
            __builtin_amdgcn_fence(__ATOMIC_RELEASE, "agent");
            asm volatile("s_waitcnt vmcnt(0)" ::: "memory");
            const unsigned og = xb_add(&bar[XB_TOP], 1u);
            const unsigned tg = og / nx;
            if (og + 1u == (tg + 1u) * nx) xb_add(&bar[XB_TOPGEN], 1u);
            else XB_SPIN(xb_ld(&bar[XB_TOPGEN]) == tg, bar);
            __builtin_amdgcn_fence(__ATOMIC_ACQUIRE, "agent");
            xb_add(&bar[XB_XGEN(b.x)], 1u);
            asm volatile("s_waitcnt vmcnt(0)" ::: "memory");
        } else {
            XB_SPIN(xb_ld(&bar[XB_XGEN(b.x)]) == gen, bar);
            __builtin_amdgcn_fence(__ATOMIC_ACQUIRE, "agent");
            asm volatile("s_waitcnt vmcnt(0)" ::: "memory");
        }
    }
    __syncthreads();
}

struct Args { const float* in[N_IN]; float* out; unsigned char* ws; int ph_lo, ph_hi, li, pad; };
struct Frame {
    LAS unsigned char* lds;
    volatile LAS unsigned* MISC;
    gu32* ctl;
    int tid, lane, wave, G;
    const float* const* in;
    float* out; unsigned char* ws;
};
__device__ __forceinline__ float wave_sum(float v) {
#pragma unroll
    for (int o = 1; o < 64; o <<= 1) v += __shfl_xor(v, o);
    return v;
}
__device__ __forceinline__ const float* xrow_ptr(const Frame& F, int m) { return m < MC ? F.in[I_XP] + (size_t)m * D : F.in[I_XS] + (size_t)(m - MC) * D; }

__device__ __forceinline__ void p0_transpose_item(const float* W, int K, int N, bf16* WT, LAS float* scr, int item, int lane) {
    const int nblk = N / 32, kb = item / nblk, nb = item % nblk, k0 = 64 * kb, n0 = 32 * nb;
#pragma unroll 4
    for (int i = 0; i < 32; ++i) { const int kk = 2 * i + (lane >> 5); scr[kk * 33 + (lane & 31)] = W[(size_t)(k0 + kk) * N + n0 + (lane & 31)]; }
    LDS_WAIT(); asm volatile("" ::: "memory");
    const int c = lane & 7;
#pragma unroll
    for (int j = 0; j < 4; ++j) { const int n = (lane >> 3) + 8 * j; const LAS float* s = scr + (8 * c) * 33 + n;
        v4u o; o.x = pk2(s[0 * 33], s[1 * 33]); o.y = pk2(s[2 * 33], s[3 * 33]); o.z = pk2(s[4 * 33], s[5 * 33]); o.w = pk2(s[6 * 33], s[7 * 33]);
        *(GAS v4u*)(WT + (size_t)(n0 + n) * K + k0 + 8 * c) = o; }
    LDS_WAIT(); asm volatile("" ::: "memory");
}
__device__ __forceinline__ void p0_prologue(Frame& F) {
    LAS float* scr = (LAS float*)(F.lds + RING_OFF + F.wave * 16384);
    const int gw = blockIdx.x * NWAVES + F.wave, NGW = F.G * NWAVES;
    bf16* WinT = (bf16*)(F.ws + WS_WIN); bf16* WoutT = (bf16*)(F.ws + WS_WOUT);
    constexpr int I_IN = (D / 64) * (DIN / 32), I_OUT = (DMIX / 64) * (D / 32), I_MOD = 16 * 12, I_CV_ = NBL * NH * (PAST / 64), I_ROPE = 1;
    constexpr int NITEMS = I_MOD + I_IN + I_OUT + I_CV_ + I_ROPE;
    for (int it = gw; it < NITEMS; it += NGW) {
        int r = it;
        if (r < I_MOD) {
            const int kc = r / 12, nb = r % 12, n0 = nb * 256 + 4 * F.lane;
            const float* wa = F.in[I_WADA] + (size_t)(kc * 64) * 3072 + n0;
            f32x4 a0 = {0.f, 0.f, 0.f, 0.f}, a1 = a0, a2 = a0;
#pragma unroll 8
            for (int k = 0; k < 64; ++k) {
                const f32x4 w = *(const f32x4*)(wa + (size_t)k * 3072);
                const float s0 = siluf_(F.in[I_CCTX][kc * 64 + k]), s1 = siluf_(F.in[I_C][kc * 64 + k]), s2 = siluf_(F.in[I_C][D + kc * 64 + k]);
                a0 += w * s0; a1 += w * s1; a2 += w * s2;
            }
            float* mp = (float*)(F.ws + WS_MODP) + (size_t)kc * 3 * 3072 + n0;
            *(f32x4*)(mp) = a0; *(f32x4*)(mp + 3072) = a1; *(f32x4*)(mp + 2 * 3072) = a2;
            continue;
        }
        r -= I_MOD;
        if (r < I_IN) { p0_transpose_item(F.in[I_WIN], D, DIN, WinT, scr, r, F.lane); continue; } r -= I_IN;
        if (r < I_OUT) { p0_transpose_item(F.in[I_WOUT], DMIX, D, WoutT, scr, r, F.lane); continue; } r -= I_OUT;
        if (r < I_CV_) {
            const int tb = r % (PAST / 64), hh = (r / (PAST / 64)) % NH, b = r / (NH * (PAST / 64));
            const float* src = F.in[I_CV] + ((size_t)(b * PAST + tb * 64 + F.lane) * NH + hh) * 128;
            bf16* dst = (bf16*)(F.ws + WS_VTL) + (size_t)((b * NH + hh) * 128) * KLAT + tb * 64 + F.lane;
#pragma unroll 4
            for (int dv = 0; dv < 128; dv += 4) { const f32x4 v = *(const f32x4*)(src + dv);
                dst[(size_t)(dv + 0) * KLAT] = (bf16)f2bf(v.x); dst[(size_t)(dv + 1) * KLAT] = (bf16)f2bf(v.y); dst[(size_t)(dv + 2) * KLAT] = (bf16)f2bf(v.z); dst[(size_t)(dv + 3) * KLAT] = (bf16)f2bf(v.w); }
            continue;
        }
        r -= I_CV_;
        {
            float* rp = (float*)(F.ws + WS_ROPE);
            for (int e = F.lane; e < 1024; e += 64) { const int pos = e >> 4, i = e & 15; const double inv = pow(10000.0, -(double)i / 16.0), ang = (double)pos * inv; rp[e] = (float)cos(ang); rp[1024 + e] = (float)sin(ang); }
        }
    }
    for (int idx = blockIdx.x * NTHR + F.tid; idx < 2 * 16 * 2 * 4 * 2 * 64; idx += F.G * NTHR) {
        const int ln = idx & 63, ks = (idx >> 6) & 1, ct = (idx >> 7) & 3, mat = (idx >> 9) & 1, hh = (idx >> 10) & 15, dd = idx >> 14;
        const float* src = F.in[mat ? I_A2 : I_W2] + (size_t)(dd * 64 + 32 * ks + 8 * (ln >> 4)) * D + hh * 64 + 16 * ct + (ln & 15);
        v4u o; o.x = pk2(src[0], src[D]); o.y = pk2(src[2 * D], src[3 * D]); o.z = pk2(src[4 * D], src[5 * D]); o.w = pk2(src[6 * D], src[7 * D]);
        ((v4u*)(F.ws + WS_WOP))[idx] = o;
    }
    bf16* KL = (bf16*)(F.ws + WS_KL);
    for (int i = blockIdx.x * NTHR + F.tid; i < NBL * PAST * D / 8; i += F.G * NTHR) {
        const int e = i * 8, b = e / (PAST * D), rem = e % (PAST * D);
        const f32x4 v0 = *(const f32x4*)(F.in[I_CK] + e), v1 = *(const f32x4*)(F.in[I_CK] + e + 4);
        v4u o; o.x = pk2(v0.x, v0.y); o.y = pk2(v0.z, v0.w); o.z = pk2(v1.x, v1.y); o.w = pk2(v1.z, v1.w);
        *(v4u*)(KL + (size_t)b * KLAT * D + rem) = o;
    }
}

template <int I0, int I1> __device__ __forceinline__ void p1_load(Frame& F, f32x4 (&v)[5][4]) {
#pragma unroll
    for (int i = I0; i < I1; ++i) { const float* xr = xrow_ptr(F, ((int)blockIdx.x + 256 * i) * 8 + F.wave);
#pragma unroll
        for (int j = 0; j < 4; ++j) v[i][j] = *(const f32x4*)(xr + 4 * F.lane + 256 * j); }
}
__device__ __forceinline__ void p1_norm(Frame& F, f32x4 (&v)[5][4]) {
    LAS float* modL = (LAS float*)(F.lds + RING_OFF);
    const float* modp = (const float*)(F.ws + WS_MODP);
    const float* bada = F.in[I_BADA];
    int mrow[5];
#pragma unroll
    for (int i = 0; i < 5; ++i) mrow[i] = ((int)blockIdx.x + 256 * i) * 8 + F.wave;
    if (blockIdx.x < 36 && F.tid < 256) {
        const int idx = blockIdx.x * 256 + F.tid, ci = idx / 3072, n = idx % 3072;
        float s = bada[n];
#pragma unroll
        for (int kc = 0; kc < 16; ++kc) s += modp[(size_t)(kc * 3 + ci) * 3072 + n];
        ((float*)(F.ws + WS_MODF))[idx] = s;
    }
    {
        const int cil = 1 + (int)blockIdx.x / 128;
        for (int e = F.tid; e < 4096; e += NTHR) { const int n = e & 2047, ci = e < 2048 ? 0 : cil; float s = bada[n];
#pragma unroll
            for (int kc = 0; kc < 16; ++kc) s += modp[(size_t)(kc * 3 + ci) * 3072 + n];
            modL[e] = s; }
    }
    __syncthreads();
    bf16* XN = (bf16*)(F.ws + WS_XN);
#pragma unroll
    for (int i = 0; i < 5; ++i) {
        float ss = 0.f;
#pragma unroll
        for (int j = 0; j < 4; ++j) ss += (v[i][j].x * v[i][j].x + v[i][j].y * v[i][j].y) + (v[i][j].z * v[i][j].z + v[i][j].w * v[i][j].w);
        const float rstd = __builtin_amdgcn_rsqf(wave_sum(ss) * (1.f / D) + 1e-6f);
        const LAS float* ml = modL + (i == 4 ? 2048 : 0);
#pragma unroll
        for (int j = 0; j < 4; ++j) {
            const int c = 4 * F.lane + 256 * j;
            const f32x4 g = *(const f32x4*)(F.in[I_NG] + c);
            const f32x4 sh = *(const LAS f32x4*)(ml + c), sc = *(const LAS f32x4*)(ml + 1024 + c);
            const f32x4 h = (v[i][j] * rstd) * g * (sc + 1.0f) + sh;
            v2u o; o.x = pk2(h.x, h.y); o.y = pk2(h.z, h.w);
            *(v2u*)(XN + (size_t)mrow[i] * D + c) = o;
        }
    }
}

struct EpiIn {
    static constexpr bool PERM = true, AFTER_DRAIN = false;
    unsigned char* ws; float* out;
    __device__ __forceinline__ void operator()(const f32x4 (&acc)[2][2][4][2], const pg8::Unit& u, int wr, int wc, int fr, int fq) const {
        const int pn = u.pn; const bool lat = u.pm >= MC / 256;
        const float* rope = (const float*)(ws + WS_ROPE);
        constexpr float QS = 0.125f * 1.44269504088896f;
#pragma unroll
        for (int ai = 0; ai < 2; ++ai)
#pragma unroll
            for (int m = 0; m < 4; ++m) {
                const int r = u.pm * 256 + ai * 128 + wr * 64 + m * 16 + fr;
#pragma unroll
                for (int bj = 0; bj < 2; ++bj) {
                    const int c = pn * 256 + bj * 128 + wc * 32 + 8 * fq;
                    f32x4 v0 = acc[ai][bj][m][0], v1 = acc[ai][bj][m][1];
                    if (pn < 8) {
                        const bool isq = pn < 4; const int cc = isq ? c : c - 1024;
                        if (lat) {
                            const int t = (r - MC) & (LSEQ - 1), pos = (wc & 1) ? (t & 63) : (t >> 6);
                            const float* cp = rope + pos * 16 + 8 * (fq & 1);
                            const f32x4 c0 = *(const f32x4*)cp, c1 = *(const f32x4*)(cp + 4), s0 = *(const f32x4*)(cp + 1024), s1 = *(const f32x4*)(cp + 1028);
                            f32x4 p0, p1;
#pragma unroll
                            for (int j = 0; j < 4; ++j) { p0[j] = __shfl_xor(v0[j], 32); p1[j] = __shfl_xor(v1[j], 32); }
                            const float sg = (fq & 2) ? 1.f : -1.f;
                            v0 = v0 * c0 + (p0 * s0) * sg; v1 = v1 * c1 + (p1 * s1) * sg;
                        }
                        if (isq) { v0 = v0 * QS; v1 = v1 * QS; }
                        else if (!lat) { float* o = out + OUT_CK + (size_t)r * D + cc; *(f32x4*)o = v0; *(f32x4*)(o + 4) = v1; }
                        v4u w; w.x = pk2(v0[0], v0[1]); w.y = pk2(v0[2], v0[3]); w.z = pk2(v1[0], v1[1]); w.w = pk2(v1[2], v1[3]);
                        bf16* dst;
                        if (isq) dst = (bf16*)(ws + WS_Q) + (size_t)r * D + cc;
                        else if (!lat) dst = (bf16*)(ws + WS_KC) + (size_t)r * D + cc;
                        else { const int b = (r - MC) >> 10, t = (r - MC) & (LSEQ - 1); dst = (bf16*)(ws + WS_KL) + ((size_t)b * KLAT + PAST + t) * D + cc; }
                        *(v4u*)dst = w;
                    } else if (pn < 12) {
                        const int cc = c - 2048, hh = cc >> 7, dv = cc & 127;
                        bf16* dst;
                        if (!lat) { float* o = out + OUT_CV + (size_t)r * D + cc; *(f32x4*)o = v0; *(f32x4*)(o + 4) = v1;
                            const int b = r >> 8, t = r & 255; dst = (bf16*)(ws + WS_VTC) + (size_t)((b * NH + hh) * 128 + dv) * SEQ + t;
#pragma unroll
                            for (int j = 0; j < 4; ++j) { dst[(size_t)j * SEQ] = (bf16)f2bf(v0[j]); dst[(size_t)(4 + j) * SEQ] = (bf16)f2bf(v1[j]); }
                        } else { const int b = (r - MC) >> 10, t = (r - MC) & (LSEQ - 1); dst = (bf16*)(ws + WS_VTL) + (size_t)((b * NH + hh) * 128 + dv) * KLAT + PAST + t;
#pragma unroll
                            for (int j = 0; j < 4; ++j) { dst[(size_t)j * KLAT] = (bf16)f2bf(v0[j]); dst[(size_t)(4 + j) * KLAT] = (bf16)f2bf(v1[j]); }
                        }
                    } else if (pn < 16 || pn >= 29) {
                        bf16* dst = pn < 16 ? (bf16*)(ws + WS_GA) + (size_t)r * D + (c - 3072) : (bf16*)(ws + WS_GB) + (size_t)r * D + (c - 7424);
                        v4u w; w.x = pk2(siluf_(v0[0]), siluf_(v0[1])); w.y = pk2(siluf_(v0[2]), siluf_(v0[3])); w.z = pk2(siluf_(v1[0]), siluf_(v1[1])); w.w = pk2(siluf_(v1[2]), siluf_(v1[3]));
                        *(v4u*)dst = w;
                    } else {
                        v4u w; w.x = pk2(v0[0], v0[1]); w.y = pk2(v0[2], v0[3]); w.z = pk2(v1[0], v1[1]); w.w = pk2(v1[2], v1[3]);
                        *(v4u*)((bf16*)(ws + WS_UB) + (size_t)r * DSH + (c - 4096)) = w;
                    }
                }
            }
    }
};

constexpr int NLATB = 32;
constexpr int LAT_UNITS = (ML / 256) * (DIN / 256);
constexpr int P2A_UNITS = 512, P2_UNITS = (M / 256) * (DIN / 256);
constexpr int LAT_BAR_IT = 6;
struct ListOrder {
    int G, v, lo, hi;
    __device__ void init(int G_, int c_, int lo_, int hi_) { G = G_; v = (G_ % 8 == 0) ? (c_ % 8) * (G_ / 8) + c_ / 8 : c_; lo = lo_; hi = hi_; }
    __device__ bool next(int i, pg8::Unit& u) const {
        int L = lo + i * G + v; if (L >= hi) return false;
        if (L < LAT_UNITS) { u.pn = L >> 3; u.pm = MC / 256 + (L & 7); return true; }
        L -= LAT_UNITS;
        const int grp = L / (8 * (DIN / 256)), r = L % (8 * (DIN / 256)); u.pn = r >> 3; u.pm = grp * 8 + (r & 7); return true;
    }
    __device__ __forceinline__ void a_ready(const pg8::Unit&) const {}
    __device__ __forceinline__ void done(const pg8::Unit&) const {}
};

constexpr size_t WS_XCH = WS_SSQ;
constexpr int CW_PANEL = 8192;
struct EpiOutFused {
    static constexpr bool PERM = false, AFTER_DRAIN = true;
    unsigned char* ws; float* out; const float* xp; const float* xs; const float* fg; gu32* ctl;
    __device__ __forceinline__ void fused(f32x4 (&acc)[2][2][4][2], const pg8::Unit& u, int wr, int wc, int fr, int fq, PG8_LAS unsigned char* lds, int wid, int lane) const {
        const float* modf = (const float*)(ws + WS_MODF);
        PG8_LAS float* P = (PG8_LAS float*)lds;
        PG8_LAS float* R = (PG8_LAS float*)(lds + 4096);
        const int col0 = u.pn * 256 + wc * 32 + 4 * fq;
#pragma unroll
        for (int ai = 0; ai < 2; ++ai)
#pragma unroll
            for (int m = 0; m < 4; ++m) {
                const int rl = ai * 128 + wr * 64 + m * 16 + fr, r = u.pm * 256 + rl;
                const int ci = r < MC ? 0 : 1 + ((r - MC) >> 10);
                const float* xr = (r < MC ? xp + (size_t)r * D : xs + (size_t)(r - MC) * D) + col0;
                const float* gt = modf + ci * 3072 + 2048 + col0;
                float ss = 0.f;
#pragma unroll
                for (int bj = 0; bj < 2; ++bj)
#pragma unroll
                    for (int n = 0; n < 2; ++n) {
                        const int off = bj * 128 + n * 16;
                        const f32x4 y = *(const f32x4*)(xr + off) + *(const f32x4*)(gt + off) * acc[ai][bj][m][n];
                        acc[ai][bj][m][n] = y;
                        ss += (y.x * y.x + y.y * y.y) + (y.z * y.z + y.w * y.w);
                    }
                ss += __shfl_xor(ss, 16); ss += __shfl_xor(ss, 32);
                if (fq == 0) P[rl * 4 + wc] = ss;
            }
        asm volatile("s_waitcnt lgkmcnt(0)" ::: "memory"); __builtin_amdgcn_s_barrier(); asm volatile("" ::: "memory");
        const int row = wid * 32 + (lane & 31);
        float* xbuf = (float*)(ws + WS_XCH) + ((size_t)(u.pm * 256 + row) * 4);
        if (lane < 32) {
            const f32x4 p = *(const PG8_LAS f32x4*)(P + row * 4);
            __hip_atomic_store(xbuf + u.pn, (p.x + p.y) + (p.z + p.w), __ATOMIC_RELAXED, __HIP_MEMORY_SCOPE_AGENT);
        }
        asm volatile("s_waitcnt vmcnt(0)" ::: "memory");
        unsigned* cnt = (unsigned*)(ctl + CW_PANEL + 64 * u.pm);
        if (lane == 0) __hip_atomic_fetch_add(cnt, 1u, __ATOMIC_RELAXED, __HIP_MEMORY_SCOPE_AGENT);
        if (wid == 0) {
            unsigned sp = 0;
            while ((unsigned)__builtin_amdgcn_readfirstlane(__hip_atomic_load(cnt, __ATOMIC_RELAXED, __HIP_MEMORY_SCOPE_AGENT)) < 32u) { __builtin_amdgcn_s_sleep(2); if (++sp > (1u << 20)) break; }
            __builtin_amdgcn_fence(__ATOMIC_ACQUIRE, "agent");
        }
        asm volatile("s_waitcnt vmcnt(0) lgkmcnt(0)" ::: "memory"); __builtin_amdgcn_s_barrier(); asm volatile("" ::: "memory");
        if (lane < 32) {
            float t = 0.f;
#pragma unroll
            for (int q = 0; q < 4; ++q) t += __hip_atomic_load(xbuf + q, __ATOMIC_RELAXED, __HIP_MEMORY_SCOPE_AGENT);
            R[row] = __builtin_amdgcn_rsqf(t * (1.f / D) + 1e-6f);
        }
        asm volatile("s_waitcnt lgkmcnt(0)" ::: "memory"); __builtin_amdgcn_s_barrier(); asm volatile("" ::: "memory");
#pragma unroll
        for (int ai = 0; ai < 2; ++ai)
#pragma unroll
            for (int m = 0; m < 4; ++m) {
                const int rl = ai * 128 + wr * 64 + m * 16 + fr; const float rs = R[rl];
                float* o = out + OUT_Y + (size_t)(u.pm * 256 + rl) * D + col0;
#pragma unroll
                for (int bj = 0; bj < 2; ++bj)
#pragma unroll
                    for (int n = 0; n < 2; ++n) { const int off = bj * 128 + n * 16; *(f32x4*)(o + off) = acc[ai][bj][m][n] * rs * *(const f32x4*)(fg + col0 + off); }
            }
    }
};

constexpr int AT_KS = 0, AT_KSTRIDE = 272, AT_VS = 64 * AT_KSTRIDE, AT_VSTRIDE = 144, AT_BUF = AT_VS + 128 * AT_VSTRIDE, AT_X = 2 * AT_BUF, AT_XSTRIDE = 132;
static_assert(AT_X + 4 * 32 * AT_XSTRIDE * 4 <= LDSCTL_OFF && (AT_X % 16) == 0, "attention LDS map");
__device__ __forceinline__ void attn_unit(Frame& F, int idx, bool lat, float lam) {
    int tid_ = F.tid; asm volatile("" : "+v"(tid_)); const int lane_ = tid_ & 63;
    int b, hh, qb, m0, nkeys, vlen; const bf16* Kb; const bf16* VT;
    if (!lat) { b = idx >> 4; hh = (idx >> 1) & 7; qb = idx & 1; m0 = b * SEQ + qb * 128; nkeys = SEQ; vlen = SEQ;
        Kb = (const bf16*)(F.ws + WS_KC) + (size_t)b * SEQ * D + hh * 128; VT = (const bf16*)(F.ws + WS_VTC) + (size_t)((b * NH + hh) * 128) * SEQ; }
    else { b = idx >> 6; hh = (idx >> 3) & 7; qb = idx & 7; m0 = MC + b * LSEQ + qb * 128; nkeys = KLAT; vlen = KLAT;
        Kb = (const bf16*)(F.ws + WS_KL) + (size_t)b * KLAT * D + hh * 128; VT = (const bf16*)(F.ws + WS_VTL) + (size_t)((b * NH + hh) * 128) * KLAT; }
    const int w = F.wave, qs = w >> 1, mp = w & 1, l31 = lane_ & 31, h5 = lane_ >> 5;
    const int kperm = (l31 & 3) + 4 * ((l31 >> 3) & 1) + 8 * ((l31 >> 2) & 1) + 16 * (l31 >> 4);
    LAS float* X = (LAS float*)(F.lds + AT_X);
    bf16x8 qf[4];
    { const bf16* qrow = (const bf16*)(F.ws + WS_Q) + (size_t)(m0 + qs * 32 + l31) * D + hh * 128 + mp * 64 + 8 * h5;
#pragma unroll
      for (int ks = 0; ks < 4; ++ks) qf[ks] = *(const bf16x8*)(qrow + 16 * ks); }
    f32x16 o[4];
#pragma unroll
    for (int i = 0; i < 4; ++i)
#pragma unroll
        for (int j = 0; j < 16; ++j) o[i][j] = 0.f;
    float mrun = -1e30f, lrun = 0.f;
    const int krow = tid_ >> 3, kch = tid_ & 7, vrow = tid_ >> 2, vch = tid_ & 3;
    const int ntile = nkeys / 64;
    const bf16* kp = Kb + (size_t)krow * D + kch * 8;
    const bf16* vp = VT + (size_t)vrow * vlen + vch * 8;
    LAS unsigned char* kd = F.lds + AT_KS + krow * AT_KSTRIDE + kch * 16;
    LAS unsigned char* vd = F.lds + AT_VS + vrow * AT_VSTRIDE + vch * 16;
    v4u k0 = *(const v4u*)kp, k1 = *(const v4u*)(kp + 64), v0 = *(const v4u*)vp, v1 = *(const v4u*)(vp + 32);
    __syncthreads();
    *(LAS v4u*)(kd) = k0; *(LAS v4u*)(kd + 128) = k1;
    *(LAS v4u*)(vd) = v0; *(LAS v4u*)(vd + 64) = v1;
    if (ntile > 1) { k0 = *(const v4u*)(kp + (size_t)64 * D); k1 = *(const v4u*)(kp + (size_t)64 * D + 64); v0 = *(const v4u*)(vp + 64); v1 = *(const v4u*)(vp + 96); }
    __syncthreads();
    for (int kt = 0; kt < ntile; ++kt) {
        const int bo = (kt & 1) * AT_BUF;
        LAS unsigned char* Ks = F.lds + AT_KS + bo; LAS unsigned char* Vs = F.lds + AT_VS + bo;
        if (kt + 1 < ntile) {
            const int bn = AT_BUF - bo;
            *(LAS v4u*)(kd + bn) = k0; *(LAS v4u*)(kd + bn + 128) = k1;
            *(LAS v4u*)(vd + bn) = v0; *(LAS v4u*)(vd + bn + 64) = v1;
            if (kt + 2 < ntile) { const bf16* kq = kp + (size_t)(kt + 2) * 64 * D; const bf16* vq = vp + (kt + 2) * 64;
                k0 = *(const v4u*)kq; k1 = *(const v4u*)(kq + 64); v0 = *(const v4u*)vq; v1 = *(const v4u*)(vq + 32); }
        }
        f32x16 s[2];
#pragma unroll
        for (int st = 0; st < 2; ++st) {
#pragma unroll
            for (int j = 0; j < 16; ++j) s[st][j] = 0.f;
#pragma unroll
            for (int ks = 0; ks < 4; ++ks) {
                const bf16x8 kf = *(const LAS bf16x8*)(Ks + (st * 32 + kperm) * AT_KSTRIDE + (mp * 64 + 16 * ks + 8 * h5) * 2);
                s[st] = __builtin_amdgcn_mfma_f32_32x32x16_bf16(kf, qf[ks], s[st], 0, 0, 0);
            }
        }
        float mx = s[0][0];
#pragma unroll
        for (int j = 0; j < 16; ++j) { mx = fmaxf(mx, s[0][j]); mx = fmaxf(mx, s[1][j]); }
        mx = fmaxf(mx, __shfl_xor(mx, 32));
        if (!__all(mx - mrun <= 8.f)) {
            const float mnew_ = fmaxf(mrun, mx), alpha = __builtin_amdgcn_exp2f(mrun - mnew_);
            mrun = mnew_; lrun *= alpha;
#pragma unroll
            for (int i = 0; i < 4; ++i) o[i] = o[i] * alpha;
        }
        const float mnew = mrun;
        float ps = 0.f;
#pragma unroll
        for (int st = 0; st < 2; ++st)
#pragma unroll
            for (int j = 0; j < 16; ++j) { const float p = __builtin_amdgcn_exp2f(s[st][j] - mnew); s[st][j] = p; ps += p; }
        lrun += ps;
        bf16x8 pf[2][2];
#pragma unroll
        for (int st = 0; st < 2; ++st)
#pragma unroll
            for (int s2 = 0; s2 < 2; ++s2) {
                v4u t; t.x = pk2(s[st][8 * s2 + 0], s[st][8 * s2 + 1]); t.y = pk2(s[st][8 * s2 + 2], s[st][8 * s2 + 3]); t.z = pk2(s[st][8 * s2 + 4], s[st][8 * s2 + 5]); t.w = pk2(s[st][8 * s2 + 6], s[st][8 * s2 + 7]);
                pf[st][s2] = __builtin_bit_cast(bf16x8, t);
            }
#pragma unroll
        for (int dvt = 0; dvt < 4; ++dvt)
#pragma unroll
            for (int st = 0; st < 2; ++st)
#pragma unroll
                for (int s2 = 0; s2 < 2; ++s2) {
                    const bf16x8 vf = *(const LAS bf16x8*)(Vs + (dvt * 32 + l31) * AT_VSTRIDE + (st * 32 + 16 * s2 + 8 * h5) * 2);
                    o[dvt] = __builtin_amdgcn_mfma_f32_32x32x16_bf16(vf, pf[st][s2], o[dvt], 0, 0, 0);
                }
        __syncthreads();
    }
    const float ltot = lrun + __shfl_xor(lrun, 32), inv = 1.f / ltot;
    LAS float* Xq = X + (qs * 32 + l31) * AT_XSTRIDE;
    if (mp == 1) {
#pragma unroll
        for (int dvt = 0; dvt < 4; ++dvt)
#pragma unroll
            for (int j = 0; j < 16; ++j) Xq[dvt * 32 + (j & 3) + 8 * (j >> 2) + 4 * h5] = o[dvt][j] * inv;
    }
    __syncthreads();
    if (mp == 0) {
        float ss = 0.f;
#pragma unroll
        for (int dvt = 0; dvt < 4; ++dvt)
#pragma unroll
            for (int j = 0; j < 16; ++j) { const float a = o[dvt][j] * inv - lam * Xq[dvt * 32 + (j & 3) + 8 * (j >> 2) + 4 * h5]; o[dvt][j] = a; ss += a * a; }
        ss += __shfl_xor(ss, 32);
        const float rstd = 0.8f / sqrtf(ss * (1.f / 128.f) + 1e-5f);
#pragma unroll
        for (int dvt = 0; dvt < 4; ++dvt)
#pragma unroll
            for (int j = 0; j < 16; ++j) Xq[dvt * 32 + (j & 3) + 8 * (j >> 2) + 4 * h5] = o[dvt][j] * rstd;
    }
    __syncthreads();
    {
        const float* sg = F.in[I_SUBG];
        const bf16* GA = (const bf16*)(F.ws + WS_GA); bf16* MIX = (bf16*)(F.ws + WS_MIX);
        const int d8 = (tid_ & 15) * 8;
        const f32x4 g0 = *(const f32x4*)(sg + d8), g1 = *(const f32x4*)(sg + d8 + 4);
#pragma unroll
        for (int p = 0; p < 4; ++p) {
            const int q = p * 32 + (tid_ >> 4), m = m0 + q;
            const LAS float* xr = X + q * AT_XSTRIDE + d8;
            const f32x4 a0 = *(const LAS f32x4*)xr, a1 = *(const LAS f32x4*)(xr + 4);
            const v4u ga = *(const v4u*)(GA + (size_t)m * D + hh * 128 + d8);
            v4u w;
            w.x = pk2(a0.x * g0.x * bflo(ga.x), a0.y * g0.y * bfhi(ga.x)); w.y = pk2(a0.z * g0.z * bflo(ga.y), a0.w * g0.w * bfhi(ga.y));
            w.z = pk2(a1.x * g1.x * bflo(ga.z), a1.y * g1.y * bfhi(ga.z)); w.w = pk2(a1.z * g1.z * bflo(ga.w), a1.w * g1.w * bfhi(ga.w));
            *(v4u*)(MIX + (size_t)m * DMIX + hh * 128 + d8) = w;
        }
    }
}

constexpr int SC_W2 = 0, SC_A2 = 16384, SC_TLW = 32768, SC_LA = 40960, SC_WD = 49152, SC_NKK = 57344, SC_BB = 65536, SC_KD = 73728, SC_R = 81920, SC_V = 90112, SC_Y = 98304, SC_BON = 106496;
template <int CTRL> __device__ __forceinline__ float dppf(float x) { return __builtin_bit_cast(float, __builtin_amdgcn_update_dpp(0, __builtin_bit_cast(int, x), CTRL, 0xf, 0xf, true)); }
__device__ __forceinline__ float reduce8(float v) { v += dppf<0xB1>(v); v += dppf<0x4E>(v); v += dppf<0x141>(v); return v; }
__device__ __forceinline__ float shift_load(const bf16* ub, const float* mu, int t, int T, int col) {
    const float u = bf2f(ub[col]);
    const float p = t > 0 ? bf2f(ub[col - DSH]) : 0.f;
    const float n = t < T - 1 ? bf2f(ub[col + DSH]) : 0.f;
    return u + mu[col] * (p - u) + mu[DSH + col] * (n - u);
}
__device__ __forceinline__ void scan_unit(Frame& F, int b, int hh, bool lat) {
    const int T = lat ? LSEQ : SEQ, m0 = lat ? MC + b * LSEQ : b * SEQ;
    const bf16* UB = (const bf16*)(F.ws + WS_UB); const bf16* GB = (const bf16*)(F.ws + WS_GB); bf16* MIX = (bf16*)(F.ws + WS_MIX);
    float* YB = F.out + OUT_Y;
    const float* mu = F.in[I_MU];
    LAS float* W2s = (LAS float*)(F.lds + SC_W2); LAS float* A2s = (LAS float*)(F.lds + SC_A2); LAS float* TLW = (LAS float*)(F.lds + SC_TLW); LAS float* LAs = (LAS float*)(F.lds + SC_LA);
    LAS float* WD = (LAS float*)(F.lds + SC_WD); LAS float* NKK = (LAS float*)(F.lds + SC_NKK); LAS float* BB = (LAS float*)(F.lds + SC_BB); LAS float* KD = (LAS float*)(F.lds + SC_KD);
    LAS float* RR = (LAS float*)(F.lds + SC_R); LAS float* VV = (LAS float*)(F.lds + SC_V); LAS float* YC = (LAS float*)(F.lds + SC_Y); LAS float* BON = (LAS float*)(F.lds + SC_BON);
    const int c = F.lane, hc = hh * 64 + c, row = F.wave * 8 + (F.lane >> 3), kq = F.lane & 7;
    const float kkc = F.in[I_KK][hc], kac = F.in[I_KA][hc], rkc = F.in[I_RK][hc];
    for (int d = 0; d < 2; ++d) {
        __syncthreads();
        for (int i = F.tid; i < 4096; i += NTHR) { const int j = i >> 6, cc = i & 63; W2s[i] = F.in[I_W2][(size_t)(d * 64 + j) * D + hh * 64 + cc]; A2s[i] = F.in[I_A2][(size_t)(d * 64 + j) * D + hh * 64 + cc]; }
        const float w0c = F.in[I_W0][d * D + hc], a0c = F.in[I_A0][d * D + hc];
        float S[8];
        if (lat) { const float* sp = F.in[I_ST] + ((size_t)((b * 2 + d) * NHB + hh) * 64 + row) * 64 + kq * 8;
            const f32x4 s0 = *(const f32x4*)sp, s1 = *(const f32x4*)(sp + 4); S[0] = s0.x; S[1] = s0.y; S[2] = s0.z; S[3] = s0.w; S[4] = s1.x; S[5] = s1.y; S[6] = s1.z; S[7] = s1.w; }
        else {
#pragma unroll
            for (int i = 0; i < 8; ++i) S[i] = 0.f; }
        const int nch = T / 32;
        for (int ch = 0; ch < nch; ++ch) {
            const int t0 = (d == 0 ? ch : nch - 1 - ch) * 32;
            __syncthreads();
            float r_[4], k_[4], v_[4];
#pragma unroll
            for (int i = 0; i < 4; ++i) {
                const int tt = F.wave * 4 + i, t = t0 + tt;
                const bf16* ub = UB + (size_t)(m0 + t) * DSH;
                r_[i] = shift_load(ub, mu, t, T, hc); k_[i] = shift_load(ub, mu, t, T, 1024 + hc); v_[i] = shift_load(ub, mu, t, T, 2048 + hc);
                const float lw = shift_load(ub, mu, t, T, 3072 + 64 * d + c), la = shift_load(ub, mu, t, T, 3200 + 64 * d + c);
                TLW[tt * 64 + c] = tanhf(lw); LAs[tt * 64 + c] = la;
            }
            __syncthreads();
            float zw[4], za[4];
#pragma unroll
            for (int i = 0; i < 4; ++i) { zw[i] = w0c; za[i] = a0c; }
            for (int j = 0; j < 64; j += 4) {
                f32x4 tw[4], ta[4];
#pragma unroll
                for (int i = 0; i < 4; ++i) { tw[i] = *(const LAS f32x4*)(TLW + (F.wave * 4 + i) * 64 + j); ta[i] = *(const LAS f32x4*)(LAs + (F.wave * 4 + i) * 64 + j); }
#pragma unroll
                for (int jj = 0; jj < 4; ++jj) { const float w2 = W2s[(j + jj) * 64 + c], a2 = A2s[(j + jj) * 64 + c];
#pragma unroll
                    for (int i = 0; i < 4; ++i) { zw[i] += tw[i][jj] * w2; za[i] += ta[i][jj] * a2; } }
            }
#pragma unroll
            for (int i = 0; i < 4; ++i) {
                const int tt = F.wave * 4 + i;
                const float dec = __expf(-0.60653065971f * sigmoidf_(zw[i])), a = sigmoidf_(za[i]);
                float kk = k_[i] * kkc; const float n2 = wave_sum(kk * kk); kk *= 1.f / sqrtf(n2 + 1e-12f);
                WD[tt * 64 + c] = dec; NKK[tt * 64 + c] = -kk; BB[tt * 64 + c] = kk * a; KD[tt * 64 + c] = k_[i] * (1.f + (a - 1.f) * kac); RR[tt * 64 + c] = r_[i]; VV[tt * 64 + c] = v_[i];
                if (d == 1) { const float bo = wave_sum(r_[i] * k_[i] * rkc); if (c == 0) BON[tt] = bo; }
            }
            __syncthreads();
            for (int s = 0; s < 32; ++s) {
                const int tt = d == 0 ? s : 31 - s; const int o = tt * 64 + kq * 8;
                const f32x4 w0 = *(const LAS f32x4*)(WD + o), w1 = *(const LAS f32x4*)(WD + o + 4), n0 = *(const LAS f32x4*)(NKK + o), n1 = *(const LAS f32x4*)(NKK + o + 4);
                const f32x4 b0 = *(const LAS f32x4*)(BB + o), b1 = *(const LAS f32x4*)(BB + o + 4), k0 = *(const LAS f32x4*)(KD + o), k1 = *(const LAS f32x4*)(KD + o + 4);
                const f32x4 r0 = *(const LAS f32x4*)(RR + o), r1 = *(const LAS f32x4*)(RR + o + 4);
                const float vv = VV[tt * 64 + row];
                float sa = (S[0] * n0.x + S[1] * n0.y) + (S[2] * n0.z + S[3] * n0.w) + (S[4] * n1.x + S[5] * n1.y) + (S[6] * n1.z + S[7] * n1.w);
                sa = reduce8(sa);
                S[0] = S[0] * w0.x + sa * b0.x + vv * k0.x; S[1] = S[1] * w0.y + sa * b0.y + vv * k0.y; S[2] = S[2] * w0.z + sa * b0.z + vv * k0.z; S[3] = S[3] * w0.w + sa * b0.w + vv * k0.w;
                S[4] = S[4] * w1.x + sa * b1.x + vv * k1.x; S[5] = S[5] * w1.y + sa * b1.y + vv * k1.y; S[6] = S[6] * w1.z + sa * b1.z + vv * k1.z; S[7] = S[7] * w1.w + sa * b1.w + vv * k1.w;
                float y = (S[0] * r0.x + S[1] * r0.y) + (S[2] * r0.z + S[3] * r0.w) + (S[4] * r1.x + S[5] * r1.y) + (S[6] * r1.z + S[7] * r1.w);
                y = reduce8(y);
                if (kq == 0) YC[tt * 64 + row] = y;
            }
            __syncthreads();
            {
                const int tt = F.tid >> 4, c4 = (F.tid & 15) * 4, m = m0 + t0 + tt;
                f32x4 y4 = *(const LAS f32x4*)(YC + tt * 64 + c4);
                float* gp = YB + (size_t)m * D + hh * 64 + c4;
                if (d == 0) *(f32x4*)gp = y4;
                else {
                    y4 += *(const f32x4*)gp;
                    float s1 = (y4.x + y4.y) + (y4.z + y4.w);
                    s1 += __shfl_xor(s1, 1); s1 += __shfl_xor(s1, 2); s1 += __shfl_xor(s1, 4); s1 += __shfl_xor(s1, 8);
                    const float mean = s1 * (1.f / 64.f);
                    const f32x4 dy = y4 - mean;
                    float s2 = (dy.x * dy.x + dy.y * dy.y) + (dy.z * dy.z + dy.w * dy.w);
                    s2 += __shfl_xor(s2, 1); s2 += __shfl_xor(s2, 2); s2 += __shfl_xor(s2, 4); s2 += __shfl_xor(s2, 8);
                    const float rstd = 1.f / sqrtf(s2 * (1.f / 64.f) + 64e-5f);
                    const f32x4 lg = *(const f32x4*)(F.in[I_LNG] + hh * 64 + c4), lb = *(const f32x4*)(F.in[I_LNB] + hh * 64 + c4);
                    const f32x4 vt = *(const LAS f32x4*)(VV + tt * 64 + c4);
                    const float bo = BON[tt];
                    const v2u gb = *(const v2u*)(GB + (size_t)m * D + hh * 64 + c4);
                    const f32x4 yn = dy * rstd * lg + lb + vt * bo;
                    v2u w; w.x = pk2(yn.x * bflo(gb.x), yn.y * bfhi(gb.x)); w.y = pk2(yn.z * bflo(gb.y), yn.w * bfhi(gb.y));
                    *(v2u*)(MIX + (size_t)m * DMIX + 1024 + hh * 64 + c4) = w;
                }
            }
        }
        if (!lat) { float* sp = F.out + OUT_ST + ((size_t)((b * 2 + d) * NHB + hh) * 64 + row) * 64 + kq * 8;
            *(f32x4*)sp = (f32x4){S[0], S[1], S[2], S[3]}; *(f32x4*)(sp + 4) = (f32x4){S[4], S[5], S[6], S[7]}; }
    }
}


constexpr int SG_ST = 144;
constexpr int G_AT = 0, G_RT = 9216, G_BH = 18432, G_KH = 26624, G_LAK = 34816, G_LBR = 36864, G_LKR = 38912, G_TM = 40960, G_GAM = 43008, G_PRIV = 44032;
constexpr int PW_TLW = 0, PW_LAB = 2304, PW_ZS = 4608, PW_LF = PW_ZS, PW_VT = PW_ZS + 1024, PW_SIZE = 8768, G_SIZE = G_PRIV + 4 * PW_SIZE;
constexpr int ZS_ST = 65, VT_ST = 40;
static_assert(2 * G_SIZE <= LDSCTL_OFF, "scan LDS map");
__device__ __forceinline__ bf16x8 mk8(v2u lo, v2u hi) { const v4u t = {lo.x, lo.y, hi.x, hi.y}; return __builtin_bit_cast(bf16x8, t); }
__device__ __forceinline__ bf16x8 pk8(f32x4 a, f32x4 b) { const v4u t = {pk2(a[0], a[1]), pk2(a[2], a[3]), pk2(b[0], b[1]), pk2(b[2], b[3])}; return __builtin_bit_cast(bf16x8, t); }
#define MFMA16(a, b, c) __builtin_amdgcn_mfma_f32_16x16x32_bf16(a, b, c, 0, 0, 0)
template <int CTRL> __device__ __forceinline__ float dpp_mov(float x) { return __builtin_bit_cast(float, __builtin_amdgcn_update_dpp(0, __builtin_bit_cast(int, x), CTRL, 0xf, 0xf, true)); }
__device__ __forceinline__ void wave_sum16(float (&v)[16], int lane) {
    float a8[8], a4[4], a2[2];
    { const bool bit = lane & 4;
#pragma unroll
      for (int m = 0; m < 8; ++m) { const float send = bit ? v[2 * m] : v[2 * m + 1], keep = bit ? v[2 * m + 1] : v[2 * m]; a8[m] = keep + dpp_mov<0x141>(send); } }
    { const bool bit = lane & 1;
#pragma unroll
      for (int m = 0; m < 4; ++m) { const float send = bit ? a8[2 * m] : a8[2 * m + 1], keep = bit ? a8[2 * m + 1] : a8[2 * m]; a4[m] = keep + dpp_mov<0xB1>(send); } }
    { const bool bit = lane & 2;
#pragma unroll
      for (int m = 0; m < 2; ++m) { const float send = bit ? a4[2 * m] : a4[2 * m + 1], keep = bit ? a4[2 * m + 1] : a4[2 * m]; a2[m] = keep + dpp_mov<0x4E>(send); } }
    float t;
    { const bool bit = lane & 8; const float send = bit ? a2[0] : a2[1], keep = bit ? a2[1] : a2[0]; t = keep + dpp_mov<0x128>(send); }
    t += __shfl_xor(t, 16); t += __shfl_xor(t, 32);
#pragma unroll
    for (int i = 0; i < 16; ++i) { constexpr int dummy = 0; const int src = ((i >> 1) & 1) + 2 * ((i >> 2) & 1) + 4 * (i & 1) + 8 * ((i >> 3) & 1);
        v[i] = __builtin_bit_cast(float, __builtin_amdgcn_readlane(__builtin_bit_cast(int, t), src)); }
}
__device__ __forceinline__ void load_shift16(const bf16* ubase, int T, int p0, int d, int col, float mA, float mB, float (&out)[16]) {
    float u[18];
#pragma unroll
    for (int j = 0; j < 18; ++j) { const int tj = d ? (T - p0 - j) : (p0 - 1 + j);
        if (j == 0 || j == 17) u[j] = (tj >= 0 && tj < T) ? bf2f(ubase[(size_t)tj * DSH + col]) : 0.f;
        else u[j] = bf2f(ubase[(size_t)tj * DSH + col]); }
#pragma unroll
    for (int i = 0; i < 16; ++i) out[i] = u[i + 1] + mA * (u[i] - u[i + 1]) + mB * (u[i + 2] - u[i + 1]);
}
__device__ __forceinline__ void scan_unit2(Frame& F, int b, int hh, bool lat) {
    const int T = lat ? LSEQ : SEQ, m0 = lat ? MC + b * LSEQ : b * SEQ, nch = T / 64;
    const int lane0 = F.lane, d = F.wave >> 2, w = F.wave & 3;
    int lane = lane0, c16 = lane & 15, g = lane >> 4, hc = hh * 64 + lane;
    LAS unsigned char* GB_ = F.lds + d * G_SIZE;
    LAS unsigned char* PW = GB_ + G_PRIV + w * PW_SIZE;
    const bf16* UB = (const bf16*)(F.ws + WS_UB) + (size_t)m0 * DSH; const bf16* GBp = (const bf16*)(F.ws + WS_GB); bf16* MIX = (bf16*)(F.ws + WS_MIX);
    float* YB = F.out + OUT_Y;
    const float* mu = F.in[I_MU];
    int cR = hc, cK = 1024 + hc, cV = 2048 + hc, cW = 3072 + 64 * d + lane, cA = 3200 + 64 * d + lane;
    const int oA = d ? DSH : 0, oB = d ? 0 : DSH;
    const float kkc = F.in[I_KK][hc], kac = F.in[I_KA][hc], rkc = F.in[I_RK][hc], w0c = F.in[I_W0][d * D + hc], a0c = F.in[I_A0][d * D + hc];
    const float lng = F.in[I_LNG][hc], lnb = F.in[I_LNB][hc];
    const v4u* wop0 = (const v4u*)(F.ws + WS_WOP) + (size_t)((d * 16 + hh) * 2) * 8 * 64;
    f32x4 S[4];
    const size_t st_off = ((size_t)((b * 2 + d) * NHB + hh) * 64 + 16 * w + c16) * 64 + 4 * g;
#pragma unroll
    for (int kt = 0; kt < 4; ++kt) S[kt] = lat ? *(const f32x4*)(F.in[I_ST] + st_off + 16 * kt) : (f32x4){0.f, 0.f, 0.f, 0.f};
    const v2u z2 = {0u, 0u};
    __syncthreads();
    for (int it = 0; it < nch; ++it) {
        const int p0 = it * 64 + w * 16;
        lane = lane0; asm volatile("" : "+v"(lane));
        c16 = lane & 15; g = lane >> 4; hc = hh * 64 + lane; cR = hc; cK = 1024 + hc; cV = 2048 + hc; cW = 3072 + 64 * d + lane; cA = 3200 + 64 * d + lane;
        const v4u* wop = wop0 + lane;
        float bon[16], v_[16];
        {
            float x_[16];
            load_shift16(UB, T, p0, d, cW, mu[oA + cW], mu[oB + cW], x_);
#pragma unroll
            for (int i = 0; i < 16; ++i) { const float e = __expf(2.f * x_[i]); *(LAS bf16*)(PW + PW_TLW + i * SG_ST + lane * 2) = (bf16)f2bf(1.f - 2.f / (e + 1.f)); }
            load_shift16(UB, T, p0, d, cA, mu[oA + cA], mu[oB + cA], x_);
#pragma unroll
            for (int i = 0; i < 16; ++i) *(LAS bf16*)(PW + PW_LAB + i * SG_ST + lane * 2) = (bf16)f2bf(x_[i]);
        }
        float lam[16], aa[16];
        {
            LAS float* Zs = (LAS float*)(PW + PW_ZS);
            {
                bf16x8 ta[2];
#pragma unroll
                for (int ks = 0; ks < 2; ++ks) ta[ks] = *(const LAS bf16x8*)(PW + PW_TLW + c16 * SG_ST + (32 * ks + 8 * g) * 2);
#pragma unroll
                for (int ct = 0; ct < 4; ++ct) { f32x4 z = {0.f, 0.f, 0.f, 0.f};
#pragma unroll
                    for (int ks = 0; ks < 2; ++ks) z = MFMA16(ta[ks], __builtin_bit_cast(bf16x8, wop[(ct * 2 + ks) * 64]), z);
#pragma unroll
                    for (int rg = 0; rg < 4; ++rg) Zs[(4 * g + rg) * ZS_ST + 16 * ct + c16] = z[rg]; }
                float l = 0.f;
#pragma unroll
                for (int i = 0; i < 16; ++i) { l += -0.60653065971f * sigmoidf_(w0c + Zs[i * ZS_ST + lane]); lam[i] = l; }
            }
            {
                bf16x8 tb[2];
#pragma unroll
                for (int ks = 0; ks < 2; ++ks) tb[ks] = *(const LAS bf16x8*)(PW + PW_LAB + c16 * SG_ST + (32 * ks + 8 * g) * 2);
#pragma unroll
                for (int ct = 0; ct < 4; ++ct) { f32x4 z = {0.f, 0.f, 0.f, 0.f};
#pragma unroll
                    for (int ks = 0; ks < 2; ++ks) z = MFMA16(tb[ks], __builtin_bit_cast(bf16x8, wop[512 + (ct * 2 + ks) * 64]), z);
#pragma unroll
                    for (int rg = 0; rg < 4; ++rg) Zs[(4 * g + rg) * ZS_ST + 16 * ct + c16] = z[rg]; }
#pragma unroll
                for (int i = 0; i < 16; ++i) aa[i] = sigmoidf_(a0c + Zs[i * ZS_ST + lane]);
            }
        }
        {
            float k_[16];
            load_shift16(UB, T, p0, d, cK, mu[oA + cK], mu[oB + cK], k_);
            {
                float n2[16];
#pragma unroll
                for (int i = 0; i < 16; ++i) { const float kk = k_[i] * kkc; n2[i] = kk * kk; }
                wave_sum16(n2, lane);
                unsigned bh[8], kh[8];
#pragma unroll
                for (int i = 0; i < 16; ++i) {
                    const float kk = k_[i] * kkc * (1.f / sqrtf(n2[i] + 1e-12f)), kd = k_[i] * (1.f + (aa[i] - 1.f) * kac), bb = kk * aa[i];
                    const float e1 = i ? __expf(lam[i - 1]) : 1.f, e2 = __expf(-lam[i]);
                    *(LAS bf16*)(GB_ + G_AT + (16 * w + i) * SG_ST + lane * 2) = (bf16)f2bf(-kk * e1);
                    const unsigned btb = f2bf(bb * e2), ktb = f2bf(kd * e2);
                    *(LAS bf16*)(PW + PW_TLW + i * SG_ST + lane * 2) = (bf16)btb;
                    *(LAS bf16*)(PW + PW_LAB + i * SG_ST + lane * 2) = (bf16)ktb;
                    if (i & 1) { bh[i >> 1] |= btb << 16; kh[i >> 1] |= ktb << 16; } else { bh[i >> 1] = btb; kh[i >> 1] = ktb; }
                }
#pragma unroll
                for (int q = 0; q < 4; ++q) {
                    *(LAS v2u*)(GB_ + G_BH + (w * 64 + lane) * 32 + 8 * q) = (v2u){bh[2 * q], bh[2 * q + 1]};
                    *(LAS v2u*)(GB_ + G_KH + (w * 64 + lane) * 32 + 8 * q) = (v2u){kh[2 * q], kh[2 * q + 1]};
                }
            }
            float r_[16];
            load_shift16(UB, T, p0, d, cR, mu[oA + cR], mu[oB + cR], r_);
#pragma unroll
            for (int i = 0; i < 16; ++i) { bon[i] = r_[i] * k_[i] * rkc; *(LAS bf16*)(GB_ + G_RT + (16 * w + i) * SG_ST + lane * 2) = (bf16)f2bf(r_[i] * __expf(lam[i])); }
            wave_sum16(bon, lane);
        }
        ((LAS float*)(GB_ + G_GAM))[w * 64 + lane] = __expf(lam[15]);
        {
            load_shift16(UB, T, p0, d, cV, mu[oA + cV], mu[oB + cV], v_);
            unsigned vt[8];
#pragma unroll
            for (int i = 0; i < 16; ++i) { const unsigned vtb = f2bf(v_[i]); if (i & 1) vt[i >> 1] |= vtb << 16; else vt[i >> 1] = vtb; v_[i] *= bon[i]; }
#pragma unroll
            for (int q = 0; q < 4; ++q) *(LAS v2u*)(PW + PW_VT + lane * VT_ST + 8 * q) = (v2u){vt[2 * q], vt[2 * q + 1]};
        }
        {
            bf16x8 fa[2], fr[2], fb[2], fk[2];
#pragma unroll
            for (int ks = 0; ks < 2; ++ks) {
                fa[ks] = *(const LAS bf16x8*)(GB_ + G_AT + (16 * w + c16) * SG_ST + (32 * ks + 8 * g) * 2); fr[ks] = *(const LAS bf16x8*)(GB_ + G_RT + (16 * w + c16) * SG_ST + (32 * ks + 8 * g) * 2);
                fb[ks] = *(const LAS bf16x8*)(PW + PW_TLW + c16 * SG_ST + (32 * ks + 8 * g) * 2); fk[ks] = *(const LAS bf16x8*)(PW + PW_LAB + c16 * SG_ST + (32 * ks + 8 * g) * 2);
            }
            f32x4 lab = {0.f, 0.f, 0.f, 0.f}, lak = lab, lbr = lab, lkr = lab;
#pragma unroll
            for (int ks = 0; ks < 2; ++ks) { lab = MFMA16(fa[ks], fb[ks], lab); lak = MFMA16(fa[ks], fk[ks], lak); lbr = MFMA16(fr[ks], fb[ks], lbr); lkr = MFMA16(fr[ks], fk[ks], lkr); }
            LAS float* Lf = (LAS float*)(PW + PW_LF);
#pragma unroll
            for (int rg = 0; rg < 4; ++rg) { const int i = 4 * g + rg, j = c16;
                Lf[i * 16 + j] = j < i ? lab[rg] : 0.f;
                *(LAS bf16*)(GB_ + G_LAK + (w * 16 + i) * 32 + j * 2) = (bf16)f2bf(j < i ? lak[rg] : 0.f);
                *(LAS bf16*)(GB_ + G_LBR + (w * 16 + i) * 32 + j * 2) = (bf16)f2bf(j <= i ? lbr[rg] : 0.f);
                *(LAS bf16*)(GB_ + G_LKR + (w * 16 + i) * 32 + j * 2) = (bf16)f2bf(j <= i ? lkr[rg] : 0.f); }
            float tm[16];
#pragma unroll
            for (int i = 0; i < 16; ++i) { float a = (i == c16) ? 1.f : 0.f;
#pragma unroll
                for (int j = 0; j < i; ++j) a += Lf[i * 16 + j] * tm[j];
                tm[i] = a; }
            if (lane < 16) {
#pragma unroll
                for (int i = 0; i < 16; ++i) *(LAS bf16*)(GB_ + G_TM + (w * 16 + i) * 32 + lane * 2) = (bf16)f2bf(tm[i]); }
        }
        __syncthreads();
        const bool first = it < nch / 2;
#pragma unroll 1
        for (int sc = 0; sc < 4; ++sc) {
            lane = lane0; asm volatile("" : "+v"(lane)); c16 = lane & 15; g = lane >> 4;
            const LAS unsigned char* at_p = GB_ + G_AT + (16 * sc + c16) * SG_ST + 8 * g;
            const LAS unsigned char* rt_p = GB_ + G_RT + (16 * sc + c16) * SG_ST + 8 * g;
            const LAS unsigned char* vt_p = GB_ + G_PRIV + sc * PW_SIZE + PW_VT + (16 * w + c16) * VT_ST + 8 * g;
            const bf16x8 sop0 = pk8(S[0], S[1]), sop1 = pk8(S[2], S[3]);
            const bf16x8 at0 = mk8(*(const LAS v2u*)(at_p), *(const LAS v2u*)(at_p + 32)), at1 = mk8(*(const LAS v2u*)(at_p + 64), *(const LAS v2u*)(at_p + 96));
            const bf16x8 rt0 = mk8(*(const LAS v2u*)(rt_p), *(const LAS v2u*)(rt_p + 32)), rt1 = mk8(*(const LAS v2u*)(rt_p + 64), *(const LAS v2u*)(rt_p + 96));
            const v2u vt2 = *(const LAS v2u*)vt_p;
            const bf16x8 alak = mk8(*(const LAS v2u*)(GB_ + G_LAK + (sc * 16 + c16) * 32 + 8 * g), z2);
            const bf16x8 atm = mk8(*(const LAS v2u*)(GB_ + G_TM + (sc * 16 + c16) * 32 + 8 * g), z2);
            const bf16x8 albk = mk8(*(const LAS v2u*)(GB_ + G_LBR + (sc * 16 + c16) * 32 + 8 * g), *(const LAS v2u*)(GB_ + G_LKR + (sc * 16 + c16) * 32 + 8 * g));
            f32x4 X = {0.f, 0.f, 0.f, 0.f};
            X = MFMA16(at0, sop0, X); X = MFMA16(at1, sop1, X); X = MFMA16(alak, mk8(vt2, z2), X);
            const v4u xo = {pk2(X[0], X[1]), pk2(X[2], X[3]), 0u, 0u};
            f32x4 U = {0.f, 0.f, 0.f, 0.f};
            U = MFMA16(atm, __builtin_bit_cast(bf16x8, xo), U);
            const v4u uo = {pk2(U[0], U[1]), pk2(U[2], U[3]), vt2.x, vt2.y};
            const bf16x8 uvop = __builtin_bit_cast(bf16x8, uo);
            float* yp[4];
#pragma unroll
            for (int rg = 0; rg < 4; ++rg) { const int p = it * 64 + sc * 16 + 4 * g + rg, t = d ? T - 1 - p : p; yp[rg] = YB + (size_t)(m0 + t) * D + hh * 64 + 16 * w + c16; }
            f32x4 Y = {0.f, 0.f, 0.f, 0.f};
            if (!first) {
#pragma unroll
                for (int rg = 0; rg < 4; ++rg) Y[rg] = *yp[rg]; }
            Y = MFMA16(rt0, sop0, Y); Y = MFMA16(rt1, sop1, Y); Y = MFMA16(albk, uvop, Y);
#pragma unroll
            for (int rg = 0; rg < 4; ++rg) *yp[rg] = Y[rg];
#pragma unroll
            for (int kt = 0; kt < 4; ++kt) {
                const bf16x8 abk = mk8(*(const LAS v2u*)(GB_ + G_BH + (sc * 64 + 16 * kt + c16) * 32 + 8 * g), *(const LAS v2u*)(GB_ + G_KH + (sc * 64 + 16 * kt + c16) * 32 + 8 * g));
                const f32x4 gm = *(const LAS f32x4*)(GB_ + G_GAM + (sc * 64 + 16 * kt + 4 * g) * 4);
                S[kt] = MFMA16(abk, uvop, S[kt]) * gm;
            }
        }
        __syncthreads();
        if (!first) {
            lane = lane0; asm volatile("" : "+v"(lane)); hc = hh * 64 + lane;
            float y_[16], s1[16];
#pragma unroll
            for (int i = 0; i < 16; ++i) { const int p = p0 + i, t = d ? T - 1 - p : p; y_[i] = YB[(size_t)(m0 + t) * D + hc]; s1[i] = y_[i]; }
            wave_sum16(s1, lane);
#pragma unroll
            for (int i = 0; i < 16; ++i) { y_[i] -= s1[i] * (1.f / 64.f); s1[i] = y_[i] * y_[i]; }
            wave_sum16(s1, lane);
#pragma unroll
            for (int i = 0; i < 16; ++i) { const int p = p0 + i, t = d ? T - 1 - p : p; const size_t m = (size_t)(m0 + t);
                const float yn = y_[i] * (1.f / sqrtf(s1[i] * (1.f / 64.f) + 64e-5f)) * lng + lnb + v_[i];
                MIX[m * DMIX + 1024 + hc] = (bf16)f2bf(yn * bf2f(GBp[m * D + hc])); }
        }
    }
    if (!lat) {
        float* sp = F.out + OUT_ST + st_off;
#pragma unroll
        for (int kt = 0; kt < 4; ++kt) *(f32x4*)(sp + 16 * kt) = S[kt];
    }
}


__device__ __forceinline__ void st_bf16(LAS unsigned char* p, float v) { *(LAS bf16*)p = (bf16)f2bf_hw(v); }
struct PfRows { unsigned off[3]; bool ok[3]; };
__device__ __forceinline__ PfRows pf_rows(int T, int p0, int d, int lane) {
    PfRows R;
#pragma unroll
    for (int q = 0; q < 3; ++q) { const int j = 8 * q + (lane >> 3), jj = j > 17 ? 17 : j, pj = p0 - 1 + jj; int tj = d ? T - 1 - pj : pj; R.ok[q] = tj >= 0 && tj < T; tj = R.ok[q] ? tj : 0;
        R.off[q] = (unsigned)tj * (unsigned)DSH + (unsigned)(lane & 7) * 8u; }
    return R;
}
__device__ __forceinline__ void pf_issue(const bf16* ubase, const PfRows& R, int colb, v4u (&r)[3]) {
#pragma unroll
    for (int q = 0; q < 3; ++q) { v4u x = *(const v4u*)(ubase + colb + R.off[q]); if (!R.ok[q]) x = (v4u){0u, 0u, 0u, 0u}; r[q] = x; }
}
__device__ __forceinline__ void pf_consume(LAS unsigned char* stg, const v4u (&r)[3], int lane, float mA, float mB, float (&out)[16]) {
#pragma unroll
    for (int q = 0; q < 3; ++q) *(LAS v4u*)(stg + (8 * q + (lane >> 3)) * SG_ST + (lane & 7) * 16) = r[q];
    asm volatile("" ::: "memory");
    float u[18];
#pragma unroll
    for (int j = 0; j < 18; ++j) u[j] = bf2f(*(const LAS bf16*)(stg + j * SG_ST + lane * 2));
    asm volatile("" ::: "memory");
    const float m0_ = 1.f - mA - mB;
#pragma unroll
    for (int i = 0; i < 16; ++i) out[i] = m0_ * u[i + 1] + mA * u[i] + mB * u[i + 2];
}
__device__ __forceinline__ void scan_unit3(Frame& F, int b, int hh, bool lat, const XcdBarrier* gbar = nullptr, int gbar_it = -1) {
    const int T = lat ? LSEQ : SEQ, m0 = lat ? MC + b * LSEQ : b * SEQ, nch = T / 64;
    int lane0 = F.lane; asm volatile("" : "+v"(lane0));
    const int d = F.wave >> 2, w = F.wave & 3;
    int lane = lane0, c16 = lane & 15, g = lane >> 4, hc = hh * 64 + lane;
    LAS unsigned char* GB_ = F.lds + d * G_SIZE;
    LAS unsigned char* PW = GB_ + G_PRIV + w * PW_SIZE;
    const bf16* UB = (const bf16*)(F.ws + WS_UB) + (size_t)m0 * DSH; const bf16* GBp = (const bf16*)(F.ws + WS_GB); bf16* MIX = (bf16*)(F.ws + WS_MIX);
    float* YB = F.out + OUT_Y;
    const float* mu = F.in[I_MU];
    const int cR = hh * 64, cK = 1024 + hh * 64, cV = 2048 + hh * 64, cW = 3072 + 64 * d, cA = 3200 + 64 * d;
    const int oA = d ? DSH : 0, oB = d ? 0 : DSH;
    const float kkc = F.in[I_KK][hc], kac = F.in[I_KA][hc], rkc = F.in[I_RK][hc], w0c = F.in[I_W0][d * D + hc], a0c = F.in[I_A0][d * D + hc];
    const float mWA = mu[oA + cW + lane], mWB = mu[oB + cW + lane], mAA = mu[oA + cA + lane], mAB = mu[oB + cA + lane], mKA = mu[oA + cK + lane], mKB = mu[oB + cK + lane];
    const float mRA = mu[oA + cR + lane], mRB = mu[oB + cR + lane], mVA = mu[oA + cV + lane], mVB = mu[oB + cV + lane];
    const v4u* wop0 = (const v4u*)(F.ws + WS_WOP) + (size_t)((d * 16 + hh) * 2) * 8 * 64;
    f32x4 S[4];
    { const size_t st_off = ((size_t)((b * 2 + d) * NHB + hh) * 64 + 16 * w + c16) * 64 + 4 * g;
#pragma unroll
    for (int kt = 0; kt < 4; ++kt) S[kt] = lat ? *(const f32x4*)(F.in[I_ST] + st_off + 16 * kt) : (f32x4){0.f, 0.f, 0.f, 0.f}; }
    const v2u z2 = {0u, 0u};
    v4u pW[3], pA[3], pK[3], pR[3], pV[3];
    { const PfRows R = pf_rows(T, w * 16, d, lane); pf_issue(UB, R, cW, pW); pf_issue(UB, R, cA, pA); pf_issue(UB, R, cK, pK); pf_issue(UB, R, cR, pR); pf_issue(UB, R, cV, pV); }
    __syncthreads();
    for (int it = 0; it < nch; ++it) {
        if (it == gbar_it) xcd_barrier(*gbar);
        const int p0 = it * 64 + w * 16;
        const bool first = it < nch / 2;
        lane = lane0; asm volatile("" : "+v"(lane));
        c16 = lane & 15; g = lane >> 4; hc = hh * 64 + lane;
        const v4u* wop = wop0 + lane;
        LAS unsigned char* stg = PW + PW_ZS;
        float bon[16], v_[16];
#ifndef SREP_PREP
#define SREP_PREP 1
#endif
#ifndef SREP_POST
#define SREP_POST 1
#endif
#ifndef SREP_B
#define SREP_B 1
#endif
#pragma unroll 1
        for (int rep_ = 0; rep_ < SREP_PREP; ++rep_) {
        {
            float x_[16];
            pf_consume(stg, pW, lane, mWA, mWB, x_);
#pragma unroll
            for (int i = 0; i < 16; ++i) { const float e = __expf(2.f * x_[i]); st_bf16(PW + PW_TLW + i * SG_ST + lane * 2, 1.f - 2.f * __builtin_amdgcn_rcpf(e + 1.f)); }
            pf_consume(stg, pA, lane, mAA, mAB, x_);
#pragma unroll
            for (int i = 0; i < 16; ++i) st_bf16(PW + PW_LAB + i * SG_ST + lane * 2, x_[i]);
        }
        float k_[16];
        pf_consume(stg, pK, lane, mKA, mKB, k_);
        asm volatile("" ::: "memory");
        float lam[16], aa[16];
        {
            LAS float* Zs = (LAS float*)(PW + PW_ZS);
            {
                bf16x8 ta[2];
#pragma unroll
                for (int ks = 0; ks < 2; ++ks) ta[ks] = *(const LAS bf16x8*)(PW + PW_TLW + c16 * SG_ST + (32 * ks + 8 * g) * 2);
#pragma unroll
                for (int ct = 0; ct < 4; ++ct) { f32x4 z = {0.f, 0.f, 0.f, 0.f};
#pragma unroll
                    for (int ks = 0; ks < 2; ++ks) z = MFMA16(ta[ks], __builtin_bit_cast(bf16x8, wop[(ct * 2 + ks) * 64]), z);
#pragma unroll
                    for (int rg = 0; rg < 4; ++rg) Zs[(4 * g + rg) * ZS_ST + 16 * ct + c16] = z[rg]; }
                float l = 0.f;
#pragma unroll
                for (int i = 0; i < 16; ++i) { l += -0.60653065971f * sigmoidf_(w0c + Zs[i * ZS_ST + lane]); lam[i] = l; }
            }
            asm volatile("" ::: "memory");
            {
                bf16x8 tb[2];
#pragma unroll
                for (int ks = 0; ks < 2; ++ks) tb[ks] = *(const LAS bf16x8*)(PW + PW_LAB + c16 * SG_ST + (32 * ks + 8 * g) * 2);
#pragma unroll
                for (int ct = 0; ct < 4; ++ct) { f32x4 z = {0.f, 0.f, 0.f, 0.f};
#pragma unroll
                    for (int ks = 0; ks < 2; ++ks) z = MFMA16(tb[ks], __builtin_bit_cast(bf16x8, wop[512 + (ct * 2 + ks) * 64]), z);
#pragma unroll
                    for (int rg = 0; rg < 4; ++rg) Zs[(4 * g + rg) * ZS_ST + 16 * ct + c16] = z[rg]; }
#pragma unroll
                for (int i = 0; i < 16; ++i) aa[i] = sigmoidf_(a0c + Zs[i * ZS_ST + lane]);
            }
        }
        {
            {
                float n2[16];
#pragma unroll
                for (int i = 0; i < 16; ++i) { const float kk = k_[i] * kkc; n2[i] = kk * kk; }
                wave_sum16(n2, lane);
                unsigned bh[8], kh[8];
                float e1 = 1.f;
#pragma unroll
                for (int i = 0; i < 16; i += 2) {
                    float bt2[2], kt2[2];
#pragma unroll
                    for (int e = 0; e < 2; ++e) {
                        const float kk = k_[i + e] * kkc * __builtin_amdgcn_rsqf(n2[i + e] + 1e-12f), kd = k_[i + e] * (1.f + (aa[i + e] - 1.f) * kac), bb = kk * aa[i + e];
                        const float e3 = __expf(lam[i + e]), e2 = __builtin_amdgcn_rcpf(e3);
                        lam[i + e] = e3;
                        st_bf16(GB_ + G_AT + (16 * w + i + e) * SG_ST + lane * 2, -kk * e1);
                        bt2[e] = bb * e2; kt2[e] = kd * e2; e1 = e3;
                    }
                    const unsigned bp = pk2(bt2[0], bt2[1]), kp = pk2(kt2[0], kt2[1]);
                    bh[i >> 1] = bp; kh[i >> 1] = kp;
                    *(LAS bf16*)(PW + PW_TLW + i * SG_ST + lane * 2) = (bf16)bp; *(LAS bf16*)(PW + PW_TLW + (i + 1) * SG_ST + lane * 2) = (bf16)(bp >> 16);
                    *(LAS bf16*)(PW + PW_LAB + i * SG_ST + lane * 2) = (bf16)kp; *(LAS bf16*)(PW + PW_LAB + (i + 1) * SG_ST + lane * 2) = (bf16)(kp >> 16);
                }
#pragma unroll
                for (int q = 0; q < 4; ++q) {
                    *(LAS v2u*)(GB_ + G_BH + (w * 64 + lane) * 32 + 8 * q) = (v2u){bh[2 * q], bh[2 * q + 1]};
                    *(LAS v2u*)(GB_ + G_KH + (w * 64 + lane) * 32 + 8 * q) = (v2u){kh[2 * q], kh[2 * q + 1]};
                }
            }
            float r_[16];
            pf_consume(stg, pR, lane, mRA, mRB, r_);
#pragma unroll
            for (int i = 0; i < 16; ++i) { bon[i] = r_[i] * k_[i] * rkc; st_bf16(GB_ + G_RT + (16 * w + i) * SG_ST + lane * 2, r_[i] * lam[i]); }
            wave_sum16(bon, lane);
        }
        ((LAS float*)(GB_ + G_GAM))[w * 64 + lane] = lam[15];
        {
            pf_consume(stg, pV, lane, mVA, mVB, v_);
            unsigned vt[8];
#pragma unroll
            for (int i = 0; i < 16; i += 2) { vt[i >> 1] = pk2(v_[i], v_[i + 1]); v_[i] *= bon[i]; v_[i + 1] *= bon[i + 1]; }
            asm volatile("" ::: "memory");
#pragma unroll
            for (int q = 0; q < 4; ++q) *(LAS v2u*)(PW + PW_VT + lane * VT_ST + 8 * q) = (v2u){vt[2 * q], vt[2 * q + 1]};
        }
        asm volatile("" ::: "memory");
        {
            bf16x8 fa[2], fr[2], fb[2], fk[2];
#pragma unroll
            for (int ks = 0; ks < 2; ++ks) {
                fa[ks] = *(const LAS bf16x8*)(GB_ + G_AT + (16 * w + c16) * SG_ST + (32 * ks + 8 * g) * 2); fr[ks] = *(const LAS bf16x8*)(GB_ + G_RT + (16 * w + c16) * SG_ST + (32 * ks + 8 * g) * 2);
                fb[ks] = *(const LAS bf16x8*)(PW + PW_TLW + c16 * SG_ST + (32 * ks + 8 * g) * 2); fk[ks] = *(const LAS bf16x8*)(PW + PW_LAB + c16 * SG_ST + (32 * ks + 8 * g) * 2);
            }
            f32x4 lab = {0.f, 0.f, 0.f, 0.f}, lak = lab, lbr = lab, lkr = lab;
#pragma unroll
            for (int ks = 0; ks < 2; ++ks) { lab = MFMA16(fa[ks], fb[ks], lab); lak = MFMA16(fa[ks], fk[ks], lak); lbr = MFMA16(fr[ks], fb[ks], lbr); lkr = MFMA16(fr[ks], fk[ks], lkr); }
            LAS float* Lf = (LAS float*)(PW + PW_LF);
#pragma unroll
            for (int rg = 0; rg < 4; ++rg) { const int i = 4 * g + rg, j = c16;
                Lf[i * 16 + j] = j < i ? lab[rg] : 0.f;
                st_bf16(GB_ + G_LAK + (w * 16 + i) * 32 + j * 2, j < i ? lak[rg] : 0.f);
                st_bf16(GB_ + G_LBR + (w * 16 + i) * 32 + j * 2, j <= i ? lbr[rg] : 0.f);
                st_bf16(GB_ + G_LKR + (w * 16 + i) * 32 + j * 2, j <= i ? lkr[rg] : 0.f); }
            float tm[16];
#pragma unroll
            for (int i = 0; i < 16; ++i) { float a = (i == c16) ? 1.f : 0.f;
#pragma unroll
                for (int j = 0; j < i; ++j) a += Lf[i * 16 + j] * tm[j];
                tm[i] = a; }
            if (lane < 16) {
#pragma unroll
                for (int i = 0; i < 16; ++i) st_bf16(GB_ + G_TM + (w * 16 + i) * 32 + lane * 2, tm[i]); }
        }
        }
        __syncthreads();
        if (it + 1 < nch) { const PfRows R = pf_rows(T, p0 + 64, d, lane); pf_issue(UB, R, cW, pW); pf_issue(UB, R, cA, pA); pf_issue(UB, R, cK, pK); pf_issue(UB, R, cR, pR); pf_issue(UB, R, cV, pV); }
        float yo[16];
        if (!first) {
#pragma unroll
            for (int i = 0; i < 16; ++i) { const int p = p0 + i, t = d ? T - 1 - p : p; yo[i] = YB[(size_t)(m0 + t) * D + hc]; } }
        {
            lane = lane0; asm volatile("" : "+v"(lane)); c16 = lane & 15; g = lane >> 4;
            const LAS unsigned char* at_b = GB_ + G_AT + c16 * SG_ST + 8 * g;
            const LAS unsigned char* rt_b = GB_ + G_RT + c16 * SG_ST + 8 * g;
            const LAS unsigned char* vt_b = GB_ + G_PRIV + PW_VT + (16 * w + c16) * VT_ST + 8 * g;
            const LAS unsigned char* l_b = GB_ + c16 * 32 + 8 * g;
            const LAS unsigned char* gm_b = GB_ + G_GAM + 16 * g;
            LAS float* yc_b = (LAS float*)(GB_ + G_PRIV + PW_TLW) + (4 * g) * ZS_ST + 16 * w + c16;
#pragma unroll
            for (int sc = 0; sc < 4; ++sc) {
                const LAS unsigned char* at_p = at_b + sc * 16 * SG_ST; const LAS unsigned char* rt_p = rt_b + sc * 16 * SG_ST;
                const bf16x8 sop0 = pk8(S[0], S[1]), sop1 = pk8(S[2], S[3]);
                const bf16x8 at0 = mk8(*(const LAS v2u*)(at_p), *(const LAS v2u*)(at_p + 32)), at1 = mk8(*(const LAS v2u*)(at_p + 64), *(const LAS v2u*)(at_p + 96));
                const bf16x8 rt0 = mk8(*(const LAS v2u*)(rt_p), *(const LAS v2u*)(rt_p + 32)), rt1 = mk8(*(const LAS v2u*)(rt_p + 64), *(const LAS v2u*)(rt_p + 96));
                const v2u vt2 = *(const LAS v2u*)(vt_b + sc * PW_SIZE);
                const bf16x8 alak = mk8(*(const LAS v2u*)(l_b + G_LAK + sc * 512), z2);
                const bf16x8 atm = mk8(*(const LAS v2u*)(l_b + G_TM + sc * 512), z2);
                const bf16x8 albk = mk8(*(const LAS v2u*)(l_b + G_LBR + sc * 512), *(const LAS v2u*)(l_b + G_LKR + sc * 512));
                f32x4 X = {0.f, 0.f, 0.f, 0.f}, Y = X;
                X = MFMA16(at0, sop0, X); Y = MFMA16(rt0, sop0, Y); X = MFMA16(at1, sop1, X); Y = MFMA16(rt1, sop1, Y); X = MFMA16(alak, mk8(vt2, z2), X);
                const v4u xo = {pk2(X[0], X[1]), pk2(X[2], X[3]), 0u, 0u};
                f32x4 U = {0.f, 0.f, 0.f, 0.f};
                U = MFMA16(atm, __builtin_bit_cast(bf16x8, xo), U);
                const v4u uo = {pk2(U[0], U[1]), pk2(U[2], U[3]), vt2.x, vt2.y};
                const bf16x8 uvop = __builtin_bit_cast(bf16x8, uo);
                Y = MFMA16(albk, uvop, Y);
#pragma unroll
                for (int kt = 0; kt < 4; ++kt) {
                    const bf16x8 abk = mk8(*(const LAS v2u*)(l_b + G_BH + (sc * 64 + 16 * kt) * 32), *(const LAS v2u*)(l_b + G_KH + (sc * 64 + 16 * kt) * 32));
                    const f32x4 gm = *(const LAS f32x4*)(gm_b + (sc * 64 + 16 * kt) * 4);
                    S[kt] = MFMA16(abk, uvop, S[kt]) * gm;
                }
                LAS float* yc = yc_b + sc * (PW_SIZE / 4);
#pragma unroll
                for (int rg = 0; rg < 4; ++rg) yc[rg * ZS_ST] = Y[rg];
            }
        }
        __syncthreads();
#pragma unroll 1
        for (int rep_ = 0; rep_ < SREP_POST; ++rep_)
        {
            lane = lane0; asm volatile("" : "+v"(lane)); hc = hh * 64 + lane;
            const LAS float* yc = (const LAS float*)(PW + PW_TLW);
            float y_[16];
#pragma unroll
            for (int i = 0; i < 16; ++i) y_[i] = yc[i * ZS_ST + lane];
            if (first) {
#pragma unroll
                for (int i = 0; i < 16; ++i) { const int p = p0 + i, t = d ? T - 1 - p : p; YB[(size_t)(m0 + t) * D + hc] = y_[i]; }
            } else {
                const float lng = F.in[I_LNG][hc], lnb = F.in[I_LNB][hc];
                float s1[16];
#pragma unroll
                for (int i = 0; i < 16; ++i) { y_[i] += yo[i]; s1[i] = y_[i]; }
                wave_sum16(s1, lane);
#pragma unroll
                for (int i = 0; i < 16; ++i) { y_[i] -= s1[i] * (1.f / 64.f); s1[i] = y_[i] * y_[i]; }
                wave_sum16(s1, lane);
#pragma unroll
                for (int i = 0; i < 16; ++i) { const int p = p0 + i, t = d ? T - 1 - p : p; const size_t m = (size_t)(m0 + t);
                    const float yn = y_[i] * __builtin_amdgcn_rsqf(s1[i] * (1.f / 64.f) + 64e-5f) * lng + lnb + v_[i];
                    MIX[m * DMIX + 1024 + hc] = (bf16)f2bf_hw(yn * bf2f(GBp[m * D + hc])); }
            }
        }
    }
    if (!lat) {
        lane = lane0; asm volatile("" : "+v"(lane)); c16 = lane & 15; g = lane >> 4;
        float* sp = F.out + OUT_ST + ((size_t)((b * 2 + d) * NHB + hh) * 64 + 16 * w + c16) * 64 + 4 * g;
#pragma unroll
        for (int kt = 0; kt < 4; ++kt) *(f32x4*)(sp + 16 * kt) = S[kt];
    }
}

template <int QW, int MASK> __device__ __forceinline__ void p3_mixers(Frame& F, const XcdBarrier& gbar) {
    float lam;
    { const float a = F.in[I_LQ1][F.lane] * F.in[I_LK1][F.lane], bq = F.in[I_LQ2][F.lane] * F.in[I_LK2][F.lane];
      lam = __expf(wave_sum(a)) - __expf(wave_sum(bq)) + 0.2f; }
    constexpr int N_SC = NBC * NHB, N_AL = NBL * NH * (LSEQ / 128), N_AC = NBC * NH * (SEQ / 128);
    constexpr int NU = N_AL + N_SC + N_AC;
    volatile LAS int* slot = (volatile LAS int*)(F.lds + MISC_OFF + 64);
    bool chain_first = (int)blockIdx.x < NLATB;
    for (;;) {
        int u, sb, sh, git = -1; bool slat = false, is_scan;
        if (chain_first) { chain_first = false; is_scan = true; slat = true; sb = (int)blockIdx.x / NHB; sh = (int)blockIdx.x % NHB; git = LAT_BAR_IT; u = 0; }
        else {
            __syncthreads();
            if (F.tid == 0) *slot = (int)__hip_atomic_fetch_add((unsigned*)(F.ctl + CW_Q3 + 64 * QW), 1u, RLX_AGENT);
            __syncthreads();
            u = *slot;
            if (u >= NU) break;
            is_scan = u < N_SC;
            sb = u / NHB; sh = u % NHB;
        }
        if (is_scan) { scan_unit3(F, sb, sh, slat, &gbar, git); continue; }
        { u -= N_SC; const bool lt = u < N_AL; if (!lt) u -= N_AL; attn_unit(F, u, lt, lam); }
    }
}

template <bool DUMMY> __device__ __forceinline__ void p5_final(Frame& F) {
    int ln = F.lane; asm volatile("" : "+v"(ln));
    const float* ssq = (const float*)(F.ws + WS_SSQ);
    const int gw = blockIdx.x * NWAVES + F.wave, NGW = F.G * NWAVES;
    for (int m = gw; m < M; m += NGW) {
        float s = ln < 16 ? ssq[(size_t)m * 16 + ln] : 0.f;
        s = wave_sum(s);
        const float rstd = 1.f / sqrtf(s * (1.f / D) + 1e-6f);
        float* yr = F.out + OUT_Y + (size_t)m * D;
#pragma unroll
        for (int j = 0; j < 4; ++j) { const int c = 4 * ln + 256 * j; const f32x4 v = *(const f32x4*)(yr + c), g = *(const f32x4*)(F.in[I_FG] + c); *(f32x4*)(yr + c) = DUMMY ? v : v * rstd * g; }
    }
}

__global__ void __launch_bounds__(NTHR, 2) hymba_fwd(Args args) {
    extern __shared__ __attribute__((aligned(16))) unsigned char lds[];
    Frame F;
    F.lds = (LAS unsigned char*)lds;
    F.MISC = (volatile LAS unsigned*)(F.lds + MISC_OFF);
    F.tid = threadIdx.x; F.lane = F.tid & 63; F.wave = __builtin_amdgcn_readfirstlane(F.tid >> 6);
    F.G = gridDim.x; F.in = args.in; F.out = args.out; F.ws = args.ws;
    F.ctl = (gu32*)(args.ws + WS_CTL);
    for (int u = F.tid; u < (LDS_BYTES - LDSCTL_OFF) / 4; u += NTHR) ((LAS unsigned*)(F.lds + LDSCTL_OFF))[u] = 0u;
    __syncthreads();
    XcdBarrier bar; bar.bar = (unsigned*)(F.ctl + CW_BAR); bar.x = 0; bar.st = nullptr;
    if (N_LAUNCHES != PER_PHASE) bar = xcd_barrier_post((unsigned*)(F.ctl + CW_BAR), F.MISC + 8);
#define GRID_BAR() do { if (N_LAUNCHES != PER_PHASE) xcd_barrier(bar); } while (0)
    const int lo = args.ph_lo, hi = args.ph_hi;
#define IN(k) (lo <= (k) && (k) < hi)
#define BOTH(k) (IN(k) && IN((k) + 1))
#ifndef REP0
#define REP0 1
#endif
#ifndef REP2
#define REP2 1
#endif
#ifndef REP3MASK
#define REP3MASK 0
#endif
#ifndef REP4
#define REP4 1
#endif
#define RELANE() do { int t_ = threadIdx.x; asm volatile("" : "+v"(t_)); F.tid = t_; F.lane = t_ & 63; } while (0)
    {
        f32x4 xv[5][4];
        p0_prologue(F); RELANE(); p1_load<0, 3>(F, xv); GRID_BAR();
        p1_load<3, 5>(F, xv); p1_norm(F, xv); GRID_BAR();
    }
    RELANE();
    if (IN(2)) {
        const pg8::Gemm g{(const bf16*)(F.ws + WS_XN), (const bf16*)(F.ws + WS_WIN), M, DIN, D};
        const EpiIn E{F.ws, F.out};
        const bool chain = (int)blockIdx.x < NLATB;
#pragma unroll 1
        for (int part = 0; part < 2; ++part) {
            if (part == 1 && chain) break;
            ListOrder S;
            if (part == 0) S.init(F.G, (int)blockIdx.x, 0, P2A_UNITS); else S.init(F.G - NLATB, (int)blockIdx.x - NLATB, P2A_UNITS, P2_UNITS);
            pg8::gemm_phase<EpiIn, ListOrder, true, true>(F.lds + RING_OFF, g, S, E);
            GRID_BAR();
        }
    }
    RELANE();
    if (IN(3)) { p3_mixers<0, 15>(F, bar); if (BOTH(3)) GRID_BAR(); }
    RELANE();
    if (IN(4)) {
        pg8::Gemm g{(const bf16*)(F.ws + WS_MIX), (const bf16*)(F.ws + WS_WOUT), M, D, DMIX}; pg8::StaticOrder S; S.init(M, D, F.G, (int)blockIdx.x);
        EpiOutFused E{F.ws, F.out, F.in[I_XP], F.in[I_XS], F.in[I_FG], F.ctl};
        pg8::gemm_phase<EpiOutFused, pg8::StaticOrder, false, true>(F.lds + RING_OFF, g, S, E);
    }
#undef IN
#undef BOTH
}

extern "C" void kernel_launch(void* const* d_in, const int* in_sizes, int n_in, void* d_out, int out_size, void* d_ws, size_t ws_size, hipStream_t stream) {
    static int grid = 0;
    if (grid == 0) {
        if (n_in != N_IN || out_size != OUT_END || ws_size < WS_END) { fprintf(stderr, "kernel_launch: unexpected sizes n_in %d out %d ws %zu\n", n_in, out_size, ws_size); grid = -1; return; }
        int dev = 0, cus = 0, per_cu = 0;
        if (hipGetDevice(&dev) != hipSuccess || hipDeviceGetAttribute(&cus, hipDeviceAttributeMultiprocessorCount, dev) != hipSuccess) { grid = -1; return; }
        if (hipFuncSetAttribute((const void*)hymba_fwd, hipFuncAttributeMaxDynamicSharedMemorySize, LDS_BYTES) != hipSuccess) { fprintf(stderr, "kernel_launch: hipFuncSetAttribute failed\n"); grid = -1; return; }
        if (hipOccupancyMaxActiveBlocksPerMultiprocessor(&per_cu, (const void*)hymba_fwd, NTHR, LDS_BYTES) != hipSuccess || per_cu < 1) { fprintf(stderr, "kernel_launch: occupancy query says %d\n", per_cu); per_cu = 1; }
        (void)hipGetLastError();
        grid = cus;
    }
    if (grid < 0) return;
    if (hipMemsetAsync((char*)d_ws + WS_CTL, 0, CTL_ZERO_BYTES, stream) != hipSuccess) return;
    Args a{};
    for (int i = 0; i < N_IN; ++i) a.in[i] = (const float*)d_in[i];
    a.out = (float*)d_out; a.ws = (unsigned char*)d_ws;
    if (N_LAUNCHES == PER_PHASE) {
        for (int li = 0; li < PER_PHASE; ++li) { a.ph_lo = li; a.ph_hi = li + 1; a.li = li; hipLaunchKernelGGL(hymba_fwd, dim3(grid), dim3(NTHR), LDS_BYTES, stream, a); }
    } else {
        a.ph_lo = 0; a.ph_hi = PER_PHASE; a.li = 0;
        hipLaunchKernelGGL(hymba_fwd, dim3(grid), dim3(NTHR), LDS_BYTES, stream, a);
    }
}
```

```cpp
#include <hip/hip_runtime.h>
#include <cstdio>
#include <cstdint>

#ifndef MK_N_LAUNCHES
#define MK_N_LAUNCHES 1
#endif

namespace pg8 {
#define PG8_LAS __attribute__((address_space(3)))
typedef unsigned short bf16_t;
typedef short bf16x8 __attribute__((ext_vector_type(8)));
typedef float f32x4 __attribute__((ext_vector_type(4)));
typedef unsigned u32x4 __attribute__((ext_vector_type(4)));
constexpr int BM = 256, BK = 64, HALF = 128, HTB = HALF * BK * 2, STAGE_BYTES = 8 * HTB, NXCD = 8, WGM = 8;

__host__ __device__ __forceinline__ int lds_byte(int r, int c) { const int st = (r >> 4) * 2 + (c >> 5), rr = r & 15, cc = c & 31, ob = rr * 64 + cc * 2; return st * 1024 + (ob ^ (((ob >> 9) & 1) << 5)); }
__host__ __device__ __forceinline__ void stage_rc(int b, int& R, int& C) { const int st = b / 1024, sb = b % 1024, swz = sb ^ (((sb >> 9) & 1) << 5); R = (st >> 1) * 16 + swz / 64; C = (st & 1) * 32 + (swz % 64) / 2; }
__host__ __device__ __forceinline__ int perm32(int rho) { const int n = rho >> 4, i = rho & 15; return 8 * (i >> 2) + 4 * n + (i & 3); }

struct Unit { int pm, pn; };
struct Gemm { const bf16_t* A; const bf16_t* Bt; int M, N, K; };

struct StaticOrder {
    int nM, nN, nwg, G, c;
    __host__ __device__ void init(int M, int N, int G_, int c_) { nM = M / BM; nN = N / BM; nwg = nM * nN; G = G_; c = c_; }
    __host__ __device__ bool next(int i, Unit& u) const {
        const long L = (long)i * G + c; if (L >= nwg) return false;
        int wgid = (int)L; { const int q = nwg / NXCD, r = nwg % NXCD, xcd = wgid % NXCD, off = wgid / NXCD; wgid = (xcd < r ? xcd * (q + 1) : r * (q + 1) + (xcd - r) * q) + off; }
        const int nig = WGM * nN, gid = wgid / nig, fm = gid * WGM, gsz = (nM - fm) < WGM ? (nM - fm) : WGM;
        u.pm = fm + ((wgid % nig) % gsz); u.pn = (wgid % nig) / gsz; return true;
    }
    __device__ __forceinline__ void a_ready(const Unit&) const {}
    __device__ __forceinline__ void done(const Unit&) const {}
};

__device__ __forceinline__ unsigned cvt_pk_bf16(float lo, float hi) { unsigned r; asm volatile("v_cvt_pk_bf16_f32 %0, %1, %2" : "=v"(r) : "v"(lo), "v"(hi)); return r; }

template <class Epi, class Sched, bool ALIGN_EPI = false, bool SP2 = false>
__device__ __forceinline__ void gemm_phase(PG8_LAS unsigned char* lds, const Gemm g, const Sched& S, const Epi& E) {
    int tid = threadIdx.x; asm volatile("" : "+v"(tid));
    const int wid = __builtin_amdgcn_readfirstlane(tid >> 6), lane = tid & 63, wr = wid >> 2, wc = wid & 3, fr = lane & 15, fq = lane >> 4;
    const int K = g.K, nt = K / BK;
    unsigned voffA[2], voffB[2];
#pragma unroll
    for (int i = 0; i < 2; ++i) { int R, C; stage_rc(tid * 16 + i * 8192, R, C); const int Rb = Epi::PERM ? ((R & ~31) + perm32(R & 31)) : R;
        voffA[i] = (unsigned)(R * K + C) * 2u; voffB[i] = (unsigned)(Rb * K + C) * 2u; }
    const size_t kstep = (size_t)(BK * 2);
    const size_t hstep = (size_t)HALF * K * 2;
    const size_t tstep = 2 * hstep;
    const unsigned ldsw = (unsigned)wid * 1024u;
    const int aoff = lds_byte(wr * 64 + fr, fq * 8), boff = lds_byte(wc * 32 + fr, fq * 8);
#define PG8_SA(b, h) (((b) * 2 + (h)) * HTB)
#define PG8_SB(b, h) ((4 + (b) * 2 + (h)) * HTB)
#define PG8_STAGE(bufoff, gbase, voff) do { _Pragma("unroll") for (int _i = 0; _i < 2; ++_i) \
        __builtin_amdgcn_global_load_lds((const unsigned*)((const char*)(gbase) + (voff)[_i]), (PG8_LAS unsigned*)(lds + (bufoff) + ldsw + _i * 8192), 16, 0, 0); } while (0)
#define PG8_LDA(dst, b, h) do { _Pragma("unroll") for (int m = 0; m < 4; ++m) _Pragma("unroll") for (int k = 0; k < 2; ++k) dst[m][k] = *(const PG8_LAS bf16x8*)(lds + PG8_SA(b, h) + aoff + m * 2048 + k * 1024); } while (0)
#define PG8_LDB(dst, b, h) do { _Pragma("unroll") for (int n = 0; n < 2; ++n) _Pragma("unroll") for (int k = 0; k < 2; ++k) dst[n][k] = *(const PG8_LAS bf16x8*)(lds + PG8_SB(b, h) + boff + n * 2048 + k * 1024); } while (0)
#define PG8_MMA(ai, bj, At, Bt) do { __builtin_amdgcn_s_setprio(1); _Pragma("unroll") for (int m = 0; m < 4; ++m) _Pragma("unroll") for (int n = 0; n < 2; ++n) _Pragma("unroll") for (int k = 0; k < 2; ++k) \
        acc[ai][bj][m][n] = __builtin_amdgcn_mfma_f32_16x16x32_bf16(Bt[n][k], At[m][k], acc[ai][bj][m][n], 0, 0, 0); __builtin_amdgcn_s_setprio(0); } while (0)
#define PG8_WAIT_V(n) asm volatile("s_waitcnt vmcnt(" #n ")" ::: "memory")
#define PG8_WAIT_L(n) asm volatile("s_waitcnt lgkmcnt(" #n ")" ::: "memory")
#define PG8_BAR __builtin_amdgcn_s_barrier()
#define PG8_SCHED __builtin_amdgcn_sched_barrier(0)
    Unit cur, nxt; int ui = 0;
    if (!S.next(0, cur)) return;
    f32x4 acc[2][2][4][2];
#pragma unroll
    for (int a = 0; a < 2; ++a)
#pragma unroll
        for (int b = 0; b < 2; ++b)
#pragma unroll
            for (int m = 0; m < 4; ++m)
#pragma unroll
                for (int n = 0; n < 2; ++n) acc[a][b][m][n] = (f32x4){0.f, 0.f, 0.f, 0.f};
    bf16x8 At[4][2], B0[2][2], B1[2][2];
    const char* cA = (const char*)g.A + (size_t)cur.pm * tstep; const char* cB = (const char*)g.Bt + (size_t)cur.pn * tstep;
    S.a_ready(cur);
    if constexpr (SP2) {
        PG8_STAGE(PG8_SB(0, 0), cB, voffB); PG8_STAGE(PG8_SB(0, 1), cB + hstep, voffB); PG8_STAGE(PG8_SA(0, 0), cA, voffA); PG8_STAGE(PG8_SA(0, 1), cA + hstep, voffA);
        if (wr == 1) PG8_BAR;
        PG8_WAIT_V(2); PG8_BAR;
        PG8_STAGE(PG8_SB(1, 0), cB + kstep, voffB); PG8_STAGE(PG8_SA(1, 0), cA + kstep, voffA); PG8_STAGE(PG8_SB(1, 1), cB + hstep + kstep, voffB);
        PG8_WAIT_V(6); PG8_BAR;
    } else {
        PG8_STAGE(PG8_SB(0, 0), cB, voffB); PG8_STAGE(PG8_SA(0, 0), cA, voffA); PG8_STAGE(PG8_SB(0, 1), cB + hstep, voffB); PG8_STAGE(PG8_SA(0, 1), cA + hstep, voffA);
        if (wr == 1) PG8_BAR;
        PG8_WAIT_V(4); PG8_BAR;
        PG8_STAGE(PG8_SB(1, 0), cB + kstep, voffB); PG8_STAGE(PG8_SA(1, 0), cA + kstep, voffA); PG8_STAGE(PG8_SB(1, 1), cB + hstep + kstep, voffB);
        PG8_WAIT_V(6); PG8_BAR;
    }
    for (;;) {
        const bool has_next = S.next(ui + 1, nxt);
        const char* nA = has_next ? (const char*)g.A + (size_t)nxt.pm * tstep : cA; const char* nB = has_next ? (const char*)g.Bt + (size_t)nxt.pn * tstep : cB;
        for (int t = 0; t < nt; t += 2) {
            const bool last = (t == nt - 2);
            const char* a1 = cA + (size_t)(t + 1) * kstep;
            const char* a2 = last ? nA : cA + (size_t)(t + 2) * kstep; const char* b2 = last ? nB : cB + (size_t)(t + 2) * kstep;
            const char* a3 = a2 + kstep; const char* b3 = b2 + kstep;
            if (last && has_next) S.a_ready(nxt);
            if constexpr (SP2) {
            PG8_LDB(B0, 0, 0); PG8_LDB(B1, 0, 1); PG8_SCHED; PG8_LDA(At, 0, 0); PG8_STAGE(PG8_SA(1, 1), a1 + hstep, voffA);
            PG8_WAIT_V(8); PG8_WAIT_L(0); PG8_BAR; PG8_MMA(0, 0, At, B0); PG8_MMA(0, 1, At, B1); PG8_BAR; PG8_SCHED;
            PG8_LDA(At, 0, 1); PG8_STAGE(PG8_SB(0, 0), b2, voffB); PG8_STAGE(PG8_SB(0, 1), b2 + hstep, voffB); PG8_STAGE(PG8_SA(0, 0), a2, voffA);
            PG8_WAIT_V(8); PG8_WAIT_L(0); PG8_BAR; PG8_MMA(1, 0, At, B0); PG8_MMA(1, 1, At, B1); PG8_BAR; PG8_SCHED;
            PG8_LDB(B0, 1, 0); PG8_LDB(B1, 1, 1); PG8_SCHED; PG8_LDA(At, 1, 0); PG8_STAGE(PG8_SA(0, 1), a2 + hstep, voffA);
            PG8_WAIT_V(8); PG8_WAIT_L(0); PG8_BAR; PG8_MMA(0, 0, At, B0); PG8_MMA(0, 1, At, B1); PG8_BAR; PG8_SCHED;
            PG8_LDA(At, 1, 1); PG8_STAGE(PG8_SB(1, 0), b3, voffB); PG8_STAGE(PG8_SB(1, 1), b3 + hstep, voffB); PG8_STAGE(PG8_SA(1, 0), a3, voffA);
            PG8_WAIT_V(8); PG8_WAIT_L(0); PG8_BAR; PG8_MMA(1, 0, At, B0); PG8_MMA(1, 1, At, B1); PG8_BAR; PG8_SCHED;
            } else {
            PG8_LDB(B0, 0, 0); PG8_SCHED; PG8_LDA(At, 0, 0); PG8_STAGE(PG8_SA(1, 1), a1 + hstep, voffA);
            PG8_WAIT_L(8); PG8_BAR; PG8_WAIT_L(0); PG8_MMA(0, 0, At, B0); PG8_BAR; PG8_SCHED;
            PG8_LDB(B1, 0, 1); PG8_STAGE(PG8_SB(0, 0), b2, voffB);
            PG8_BAR; PG8_WAIT_L(0); PG8_MMA(0, 1, At, B1); PG8_BAR;
            PG8_LDA(At, 0, 1); PG8_STAGE(PG8_SA(0, 0), a2, voffA);
            PG8_BAR; PG8_WAIT_L(0); PG8_MMA(1, 0, At, B0); PG8_BAR; PG8_SCHED;
            PG8_STAGE(PG8_SB(0, 1), b2 + hstep, voffB);
            PG8_WAIT_V(6); PG8_BAR; PG8_MMA(1, 1, At, B1); PG8_BAR;
            PG8_LDB(B0, 1, 0); PG8_SCHED; PG8_LDA(At, 1, 0); PG8_STAGE(PG8_SA(0, 1), a2 + hstep, voffA);
            PG8_WAIT_L(8); PG8_BAR; PG8_WAIT_L(0); PG8_MMA(0, 0, At, B0); PG8_BAR; PG8_SCHED;
            PG8_LDB(B1, 1, 1); PG8_STAGE(PG8_SB(1, 0), b3, voffB);
            PG8_BAR; PG8_WAIT_L(0); PG8_MMA(0, 1, At, B1); PG8_BAR;
            PG8_LDA(At, 1, 1); PG8_STAGE(PG8_SA(1, 0), a3, voffA);
            PG8_BAR; PG8_WAIT_L(0); PG8_MMA(1, 0, At, B0); PG8_BAR; PG8_SCHED;
            PG8_STAGE(PG8_SB(1, 1), b3 + hstep, voffB);
            PG8_WAIT_V(6); PG8_BAR; PG8_MMA(1, 1, At, B1); PG8_BAR;
            }
        }
        if constexpr (ALIGN_EPI) { if (wr == 0) PG8_BAR; }
        if constexpr (!Epi::AFTER_DRAIN) { E(acc, cur, wr, wc, fr, fq); S.done(cur); }
        if (!has_next) break;
#pragma unroll
        for (int a = 0; a < 2; ++a)
#pragma unroll
            for (int b = 0; b < 2; ++b)
#pragma unroll
                for (int m = 0; m < 4; ++m)
#pragma unroll
                    for (int n = 0; n < 2; ++n) acc[a][b][m][n] = (f32x4){0.f, 0.f, 0.f, 0.f};
        cur = nxt; cA = nA; cB = nB; ++ui;
        if constexpr (ALIGN_EPI) { if (wr == 1) PG8_BAR; }
    }
    PG8_WAIT_V(0);
    if constexpr (!ALIGN_EPI) { if (wr == 0) PG8_BAR; }
    PG8_BAR;
    if constexpr (Epi::AFTER_DRAIN) { E.fused(acc, cur, wr, wc, fr, fq, lds, wid, lane); S.done(cur); }
#undef PG8_SA
#undef PG8_SB
#undef PG8_STAGE
#undef PG8_LDA
#undef PG8_LDB
#undef PG8_MMA
#undef PG8_WAIT_V
#undef PG8_WAIT_L
#undef PG8_BAR
#undef PG8_SCHED
}
}

constexpr int NWAVES = 8, NTHR = 512;
constexpr int N_LAUNCHES = MK_N_LAUNCHES;
constexpr int PER_PHASE = 6;
constexpr int D = 1024, NBC = 32, SEQ = 256, NBL = 2, LSEQ = 1024, PAST = 512, KLAT = PAST + LSEQ;
constexpr int MC = NBC * SEQ, ML = NBL * LSEQ, M = MC + ML;
constexpr int DIN = 8448, DMIX = 2048, DSH = 3328, NH = 8, NHB = 16;
constexpr int OUT_Y = 0, OUT_CK = M * D, OUT_CV = OUT_CK + MC * D, OUT_ST = OUT_CV + MC * D, OUT_END = OUT_ST + NBC * 2 * NHB * 64 * 64;

enum { I_XP = 0, I_XS, I_CK, I_CV, I_ST, I_C, I_CCTX, I_NG, I_WADA, I_BADA, I_WIN, I_LQ1, I_LK1, I_LQ2, I_LK2, I_SUBG, I_MU, I_W0, I_W2, I_A0, I_A2, I_KK, I_KA, I_RK, I_LNG, I_LNB, I_WOUT, I_FG, N_IN };

constexpr size_t MiB = 1u << 20;
constexpr size_t WS_CTL = 0, CTL_ZERO_BYTES = 1 * MiB;
constexpr size_t WS_MODP = 1 * MiB;
constexpr size_t WS_MODF = WS_MODP + 640 * 1024;
constexpr size_t WS_ROPE = WS_MODF + 64 * 1024;
constexpr size_t WS_SSQ = 2 * MiB;
constexpr size_t WS_WOP = 3 * MiB;
constexpr size_t WS_WIN = 4 * MiB;
constexpr size_t WS_WOUT = 21 * MiB;
constexpr size_t WS_XN = 25 * MiB;
constexpr size_t WS_Q = 45 * MiB;
constexpr size_t WS_KC = 65 * MiB;
constexpr size_t WS_KL = 81 * MiB;
constexpr size_t WS_VTC = 87 * MiB;
constexpr size_t WS_VTL = 103 * MiB;
constexpr size_t WS_GA = 109 * MiB;
constexpr size_t WS_GB = 129 * MiB;
constexpr size_t WS_UB = 149 * MiB;
constexpr size_t WS_MIX = 214 * MiB;
constexpr size_t WS_END = 254 * MiB;
constexpr int CW_BAR = 4096;
constexpr int CW_Q3 = 64;

constexpr int RING_OFF = 0, RING_BYTES = 131072;
constexpr int LDS_BYTES = 163840;
constexpr int LDSCTL_OFF = LDS_BYTES - 1024, MISC_OFF = LDSCTL_OFF + 320;

#define GAS __attribute__((address_space(1)))
#define LAS __attribute__((address_space(3)))
typedef unsigned short bf16;
typedef unsigned v4u __attribute__((ext_vector_type(4)));
typedef unsigned v2u __attribute__((ext_vector_type(2)));
typedef float f32x4 __attribute__((ext_vector_type(4)));
typedef float f32x16 __attribute__((ext_vector_type(16)));
typedef short bf16x8 __attribute__((ext_vector_type(8)));
typedef GAS unsigned gu32;
#define RLX_AGENT __ATOMIC_RELAXED, __HIP_MEMORY_SCOPE_AGENT
#define LDS_WAIT() asm volatile("s_waitcnt lgkmcnt(0)" ::: "memory")
#define VM_WAIT() asm volatile("s_waitcnt vmcnt(0)" ::: "memory")
__device__ __forceinline__ unsigned f2bf(float f) { unsigned u = __builtin_bit_cast(unsigned, f); return (u + 0x7fffu + ((u >> 16) & 1u)) >> 16; }
typedef float f32x2_t __attribute__((ext_vector_type(2)));
typedef __bf16 bf16x2_t __attribute__((ext_vector_type(2)));
__device__ __forceinline__ unsigned pk2(float lo, float hi) { const f32x2_t f = {lo, hi}; return __builtin_bit_cast(unsigned, __builtin_convertvector(f, bf16x2_t)); }
__device__ __forceinline__ unsigned f2bf_hw(float f) { return pk2(f, f); }
__device__ __forceinline__ float bf2f(unsigned b) { return __builtin_bit_cast(float, b << 16); }
__device__ __forceinline__ float bflo(unsigned w) { return __builtin_bit_cast(float, w << 16); }
__device__ __forceinline__ float bfhi(unsigned w) { return __builtin_bit_cast(float, w & 0xffff0000u); }
__device__ __forceinline__ float sigmoidf_(float x) { return __builtin_amdgcn_rcpf(1.f + __expf(-x)); }
__device__ __forceinline__ float siluf_(float x) { return x * __builtin_amdgcn_rcpf(1.f + __expf(-x)); }

#define XB_TMO      128
#define XB_XCNT(j)  (256  + 64 * (j))
#define XB_XSUB(j)  (1280 + 64 * (j))
#define XB_XGEN(j)  (2304 + 64 * (j))
#define XB_TOP      3328
#define XB_TOPGEN   3392
#define XCD_BAR_WORDS 3456
#define XB_SPIN_CAP (1u << 18)
__device__ __forceinline__ unsigned xb_ld(unsigned* p)              { return __hip_atomic_load(p, __ATOMIC_RELAXED, __HIP_MEMORY_SCOPE_AGENT); }
__device__ __forceinline__ unsigned xb_add(unsigned* p, unsigned v) { return __hip_atomic_fetch_add(p, v, __ATOMIC_RELAXED, __HIP_MEMORY_SCOPE_AGENT); }
__device__ __forceinline__ unsigned xb_xcc_id() { return (unsigned)__builtin_amdgcn_s_getreg((3 << 11) | 20) & 0xFu; }
#define XB_SPIN(cond, bar) do { unsigned _sp = 0; while (cond) { __builtin_amdgcn_s_sleep(1); \
    if ((++_sp & 255u) == 0u) { if (xb_ld(&(bar)[XB_TMO])) break; if (_sp > XB_SPIN_CAP) { atomicAdd(&(bar)[XB_TMO], 1u); break; } } } } while (0)
struct XcdBarrier { unsigned* bar; unsigned x; volatile LAS unsigned* st; };
__device__ __forceinline__ XcdBarrier xcd_barrier_post(unsigned* bar, volatile LAS unsigned* st) {
    XcdBarrier b; b.bar = bar; b.x = xb_xcc_id(); b.st = st;
    if (threadIdx.x == 0) (void)xb_add(&bar[XB_XCNT(b.x)], 1u);
    return b;
}
__device__ __forceinline__ void xcd_barrier_complete(unsigned* bar, unsigned x, unsigned& nloc, unsigned& nx) {
    const unsigned G = gridDim.x * gridDim.y * gridDim.z;
    unsigned sum, cnt, mine, sp = 0u;
    for (;;) {
        sum = 0u; cnt = 0u; mine = 0u;
#pragma unroll
        for (unsigned j = 0; j < 16; ++j) { const unsigned c = xb_ld(&bar[XB_XCNT(j)]); sum += c; cnt += (c > 0u) ? 1u : 0u; mine = (j == x) ? c : mine; }
        if (sum == G) break;
        __builtin_amdgcn_s_sleep(1);
        if ((++sp & 255u) == 0u) { if (xb_ld(&bar[XB_TMO])) break; if (sp > XB_SPIN_CAP) { atomicAdd(&bar[XB_TMO], 1u); break; } }
    }
    nloc = mine > 0u ? mine : 1u; nx = cnt > 0u ? cnt : 1u;
}
__device__ __forceinline__ void xcd_barrier(const XcdBarrier& b) {
    asm volatile("s_waitcnt vmcnt(0)" ::: "memory");
    __syncthreads();
    if (threadIdx.x == 0) {
        unsigned* bar = b.bar;
        __builtin_amdgcn_s_waitcnt(0);
        unsigned nloc = b.st[0], nx = b.st[1];
        if (nloc == 0u) { xcd_barrier_complete(bar, b.x, nloc, nx); b.st[0] = nloc; b.st[1] = nx; }
        const unsigned old = xb_add(&bar[XB_XSUB(b.x)], 1u);
        const unsigned gen = old / nloc;
        if (old + 1u == (gen + 1u) * nloc) {
            __builtin_amdgcn_fence(__ATOMIC_RELEASE, "agent");
            asm volatile("s_waitcnt vmcnt(0)" ::: "memory");
            const unsigned og = xb_add(&bar[XB_TOP], 1u);
            const unsigned tg = og / nx;
            if (og + 1u == (tg + 1u) * nx) xb_add(&bar[XB_TOPGEN], 1u);
            else XB_SPIN(xb_ld(&bar[XB_TOPGEN]) == tg, bar);
            __builtin_amdgcn_fence(__ATOMIC_ACQUIRE, "agent");
            xb_add(&bar[XB_XGEN(b.x)], 1u);
            asm volatile("s_waitcnt vmcnt(0)" ::: "memory");
        } else {
            XB_SPIN(xb_ld(&bar[XB_XGEN(b.x)]) == gen, bar);
            __builtin_amdgcn_fence(__ATOMIC_ACQUIRE, "agent");
            asm volatile("s_waitcnt vmcnt(0)" ::: "memory");
        }
    }
    __syncthreads();
}

struct Args { const float* in[N_IN]; float* out; unsigned char* ws; int ph_lo, ph_hi, li, pad; };
struct Frame {
    LAS unsigned char* lds;
    volatile LAS unsigned* MISC;
    gu32* ctl;
    int tid, lane, wave, G;
    const float* const* in;
    float* out; unsigned char* ws;
};
__device__ __forceinline__ float wave_sum(float v) {
#pragma unroll
    for (int o = 1; o < 64; o <<= 1) v += __shfl_xor(v, o);
    return v;
}
__device__ __forceinline__ const float* xrow_ptr(const Frame& F, int m) { return m < MC ? F.in[I_XP] + (size_t)m * D : F.in[I_XS] + (size_t)(m - MC) * D; }

__device__ __forceinline__ void p0_transpose_item(const float* W, int K, int N, bf16* WT, LAS float* scr, int item, int lane) {
    const int nblk = N / 32, kb = item / nblk, nb = item % nblk, k0 = 64 * kb, n0 = 32 * nb;
#pragma unroll 4
    for (int i = 0; i < 32; ++i) { const int kk = 2 * i + (lane >> 5); scr[kk * 33 + (lane & 31)] = W[(size_t)(k0 + kk) * N + n0 + (lane & 31)]; }
    LDS_WAIT(); asm volatile("" ::: "memory");
    const int c = lane & 7;
#pragma unroll
    for (int j = 0; j < 4; ++j) { const int n = (lane >> 3) + 8 * j; const LAS float* s = scr + (8 * c) * 33 + n;
        v4u o; o.x = pk2(s[0 * 33], s[1 * 33]); o.y = pk2(s[2 * 33], s[3 * 33]); o.z = pk2(s[4 * 33], s[5 * 33]); o.w = pk2(s[6 * 33], s[7 * 33]);
        *(GAS v4u*)(WT + (size_t)(n0 + n) * K + k0 + 8 * c) = o; }
    LDS_WAIT(); asm volatile("" ::: "memory");
}
__device__ __forceinline__ void p0_prologue(Frame& F) {
    LAS float* scr = (LAS float*)(F.lds + RING_OFF + F.wave * 16384);
    const int gw = blockIdx.x * NWAVES + F.wave, NGW = F.G * NWAVES;
    bf16* WinT = (bf16*)(F.ws + WS_WIN); bf16* WoutT = (bf16*)(F.ws + WS_WOUT);
    constexpr int I_IN = (D / 64) * (DIN / 32), I_OUT = (DMIX / 64) * (D / 32), I_MOD = 16 * 12, I_CV_ = NBL * NH * (PAST / 64), I_ROPE = 1;
    constexpr int NITEMS = I_MOD + I_IN + I_OUT + I_CV_ + I_ROPE;
    for (int it = gw; it < NITEMS; it += NGW) {
        int r = it;
        if (r < I_MOD) {
            const int kc = r / 12, nb = r % 12, n0 = nb * 256 + 4 * F.lane;
            const float* wa = F.in[I_WADA] + (size_t)(kc * 64) * 3072 + n0;
            f32x4 a0 = {0.f, 0.f, 0.f, 0.f}, a1 = a0, a2 = a0;
#pragma unroll 8
            for (int k = 0; k < 64; ++k) {
                const f32x4 w = *(const f32x4*)(wa + (size_t)k * 3072);
                const float s0 = siluf_(F.in[I_CCTX][kc * 64 + k]), s1 = siluf_(F.in[I_C][kc * 64 + k]), s2 = siluf_(F.in[I_C][D + kc * 64 + k]);
                a0 += w * s0; a1 += w * s1; a2 += w * s2;
            }
            float* mp = (float*)(F.ws + WS_MODP) + (size_t)kc * 3 * 3072 + n0;
            *(f32x4*)(mp) = a0; *(f32x4*)(mp + 3072) = a1; *(f32x4*)(mp + 2 * 3072) = a2;
            continue;
        }
        r -= I_MOD;
        if (r < I_IN) { p0_transpose_item(F.in[I_WIN], D, DIN, WinT, scr, r, F.lane); continue; } r -= I_IN;
        if (r < I_OUT) { p0_transpose_item(F.in[I_WOUT], DMIX, D, WoutT, scr, r, F.lane); continue; } r -= I_OUT;
        if (r < I_CV_) {
            const int tb = r % (PAST / 64), hh = (r / (PAST / 64)) % NH, b = r / (NH * (PAST / 64));
            const float* src = F.in[I_CV] + ((size_t)(b * PAST + tb * 64 + F.lane) * NH + hh) * 128;
            bf16* dst = (bf16*)(F.ws + WS_VTL) + (size_t)((b * NH + hh) * 128) * KLAT + tb * 64 + F.lane;
#pragma unroll 4
            for (int dv = 0; dv < 128; dv += 4) { const f32x4 v = *(const f32x4*)(src + dv);
                dst[(size_t)(dv + 0) * KLAT] = (bf16)f2bf(v.x); dst[(size_t)(dv + 1) * KLAT] = (bf16)f2bf(v.y); dst[(size_t)(dv + 2) * KLAT] = (bf16)f2bf(v.z); dst[(size_t)(dv + 3) * KLAT] = (bf16)f2bf(v.w); }
            continue;
        }
        r -= I_CV_;
        {
            float* rp = (float*)(F.ws + WS_ROPE);
            for (int e = F.lane; e < 1024; e += 64) { const int pos = e >> 4, i = e & 15; const double inv = pow(10000.0, -(double)i / 16.0), ang = (double)pos * inv; rp[e] = (float)cos(ang); rp[1024 + e] = (float)sin(ang); }
        }
    }
    for (int idx = blockIdx.x * NTHR + F.tid; idx < 2 * 16 * 2 * 4 * 2 * 64; idx += F.G * NTHR) {
        const int ln = idx & 63, ks = (idx >> 6) & 1, ct = (idx >> 7) & 3, mat = (idx >> 9) & 1, hh = (idx >> 10) & 15, dd = idx >> 14;
        const float* src = F.in[mat ? I_A2 : I_W2] + (size_t)(dd * 64 + 32 * ks + 8 * (ln >> 4)) * D + hh * 64 + 16 * ct + (ln & 15);
        v4u o; o.x = pk2(src[0], src[D]); o.y = pk2(src[2 * D], src[3 * D]); o.z = pk2(src[4 * D], src[5 * D]); o.w = pk2(src[6 * D], src[7 * D]);
        ((v4u*)(F.ws + WS_WOP))[idx] = o;
    }
    bf16* KL = (bf16*)(F.ws + WS_KL);
    for (int i = blockIdx.x * NTHR + F.tid; i < NBL * PAST * D / 8; i += F.G * NTHR) {
        const int e = i * 8, b = e / (PAST * D), rem = e % (PAST * D);
        const f32x4 v0 = *(const f32x4*)(F.in[I_CK] + e), v1 = *(const f32x4*)(F.in[I_CK] + e + 4);
        v4u o; o.x = pk2(v0.x, v0.y); o.y = pk2(v0.z, v0.w); o.z = pk2(v1.x, v1.y); o.w = pk2(v1.z, v1.w);
        *(v4u*)(KL + (size_t)b * KLAT * D + rem) = o;
    }
}

template <int I0, int I1> __device__ __forceinline__ void p1_load(Frame& F, f32x4 (&v)[5][4]) {
#pragma unroll
    for (int i = I0; i < I1; ++i) { const float* xr = xrow_ptr(F, ((int)blockIdx.x + 256 * i) * 8 + F.wave);
#pragma unroll
        for (int j = 0; j < 4; ++j) v[i][j] = *(const f32x4*)(xr + 4 * F.lane + 256 * j); }
}
__device__ __forceinline__ void p1_norm(Frame& F, f32x4 (&v)[5][4]) {
    LAS float* modL = (LAS float*)(F.lds + RING_OFF);
    const float* modp = (const float*)(F.ws + WS_MODP);
    const float* bada = F.in[I_BADA];
    int mrow[5];
#pragma unroll
    for (int i = 0; i < 5; ++i) mrow[i] = ((int)blockIdx.x + 256 * i) * 8 + F.wave;
    if (blockIdx.x < 36 && F.tid < 256) {
        const int idx = blockIdx.x * 256 + F.tid, ci = idx / 3072, n = idx % 3072;
        float s = bada[n];
#pragma unroll
        for (int kc = 0; kc < 16; ++kc) s += modp[(size_t)(kc * 3 + ci) * 3072 + n];
        ((float*)(F.ws + WS_MODF))[idx] = s;
    }
    {
        const int cil = 1 + (int)blockIdx.x / 128;
        for (int e = F.tid; e < 4096; e += NTHR) { const int n = e & 2047, ci = e < 2048 ? 0 : cil; float s = bada[n];
#pragma unroll
            for (int kc = 0; kc < 16; ++kc) s += modp[(size_t)(kc * 3 + ci) * 3072 + n];
            modL[e] = s; }
    }
    __syncthreads();
    bf16* XN = (bf16*)(F.ws + WS_XN);
#pragma unroll
    for (int i = 0; i < 5; ++i) {
        float ss = 0.f;
#pragma unroll
        for (int j = 0; j < 4; ++j) ss += (v[i][j].x * v[i][j].x + v[i][j].y * v[i][j].y) + (v[i][j].z * v[i][j].z + v[i][j].w * v[i][j].w);
        const float rstd = __builtin_amdgcn_rsqf(wave_sum(ss) * (1.f / D) + 1e-6f);
        const LAS float* ml = modL + (i == 4 ? 2048 : 0);
#pragma unroll
        for (int j = 0; j < 4; ++j) {
            const int c = 4 * F.lane + 256 * j;
            const f32x4 g = *(const f32x4*)(F.in[I_NG] + c);
            const f32x4 sh = *(const LAS f32x4*)(ml + c), sc = *(const LAS f32x4*)(ml + 1024 + c);
            const f32x4 h = (v[i][j] * rstd) * g * (sc + 1.0f) + sh;
            v2u o; o.x = pk2(h.x, h.y); o.y = pk2(h.z, h.w);
            *(v2u*)(XN + (size_t)mrow[i] * D + c) = o;
        }
    }
}

struct EpiIn {
    static constexpr bool PERM = true, AFTER_DRAIN = false;
    unsigned char* ws; float* out;
    __device__ __forceinline__ void operator()(const f32x4 (&acc)[2][2][4][2], const pg8::Unit& u, int wr, int wc, int fr, int fq) const {
        const int pn = u.pn; const bool lat = u.pm >= MC / 256;
        const float* rope = (const float*)(ws + WS_ROPE);
        constexpr float QS = 0.125f * 1.44269504088896f;
#pragma unroll
        for (int ai = 0; ai < 2; ++ai)
#pragma unroll
            for (int m = 0; m < 4; ++m) {
                const int r = u.pm * 256 + ai * 128 + wr * 64 + m * 16 + fr;
#pragma unroll
                for (int bj = 0; bj < 2; ++bj) {
                    const int c = pn * 256 + bj * 128 + wc * 32 + 8 * fq;
                    f32x4 v0 = acc[ai][bj][m][0], v1 = acc[ai][bj][m][1];
                    if (pn < 8) {
                        const bool isq = pn < 4; const int cc = isq ? c : c - 1024;
                        if (lat) {
                            const int t = (r - MC) & (LSEQ - 1), pos = (wc & 1) ? (t & 63) : (t >> 6);
                            const float* cp = rope + pos * 16 + 8 * (fq & 1);
                            const f32x4 c0 = *(const f32x4*)cp, c1 = *(const f32x4*)(cp + 4), s0 = *(const f32x4*)(cp + 1024), s1 = *(const f32x4*)(cp + 1028);
                            f32x4 p0, p1;
#pragma unroll
                            for (int j = 0; j < 4; ++j) { p0[j] = __shfl_xor(v0[j], 32); p1[j] = __shfl_xor(v1[j], 32); }
                            const float sg = (fq & 2) ? 1.f : -1.f;
                            v0 = v0 * c0 + (p0 * s0) * sg; v1 = v1 * c1 + (p1 * s1) * sg;
                        }
                        if (isq) { v0 = v0 * QS; v1 = v1 * QS; }
                        else if (!lat) { float* o = out + OUT_CK + (size_t)r * D + cc; *(f32x4*)o = v0; *(f32x4*)(o + 4) = v1; }
                        v4u w; w.x = pk2(v0[0], v0[1]); w.y = pk2(v0[2], v0[3]); w.z = pk2(v1[0], v1[1]); w.w = pk2(v1[2], v1[3]);
                        bf16* dst;
                        if (isq) dst = (bf16*)(ws + WS_Q) + (size_t)r * D + cc;
                        else if (!lat) dst = (bf16*)(ws + WS_KC) + (size_t)r * D + cc;
                        else { const int b = (r - MC) >> 10, t = (r - MC) & (LSEQ - 1); dst = (bf16*)(ws + WS_KL) + ((size_t)b * KLAT + PAST + t) * D + cc; }
                        *(v4u*)dst = w;
                    } else if (pn < 12) {
                        const int cc = c - 2048, hh = cc >> 7, dv = cc & 127;
                        bf16* dst;
                        if (!lat) { float* o = out + OUT_CV + (size_t)r * D + cc; *(f32x4*)o = v0; *(f32x4*)(o + 4) = v1;
                            const int b = r >> 8, t = r & 255; dst = (bf16*)(ws + WS_VTC) + (size_t)((b * NH + hh) * 128 + dv) * SEQ + t;
#pragma unroll
                            for (int j = 0; j < 4; ++j) { dst[(size_t)j * SEQ] = (bf16)f2bf(v0[j]); dst[(size_t)(4 + j) * SEQ] = (bf16)f2bf(v1[j]); }
                        } else { const int b = (r - MC) >> 10, t = (r - MC) & (LSEQ - 1); dst = (bf16*)(ws + WS_VTL) + (size_t)((b * NH + hh) * 128 + dv) * KLAT + PAST + t;
#pragma unroll
                            for (int j = 0; j < 4; ++j) { dst[(size_t)j * KLAT] = (bf16)f2bf(v0[j]); dst[(size_t)(4 + j) * KLAT] = (bf16)f2bf(v1[j]); }
                        }
                    } else if (pn < 16 || pn >= 29) {
                        bf16* dst = pn < 16 ? (bf16*)(ws + WS_GA) + (size_t)r * D + (c - 3072) : (bf16*)(ws + WS_GB) + (size_t)r * D + (c - 7424);
                        v4u w; w.x = pk2(siluf_(v0[0]), siluf_(v0[1])); w.y = pk2(siluf_(v0[2]), siluf_(v0[3])); w.z = pk2(siluf_(v1[0]), siluf_(v1[1])); w.w = pk2(siluf_(v1[2]), siluf_(v1[3]));
                        *(v4u*)dst = w;
                    } else {
                        v4u w; w.x = pk2(v0[0], v0[1]); w.y = pk2(v0[2], v0[3]); w.z = pk2(v1[0], v1[1]); w.w = pk2(v1[2], v1[3]);
                        *(v4u*)((bf16*)(ws + WS_UB) + (size_t)r * DSH + (c - 4096)) = w;
                    }
                }
            }
    }
};

constexpr int NLATB = 32;
constexpr int LAT_UNITS = (ML / 256) * (DIN / 256);
constexpr int P2A_UNITS = 512, P2_UNITS = (M / 256) * (DIN / 256);
constexpr int LAT_BAR_IT = 6;
struct ListOrder {
    int G, v, lo, hi;
    __device__ void init(int G_, int c_, int lo_, int hi_) { G = G_; v = (G_ % 8 == 0) ? (c_ % 8) * (G_ / 8) + c_ / 8 : c_; lo = lo_; hi = hi_; }
    __device__ bool next(int i, pg8::Unit& u) const {
        int L = lo + i * G + v; if (L >= hi) return false;
        if (L < LAT_UNITS) { u.pn = L >> 3; u.pm = MC / 256 + (L & 7); return true; }
        L -= LAT_UNITS;
        const int grp = L / (8 * (DIN / 256)), r = L % (8 * (DIN / 256)); u.pn = r >> 3; u.pm = grp * 8 + (r & 7); return true;
    }
    __device__ __forceinline__ void a_ready(const pg8::Unit&) const {}
    __device__ __forceinline__ void done(const pg8::Unit&) const {}
};

constexpr size_t WS_XCH = WS_SSQ;
constexpr int CW_PANEL = 8192;
struct EpiOutFused {
    static constexpr bool PERM = false, AFTER_DRAIN = true;
    unsigned char* ws; float* out; const float* xp; const float* xs; const float* fg; gu32* ctl;
    __device__ __forceinline__ void fused(f32x4 (&acc)[2][2][4][2], const pg8::Unit& u, int wr, int wc, int fr, int fq, PG8_LAS unsigned char* lds, int wid, int lane) const {
        const float* modf = (const float*)(ws + WS_MODF);
        PG8_LAS float* P = (PG8_LAS float*)lds;
        PG8_LAS float* R = (PG8_LAS float*)(lds + 4096);
        const int col0 = u.pn * 256 + wc * 32 + 4 * fq;
#pragma unroll
        for (int ai = 0; ai < 2; ++ai)
#pragma unroll
            for (int m = 0; m < 4; ++m) {
                const int rl = ai * 128 + wr * 64 + m * 16 + fr, r = u.pm * 256 + rl;
                const int ci = r < MC ? 0 : 1 + ((r - MC) >> 10);
                const float* xr = (r < MC ? xp + (size_t)r * D : xs + (size_t)(r - MC) * D) + col0;
                const float* gt = modf + ci * 3072 + 2048 + col0;
                float ss = 0.f;
#pragma unroll
                for (int bj = 0; bj < 2; ++bj)
#pragma unroll
                    for (int n = 0; n < 2; ++n) {
                        const int off = bj * 128 + n * 16;
                        const f32x4 y = *(const f32x4*)(xr + off) + *(const f32x4*)(gt + off) * acc[ai][bj][m][n];
                        acc[ai][bj][m][n] = y;
                        ss += (y.x * y.x + y.y * y.y) + (y.z * y.z + y.w * y.w);
                    }
                ss += __shfl_xor(ss, 16); ss += __shfl_xor(ss, 32);
                if (fq == 0) P[rl * 4 + wc] = ss;
            }
        asm volatile("s_waitcnt lgkmcnt(0)" ::: "memory"); __builtin_amdgcn_s_barrier(); asm volatile("" ::: "memory");
        const int row = wid * 32 + (lane & 31);
        float* xbuf = (float*)(ws + WS_XCH) + ((size_t)(u.pm * 256 + row) * 4);
        if (lane < 32) {
            const f32x4 p = *(const PG8_LAS f32x4*)(P + row * 4);
            __hip_atomic_store(xbuf + u.pn, (p.x + p.y) + (p.z + p.w), __ATOMIC_RELAXED, __HIP_MEMORY_SCOPE_AGENT);
        }
        asm volatile("s_waitcnt vmcnt(0)" ::: "memory");
        unsigned* cnt = (unsigned*)(ctl + CW_PANEL + 64 * u.pm);
        if (lane == 0) __hip_atomic_fetch_add(cnt, 1u, __ATOMIC_RELAXED, __HIP_MEMORY_SCOPE_AGENT);
        if (wid == 0) {
            unsigned sp = 0;
            while ((unsigned)__builtin_amdgcn_readfirstlane(__hip_atomic_load(cnt, __ATOMIC_RELAXED, __HIP_MEMORY_SCOPE_AGENT)) < 32u) { __builtin_amdgcn_s_sleep(2); if (++sp > (1u << 20)) break; }
            __builtin_amdgcn_fence(__ATOMIC_ACQUIRE, "agent");
        }
        asm volatile("s_waitcnt vmcnt(0) lgkmcnt(0)" ::: "memory"); __builtin_amdgcn_s_barrier(); asm volatile("" ::: "memory");
        if (lane < 32) {
            float t = 0.f;
#pragma unroll
            for (int q = 0; q < 4; ++q) t += __hip_atomic_load(xbuf + q, __ATOMIC_RELAXED, __HIP_MEMORY_SCOPE_AGENT);
            R[row] = __builtin_amdgcn_rsqf(t * (1.f / D) + 1e-6f);
        }
        asm volatile("s_waitcnt lgkmcnt(0)" ::: "memory"); __builtin_amdgcn_s_barrier(); asm volatile("" ::: "memory");
#pragma unroll
        for (int ai = 0; ai < 2; ++ai)
#pragma unroll
            for (int m = 0; m < 4; ++m) {
                const int rl = ai * 128 + wr * 64 + m * 16 + fr; const float rs = R[rl];
                float* o = out + OUT_Y + (size_t)(u.pm * 256 + rl) * D + col0;
#pragma unroll
                for (int bj = 0; bj < 2; ++bj)
#pragma unroll
                    for (int n = 0; n < 2; ++n) { const int off = bj * 128 + n * 16; *(f32x4*)(o + off) = acc[ai][bj][m][n] * rs * *(const f32x4*)(fg + col0 + off); }
            }
    }
};

constexpr int AT_KS = 0, AT_KSTRIDE = 272, AT_VS = 64 * AT_KSTRIDE, AT_VSTRIDE = 144, AT_BUF = AT_VS + 128 * AT_VSTRIDE, AT_X = 2 * AT_BUF, AT_XSTRIDE = 132;
static_assert(AT_X + 4 * 32 * AT_XSTRIDE * 4 <= LDSCTL_OFF && (AT_X % 16) == 0, "attention LDS map");
__device__ __forceinline__ void attn_unit(Frame& F, int idx, bool lat, float lam) {
    int tid_ = F.tid; asm volatile("" : "+v"(tid_)); const int lane_ = tid_ & 63;
    int b, hh, qb, m0, nkeys, vlen; const bf16* Kb; const bf16* VT;
    if (!lat) { b = idx >> 4; hh = (idx >> 1) & 7; qb = idx & 1; m0 = b * SEQ + qb * 128; nkeys = SEQ; vlen = SEQ;
        Kb = (const bf16*)(F.ws + WS_KC) + (size_t)b * SEQ * D + hh * 128; VT = (const bf16*)(F.ws + WS_VTC) + (size_t)((b * NH + hh) * 128) * SEQ; }
    else { b = idx >> 6; hh = (idx >> 3) & 7; qb = idx & 7; m0 = MC + b * LSEQ + qb * 128; nkeys = KLAT; vlen = KLAT;
        Kb = (const bf16*)(F.ws + WS_KL) + (size_t)b * KLAT * D + hh * 128; VT = (const bf16*)(F.ws + WS_VTL) + (size_t)((b * NH + hh) * 128) * KLAT; }
    const int w = F.wave, qs = w >> 1, mp = w & 1, l31 = lane_ & 31, h5 = lane_ >> 5;
    const int kperm = (l31 & 3) + 4 * ((l31 >> 3) & 1) + 8 * ((l31 >> 2) & 1) + 16 * (l31 >> 4);
    LAS float* X = (LAS float*)(F.lds + AT_X);
    bf16x8 qf[4];
    { const bf16* qrow = (const bf16*)(F.ws + WS_Q) + (size_t)(m0 + qs * 32 + l31) * D + hh * 128 + mp * 64 + 8 * h5;
#pragma unroll
      for (int ks = 0; ks < 4; ++ks) qf[ks] = *(const bf16x8*)(qrow + 16 * ks); }
    f32x16 o[4];
#pragma unroll
    for (int i = 0; i < 4; ++i)
#pragma unroll
        for (int j = 0; j < 16; ++j) o[i][j] = 0.f;
    float mrun = -1e30f, lrun = 0.f;
    const int krow = tid_ >> 3, kch = tid_ & 7, vrow = tid_ >> 2, vch = tid_ & 3;
    const int ntile = nkeys / 64;
    const bf16* kp = Kb + (size_t)krow * D + kch * 8;
    const bf16* vp = VT + (size_t)vrow * vlen + vch * 8;
    LAS unsigned char* kd = F.lds + AT_KS + krow * AT_KSTRIDE + kch * 16;
    LAS unsigned char* vd = F.lds + AT_VS + vrow * AT_VSTRIDE + vch * 16;
    v4u k0 = *(const v4u*)kp, k1 = *(const v4u*)(kp + 64), v0 = *(const v4u*)vp, v1 = *(const v4u*)(vp + 32);
    __syncthreads();
    *(LAS v4u*)(kd) = k0; *(LAS v4u*)(kd + 128) = k1;
    *(LAS v4u*)(vd) = v0; *(LAS v4u*)(vd + 64) = v1;
    if (ntile > 1) { k0 = *(const v4u*)(kp + (size_t)64 * D); k1 = *(const v4u*)(kp + (size_t)64 * D + 64); v0 = *(const v4u*)(vp + 64); v1 = *(const v4u*)(vp + 96); }
    __syncthreads();
    for (int kt = 0; kt < ntile; ++kt) {
        const int bo = (kt & 1) * AT_BUF;
        LAS unsigned char* Ks = F.lds + AT_KS + bo; LAS unsigned char* Vs = F.lds + AT_VS + bo;
        if (kt + 1 < ntile) {
            const int bn = AT_BUF - bo;
            *(LAS v4u*)(kd + bn) = k0; *(LAS v4u*)(kd + bn + 128) = k1;
            *(LAS v4u*)(vd + bn) = v0; *(LAS v4u*)(vd + bn + 64) = v1;
            if (kt + 2 < ntile) { const bf16* kq = kp + (size_t)(kt + 2) * 64 * D; const bf16* vq = vp + (kt + 2) * 64;
                k0 = *(const v4u*)kq; k1 = *(const v4u*)(kq + 64); v0 = *(const v4u*)vq; v1 = *(const v4u*)(vq + 32); }
        }
        f32x16 s[2];
#pragma unroll
        for (int st = 0; st < 2; ++st) {
#pragma unroll
            for (int j = 0; j < 16; ++j) s[st][j] = 0.f;
#pragma unroll
            for (int ks = 0; ks < 4; ++ks) {
                const bf16x8 kf = *(const LAS bf16x8*)(Ks + (st * 32 + kperm) * AT_KSTRIDE + (mp * 64 + 16 * ks + 8 * h5) * 2);
                s[st] = __builtin_amdgcn_mfma_f32_32x32x16_bf16(kf, qf[ks], s[st], 0, 0, 0);
            }
        }
        float mx = s[0][0];
#pragma unroll
        for (int j = 0; j < 16; ++j) { mx = fmaxf(mx, s[0][j]); mx = fmaxf(mx, s[1][j]); }
        mx = fmaxf(mx, __shfl_xor(mx, 32));
        if (!__all(mx - mrun <= 8.f)) {
            const float mnew_ = fmaxf(mrun, mx), alpha = __builtin_amdgcn_exp2f(mrun - mnew_);
            mrun = mnew_; lrun *= alpha;
#pragma unroll
            for (int i = 0; i < 4; ++i) o[i] = o[i] * alpha;
        }
        const float mnew = mrun;
        float ps = 0.f;
#pragma unroll
        for (int st = 0; st < 2; ++st)
#pragma unroll
            for (int j = 0; j < 16; ++j) { const float p = __builtin_amdgcn_exp2f(s[st][j] - mnew); s[st][j] = p; ps += p; }
        lrun += ps;
        bf16x8 pf[2][2];
#pragma unroll
        for (int st = 0; st < 2; ++st)
#pragma unroll
            for (int s2 = 0; s2 < 2; ++s2) {
                v4u t; t.x = pk2(s[st][8 * s2 + 0], s[st][8 * s2 + 1]); t.y = pk2(s[st][8 * s2 + 2], s[st][8 * s2 + 3]); t.z = pk2(s[st][8 * s2 + 4], s[st][8 * s2 + 5]); t.w = pk2(s[st][8 * s2 + 6], s[st][8 * s2 + 7]);
                pf[st][s2] = __builtin_bit_cast(bf16x8, t);
            }
#pragma unroll
        for (int dvt = 0; dvt < 4; ++dvt)
#pragma unroll
            for (int st = 0; st < 2; ++st)
#pragma unroll
                for (int s2 = 0; s2 < 2; ++s2) {
                    const bf16x8 vf = *(const LAS bf16x8*)(Vs + (dvt * 32 + l31) * AT_VSTRIDE + (st * 32 + 16 * s2 + 8 * h5) * 2);
                    o[dvt] = __builtin_amdgcn_mfma_f32_32x32x16_bf16(vf, pf[st][s2], o[dvt], 0, 0, 0);
                }
        __syncthreads();
    }
    const float ltot = lrun + __shfl_xor(lrun, 32), inv = 1.f / ltot;
    LAS float* Xq = X + (qs * 32 + l31) * AT_XSTRIDE;
    if (mp == 1) {
#pragma unroll
        for (int dvt = 0; dvt < 4; ++dvt)
#pragma unroll
            for (int j = 0; j < 16; ++j) Xq[dvt * 32 + (j & 3) + 8 * (j >> 2) + 4 * h5] = o[dvt][j] * inv;
    }
    __syncthreads();
    if (mp == 0) {
        float ss = 0.f;
#pragma unroll
        for (int dvt = 0; dvt < 4; ++dvt)
#pragma unroll
            for (int j = 0; j < 16; ++j) { const float a = o[dvt][j] * inv - lam * Xq[dvt * 32 + (j & 3) + 8 * (j >> 2) + 4 * h5]; o[dvt][j] = a; ss += a * a; }
        ss += __shfl_xor(ss, 32);
        const float rstd = 0.8f / sqrtf(ss * (1.f / 128.f) + 1e-5f);
#pragma unroll
        for (int dvt = 0; dvt < 4; ++dvt)
#pragma unroll
            for (int j = 0; j < 16; ++j) Xq[dvt * 32 + (j & 3) + 8 * (j >> 2) + 4 * h5] = o[dvt][j] * rstd;
    }
    __syncthreads();
    {
        const float* sg = F.in[I_SUBG];
        const bf16* GA = (const bf16*)(F.ws + WS_GA); bf16* MIX = (bf16*)(F.ws + WS_MIX);
        const int d8 = (tid_ & 15) * 8;
        const f32x4 g0 = *(const f32x4*)(sg + d8), g1 = *(const f32x4*)(sg + d8 + 4);
#pragma unroll
        for (int p = 0; p < 4; ++p) {
            const int q = p * 32 + (tid_ >> 4), m = m0 + q;
            const LAS float* xr = X + q * AT_XSTRIDE + d8;
            const f32x4 a0 = *(const LAS f32x4*)xr, a1 = *(const LAS f32x4*)(xr + 4);
            const v4u ga = *(const v4u*)(GA + (size_t)m * D + hh * 128 + d8);
            v4u w;
            w.x = pk2(a0.x * g0.x * bflo(ga.x), a0.y * g0.y * bfhi(ga.x)); w.y = pk2(a0.z * g0.z * bflo(ga.y), a0.w * g0.w * bfhi(ga.y));
            w.z = pk2(a1.x * g1.x * bflo(ga.z), a1.y * g1.y * bfhi(ga.z)); w.w = pk2(a1.z * g1.z * bflo(ga.w), a1.w * g1.w * bfhi(ga.w));
            *(v4u*)(MIX + (size_t)m * DMIX + hh * 128 + d8) = w;
        }
    }
}

constexpr int SC_W2 = 0, SC_A2 = 16384, SC_TLW = 32768, SC_LA = 40960, SC_WD = 49152, SC_NKK = 57344, SC_BB = 65536, SC_KD = 73728, SC_R = 81920, SC_V = 90112, SC_Y = 98304, SC_BON = 106496;
template <int CTRL> __device__ __forceinline__ float dppf(float x) { return __builtin_bit_cast(float, __builtin_amdgcn_update_dpp(0, __builtin_bit_cast(int, x), CTRL, 0xf, 0xf, true)); }
__device__ __forceinline__ float reduce8(float v) { v += dppf<0xB1>(v); v += dppf<0x4E>(v); v += dppf<0x141>(v); return v; }
__device__ __forceinline__ float shift_load(const bf16* ub, const float* mu, int t, int T, int col) {
    const float u = bf2f(ub[col]);
    const float p = t > 0 ? bf2f(ub[col - DSH]) : 0.f;
    const float n = t < T - 1 ? bf2f(ub[col + DSH]) : 0.f;
    return u + mu[col] * (p - u) + mu[DSH + col] * (n - u);
}
__device__ __forceinline__ void scan_unit(Frame& F, int b, int hh, bool lat) {
    const int T = lat ? LSEQ : SEQ, m0 = lat ? MC + b * LSEQ : b * SEQ;
    const bf16* UB = (const bf16*)(F.ws + WS_UB); const bf16* GB = (const bf16*)(F.ws + WS_GB); bf16* MIX = (bf16*)(F.ws + WS_MIX);
    float* YB = F.out + OUT_Y;
    const float* mu = F.in[I_MU];
    LAS float* W2s = (LAS float*)(F.lds + SC_W2); LAS float* A2s = (LAS float*)(F.lds + SC_A2); LAS float* TLW = (LAS float*)(F.lds + SC_TLW); LAS float* LAs = (LAS float*)(F.lds + SC_LA);
    LAS float* WD = (LAS float*)(F.lds + SC_WD); LAS float* NKK = (LAS float*)(F.lds + SC_NKK); LAS float* BB = (LAS float*)(F.lds + SC_BB); LAS float* KD = (LAS float*)(F.lds + SC_KD);
    LAS float* RR = (LAS float*)(F.lds + SC_R); LAS float* VV = (LAS float*)(F.lds + SC_V); LAS float* YC = (LAS float*)(F.lds + SC_Y); LAS float* BON = (LAS float*)(F.lds + SC_BON);
    const int c = F.lane, hc = hh * 64 + c, row = F.wave * 8 + (F.lane >> 3), kq = F.lane & 7;
    const float kkc = F.in[I_KK][hc], kac = F.in[I_KA][hc], rkc = F.in[I_RK][hc];
    for (int d = 0; d < 2; ++d) {
        __syncthreads();
        for (int i = F.tid; i < 4096; i += NTHR) { const int j = i >> 6, cc = i & 63; W2s[i] = F.in[I_W2][(size_t)(d * 64 + j) * D + hh * 64 + cc]; A2s[i] = F.in[I_A2][(size_t)(d * 64 + j) * D + hh * 64 + cc]; }
        const float w0c = F.in[I_W0][d * D + hc], a0c = F.in[I_A0][d * D + hc];
        float S[8];
        if (lat) { const float* sp = F.in[I_ST] + ((size_t)((b * 2 + d) * NHB + hh) * 64 + row) * 64 + kq * 8;
            const f32x4 s0 = *(const f32x4*)sp, s1 = *(const f32x4*)(sp + 4); S[0] = s0.x; S[1] = s0.y; S[2] = s0.z; S[3] = s0.w; S[4] = s1.x; S[5] = s1.y; S[6] = s1.z; S[7] = s1.w; }
        else {
#pragma unroll
            for (int i = 0; i < 8; ++i) S[i] = 0.f; }
        const int nch = T / 32;
        for (int ch = 0; ch < nch; ++ch) {
            const int t0 = (d == 0 ? ch : nch - 1 - ch) * 32;
            __syncthreads();
            float r_[4], k_[4], v_[4];
#pragma unroll
            for (int i = 0; i < 4; ++i) {
                const int tt = F.wave * 4 + i, t = t0 + tt;
                const bf16* ub = UB + (size_t)(m0 + t) * DSH;
                r_[i] = shift_load(ub, mu, t, T, hc); k_[i] = shift_load(ub, mu, t, T, 1024 + hc); v_[i] = shift_load(ub, mu, t, T, 2048 + hc);
                const float lw = shift_load(ub, mu, t, T, 3072 + 64 * d + c), la = shift_load(ub, mu, t, T, 3200 + 64 * d + c);
                TLW[tt * 64 + c] = tanhf(lw); LAs[tt * 64 + c] = la;
            }
            __syncthreads();
            float zw[4], za[4];
#pragma unroll
            for (int i = 0; i < 4; ++i) { zw[i] = w0c; za[i] = a0c; }
            for (int j = 0; j < 64; j += 4) {
                f32x4 tw[4], ta[4];
#pragma unroll
                for (int i = 0; i < 4; ++i) { tw[i] = *(const LAS f32x4*)(TLW + (F.wave * 4 + i) * 64 + j); ta[i] = *(const LAS f32x4*)(LAs + (F.wave * 4 + i) * 64 + j); }
#pragma unroll
                for (int jj = 0; jj < 4; ++jj) { const float w2 = W2s[(j + jj) * 64 + c], a2 = A2s[(j + jj) * 64 + c];
#pragma unroll
                    for (int i = 0; i < 4; ++i) { zw[i] += tw[i][jj] * w2; za[i] += ta[i][jj] * a2; } }
            }
#pragma unroll
            for (int i = 0; i < 4; ++i) {
                const int tt = F.wave * 4 + i;
                const float dec = __expf(-0.60653065971f * sigmoidf_(zw[i])), a = sigmoidf_(za[i]);
                float kk = k_[i] * kkc; const float n2 = wave_sum(kk * kk); kk *= 1.f / sqrtf(n2 + 1e-12f);
                WD[tt * 64 + c] = dec; NKK[tt * 64 + c] = -kk; BB[tt * 64 + c] = kk * a; KD[tt * 64 + c] = k_[i] * (1.f + (a - 1.f) * kac); RR[tt * 64 + c] = r_[i]; VV[tt * 64 + c] = v_[i];
                if (d == 1) { const float bo = wave_sum(r_[i] * k_[i] * rkc); if (c == 0) BON[tt] = bo; }
            }
            __syncthreads();
            for (int s = 0; s < 32; ++s) {
                const int tt = d == 0 ? s : 31 - s; const int o = tt * 64 + kq * 8;
                const f32x4 w0 = *(const LAS f32x4*)(WD + o), w1 = *(const LAS f32x4*)(WD + o + 4), n0 = *(const LAS f32x4*)(NKK + o), n1 = *(const LAS f32x4*)(NKK + o + 4);
                const f32x4 b0 = *(const LAS f32x4*)(BB + o), b1 = *(const LAS f32x4*)(BB + o + 4), k0 = *(const LAS f32x4*)(KD + o), k1 = *(const LAS f32x4*)(KD + o + 4);
                const f32x4 r0 = *(const LAS f32x4*)(RR + o), r1 = *(const LAS f32x4*)(RR + o + 4);
                const float vv = VV[tt * 64 + row];
                float sa = (S[0] * n0.x + S[1] * n0.y) + (S[2] * n0.z + S[3] * n0.w) + (S[4] * n1.x + S[5] * n1.y) + (S[6] * n1.z + S[7] * n1.w);
                sa = reduce8(sa);
                S[0] = S[0] * w0.x + sa * b0.x + vv * k0.x; S[1] = S[1] * w0.y + sa * b0.y + vv * k0.y; S[2] = S[2] * w0.z + sa * b0.z + vv * k0.z; S[3] = S[3] * w0.w + sa * b0.w + vv * k0.w;
                S[4] = S[4] * w1.x + sa * b1.x + vv * k1.x; S[5] = S[5] * w1.y + sa * b1.y + vv * k1.y; S[6] = S[6] * w1.z + sa * b1.z + vv * k1.z; S[7] = S[7] * w1.w + sa * b1.w + vv * k1.w;
                float y = (S[0] * r0.x + S[1] * r0.y) + (S[2] * r0.z + S[3] * r0.w) + (S[4] * r1.x + S[5] * r1.y) + (S[6] * r1.z + S[7] * r1.w);
                y = reduce8(y);
                if (kq == 0) YC[tt * 64 + row] = y;
            }
            __syncthreads();
            {
                const int tt = F.tid >> 4, c4 = (F.tid & 15) * 4, m = m0 + t0 + tt;
                f32x4 y4 = *(const LAS f32x4*)(YC + tt * 64 + c4);
                float* gp = YB + (size_t)m * D + hh * 64 + c4;
                if (d == 0) *(f32x4*)gp = y4;
                else {
                    y4 += *(const f32x4*)gp;
                    float s1 = (y4.x + y4.y) + (y4.z + y4.w);
                    s1 += __shfl_xor(s1, 1); s1 += __shfl_xor(s1, 2); s1 += __shfl_xor(s1, 4); s1 += __shfl_xor(s1, 8);
                    const float mean = s1 * (1.f / 64.f);
                    const f32x4 dy = y4 - mean;
                    float s2 = (dy.x * dy.x + dy.y * dy.y) + (dy.z * dy.z + dy.w * dy.w);
                    s2 += __shfl_xor(s2, 1); s2 += __shfl_xor(s2, 2); s2 += __shfl_xor(s2, 4); s2 += __shfl_xor(s2, 8);
                    const float rstd = 1.f / sqrtf(s2 * (1.f / 64.f) + 64e-5f);
                    const f32x4 lg = *(const f32x4*)(F.in[I_LNG] + hh * 64 + c4), lb = *(const f32x4*)(F.in[I_LNB] + hh * 64 + c4);
                    const f32x4 vt = *(const LAS f32x4*)(VV + tt * 64 + c4);
                    const float bo = BON[tt];
                    const v2u gb = *(const v2u*)(GB + (size_t)m * D + hh * 64 + c4);
                    const f32x4 yn = dy * rstd * lg + lb + vt * bo;
                    v2u w; w.x = pk2(yn.x * bflo(gb.x), yn.y * bfhi(gb.x)); w.y = pk2(yn.z * bflo(gb.y), yn.w * bfhi(gb.y));
                    *(v2u*)(MIX + (size_t)m * DMIX + 1024 + hh * 64 + c4) = w;
                }
            }
        }
        if (!lat) { float* sp = F.out + OUT_ST + ((size_t)((b * 2 + d) * NHB + hh) * 64 + row) * 64 + kq * 8;
            *(f32x4*)sp = (f32x4){S[0], S[1], S[2], S[3]}; *(f32x4*)(sp + 4) = (f32x4){S[4], S[5], S[6], S[7]}; }
    }
}


constexpr int SG_ST = 144;
constexpr int G_AT = 0, G_RT = 9216, G_BH = 18432, G_KH = 26624, G_LAK = 34816, G_LBR = 36864, G_LKR = 38912, G_TM = 40960, G_GAM = 43008, G_PRIV = 44032;
constexpr int PW_TLW = 0, PW_LAB = 2304, PW_ZS = 4608, PW_LF = PW_ZS, PW_VT = PW_ZS + 1024, PW_SIZE = 8768, G_SIZE = G_PRIV + 4 * PW_SIZE;
constexpr int ZS_ST = 65, VT_ST = 40;
static_assert(2 * G_SIZE <= LDSCTL_OFF, "scan LDS map");
__device__ __forceinline__ bf16x8 mk8(v2u lo, v2u hi) { const v4u t = {lo.x, lo.y, hi.x, hi.y}; return __builtin_bit_cast(bf16x8, t); }
__device__ __forceinline__ bf16x8 pk8(f32x4 a, f32x4 b) { const v4u t = {pk2(a[0], a[1]), pk2(a[2], a[3]), pk2(b[0], b[1]), pk2(b[2], b[3])}; return __builtin_bit_cast(bf16x8, t); }
#define MFMA16(a, b, c) __builtin_amdgcn_mfma_f32_16x16x32_bf16(a, b, c, 0, 0, 0)
template <int CTRL> __device__ __forceinline__ float dpp_mov(float x) { return __builtin_bit_cast(float, __builtin_amdgcn_update_dpp(0, __builtin_bit_cast(int, x), CTRL, 0xf, 0xf, true)); }
__device__ __forceinline__ void wave_sum16(float (&v)[16], int lane) {
    float a8[8], a4[4], a2[2];
    { const bool bit = lane & 4;
#pragma unroll
      for (int m = 0; m < 8; ++m) { const float send = bit ? v[2 * m] : v[2 * m + 1], keep = bit ? v[2 * m + 1] : v[2 * m]; a8[m] = keep + dpp_mov<0x141>(send); } }
    { const bool bit = lane & 1;
#pragma unroll
      for (int m = 0; m < 4; ++m) { const float send = bit ? a8[2 * m] : a8[2 * m + 1], keep = bit ? a8[2 * m + 1] : a8[2 * m]; a4[m] = keep + dpp_mov<0xB1>(send); } }
    { const bool bit = lane & 2;
#pragma unroll
      for (int m = 0; m < 2; ++m) { const float send = bit ? a4[2 * m] : a4[2 * m + 1], keep = bit ? a4[2 * m + 1] : a4[2 * m]; a2[m] = keep + dpp_mov<0x4E>(send); } }
    float t;
    { const bool bit = lane & 8; const float send = bit ? a2[0] : a2[1], keep = bit ? a2[1] : a2[0]; t = keep + dpp_mov<0x128>(send); }
    t += __shfl_xor(t, 16); t += __shfl_xor(t, 32);
#pragma unroll
    for (int i = 0; i < 16; ++i) { constexpr int dummy = 0; const int src = ((i >> 1) & 1) + 2 * ((i >> 2) & 1) + 4 * (i & 1) + 8 * ((i >> 3) & 1);
        v[i] = __builtin_bit_cast(float, __builtin_amdgcn_readlane(__builtin_bit_cast(int, t), src)); }
}
__device__ __forceinline__ void load_shift16(const bf16* ubase, int T, int p0, int d, int col, float mA, float mB, float (&out)[16]) {
    float u[18];
#pragma unroll
    for (int j = 0; j < 18; ++j) { const int tj = d ? (T - p0 - j) : (p0 - 1 + j);
        if (j == 0 || j == 17) u[j] = (tj >= 0 && tj < T) ? bf2f(ubase[(size_t)tj * DSH + col]) : 0.f;
        else u[j] = bf2f(ubase[(size_t)tj * DSH + col]); }
#pragma unroll
    for (int i = 0; i < 16; ++i) out[i] = u[i + 1] + mA * (u[i] - u[i + 1]) + mB * (u[i + 2] - u[i + 1]);
}
__device__ __forceinline__ void scan_unit2(Frame& F, int b, int hh, bool lat) {
    const int T = lat ? LSEQ : SEQ, m0 = lat ? MC + b * LSEQ : b * SEQ, nch = T / 64;
    const int lane0 = F.lane, d = F.wave >> 2, w = F.wave & 3;
    int lane = lane0, c16 = lane & 15, g = lane >> 4, hc = hh * 64 + lane;
    LAS unsigned char* GB_ = F.lds + d * G_SIZE;
    LAS unsigned char* PW = GB_ + G_PRIV + w * PW_SIZE;
    const bf16* UB = (const bf16*)(F.ws + WS_UB) + (size_t)m0 * DSH; const bf16* GBp = (const bf16*)(F.ws + WS_GB); bf16* MIX = (bf16*)(F.ws + WS_MIX);
    float* YB = F.out + OUT_Y;
    const float* mu = F.in[I_MU];
    int cR = hc, cK = 1024 + hc, cV = 2048 + hc, cW = 3072 + 64 * d + lane, cA = 3200 + 64 * d + lane;
    const int oA = d ? DSH : 0, oB = d ? 0 : DSH;
    const float kkc = F.in[I_KK][hc], kac = F.in[I_KA][hc], rkc = F.in[I_RK][hc], w0c = F.in[I_W0][d * D + hc], a0c = F.in[I_A0][d * D + hc];
    const float lng = F.in[I_LNG][hc], lnb = F.in[I_LNB][hc];
    const v4u* wop0 = (const v4u*)(F.ws + WS_WOP) + (size_t)((d * 16 + hh) * 2) * 8 * 64;
    f32x4 S[4];
    const size_t st_off = ((size_t)((b * 2 + d) * NHB + hh) * 64 + 16 * w + c16) * 64 + 4 * g;
#pragma unroll
    for (int kt = 0; kt < 4; ++kt) S[kt] = lat ? *(const f32x4*)(F.in[I_ST] + st_off + 16 * kt) : (f32x4){0.f, 0.f, 0.f, 0.f};
    const v2u z2 = {0u, 0u};
    __syncthreads();
    for (int it = 0; it < nch; ++it) {
        const int p0 = it * 64 + w * 16;
        lane = lane0; asm volatile("" : "+v"(lane));
        c16 = lane & 15; g = lane >> 4; hc = hh * 64 + lane; cR = hc; cK = 1024 + hc; cV = 2048 + hc; cW = 3072 + 64 * d + lane; cA = 3200 + 64 * d + lane;
        const v4u* wop = wop0 + lane;
        float bon[16], v_[16];
        {
            float x_[16];
            load_shift16(UB, T, p0, d, cW, mu[oA + cW], mu[oB + cW], x_);
#pragma unroll
            for (int i = 0; i < 16; ++i) { const float e = __expf(2.f * x_[i]); *(LAS bf16*)(PW + PW_TLW + i * SG_ST + lane * 2) = (bf16)f2bf(1.f - 2.f / (e + 1.f)); }
            load_shift16(UB, T, p0, d, cA, mu[oA + cA], mu[oB + cA], x_);
#pragma unroll
            for (int i = 0; i < 16; ++i) *(LAS bf16*)(PW + PW_LAB + i * SG_ST + lane * 2) = (bf16)f2bf(x_[i]);
        }
        float lam[16], aa[16];
        {
            LAS float* Zs = (LAS float*)(PW + PW_ZS);
            {
                bf16x8 ta[2];
#pragma unroll
                for (int ks = 0; ks < 2; ++ks) ta[ks] = *(const LAS bf16x8*)(PW + PW_TLW + c16 * SG_ST + (32 * ks + 8 * g) * 2);
#pragma unroll
                for (int ct = 0; ct < 4; ++ct) { f32x4 z = {0.f, 0.f, 0.f, 0.f};
#pragma unroll
                    for (int ks = 0; ks < 2; ++ks) z = MFMA16(ta[ks], __builtin_bit_cast(bf16x8, wop[(ct * 2 + ks) * 64]), z);
#pragma unroll
                    for (int rg = 0; rg < 4; ++rg) Zs[(4 * g + rg) * ZS_ST + 16 * ct + c16] = z[rg]; }
                float l = 0.f;
#pragma unroll
                for (int i = 0; i < 16; ++i) { l += -0.60653065971f * sigmoidf_(w0c + Zs[i * ZS_ST + lane]); lam[i] = l; }
            }
            {
                bf16x8 tb[2];
#pragma unroll
                for (int ks = 0; ks < 2; ++ks) tb[ks] = *(const LAS bf16x8*)(PW + PW_LAB + c16 * SG_ST + (32 * ks + 8 * g) * 2);
#pragma unroll
                for (int ct = 0; ct < 4; ++ct) { f32x4 z = {0.f, 0.f, 0.f, 0.f};
#pragma unroll
                    for (int ks = 0; ks < 2; ++ks) z = MFMA16(tb[ks], __builtin_bit_cast(bf16x8, wop[512 + (ct * 2 + ks) * 64]), z);
#pragma unroll
                    for (int rg = 0; rg < 4; ++rg) Zs[(4 * g + rg) * ZS_ST + 16 * ct + c16] = z[rg]; }
#pragma unroll
                for (int i = 0; i < 16; ++i) aa[i] = sigmoidf_(a0c + Zs[i * ZS_ST + lane]);
            }
        }
        {
            float k_[16];
            load_shift16(UB, T, p0, d, cK, mu[oA + cK], mu[oB + cK], k_);
            {
                float n2[16];
#pragma unroll
                for (int i = 0; i < 16; ++i) { const float kk = k_[i] * kkc; n2[i] = kk * kk; }
                wave_sum16(n2, lane);
                unsigned bh[8], kh[8];
#pragma unroll
                for (int i = 0; i < 16; ++i) {
                    const float kk = k_[i] * kkc * (1.f / sqrtf(n2[i] + 1e-12f)), kd = k_[i] * (1.f + (aa[i] - 1.f) * kac), bb = kk * aa[i];
                    const float e1 = i ? __expf(lam[i - 1]) : 1.f, e2 = __expf(-lam[i]);
                    *(LAS bf16*)(GB_ + G_AT + (16 * w + i) * SG_ST + lane * 2) = (bf16)f2bf(-kk * e1);
                    const unsigned btb = f2bf(bb * e2), ktb = f2bf(kd * e2);
                    *(LAS bf16*)(PW + PW_TLW + i * SG_ST + lane * 2) = (bf16)btb;
                    *(LAS bf16*)(PW + PW_LAB + i * SG_ST + lane * 2) = (bf16)ktb;
                    if (i & 1) { bh[i >> 1] |= btb << 16; kh[i >> 1] |= ktb << 16; } else { bh[i >> 1] = btb; kh[i >> 1] = ktb; }
                }
#pragma unroll
                for (int q = 0; q < 4; ++q) {
                    *(LAS v2u*)(GB_ + G_BH + (w * 64 + lane) * 32 + 8 * q) = (v2u){bh[2 * q], bh[2 * q + 1]};
                    *(LAS v2u*)(GB_ + G_KH + (w * 64 + lane) * 32 + 8 * q) = (v2u){kh[2 * q], kh[2 * q + 1]};
                }
            }
            float r_[16];
            load_shift16(UB, T, p0, d, cR, mu[oA + cR], mu[oB + cR], r_);
#pragma unroll
            for (int i = 0; i < 16; ++i) { bon[i] = r_[i] * k_[i] * rkc; *(LAS bf16*)(GB_ + G_RT + (16 * w + i) * SG_ST + lane * 2) = (bf16)f2bf(r_[i] * __expf(lam[i])); }
            wave_sum16(bon, lane);
        }
        ((LAS float*)(GB_ + G_GAM))[w * 64 + lane] = __expf(lam[15]);
        {
            load_shift16(UB, T, p0, d, cV, mu[oA + cV], mu[oB + cV], v_);
            unsigned vt[8];
#pragma unroll
            for (int i = 0; i < 16; ++i) { const unsigned vtb = f2bf(v_[i]); if (i & 1) vt[i >> 1] |= vtb << 16; else vt[i >> 1] = vtb; v_[i] *= bon[i]; }
#pragma unroll
            for (int q = 0; q < 4; ++q) *(LAS v2u*)(PW + PW_VT + lane * VT_ST + 8 * q) = (v2u){vt[2 * q], vt[2 * q + 1]};
        }
        {
            bf16x8 fa[2], fr[2], fb[2], fk[2];
#pragma unroll
            for (int ks = 0; ks < 2; ++ks) {
                fa[ks] = *(const LAS bf16x8*)(GB_ + G_AT + (16 * w + c16) * SG_ST + (32 * ks + 8 * g) * 2); fr[ks] = *(const LAS bf16x8*)(GB_ + G_RT + (16 * w + c16) * SG_ST + (32 * ks + 8 * g) * 2);
                fb[ks] = *(const LAS bf16x8*)(PW + PW_TLW + c16 * SG_ST + (32 * ks + 8 * g) * 2); fk[ks] = *(const LAS bf16x8*)(PW + PW_LAB + c16 * SG_ST + (32 * ks + 8 * g) * 2);
            }
            f32x4 lab = {0.f, 0.f, 0.f, 0.f}, lak = lab, lbr = lab, lkr = lab;
#pragma unroll
            for (int ks = 0; ks < 2; ++ks) { lab = MFMA16(fa[ks], fb[ks], lab); lak = MFMA16(fa[ks], fk[ks], lak); lbr = MFMA16(fr[ks], fb[ks], lbr); lkr = MFMA16(fr[ks], fk[ks], lkr); }
            LAS float* Lf = (LAS float*)(PW + PW_LF);
#pragma unroll
            for (int rg = 0; rg < 4; ++rg) { const int i = 4 * g + rg, j = c16;
                Lf[i * 16 + j] = j < i ? lab[rg] : 0.f;
                *(LAS bf16*)(GB_ + G_LAK + (w * 16 + i) * 32 + j * 2) = (bf16)f2bf(j < i ? lak[rg] : 0.f);
                *(LAS bf16*)(GB_ + G_LBR + (w * 16 + i) * 32 + j * 2) = (bf16)f2bf(j <= i ? lbr[rg] : 0.f);
                *(LAS bf16*)(GB_ + G_LKR + (w * 16 + i) * 32 + j * 2) = (bf16)f2bf(j <= i ? lkr[rg] : 0.f); }
            float tm[16];
#pragma unroll
            for (int i = 0; i < 16; ++i) { float a = (i == c16) ? 1.f : 0.f;
#pragma unroll
                for (int j = 0; j < i; ++j) a += Lf[i * 16 + j] * tm[j];
                tm[i] = a; }
            if (lane < 16) {
#pragma unroll
                for (int i = 0; i < 16; ++i) *(LAS bf16*)(GB_ + G_TM + (w * 16 + i) * 32 + lane * 2) = (bf16)f2bf(tm[i]); }
        }
        __syncthreads();
        const bool first = it < nch / 2;
#pragma unroll 1
        for (int sc = 0; sc < 4; ++sc) {
            lane = lane0; asm volatile("" : "+v"(lane)); c16 = lane & 15; g = lane >> 4;
            const LAS unsigned char* at_p = GB_ + G_AT + (16 * sc + c16) * SG_ST + 8 * g;
            const LAS unsigned char* rt_p = GB_ + G_RT + (16 * sc + c16) * SG_ST + 8 * g;
            const LAS unsigned char* vt_p = GB_ + G_PRIV + sc * PW_SIZE + PW_VT + (16 * w + c16) * VT_ST + 8 * g;
            const bf16x8 sop0 = pk8(S[0], S[1]), sop1 = pk8(S[2], S[3]);
            const bf16x8 at0 = mk8(*(const LAS v2u*)(at_p), *(const LAS v2u*)(at_p + 32)), at1 = mk8(*(const LAS v2u*)(at_p + 64), *(const LAS v2u*)(at_p + 96));
            const bf16x8 rt0 = mk8(*(const LAS v2u*)(rt_p), *(const LAS v2u*)(rt_p + 32)), rt1 = mk8(*(const LAS v2u*)(rt_p + 64), *(const LAS v2u*)(rt_p + 96));
            const v2u vt2 = *(const LAS v2u*)vt_p;
            const bf16x8 alak = mk8(*(const LAS v2u*)(GB_ + G_LAK + (sc * 16 + c16) * 32 + 8 * g), z2);
            const bf16x8 atm = mk8(*(const LAS v2u*)(GB_ + G_TM + (sc * 16 + c16) * 32 + 8 * g), z2);
            const bf16x8 albk = mk8(*(const LAS v2u*)(GB_ + G_LBR + (sc * 16 + c16) * 32 + 8 * g), *(const LAS v2u*)(GB_ + G_LKR + (sc * 16 + c16) * 32 + 8 * g));
            f32x4 X = {0.f, 0.f, 0.f, 0.f};
            X = MFMA16(at0, sop0, X); X = MFMA16(at1, sop1, X); X = MFMA16(alak, mk8(vt2, z2), X);
            const v4u xo = {pk2(X[0], X[1]), pk2(X[2], X[3]), 0u, 0u};
            f32x4 U = {0.f, 0.f, 0.f, 0.f};
            U = MFMA16(atm, __builtin_bit_cast(bf16x8, xo), U);
            const v4u uo = {pk2(U[0], U[1]), pk2(U[2], U[3]), vt2.x, vt2.y};
            const bf16x8 uvop = __builtin_bit_cast(bf16x8, uo);
            float* yp[4];
#pragma unroll
            for (int rg = 0; rg < 4; ++rg) { const int p = it * 64 + sc * 16 + 4 * g + rg, t = d ? T - 1 - p : p; yp[rg] = YB + (size_t)(m0 + t) * D + hh * 64 + 16 * w + c16; }
            f32x4 Y = {0.f, 0.f, 0.f, 0.f};
            if (!first) {
#pragma unroll
                for (int rg = 0; rg < 4; ++rg) Y[rg] = *yp[rg]; }
            Y = MFMA16(rt0, sop0, Y); Y = MFMA16(rt1, sop1, Y); Y = MFMA16(albk, uvop, Y);
#pragma unroll
            for (int rg = 0; rg < 4; ++rg) *yp[rg] = Y[rg];
#pragma unroll
            for (int kt = 0; kt < 4; ++kt) {
                const bf16x8 abk = mk8(*(const LAS v2u*)(GB_ + G_BH + (sc * 64 + 16 * kt + c16) * 32 + 8 * g), *(const LAS v2u*)(GB_ + G_KH + (sc * 64 + 16 * kt + c16) * 32 + 8 * g));
                const f32x4 gm = *(const LAS f32x4*)(GB_ + G_GAM + (sc * 64 + 16 * kt + 4 * g) * 4);
                S[kt] = MFMA16(abk, uvop, S[kt]) * gm;
            }
        }
        __syncthreads();
        if (!first) {
            lane = lane0; asm volatile("" : "+v"(lane)); hc = hh * 64 + lane;
            float y_[16], s1[16];
#pragma unroll
            for (int i = 0; i < 16; ++i) { const int p = p0 + i, t = d ? T - 1 - p : p; y_[i] = YB[(size_t)(m0 + t) * D + hc]; s1[i] = y_[i]; }
            wave_sum16(s1, lane);
#pragma unroll
            for (int i = 0; i < 16; ++i) { y_[i] -= s1[i] * (1.f / 64.f); s1[i] = y_[i] * y_[i]; }
            wave_sum16(s1, lane);
#pragma unroll
            for (int i = 0; i < 16; ++i) { const int p = p0 + i, t = d ? T - 1 - p : p; const size_t m = (size_t)(m0 + t);
                const float yn = y_[i] * (1.f / sqrtf(s1[i] * (1.f / 64.f) + 64e-5f)) * lng + lnb + v_[i];
                MIX[m * DMIX + 1024 + hc] = (bf16)f2bf(yn * bf2f(GBp[m * D + hc])); }
        }
    }
    if (!lat) {
        float* sp = F.out + OUT_ST + st_off;
#pragma unroll
        for (int kt = 0; kt < 4; ++kt) *(f32x4*)(sp + 16 * kt) = S[kt];
    }
}


__device__ __forceinline__ void st_bf16(LAS unsigned char* p, float v) { *(LAS bf16*)p = (bf16)f2bf_hw(v); }
struct PfRows { unsigned off[3]; bool ok[3]; };
__device__ __forceinline__ PfRows pf_rows(int T, int p0, int d, int lane) {
    PfRows R;
#pragma unroll
    for (int q = 0; q < 3; ++q) { const int j = 8 * q + (lane >> 3), jj = j > 17 ? 17 : j, pj = p0 - 1 + jj; int tj = d ? T - 1 - pj : pj; R.ok[q] = tj >= 0 && tj < T; tj = R.ok[q] ? tj : 0;
        R.off[q] = (unsigned)tj * (unsigned)DSH + (unsigned)(lane & 7) * 8u; }
    return R;
}
__device__ __forceinline__ void pf_issue(const bf16* ubase, const PfRows& R, int colb, v4u (&r)[3]) {
#pragma unroll
    for (int q = 0; q < 3; ++q) { v4u x = *(const v4u*)(ubase + colb + R.off[q]); if (!R.ok[q]) x = (v4u){0u, 0u, 0u, 0u}; r[q] = x; }
}
__device__ __forceinline__ void pf_consume(LAS unsigned char* stg, const v4u (&r)[3], int lane, float mA, float mB, float (&out)[16]) {
#pragma unroll
    for (int q = 0; q < 3; ++q) *(LAS v4u*)(stg + (8 * q + (lane >> 3)) * SG_ST + (lane & 7) * 16) = r[q];
    asm volatile("" ::: "memory");
    float u[18];
#pragma unroll
    for (int j = 0; j < 18; ++j) u[j] = bf2f(*(const LAS bf16*)(stg + j * SG_ST + lane * 2));
    asm volatile("" ::: "memory");
    const float m0_ = 1.f - mA - mB;
#pragma unroll
    for (int i = 0; i < 16; ++i) out[i] = m0_ * u[i + 1] + mA * u[i] + mB * u[i + 2];
}
__device__ __forceinline__ void scan_unit3(Frame& F, int b, int hh, bool lat, const XcdBarrier* gbar = nullptr, int gbar_it = -1) {
    const int T = lat ? LSEQ : SEQ, m0 = lat ? MC + b * LSEQ : b * SEQ, nch = T / 64;
    int lane0 = F.lane; asm volatile("" : "+v"(lane0));
    const int d = F.wave >> 2, w = F.wave & 3;
    int lane = lane0, c16 = lane & 15, g = lane >> 4, hc = hh * 64 + lane;
    LAS unsigned char* GB_ = F.lds + d * G_SIZE;
    LAS unsigned char* PW = GB_ + G_PRIV + w * PW_SIZE;
    const bf16* UB = (const bf16*)(F.ws + WS_UB) + (size_t)m0 * DSH; const bf16* GBp = (const bf16*)(F.ws + WS_GB); bf16* MIX = (bf16*)(F.ws + WS_MIX);
    float* YB = F.out + OUT_Y;
    const float* mu = F.in[I_MU];
    const int cR = hh * 64, cK = 1024 + hh * 64, cV = 2048 + hh * 64, cW = 3072 + 64 * d, cA = 3200 + 64 * d;
    const int oA = d ? DSH : 0, oB = d ? 0 : DSH;
    const float kkc = F.in[I_KK][hc], kac = F.in[I_KA][hc], rkc = F.in[I_RK][hc], w0c = F.in[I_W0][d * D + hc], a0c = F.in[I_A0][d * D + hc];
    const float mWA = mu[oA + cW + lane], mWB = mu[oB + cW + lane], mAA = mu[oA + cA + lane], mAB = mu[oB + cA + lane], mKA = mu[oA + cK + lane], mKB = mu[oB + cK + lane];
    const float mRA = mu[oA + cR + lane], mRB = mu[oB + cR + lane], mVA = mu[oA + cV + lane], mVB = mu[oB + cV + lane];
    const v4u* wop0 = (const v4u*)(F.ws + WS_WOP) + (size_t)((d * 16 + hh) * 2) * 8 * 64;
    f32x4 S[4];
    { const size_t st_off = ((size_t)((b * 2 + d) * NHB + hh) * 64 + 16 * w + c16) * 64 + 4 * g;
#pragma unroll
    for (int kt = 0; kt < 4; ++kt) S[kt] = lat ? *(const f32x4*)(F.in[I_ST] + st_off + 16 * kt) : (f32x4){0.f, 0.f, 0.f, 0.f}; }
    const v2u z2 = {0u, 0u};
    v4u pW[3], pA[3], pK[3], pR[3], pV[3];
    { const PfRows R = pf_rows(T, w * 16, d, lane); pf_issue(UB, R, cW, pW); pf_issue(UB, R, cA, pA); pf_issue(UB, R, cK, pK); pf_issue(UB, R, cR, pR); pf_issue(UB, R, cV, pV); }
    __syncthreads();
    for (int it = 0; it < nch; ++it) {
        if (it == gbar_it) xcd_barrier(*gbar);
        const int p0 = it * 64 + w * 16;
        const bool first = it < nch / 2;
        lane = lane0; asm volatile("" : "+v"(lane));
        c16 = lane & 15; g = lane >> 4; hc = hh * 64 + lane;
        const v4u* wop = wop0 + lane;
        LAS unsigned char* stg = PW + PW_ZS;
        float bon[16], v_[16];
#ifndef SREP_PREP
#define SREP_PREP 1
#endif
#ifndef SREP_POST
#define SREP_POST 1
#endif
#ifndef SREP_B
#define SREP_B 1
#endif
#pragma unroll 1
        for (int rep_ = 0; rep_ < SREP_PREP; ++rep_) {
        {
            float x_[16];
            pf_consume(stg, pW, lane, mWA, mWB, x_);
#pragma unroll
            for (int i = 0; i < 16; ++i) { const float e = __expf(2.f * x_[i]); st_bf16(PW + PW_TLW + i * SG_ST + lane * 2, 1.f - 2.f * __builtin_amdgcn_rcpf(e + 1.f)); }
            pf_consume(stg, pA, lane, mAA, mAB, x_);
#pragma unroll
            for (int i = 0; i < 16; ++i) st_bf16(PW + PW_LAB + i * SG_ST + lane * 2, x_[i]);
        }
        float k_[16];
        pf_consume(stg, pK, lane, mKA, mKB, k_);
        asm volatile("" ::: "memory");
        float lam[16], aa[16];
        {
            LAS float* Zs = (LAS float*)(PW + PW_ZS);
            {
                bf16x8 ta[2];
#pragma unroll
                for (int ks = 0; ks < 2; ++ks) ta[ks] = *(const LAS bf16x8*)(PW + PW_TLW + c16 * SG_ST + (32 * ks + 8 * g) * 2);
#pragma unroll
                for (int ct = 0; ct < 4; ++ct) { f32x4 z = {0.f, 0.f, 0.f, 0.f};
#pragma unroll
                    for (int ks = 0; ks < 2; ++ks) z = MFMA16(ta[ks], __builtin_bit_cast(bf16x8, wop[(ct * 2 + ks) * 64]), z);
#pragma unroll
                    for (int rg = 0; rg < 4; ++rg) Zs[(4 * g + rg) * ZS_ST + 16 * ct + c16] = z[rg]; }
                float l = 0.f;
#pragma unroll
                for (int i = 0; i < 16; ++i) { l += -0.60653065971f * sigmoidf_(w0c + Zs[i * ZS_ST + lane]); lam[i] = l; }
            }
            asm volatile("" ::: "memory");
            {
                bf16x8 tb[2];
#pragma unroll
                for (int ks = 0; ks < 2; ++ks) tb[ks] = *(const LAS bf16x8*)(PW + PW_LAB + c16 * SG_ST + (32 * ks + 8 * g) * 2);
#pragma unroll
                for (int ct = 0; ct < 4; ++ct) { f32x4 z = {0.f, 0.f, 0.f, 0.f};
#pragma unroll
                    for (int ks = 0; ks < 2; ++ks) z = MFMA16(tb[ks], __builtin_bit_cast(bf16x8, wop[512 + (ct * 2 + ks) * 64]), z);
#pragma unroll
                    for (int rg = 0; rg < 4; ++rg) Zs[(4 * g + rg) * ZS_ST + 16 * ct + c16] = z[rg]; }
#pragma unroll
                for (int i = 0; i < 16; ++i) aa[i] = sigmoidf_(a0c + Zs[i * ZS_ST + lane]);
            }
        }
        {
            {
                float n2[16];
#pragma unroll
                for (int i = 0; i < 16; ++i) { const float kk = k_[i] * kkc; n2[i] = kk * kk; }
                wave_sum16(n2, lane);
                unsigned bh[8], kh[8];
                float e1 = 1.f;
#pragma unroll
                for (int i = 0; i < 16; i += 2) {
                    float bt2[2], kt2[2];
#pragma unroll
                    for (int e = 0; e < 2; ++e) {
                        const float kk = k_[i + e] * kkc * __builtin_amdgcn_rsqf(n2[i + e] + 1e-12f), kd = k_[i + e] * (1.f + (aa[i + e] - 1.f) * kac), bb = kk * aa[i + e];
                        const float e3 = __expf(lam[i + e]), e2 = __builtin_amdgcn_rcpf(e3);
                        lam[i + e] = e3;
                        st_bf16(GB_ + G_AT + (16 * w + i + e) * SG_ST + lane * 2, -kk * e1);
                        bt2[e] = bb * e2; kt2[e] = kd * e2; e1 = e3;
                    }
                    const unsigned bp = pk2(bt2[0], bt2[1]), kp = pk2(kt2[0], kt2[1]);
                    bh[i >> 1] = bp; kh[i >> 1] = kp;
                    *(LAS bf16*)(PW + PW_TLW + i * SG_ST + lane * 2) = (bf16)bp; *(LAS bf16*)(PW + PW_TLW + (i + 1) * SG_ST + lane * 2) = (bf16)(bp >> 16);
                    *(LAS bf16*)(PW + PW_LAB + i * SG_ST + lane * 2) = (bf16)kp; *(LAS bf16*)(PW + PW_LAB + (i + 1) * SG_ST + lane * 2) = (bf16)(kp >> 16);
                }
#pragma unroll
                for (int q = 0; q < 4; ++q) {
                    *(LAS v2u*)(GB_ + G_BH + (w * 64 + lane) * 32 + 8 * q) = (v2u){bh[2 * q], bh[2 * q + 1]};
                    *(LAS v2u*)(GB_ + G_KH + (w * 64 + lane) * 32 + 8 * q) = (v2u){kh[2 * q], kh[2 * q + 1]};
                }
            }
            float r_[16];
            pf_consume(stg, pR, lane, mRA, mRB, r_);
#pragma unroll
            for (int i = 0; i < 16; ++i) { bon[i] = r_[i] * k_[i] * rkc; st_bf16(GB_ + G_RT + (16 * w + i) * SG_ST + lane * 2, r_[i] * lam[i]); }
            wave_sum16(bon, lane);
        }
        ((LAS float*)(GB_ + G_GAM))[w * 64 + lane] = lam[15];
        {
            pf_consume(stg, pV, lane, mVA, mVB, v_);
            unsigned vt[8];
#pragma unroll
            for (int i = 0; i < 16; i += 2) { vt[i >> 1] = pk2(v_[i], v_[i + 1]); v_[i] *= bon[i]; v_[i + 1] *= bon[i + 1]; }
            asm volatile("" ::: "memory");
#pragma unroll
            for (int q = 0; q < 4; ++q) *(LAS v2u*)(PW + PW_VT + lane * VT_ST + 8 * q) = (v2u){vt[2 * q], vt[2 * q + 1]};
        }
        asm volatile("" ::: "memory");
        {
            bf16x8 fa[2], fr[2], fb[2], fk[2];
#pragma unroll
            for (int ks = 0; ks < 2; ++ks) {
                fa[ks] = *(const LAS bf16x8*)(GB_ + G_AT + (16 * w + c16) * SG_ST + (32 * ks + 8 * g) * 2); fr[ks] = *(const LAS bf16x8*)(GB_ + G_RT + (16 * w + c16) * SG_ST + (32 * ks + 8 * g) * 2);
                fb[ks] = *(const LAS bf16x8*)(PW + PW_TLW + c16 * SG_ST + (32 * ks + 8 * g) * 2); fk[ks] = *(const LAS bf16x8*)(PW + PW_LAB + c16 * SG_ST + (32 * ks + 8 * g) * 2);
            }
            f32x4 lab = {0.f, 0.f, 0.f, 0.f}, lak = lab, lbr = lab, lkr = lab;
#pragma unroll
            for (int ks = 0; ks < 2; ++ks) { lab = MFMA16(fa[ks], fb[ks], lab); lak = MFMA16(fa[ks], fk[ks], lak); lbr = MFMA16(fr[ks], fb[ks], lbr); lkr = MFMA16(fr[ks], fk[ks], lkr); }
            LAS float* Lf = (LAS float*)(PW + PW_LF);
#pragma unroll
            for (int rg = 0; rg < 4; ++rg) { const int i = 4 * g + rg, j = c16;
                Lf[i * 16 + j] = j < i ? lab[rg] : 0.f;
                st_bf16(GB_ + G_LAK + (w * 16 + i) * 32 + j * 2, j < i ? lak[rg] : 0.f);
                st_bf16(GB_ + G_LBR + (w * 16 + i) * 32 + j * 2, j <= i ? lbr[rg] : 0.f);
                st_bf16(GB_ + G_LKR + (w * 16 + i) * 32 + j * 2, j <= i ? lkr[rg] : 0.f); }
            float tm[16];
#pragma unroll
            for (int i = 0; i < 16; ++i) { float a = (i == c16) ? 1.f : 0.f;
#pragma unroll
                for (int j = 0; j < i; ++j) a += Lf[i * 16 + j] * tm[j];
                tm[i] = a; }
            if (lane < 16) {
#pragma unroll
                for (int i = 0; i < 16; ++i) st_bf16(GB_ + G_TM + (w * 16 + i) * 32 + lane * 2, tm[i]); }
        }
        }
        __syncthreads();
        if (it + 1 < nch) { const PfRows R = pf_rows(T, p0 + 64, d, lane); pf_issue(UB, R, cW, pW); pf_issue(UB, R, cA, pA); pf_issue(UB, R, cK, pK); pf_issue(UB, R, cR, pR); pf_issue(UB, R, cV, pV); }
        float yo[16];
        if (!first) {
#pragma unroll
            for (int i = 0; i < 16; ++i) { const int p = p0 + i, t = d ? T - 1 - p : p; yo[i] = YB[(size_t)(m0 + t) * D + hc]; } }
        {
            lane = lane0; asm volatile("" : "+v"(lane)); c16 = lane & 15; g = lane >> 4;
            const LAS unsigned char* at_b = GB_ + G_AT + c16 * SG_ST + 8 * g;
            const LAS unsigned char* rt_b = GB_ + G_RT + c16 * SG_ST + 8 * g;
            const LAS unsigned char* vt_b = GB_ + G_PRIV + PW_VT + (16 * w + c16) * VT_ST + 8 * g;
            const LAS unsigned char* l_b = GB_ + c16 * 32 + 8 * g;
            const LAS unsigned char* gm_b = GB_ + G_GAM + 16 * g;
            LAS float* yc_b = (LAS float*)(GB_ + G_PRIV + PW_TLW) + (4 * g) * ZS_ST + 16 * w + c16;
#pragma unroll
            for (int sc = 0; sc < 4; ++sc) {
                const LAS unsigned char* at_p = at_b + sc * 16 * SG_ST; const LAS unsigned char* rt_p = rt_b + sc * 16 * SG_ST;
                const bf16x8 sop0 = pk8(S[0], S[1]), sop1 = pk8(S[2], S[3]);
                const bf16x8 at0 = mk8(*(const LAS v2u*)(at_p), *(const LAS v2u*)(at_p + 32)), at1 = mk8(*(const LAS v2u*)(at_p + 64), *(const LAS v2u*)(at_p + 96));
                const bf16x8 rt0 = mk8(*(const LAS v2u*)(rt_p), *(const LAS v2u*)(rt_p + 32)), rt1 = mk8(*(const LAS v2u*)(rt_p + 64), *(const LAS v2u*)(rt_p + 96));
                const v2u vt2 = *(const LAS v2u*)(vt_b + sc * PW_SIZE);
                const bf16x8 alak = mk8(*(const LAS v2u*)(l_b + G_LAK + sc * 512), z2);
                const bf16x8 atm = mk8(*(const LAS v2u*)(l_b + G_TM + sc * 512), z2);
                const bf16x8 albk = mk8(*(const LAS v2u*)(l_b + G_LBR + sc * 512), *(const LAS v2u*)(l_b + G_LKR + sc * 512));
                f32x4 X = {0.f, 0.f, 0.f, 0.f}, Y = X;
                X = MFMA16(at0, sop0, X); Y = MFMA16(rt0, sop0, Y); X = MFMA16(at1, sop1, X); Y = MFMA16(rt1, sop1, Y); X = MFMA16(alak, mk8(vt2, z2), X);
                const v4u xo = {pk2(X[0], X[1]), pk2(X[2], X[3]), 0u, 0u};
                f32x4 U = {0.f, 0.f, 0.f, 0.f};
                U = MFMA16(atm, __builtin_bit_cast(bf16x8, xo), U);
                const v4u uo = {pk2(U[0], U[1]), pk2(U[2], U[3]), vt2.x, vt2.y};
                const bf16x8 uvop = __builtin_bit_cast(bf16x8, uo);
                Y = MFMA16(albk, uvop, Y);
#pragma unroll
                for (int kt = 0; kt < 4; ++kt) {
                    const bf16x8 abk = mk8(*(const LAS v2u*)(l_b + G_BH + (sc * 64 + 16 * kt) * 32), *(const LAS v2u*)(l_b + G_KH + (sc * 64 + 16 * kt) * 32));
                    const f32x4 gm = *(const LAS f32x4*)(gm_b + (sc * 64 + 16 * kt) * 4);
                    S[kt] = MFMA16(abk, uvop, S[kt]) * gm;
                }
                LAS float* yc = yc_b + sc * (PW_SIZE / 4);
#pragma unroll
                for (int rg = 0; rg < 4; ++rg) yc[rg * ZS_ST] = Y[rg];
            }
        }
        __syncthreads();
#pragma unroll 1
        for (int rep_ = 0; rep_ < SREP_POST; ++rep_)
        {
            lane = lane0; asm volatile("" : "+v"(lane)); hc = hh * 64 + lane;
            const LAS float* yc = (const LAS float*)(PW + PW_TLW);
            float y_[16];
#pragma unroll
            for (int i = 0; i < 16; ++i) y_[i] = yc[i * ZS_ST + lane];
            if (first) {
#pragma unroll
                for (int i = 0; i < 16; ++i) { const int p = p0 + i, t = d ? T - 1 - p : p; YB[(size_t)(m0 + t) * D + hc] = y_[i]; }
            } else {
                const float lng = F.in[I_LNG][hc], lnb = F.in[I_LNB][hc];
                float s1[16];
#pragma unroll
                for (int i = 0; i < 16; ++i) { y_[i] += yo[i]; s1[i] = y_[i]; }
                wave_sum16(s1, lane);
#pragma unroll
                for (int i = 0; i < 16; ++i) { y_[i] -= s1[i] * (1.f / 64.f); s1[i] = y_[i] * y_[i]; }
                wave_sum16(s1, lane);
#pragma unroll
                for (int i = 0; i < 16; ++i) { const int p = p0 + i, t = d ? T - 1 - p : p; const size_t m = (size_t)(m0 + t);
                    const float yn = y_[i] * __builtin_amdgcn_rsqf(s1[i] * (1.f / 64.f) + 64e-5f) * lng + lnb + v_[i];
                    MIX[m * DMIX + 1024 + hc] = (bf16)f2bf_hw(yn * bf2f(GBp[m * D + hc])); }
            }
        }
    }
    if (!lat) {
        lane = lane0; asm volatile("" : "+v"(lane)); c16 = lane & 15; g = lane >> 4;
        float* sp = F.out + OUT_ST + ((size_t)((b * 2 + d) * NHB + hh) * 64 + 16 * w + c16) * 64 + 4 * g;
#pragma unroll
        for (int kt = 0; kt < 4; ++kt) *(f32x4*)(sp + 16 * kt) = S[kt];
    }
}

template <int QW, int MASK> __device__ __forceinline__ void p3_mixers(Frame& F, const XcdBarrier& gbar) {
    float lam;
    { const float a = F.in[I_LQ1][F.lane] * F.in[I_LK1][F.lane], bq = F.in[I_LQ2][F.lane] * F.in[I_LK2][F.lane];
      lam = __expf(wave_sum(a)) - __expf(wave_sum(bq)) + 0.2f; }
    constexpr int N_SC = NBC * NHB, N_AL = NBL * NH * (LSEQ / 128), N_AC = NBC * NH * (SEQ / 128);
    constexpr int NU = N_AL + N_SC + N_AC;
    volatile LAS int* slot = (volatile LAS int*)(F.lds + MISC_OFF + 64);
    bool chain_first = (int)blockIdx.x < NLATB;
    for (;;) {
        int u, sb, sh, git = -1; bool slat = false, is_scan;
        if (chain_first) { chain_first = false; is_scan = true; slat = true; sb = (int)blockIdx.x / NHB; sh = (int)blockIdx.x % NHB; git = LAT_BAR_IT; u = 0; }
        else {
            __syncthreads();
            if (F.tid == 0) *slot = (int)__hip_atomic_fetch_add((unsigned*)(F.ctl + CW_Q3 + 64 * QW), 1u, RLX_AGENT);
            __syncthreads();
            u = *slot;
            if (u >= NU) break;
            is_scan = u < N_SC;
            sb = u / NHB; sh = u % NHB;
        }
        if (is_scan) { scan_unit3(F, sb, sh, slat, &gbar, git); continue; }
        { u -= N_SC; const bool lt = u < N_AL; if (!lt) u -= N_AL; attn_unit(F, u, lt, lam); }
    }
}

template <bool DUMMY> __device__ __forceinline__ void p5_final(Frame& F) {
    int ln = F.lane; asm volatile("" : "+v"(ln));
    const float* ssq = (const float*)(F.ws + WS_SSQ);
    const int gw = blockIdx.x * NWAVES + F.wave, NGW = F.G * NWAVES;
    for (int m = gw; m < M; m += NGW) {
        float s = ln < 16 ? ssq[(size_t)m * 16 + ln] : 0.f;
        s = wave_sum(s);
        const float rstd = 1.f / sqrtf(s * (1.f / D) + 1e-6f);
        float* yr = F.out + OUT_Y + (size_t)m * D;
#pragma unroll
        for (int j = 0; j < 4; ++j) { const int c = 4 * ln + 256 * j; const f32x4 v = *(const f32x4*)(yr + c), g = *(const f32x4*)(F.in[I_FG] + c); *(f32x4*)(yr + c) = DUMMY ? v : v * rstd * g; }
    }
}

__global__ void __launch_bounds__(NTHR, 2) hymba_fwd(Args args) {
    extern __shared__ __attribute__((aligned(16))) unsigned char lds[];
    Frame F;
    F.lds = (LAS unsigned char*)lds;
    F.MISC = (volatile LAS unsigned*)(F.lds + MISC_OFF);
    F.tid = threadIdx.x; F.lane = F.tid & 63; F.wave = __builtin_amdgcn_readfirstlane(F.tid >> 6);
    F.G = gridDim.x; F.in = args.in; F.out = args.out; F.ws = args.ws;
    F.ctl = (gu32*)(args.ws + WS_CTL);
    for (int u = F.tid; u < (LDS_BYTES - LDSCTL_OFF) / 4; u += NTHR) ((LAS unsigned*)(F.lds + LDSCTL_OFF))[u] = 0u;
    __syncthreads();
    XcdBarrier bar; bar.bar = (unsigned*)(F.ctl + CW_BAR); bar.x = 0; bar.st = nullptr;
    if (N_LAUNCHES != PER_PHASE) bar = xcd_barrier_post((unsigned*)(F.ctl + CW_BAR), F.MISC + 8);
#define GRID_BAR() do { if (N_LAUNCHES != PER_PHASE) xcd_barrier(bar); } while (0)
    const int lo = args.ph_lo, hi = args.ph_hi;
#define IN(k) (lo <= (k) && (k) < hi)
#define BOTH(k) (IN(k) && IN((k) + 1))
#ifndef REP0
#define REP0 1
#endif
#ifndef REP2
#define REP2 1
#endif
#ifndef REP3MASK
#define REP3MASK 0
#endif
#ifndef REP4
#define REP4 1
#endif
#define RELANE() do { int t_ = threadIdx.x; asm volatile("" : "+v"(t_)); F.tid = t_; F.lane = t_ & 63; } while (0)
    {
        f32x4 xv[5][4];
        p0_prologue(F); RELANE(); p1_load<0, 3>(F, xv); GRID_BAR();
        p1_load<3, 5>(F, xv); p1_norm(F, xv); GRID_BAR();
    }
    RELANE();
    if (IN(2)) {
        const pg8::Gemm g{(const bf16*)(F.ws + WS_XN), (const bf16*)(F.ws + WS_WIN), M, DIN, D};
        const EpiIn E{F.ws, F.out};
        const bool chain = (int)blockIdx.x < NLATB;
#pragma unroll 1
        for (int part = 0; part < 2; ++part) {
            if (part == 1 && chain) break;
            ListOrder S;
            if (part == 0) S.init(F.G, (int)blockIdx.x, 0, P2A_UNITS); else S.init(F.G - NLATB, (int)blockIdx.x - NLATB, P2A_UNITS, P2_UNITS);
            pg8::gemm_phase<EpiIn, ListOrder, true, true>(F.lds + RING_OFF, g, S, E);
            GRID_BAR();
        }
    }
    RELANE();
    if (IN(3)) { p3_mixers<0, 15>(F, bar); if (BOTH(3)) GRID_BAR(); }
    RELANE();
    if (IN(4)) {
        pg8::Gemm g{(const bf16*)(F.ws + WS_MIX), (const bf16*)(F.ws + WS_WOUT), M, D, DMIX}; pg8::StaticOrder S; S.init(M, D, F.G, (int)blockIdx.x);
        EpiOutFused E{F.ws, F.out, F.in[I_XP], F.in[I_XS], F.in[I_FG], F.ctl};
        pg8::gemm_phase<EpiOutFused, pg8::StaticOrder, false, true>(F.lds + RING_OFF, g, S, E);
    }
#undef IN
#undef BOTH
}

extern "C" void kernel_launch(void* const* d_in, const int* in_sizes, int n_in, void* d_out, int out_size, void* d_ws, size_t ws_size, hipStream_t stream) {
    static int grid = 0;
    if (grid == 0) {
        if (n_in != N_IN || out_size != OUT_END || ws_size < WS_END) { fprintf(stderr, "kernel_launch: unexpected sizes n_in %d out %d ws %zu\n", n_in, out_size, ws_size); grid = -1; return; }
        int dev = 0, cus = 0, per_cu = 0;
        if (hipGetDevice(&dev) != hipSuccess || hipDeviceGetAttribute(&cus, hipDeviceAttributeMultiprocessorCount, dev) != hipSuccess) { grid = -1; return; }
        if (hipFuncSetAttribute((const void*)hymba_fwd, hipFuncAttributeMaxDynamicSharedMemorySize, LDS_BYTES) != hipSuccess) { fprintf(stderr, "kernel_launch: hipFuncSetAttribute failed\n"); grid = -1; return; }
        if (hipOccupancyMaxActiveBlocksPerMultiprocessor(&per_cu, (const void*)hymba_fwd, NTHR, LDS_BYTES) != hipSuccess || per_cu < 1) { fprintf(stderr, "kernel_launch: occupancy query says %d\n", per_cu); per_cu = 1; }
        (void)hipGetLastError();
        grid = cus;
        if (grid != 256) { fprintf(stderr, "kernel_launch: built for a 256-CU device (got %d CUs)\n", cus); grid = -1; return; }
    }
    if (grid < 0) return;
    if (hipMemsetAsync((char*)d_ws + WS_CTL, 0, CTL_ZERO_BYTES, stream) != hipSuccess) return;
    Args a{};
    for (int i = 0; i < N_IN; ++i) a.in[i] = (const float*)d_in[i];
    a.out = (float*)d_out; a.ws = (unsigned char*)d_ws;
    a.ph_lo = 0; a.ph_hi = PER_PHASE; a.li = 0;
    hipLaunchKernelGGL(hymba_fwd, dim3(grid), dim3(NTHR), LDS_BYTES, stream, a);
}
```

```cpp
#include <hip/hip_runtime.h>
#include <cstdio>
#include <cstdint>

#ifndef MK_N_LAUNCHES
#define MK_N_LAUNCHES 1
#endif

namespace pg8 {
#define PG8_LAS __attribute__((address_space(3)))
typedef unsigned short bf16_t;
typedef short bf16x8 __attribute__((ext_vector_type(8)));
typedef float f32x4 __attribute__((ext_vector_type(4)));
typedef unsigned u32x4 __attribute__((ext_vector_type(4)));
constexpr int BM = 256, BK = 64, HALF = 128, HTB = HALF * BK * 2, STAGE_BYTES = 8 * HTB, NXCD = 8, WGM = 8;

__host__ __device__ __forceinline__ int lds_byte(int r, int c) { const int st = (r >> 4) * 2 + (c >> 5), rr = r & 15, cc = c & 31, ob = rr * 64 + cc * 2; return st * 1024 + (ob ^ (((ob >> 9) & 1) << 5)); }
__host__ __device__ __forceinline__ void stage_rc(int b, int& R, int& C) { const int st = b / 1024, sb = b % 1024, swz = sb ^ (((sb >> 9) & 1) << 5); R = (st >> 1) * 16 + swz / 64; C = (st & 1) * 32 + (swz % 64) / 2; }
__host__ __device__ __forceinline__ int perm32(int rho) { const int n = rho >> 4, i = rho & 15; return 8 * (i >> 2) + 4 * n + (i & 3); }

struct Unit { int pm, pn; };
struct Gemm { const bf16_t* A; const bf16_t* Bt; int M, N, K; };

struct StaticOrder {
    int nM, nN, nwg, G, c;
    __host__ __device__ void init(int M, int N, int G_, int c_) { nM = M / BM; nN = N / BM; nwg = nM * nN; G = G_; c = c_; }
    __host__ __device__ bool next(int i, Unit& u) const {
        const long L = (long)i * G + c; if (L >= nwg) return false;
        int wgid = (int)L; { const int q = nwg / NXCD, r = nwg % NXCD, xcd = wgid % NXCD, off = wgid / NXCD; wgid = (xcd < r ? xcd * (q + 1) : r * (q + 1) + (xcd - r) * q) + off; }
        const int nig = WGM * nN, gid = wgid / nig, fm = gid * WGM, gsz = (nM - fm) < WGM ? (nM - fm) : WGM;
        u.pm = fm + ((wgid % nig) % gsz); u.pn = (wgid % nig) / gsz; return true;
    }
    __device__ __forceinline__ void a_ready(const Unit&) const {}
    __device__ __forceinline__ void done(const Unit&) const {}
};

__device__ __forceinline__ unsigned cvt_pk_bf16(float lo, float hi) { unsigned r; asm volatile("v_cvt_pk_bf16_f32 %0, %1, %2" : "=v"(r) : "v"(lo), "v"(hi)); return r; }

template <class Epi, class Sched, bool ALIGN_EPI = false, bool SP2 = false>
__device__ __forceinline__ void gemm_phase(PG8_LAS unsigned char* lds, const Gemm g, const Sched& S, const Epi& E) {
    int tid = threadIdx.x; asm volatile("" : "+v"(tid));
    const int wid = __builtin_amdgcn_readfirstlane(tid >> 6), lane = tid & 63, wr = wid >> 2, wc = wid & 3, fr = lane & 15, fq = lane >> 4;
    const int K = g.K, nt = K / BK;
    unsigned voffA[2], voffB[2];
#pragma unroll
    for (int i = 0; i < 2; ++i) { int R, C; stage_rc(tid * 16 + i * 8192, R, C); const int Rb = Epi::PERM ? ((R & ~31) + perm32(R & 31)) : R;
        voffA[i] = (unsigned)(R * K + C) * 2u; voffB[i] = (unsigned)(Rb * K + C) * 2u; }
    const size_t kstep = (size_t)(BK * 2);
    const size_t hstep = (size_t)HALF * K * 2;
    const size_t tstep = 2 * hstep;
    const unsigned ldsw = (unsigned)wid * 1024u;
    const int aoff = lds_byte(wr * 64 + fr, fq * 8), boff = lds_byte(wc * 32 + fr, fq * 8);
#define PG8_SA(b, h) (((b) * 2 + (h)) * HTB)
#define PG8_SB(b, h) ((4 + (b) * 2 + (h)) * HTB)
#define PG8_STAGE(bufoff, gbase, voff) do { _Pragma("unroll") for (int _i = 0; _i < 2; ++_i) \
        __builtin_amdgcn_global_load_lds((const unsigned*)((const char*)(gbase) + (voff)[_i]), (PG8_LAS unsigned*)(lds + (bufoff) + ldsw + _i * 8192), 16, 0, 0); } while (0)
#define PG8_LDA(dst, b, h) do { _Pragma("unroll") for (int m = 0; m < 4; ++m) _Pragma("unroll") for (int k = 0; k < 2; ++k) dst[m][k] = *(const PG8_LAS bf16x8*)(lds + PG8_SA(b, h) + aoff + m * 2048 + k * 1024); } while (0)
#define PG8_LDB(dst, b, h) do { _Pragma("unroll") for (int n = 0; n < 2; ++n) _Pragma("unroll") for (int k = 0; k < 2; ++k) dst[n][k] = *(const PG8_LAS bf16x8*)(lds + PG8_SB(b, h) + boff + n * 2048 + k * 1024); } while (0)
#define PG8_MMA(ai, bj, At, Bt) do { __builtin_amdgcn_s_setprio(1); _Pragma("unroll") for (int m = 0; m < 4; ++m) _Pragma("unroll") for (int n = 0; n < 2; ++n) _Pragma("unroll") for (int k = 0; k < 2; ++k) \
        acc[ai][bj][m][n] = __builtin_amdgcn_mfma_f32_16x16x32_bf16(Bt[n][k], At[m][k], acc[ai][bj][m][n], 0, 0, 0); __builtin_amdgcn_s_setprio(0); } while (0)
#define PG8_WAIT_V(n) asm volatile("s_waitcnt vmcnt(" #n ")" ::: "memory")
#define PG8_WAIT_L(n) asm volatile("s_waitcnt lgkmcnt(" #n ")" ::: "memory")
#define PG8_BAR __builtin_amdgcn_s_barrier()
#define PG8_SCHED __builtin_amdgcn_sched_barrier(0)
    Unit cur, nxt; int ui = 0;
    if (!S.next(0, cur)) return;
    f32x4 acc[2][2][4][2];
#pragma unroll
    for (int a = 0; a < 2; ++a)
#pragma unroll
        for (int b = 0; b < 2; ++b)
#pragma unroll
            for (int m = 0; m < 4; ++m)
#pragma unroll
                for (int n = 0; n < 2; ++n) acc[a][b][m][n] = (f32x4){0.f, 0.f, 0.f, 0.f};
    bf16x8 At[4][2], B0[2][2], B1[2][2];
    const char* cA = (const char*)g.A + (size_t)cur.pm * tstep; const char* cB = (const char*)g.Bt + (size_t)cur.pn * tstep;
    S.a_ready(cur);
    if constexpr (SP2) {
        PG8_STAGE(PG8_SB(0, 0), cB, voffB); PG8_STAGE(PG8_SB(0, 1), cB + hstep, voffB); PG8_STAGE(PG8_SA(0, 0), cA, voffA); PG8_STAGE(PG8_SA(0, 1), cA + hstep, voffA);
        if (wr == 1) PG8_BAR;
        PG8_WAIT_V(2); PG8_BAR;
        PG8_STAGE(PG8_SB(1, 0), cB + kstep, voffB); PG8_STAGE(PG8_SA(1, 0), cA + kstep, voffA); PG8_STAGE(PG8_SB(1, 1), cB + hstep + kstep, voffB);
        PG8_WAIT_V(6); PG8_BAR;
    } else {
        PG8_STAGE(PG8_SB(0, 0), cB, voffB); PG8_STAGE(PG8_SA(0, 0), cA, voffA); PG8_STAGE(PG8_SB(0, 1), cB + hstep, voffB); PG8_STAGE(PG8_SA(0, 1), cA + hstep, voffA);
        if (wr == 1) PG8_BAR;
        PG8_WAIT_V(4); PG8_BAR;
        PG8_STAGE(PG8_SB(1, 0), cB + kstep, voffB); PG8_STAGE(PG8_SA(1, 0), cA + kstep, voffA); PG8_STAGE(PG8_SB(1, 1), cB + hstep + kstep, voffB);
        PG8_WAIT_V(6); PG8_BAR;
    }
    for (;;) {
        const bool has_next = S.next(ui + 1, nxt);
        const char* nA = has_next ? (const char*)g.A + (size_t)nxt.pm * tstep : cA; const char* nB = has_next ? (const char*)g.Bt + (size_t)nxt.pn * tstep : cB;
        for (int t = 0; t < nt; t += 2) {
            const bool last = (t == nt - 2);
            const char* a1 = cA + (size_t)(t + 1) * kstep;
            const char* a2 = last ? nA : cA + (size_t)(t + 2) * kstep; const char* b2 = last ? nB : cB + (size_t)(t + 2) * kstep;
            const char* a3 = a2 + kstep; const char* b3 = b2 + kstep;
            if (last && has_next) S.a_ready(nxt);
            if constexpr (SP2) {
            PG8_LDB(B0, 0, 0); PG8_LDB(B1, 0, 1); PG8_SCHED; PG8_LDA(At, 0, 0); PG8_STAGE(PG8_SA(1, 1), a1 + hstep, voffA);
            PG8_WAIT_V(8); PG8_WAIT_L(0); PG8_BAR; PG8_MMA(0, 0, At, B0); PG8_MMA(0, 1, At, B1); PG8_BAR; PG8_SCHED;
            PG8_LDA(At, 0, 1); PG8_STAGE(PG8_SB(0, 0), b2, voffB); PG8_STAGE(PG8_SB(0, 1), b2 + hstep, voffB); PG8_STAGE(PG8_SA(0, 0), a2, voffA);
            PG8_WAIT_V(8); PG8_WAIT_L(0); PG8_BAR; PG8_MMA(1, 0, At, B0); PG8_MMA(1, 1, At, B1); PG8_BAR; PG8_SCHED;
            PG8_LDB(B0, 1, 0); PG8_LDB(B1, 1, 1); PG8_SCHED; PG8_LDA(At, 1, 0); PG8_STAGE(PG8_SA(0, 1), a2 + hstep, voffA);
            PG8_WAIT_V(8); PG8_WAIT_L(0); PG8_BAR; PG8_MMA(0, 0, At, B0); PG8_MMA(0, 1, At, B1); PG8_BAR; PG8_SCHED;
            PG8_LDA(At, 1, 1); PG8_STAGE(PG8_SB(1, 0), b3, voffB); PG8_STAGE(PG8_SB(1, 1), b3 + hstep, voffB); PG8_STAGE(PG8_SA(1, 0), a3, voffA);
            PG8_WAIT_V(8); PG8_WAIT_L(0); PG8_BAR; PG8_MMA(1, 0, At, B0); PG8_MMA(1, 1, At, B1); PG8_BAR; PG8_SCHED;
            } else {
            PG8_LDB(B0, 0, 0); PG8_SCHED; PG8_LDA(At, 0, 0); PG8_STAGE(PG8_SA(1, 1), a1 + hstep, voffA);
            PG8_WAIT_L(8); PG8_BAR; PG8_WAIT_L(0); PG8_MMA(0, 0, At, B0); PG8_BAR; PG8_SCHED;
            PG8_LDB(B1, 0, 1); PG8_STAGE(PG8_SB(0, 0), b2, voffB);
            PG8_BAR; PG8_WAIT_L(0); PG8_MMA(0, 1, At, B1); PG8_BAR;
            PG8_LDA(At, 0, 1); PG8_STAGE(PG8_SA(0, 0), a2, voffA);
            PG8_BAR; PG8_WAIT_L(0); PG8_MMA(1, 0, At, B0); PG8_BAR; PG8_SCHED;
            PG8_STAGE(PG8_SB(0, 1), b2 + hstep, voffB);
            PG8_WAIT_V(6); PG8_BAR; PG8_MMA(1, 1, At, B1); PG8_BAR;
            PG8_LDB(B0, 1, 0); PG8_SCHED; PG8_LDA(At, 1, 0); PG8_STAGE(PG8_SA(0, 1), a2 + hstep, voffA);
            PG8_WAIT_L(8); PG8_BAR; PG8_WAIT_L(0); PG8_MMA(0, 0, At, B0); PG8_BAR; PG8_SCHED;
            PG8_LDB(B1, 1, 1); PG8_STAGE(PG8_SB(1, 0), b3, voffB);
            PG8_BAR; PG8_WAIT_L(0); PG8_MMA(0, 1, At, B1); PG8_BAR;
            PG8_LDA(At, 1, 1); PG8_STAGE(PG8_SA(1, 0), a3, voffA);
            PG8_BAR; PG8_WAIT_L(0); PG8_MMA(1, 0, At, B0); PG8_BAR; PG8_SCHED;
            PG8_STAGE(PG8_SB(1, 1), b3 + hstep, voffB);
            PG8_WAIT_V(6); PG8_BAR; PG8_MMA(1, 1, At, B1); PG8_BAR;
            }
        }
        if constexpr (ALIGN_EPI) { if (wr == 0) PG8_BAR; }
        if constexpr (!Epi::AFTER_DRAIN) { E(acc, cur, wr, wc, fr, fq); S.done(cur); }
        if (!has_next) break;
#pragma unroll
        for (int a = 0; a < 2; ++a)
#pragma unroll
            for (int b = 0; b < 2; ++b)
#pragma unroll
                for (int m = 0; m < 4; ++m)
#pragma unroll
                    for (int n = 0; n < 2; ++n) acc[a][b][m][n] = (f32x4){0.f, 0.f, 0.f, 0.f};
        cur = nxt; cA = nA; cB = nB; ++ui;
        if constexpr (ALIGN_EPI) { if (wr == 1) PG8_BAR; }
    }
    PG8_WAIT_V(0);
    if constexpr (!ALIGN_EPI) { if (wr == 0) PG8_BAR; }
    PG8_BAR;
    if constexpr (Epi::AFTER_DRAIN) { E.fused(acc, cur, wr, wc, fr, fq, lds, wid, lane); S.done(cur); }
#undef PG8_SA
#undef PG8_SB
#undef PG8_STAGE
#undef PG8_LDA
#undef PG8_LDB
#undef PG8_MMA
#undef PG8_WAIT_V
#undef PG8_WAIT_L
#undef PG8_BAR
#undef PG8_SCHED
}
}

constexpr int NWAVES = 8, NTHR = 512;
constexpr int N_LAUNCHES = MK_N_LAUNCHES;
constexpr int PER_PHASE = 6;
constexpr int D = 1024, NBC = 32, SEQ = 256, NBL = 2, LSEQ = 1024, PAST = 512, KLAT = PAST + LSEQ;
constexpr int MC = NBC * SEQ, ML = NBL * LSEQ, M = MC + ML;
constexpr int DIN = 8448, DMIX = 2048, DSH = 3328, NH = 8, NHB = 16;
constexpr int OUT_Y = 0, OUT_CK = M * D, OUT_CV = OUT_CK + MC * D, OUT_ST = OUT_CV + MC * D, OUT_END = OUT_ST + NBC * 2 * NHB * 64 * 64;

enum { I_XP = 0, I_XS, I_CK, I_CV, I_ST, I_C, I_CCTX, I_NG, I_WADA, I_BADA, I_WIN, I_LQ1, I_LK1, I_LQ2, I_LK2, I_SUBG, I_MU, I_W0, I_W2, I_A0, I_A2, I_KK, I_KA, I_RK, I_LNG, I_LNB, I_WOUT, I_FG, N_IN };

constexpr size_t MiB = 1u << 20;
constexpr size_t WS_CTL = 0, CTL_ZERO_BYTES = 1 * MiB;
constexpr size_t WS_MODP = 1 * MiB;
constexpr size_t WS_MODF = WS_MODP + 640 * 1024;
constexpr size_t WS_ROPE = WS_MODF + 64 * 1024;
constexpr size_t WS_SSQ = 2 * MiB;
constexpr size_t WS_WOP = 3 * MiB;
constexpr size_t WS_WIN = 4 * MiB;
constexpr size_t WS_WOUT = 21 * MiB;
constexpr size_t WS_XN = 25 * MiB;
constexpr size_t WS_Q = 45 * MiB;
constexpr size_t WS_KC = 65 * MiB;
constexpr size_t WS_KL = 81 * MiB;
constexpr size_t WS_VTC = 87 * MiB;
constexpr size_t WS_VTL = 103 * MiB;
constexpr size_t WS_GA = 109 * MiB;
constexpr size_t WS_GB = 129 * MiB;
constexpr size_t WS_UB = 149 * MiB;
constexpr size_t WS_MIX = 214 * MiB;
constexpr size_t WS_END = 254 * MiB;
constexpr int CW_BAR = 4096;
constexpr int CW_Q3 = 64;

constexpr int RING_OFF = 0, RING_BYTES = 131072;
constexpr int LDS_BYTES = 163840;
constexpr int LDSCTL_OFF = LDS_BYTES - 1024, MISC_OFF = LDSCTL_OFF + 320;

#define GAS __attribute__((address_space(1)))
#define LAS __attribute__((address_space(3)))
typedef unsigned short bf16;
typedef unsigned v4u __attribute__((ext_vector_type(4)));
typedef unsigned v2u __attribute__((ext_vector_type(2)));
typedef float f32x4 __attribute__((ext_vector_type(4)));
typedef float f32x16 __attribute__((ext_vector_type(16)));
typedef short bf16x8 __attribute__((ext_vector_type(8)));
typedef GAS unsigned gu32;
#define RLX_AGENT __ATOMIC_RELAXED, __HIP_MEMORY_SCOPE_AGENT
#define LDS_WAIT() asm volatile("s_waitcnt lgkmcnt(0)" ::: "memory")
#define VM_WAIT() asm volatile("s_waitcnt vmcnt(0)" ::: "memory")
__device__ __forceinline__ unsigned f2bf(float f) { unsigned u = __builtin_bit_cast(unsigned, f); return (u + 0x7fffu + ((u >> 16) & 1u)) >> 16; }
typedef float f32x2_t __attribute__((ext_vector_type(2)));
typedef __bf16 bf16x2_t __attribute__((ext_vector_type(2)));
__device__ __forceinline__ unsigned pk2(float lo, float hi) { const f32x2_t f = {lo, hi}; return __builtin_bit_cast(unsigned, __builtin_convertvector(f, bf16x2_t)); }
__device__ __forceinline__ unsigned f2bf_hw(float f) { return pk2(f, f); }
__device__ __forceinline__ float bf2f(unsigned b) { return __builtin_bit_cast(float, b << 16); }
__device__ __forceinline__ float bflo(unsigned w) { return __builtin_bit_cast(float, w << 16); }
__device__ __forceinline__ float bfhi(unsigned w) { return __builtin_bit_cast(float, w & 0xffff0000u); }
__device__ __forceinline__ float sigmoidf_(float x) { return __builtin_amdgcn_rcpf(1.f + __expf(-x)); }
__device__ __forceinline__ float siluf_(float x) { return x * __builtin_amdgcn_rcpf(1.f + __expf(-x)); }

#define XB_TMO      128
#define XB_XCNT(j)  (256  + 64 * (j))
#define XB_XSUB(j)  (1280 + 64 * (j))
#define XB_XGEN(j)  (2304 + 64 * (j))
#define XB_TOP      3328
#define XB_TOPGEN   3392
#define XCD_BAR_WORDS 3456
#define XB_SPIN_CAP (1u << 18)
__device__ __forceinline__ unsigned xb_ld(unsigned* p)              { return __hip_atomic_load(p, __ATOMIC_RELAXED, __HIP_MEMORY_SCOPE_AGENT); }
__device__ __forceinline__ unsigned xb_add(unsigned* p, unsigned v) { return __hip_atomic_fetch_add(p, v, __ATOMIC_RELAXED, __HIP_MEMORY_SCOPE_AGENT); }
__device__ __forceinline__ unsigned xb_xcc_id() { return (unsigned)__builtin_amdgcn_s_getreg((3 << 11) | 20) & 0xFu; }
#define XB_SPIN(cond, bar) do { unsigned _sp = 0; while (cond) { __builtin_amdgcn_s_sleep(1); \
    if ((++_sp & 255u) == 0u) { if (xb_ld(&(bar)[XB_TMO])) break; if (_sp > XB_SPIN_CAP) { atomicAdd(&(bar)[XB_TMO], 1u); break; } } } } while (0)
struct XcdBarrier { unsigned* bar; unsigned x; volatile LAS unsigned* st; };
__device__ __forceinline__ XcdBarrier xcd_barrier_post(unsigned* bar, volatile LAS unsigned* st) {
    XcdBarrier b; b.bar = bar; b.x = xb_xcc_id(); b.st = st;
    if (threadIdx.x == 0) (void)xb_add(&bar[XB_XCNT(b.x)], 1u);
    return b;
}
__device__ __forceinline__ void xcd_barrier_complete(unsigned* bar, unsigned x, unsigned& nloc, unsigned& nx) {
    const unsigned G = gridDim.x * gridDim.y * gridDim.z;
    unsigned sum, cnt, mine, sp = 0u;
    for (;;) {
        sum = 0u; cnt = 0u; mine = 0u;
#pragma unroll
        for (unsigned j = 0; j < 16; ++j) { const unsigned c = xb_ld(&bar[XB_XCNT(j)]); sum += c; cnt += (c > 0u) ? 1u : 0u; mine = (j == x) ? c : mine; }
        if (sum == G) break;
        __builtin_amdgcn_s_sleep(1);
        if ((++sp & 255u) == 0u) { if (xb_ld(&bar[XB_TMO])) break; if (sp > XB_SPIN_CAP) { atomicAdd(&bar[XB_TMO], 1u); break; } }
    }
    nloc = mine > 0u ? mine : 1u; nx = cnt > 0u ? cnt : 1u;
}
__device__ __forceinline__ void xcd_barrier(const XcdBarrier& b) {
    asm volatile("s_waitcnt vmcnt(0)" ::: "memory");
    __syncthreads();
    if (threadIdx.x == 0) {
        unsigned* bar = b.bar;
        __builtin_amdgcn_s_waitcnt(0);
        unsigned nloc = b.st[0], nx = b.st[1];
        if (nloc == 0u) { xcd_barrier_complete(bar, b.x, nloc, nx); b.st[0] = nloc; b.st[1] = nx; }
        const unsigned old = xb_add(&bar[XB_XSUB(b.x)], 1u);
        const unsigned gen = old / nloc;
        if (old + 1u == (gen + 1u) * nloc) {
            __builtin_amdgcn_fence(__ATOMIC_RELEASE, "agent");
            asm volatile("s_waitcnt vmcnt(0)" ::: "memory");
            const unsigned og = xb_add(&bar[XB_TOP], 1u);
            const unsigned tg = og / nx;
            if (og + 1u == (tg + 1u) * nx) xb_add(&bar[XB_TOPGEN], 1u);
            else XB_SPIN(xb_ld(&bar[XB_TOPGEN]) == tg, bar);
            __builtin_amdgcn_fence(__ATOMIC_ACQUIRE, "agent");
            xb_add(&bar[XB_XGEN(b.x)], 1u);
            asm volatile("s_waitcnt vmcnt(0)" ::: "memory");
        } else {
            XB_SPIN(xb_ld(&bar[XB_XGEN(b.x)]) == gen, bar);
            __builtin_amdgcn_fence(__ATOMIC_ACQUIRE, "agent");
            asm volatile("s_waitcnt vmcnt(0)" ::: "memory");
        }
    }
    __syncthreads();
}

struct Args { const float* in[N_IN]; float* out; unsigned char* ws; int ph_lo, ph_hi, li, pad; };
struct Frame {
    LAS unsigned char* lds;
    volatile LAS unsigned* MISC;
    gu32* ctl;
    int tid, lane, wave, G;
    const float* const* in;
    float* out; unsigned char* ws;
};
__device__ __forceinline__ float wave_sum(float v) {
#pragma unroll
    for (int o = 1; o < 64; o <<= 1) v += __shfl_xor(v, o);
    return v;
}
__device__ __forceinline__ const float* xrow_ptr(const Frame& F, int m) { return m < MC ? F.in[I_XP] + (size_t)m * D : F.in[I_XS] + (size_t)(m - MC) * D; }

__device__ __forceinline__ void p0_transpose_item(const float* W, int K, int N, bf16* WT, LAS float* scr, int item, int lane) {
    const int nblk = N / 32, kb = item / nblk, nb = item % nblk, k0 = 64 * kb, n0 = 32 * nb;
#pragma unroll 4
    for (int i = 0; i < 32; ++i) { const int kk = 2 * i + (lane >> 5); scr[kk * 33 + (lane & 31)] = W[(size_t)(k0 + kk) * N + n0 + (lane & 31)]; }
    LDS_WAIT(); asm volatile("" ::: "memory");
    const int c = lane & 7;
#pragma unroll
    for (int j = 0; j < 4; ++j) { const int n = (lane >> 3) + 8 * j; const LAS float* s = scr + (8 * c) * 33 + n;
        v4u o; o.x = pk2(s[0 * 33], s[1 * 33]); o.y = pk2(s[2 * 33], s[3 * 33]); o.z = pk2(s[4 * 33], s[5 * 33]); o.w = pk2(s[6 * 33], s[7 * 33]);
        *(GAS v4u*)(WT + (size_t)(n0 + n) * K + k0 + 8 * c) = o; }
    LDS_WAIT(); asm volatile("" ::: "memory");
}
__device__ __forceinline__ void p0_prologue(Frame& F) {
    LAS float* scr = (LAS float*)(F.lds + RING_OFF + F.wave * 16384);
    const int gw = blockIdx.x * NWAVES + F.wave, NGW = F.G * NWAVES;
    bf16* WinT = (bf16*)(F.ws + WS_WIN); bf16* WoutT = (bf16*)(F.ws + WS_WOUT);
    constexpr int I_IN = (D / 64) * (DIN / 32), I_OUT = (DMIX / 64) * (D / 32), I_MOD = 16 * 12, I_CV_ = NBL * NH * (PAST / 64), I_ROPE = 1;
    constexpr int NITEMS = I_MOD + I_IN + I_OUT + I_CV_ + I_ROPE;
    for (int it = gw; it < NITEMS; it += NGW) {
        int r = it;
        if (r < I_MOD) {
            const int kc = r / 12, nb = r % 12, n0 = nb * 256 + 4 * F.lane;
            const float* wa = F.in[I_WADA] + (size_t)(kc * 64) * 3072 + n0;
            f32x4 a0 = {0.f, 0.f, 0.f, 0.f}, a1 = a0, a2 = a0;
#pragma unroll 8
            for (int k = 0; k < 64; ++k) {
                const f32x4 w = *(const f32x4*)(wa + (size_t)k * 3072);
                const float s0 = siluf_(F.in[I_CCTX][kc * 64 + k]), s1 = siluf_(F.in[I_C][kc * 64 + k]), s2 = siluf_(F.in[I_C][D + kc * 64 + k]);
                a0 += w * s0; a1 += w * s1; a2 += w * s2;
            }
            float* mp = (float*)(F.ws + WS_MODP) + (size_t)kc * 3 * 3072 + n0;
            *(f32x4*)(mp) = a0; *(f32x4*)(mp + 3072) = a1; *(f32x4*)(mp + 2 * 3072) = a2;
            continue;
        }
        r -= I_MOD;
        if (r < I_IN) { p0_transpose_item(F.in[I_WIN], D, DIN, WinT, scr, r, F.lane); continue; } r -= I_IN;
        if (r < I_OUT) { p0_transpose_item(F.in[I_WOUT], DMIX, D, WoutT, scr, r, F.lane); continue; } r -= I_OUT;
        if (r < I_CV_) {
            const int tb = r % (PAST / 64), hh = (r / (PAST / 64)) % NH, b = r / (NH * (PAST / 64));
            const float* src = F.in[I_CV] + ((size_t)(b * PAST + tb * 64 + F.lane) * NH + hh) * 128;
            bf16* dst = (bf16*)(F.ws + WS_VTL) + (size_t)((b * NH + hh) * 128) * KLAT + tb * 64 + F.lane;
#pragma unroll 4
            for (int dv = 0; dv < 128; dv += 4) { const f32x4 v = *(const f32x4*)(src + dv);
                dst[(size_t)(dv + 0) * KLAT] = (bf16)f2bf(v.x); dst[(size_t)(dv + 1) * KLAT] = (bf16)f2bf(v.y); dst[(size_t)(dv + 2) * KLAT] = (bf16)f2bf(v.z); dst[(size_t)(dv + 3) * KLAT] = (bf16)f2bf(v.w); }
            continue;
        }
        r -= I_CV_;
        {
            float* rp = (float*)(F.ws + WS_ROPE);
            for (int e = F.lane; e < 1024; e += 64) { const int pos = e >> 4, i = e & 15; const double inv = pow(10000.0, -(double)i / 16.0), ang = (double)pos * inv; rp[e] = (float)cos(ang); rp[1024 + e] = (float)sin(ang); }
        }
    }
    for (int idx = blockIdx.x * NTHR + F.tid; idx < 2 * 16 * 2 * 4 * 2 * 64; idx += F.G * NTHR) {
        const int ln = idx & 63, ks = (idx >> 6) & 1, ct = (idx >> 7) & 3, mat = (idx >> 9) & 1, hh = (idx >> 10) & 15, dd = idx >> 14;
        const float* src = F.in[mat ? I_A2 : I_W2] + (size_t)(dd * 64 + 32 * ks + 8 * (ln >> 4)) * D + hh * 64 + 16 * ct + (ln & 15);
        v4u o; o.x = pk2(src[0], src[D]); o.y = pk2(src[2 * D], src[3 * D]); o.z = pk2(src[4 * D], src[5 * D]); o.w = pk2(src[6 * D], src[7 * D]);
        ((v4u*)(F.ws + WS_WOP))[idx] = o;
    }
    bf16* KL = (bf16*)(F.ws + WS_KL);
    for (int i = blockIdx.x * NTHR + F.tid; i < NBL * PAST * D / 8; i += F.G * NTHR) {
        const int e = i * 8, b = e / (PAST * D), rem = e % (PAST * D);
        const f32x4 v0 = *(const f32x4*)(F.in[I_CK] + e), v1 = *(const f32x4*)(F.in[I_CK] + e + 4);
        v4u o; o.x = pk2(v0.x, v0.y); o.y = pk2(v0.z, v0.w); o.z = pk2(v1.x, v1.y); o.w = pk2(v1.z, v1.w);
        *(v4u*)(KL + (size_t)b * KLAT * D + rem) = o;
    }
}

template <int I0, int I1> __device__ __forceinline__ void p1_load(Frame& F, f32x4 (&v)[5][4]) {
#pragma unroll
    for (int i = I0; i < I1; ++i) { const float* xr = xrow_ptr(F, ((int)blockIdx.x + 256 * i) * 8 + F.wave);
#pragma unroll
        for (int j = 0; j < 4; ++j) v[i][j] = *(const f32x4*)(xr + 4 * F.lane + 256 * j); }
}
__device__ __forceinline__ void p1_norm(Frame& F, f32x4 (&v)[5][4]) {
    LAS float* modL = (LAS float*)(F.lds + RING_OFF);
    const float* modp = (const float*)(F.ws + WS_MODP);
    const float* bada = F.in[I_BADA];
    int mrow[5];
#pragma unroll
    for (int i = 0; i < 5; ++i) mrow[i] = ((int)blockIdx.x + 256 * i) * 8 + F.wave;
    if (blockIdx.x < 36 && F.tid < 256) {
        const int idx = blockIdx.x * 256 + F.tid, ci = idx / 3072, n = idx % 3072;
        float s = bada[n];
#pragma unroll
        for (int kc = 0; kc < 16; ++kc) s += modp[(size_t)(kc * 3 + ci) * 3072 + n];
        ((float*)(F.ws + WS_MODF))[idx] = s;
    }
    {
        const int cil = 1 + (int)blockIdx.x / 128;
        for (int e = F.tid; e < 4096; e += NTHR) { const int n = e & 2047, ci = e < 2048 ? 0 : cil; float s = bada[n];
#pragma unroll
            for (int kc = 0; kc < 16; ++kc) s += modp[(size_t)(kc * 3 + ci) * 3072 + n];
            modL[e] = s; }
    }
    __syncthreads();
    bf16* XN = (bf16*)(F.ws + WS_XN);
#pragma unroll
    for (int i = 0; i < 5; ++i) {
        float ss = 0.f;
#pragma unroll
        for (int j = 0; j < 4; ++j) ss += (v[i][j].x * v[i][j].x + v[i][j].y * v[i][j].y) + (v[i][j].z * v[i][j].z + v[i][j].w * v[i][j].w);
        const float rstd = __builtin_amdgcn_rsqf(wave_sum(ss) * (1.f / D) + 1e-6f);
        const LAS float* ml = modL + (i == 4 ? 2048 : 0);
#pragma unroll
        for (int j = 0; j < 4; ++j) {
            const int c = 4 * F.lane + 256 * j;
            const f32x4 g = *(const f32x4*)(F.in[I_NG] + c);
            const f32x4 sh = *(const LAS f32x4*)(ml + c), sc = *(const LAS f32x4*)(ml + 1024 + c);
            const f32x4 h = (v[i][j] * rstd) * g * (sc + 1.0f) + sh;
            v2u o; o.x = pk2(h.x, h.y); o.y = pk2(h.z, h.w);
            *(v2u*)(XN + (size_t)mrow[i] * D + c) = o;
        }
    }
}

struct EpiIn {
    static constexpr bool PERM = true, AFTER_DRAIN = false;
    unsigned char* ws; float* out;
    __device__ __forceinline__ void operator()(const f32x4 (&acc)[2][2][4][2], const pg8::Unit& u, int wr, int wc, int fr, int fq) const {
        const int pn = u.pn; const bool lat = u.pm >= MC / 256;
        const float* rope = (const float*)(ws + WS_ROPE);
        constexpr float QS = 0.125f * 1.44269504088896f;
#pragma unroll
        for (int ai = 0; ai < 2; ++ai)
#pragma unroll
            for (int m = 0; m < 4; ++m) {
                const int r = u.pm * 256 + ai * 128 + wr * 64 + m * 16 + fr;
#pragma unroll
                for (int bj = 0; bj < 2; ++bj) {
                    const int c = pn * 256 + bj * 128 + wc * 32 + 8 * fq;
                    f32x4 v0 = acc[ai][bj][m][0], v1 = acc[ai][bj][m][1];
                    if (pn < 8) {
                        const bool isq = pn < 4; const int cc = isq ? c : c - 1024;
                        if (lat) {
                            const int t = (r - MC) & (LSEQ - 1), pos = (wc & 1) ? (t & 63) : (t >> 6);
                            const float* cp = rope + pos * 16 + 8 * (fq & 1);
                            const f32x4 c0 = *(const f32x4*)cp, c1 = *(const f32x4*)(cp + 4), s0 = *(const f32x4*)(cp + 1024), s1 = *(const f32x4*)(cp + 1028);
                            f32x4 p0, p1;
#pragma unroll
                            for (int j = 0; j < 4; ++j) { p0[j] = __shfl_xor(v0[j], 32); p1[j] = __shfl_xor(v1[j], 32); }
                            const float sg = (fq & 2) ? 1.f : -1.f;
                            v0 = v0 * c0 + (p0 * s0) * sg; v1 = v1 * c1 + (p1 * s1) * sg;
                        }
                        if (isq) { v0 = v0 * QS; v1 = v1 * QS; }
                        else if (!lat) { float* o = out + OUT_CK + (size_t)r * D + cc; *(f32x4*)o = v0; *(f32x4*)(o + 4) = v1; }
                        v4u w; w.x = pk2(v0[0], v0[1]); w.y = pk2(v0[2], v0[3]); w.z = pk2(v1[0], v1[1]); w.w = pk2(v1[2], v1[3]);
                        bf16* dst;
                        if (isq) dst = (bf16*)(ws + WS_Q) + (size_t)r * D + cc;
                        else if (!lat) dst = (bf16*)(ws + WS_KC) + (size_t)r * D + cc;
                        else { const int b = (r - MC) >> 10, t = (r - MC) & (LSEQ - 1); dst = (bf16*)(ws + WS_KL) + ((size_t)b * KLAT + PAST + t) * D + cc; }
                        *(v4u*)dst = w;
                    } else if (pn < 12) {
                        const int cc = c - 2048, hh = cc >> 7, dv = cc & 127;
                        bf16* dst;
                        if (!lat) { float* o = out + OUT_CV + (size_t)r * D + cc; *(f32x4*)o = v0; *(f32x4*)(o + 4) = v1;
                            const int b = r >> 8, t = r & 255; dst = (bf16*)(ws + WS_VTC) + (size_t)((b * NH + hh) * 128 + dv) * SEQ + t;
#pragma unroll
                            for (int j = 0; j < 4; ++j) { dst[(size_t)j * SEQ] = (bf16)f2bf(v0[j]); dst[(size_t)(4 + j) * SEQ] = (bf16)f2bf(v1[j]); }
                        } else { const int b = (r - MC) >> 10, t = (r - MC) & (LSEQ - 1); dst = (bf16*)(ws + WS_VTL) + (size_t)((b * NH + hh) * 128 + dv) * KLAT + PAST + t;
#pragma unroll
                            for (int j = 0; j < 4; ++j) { dst[(size_t)j * KLAT] = (bf16)f2bf(v0[j]); dst[(size_t)(4 + j) * KLAT] = (bf16)f2bf(v1[j]); }
                        }
                    } else if (pn < 16 || pn >= 29) {
                        bf16* dst = pn < 16 ? (bf16*)(ws + WS_GA) + (size_t)r * D + (c - 3072) : (bf16*)(ws + WS_GB) + (size_t)r * D + (c - 7424);
                        v4u w; w.x = pk2(siluf_(v0[0]), siluf_(v0[1])); w.y = pk2(siluf_(v0[2]), siluf_(v0[3])); w.z = pk2(siluf_(v1[0]), siluf_(v1[1])); w.w = pk2(siluf_(v1[2]), siluf_(v1[3]));
                        *(v4u*)dst = w;
                    } else {
                        v4u w; w.x = pk2(v0[0], v0[1]); w.y = pk2(v0[2], v0[3]); w.z = pk2(v1[0], v1[1]); w.w = pk2(v1[2], v1[3]);
                        *(v4u*)((bf16*)(ws + WS_UB) + (size_t)r * DSH + (c - 4096)) = w;
                    }
                }
            }
    }
};

constexpr int NLATB = 32;
constexpr int LAT_UNITS = (ML / 256) * (DIN / 256);
constexpr int P2A_UNITS = 512, P2_UNITS = (M / 256) * (DIN / 256);
constexpr int LAT_BAR_IT = 6;
struct ListOrder {
    int G, v, lo, hi;
    __device__ void init(int G_, int c_, int lo_, int hi_) { G = G_; v = (G_ % 8 == 0) ? (c_ % 8) * (G_ / 8) + c_ / 8 : c_; lo = lo_; hi = hi_; }
    __device__ bool next(int i, pg8::Unit& u) const {
        int L = lo + i * G + v; if (L >= hi) return false;
        if (L < LAT_UNITS) { u.pn = L >> 3; u.pm = MC / 256 + (L & 7); return true; }
        L -= LAT_UNITS;
        const int grp = L / (8 * (DIN / 256)), r = L % (8 * (DIN / 256)); u.pn = r >> 3; u.pm = grp * 8 + (r & 7); return true;
    }
    __device__ __forceinline__ void a_ready(const pg8::Unit&) const {}
    __device__ __forceinline__ void done(const pg8::Unit&) const {}
};

constexpr size_t WS_XCH = WS_SSQ;
constexpr int CW_PANEL = 8192;
struct EpiOutFused {
    static constexpr bool PERM = false, AFTER_DRAIN = true;
    unsigned char* ws; float* out; const float* xp; const float* xs; const float* fg; gu32* ctl;
    __device__ __forceinline__ void fused(f32x4 (&acc)[2][2][4][2], const pg8::Unit& u, int wr, int wc, int fr, int fq, PG8_LAS unsigned char* lds, int wid, int lane) const {
        const float* modf = (const float*)(ws + WS_MODF);
        PG8_LAS float* P = (PG8_LAS float*)lds;
        PG8_LAS float* R = (PG8_LAS float*)(lds + 4096);
        const int col0 = u.pn * 256 + wc * 32 + 4 * fq;
#pragma unroll
        for (int ai = 0; ai < 2; ++ai)
#pragma unroll
            for (int m = 0; m < 4; ++m) {
                const int rl = ai * 128 + wr * 64 + m * 16 + fr, r = u.pm * 256 + rl;
                const int ci = r < MC ? 0 : 1 + ((r - MC) >> 10);
                const float* xr = (r < MC ? xp + (size_t)r * D : xs + (size_t)(r - MC) * D) + col0;
                const float* gt = modf + ci * 3072 + 2048 + col0;
                float ss = 0.f;
#pragma unroll
                for (int bj = 0; bj < 2; ++bj)
#pragma unroll
                    for (int n = 0; n < 2; ++n) {
                        const int off = bj * 128 + n * 16;
                        const f32x4 y = *(const f32x4*)(xr + off) + *(const f32x4*)(gt + off) * acc[ai][bj][m][n];
                        acc[ai][bj][m][n] = y;
                        ss += (y.x * y.x + y.y * y.y) + (y.z * y.z + y.w * y.w);
                    }
                ss += __shfl_xor(ss, 16); ss += __shfl_xor(ss, 32);
                if (fq == 0) P[rl * 4 + wc] = ss;
            }
        asm volatile("s_waitcnt lgkmcnt(0)" ::: "memory"); __builtin_amdgcn_s_barrier(); asm volatile("" ::: "memory");
        const int row = wid * 32 + (lane & 31);
        float* xbuf = (float*)(ws + WS_XCH) + ((size_t)(u.pm * 256 + row) * 4);
        if (lane < 32) {
            const f32x4 p = *(const PG8_LAS f32x4*)(P + row * 4);
            __hip_atomic_store(xbuf + u.pn, (p.x + p.y) + (p.z + p.w), __ATOMIC_RELAXED, __HIP_MEMORY_SCOPE_AGENT);
        }
        asm volatile("s_waitcnt vmcnt(0)" ::: "memory");
        unsigned* cnt = (unsigned*)(ctl + CW_PANEL + 64 * u.pm);
        if (lane == 0) __hip_atomic_fetch_add(cnt, 1u, __ATOMIC_RELAXED, __HIP_MEMORY_SCOPE_AGENT);
        if (wid == 0) {
            unsigned sp = 0;
            while ((unsigned)__builtin_amdgcn_readfirstlane(__hip_atomic_load(cnt, __ATOMIC_RELAXED, __HIP_MEMORY_SCOPE_AGENT)) < 32u) { __builtin_amdgcn_s_sleep(2); if (++sp > (1u << 20)) break; }
            __builtin_amdgcn_fence(__ATOMIC_ACQUIRE, "agent");
        }
        asm volatile("s_waitcnt vmcnt(0) lgkmcnt(0)" ::: "memory"); __builtin_amdgcn_s_barrier(); asm volatile("" ::: "memory");
        if (lane < 32) {
            float t = 0.f;
#pragma unroll
            for (int q = 0; q < 4; ++q) t += __hip_atomic_load(xbuf + q, __ATOMIC_RELAXED, __HIP_MEMORY_SCOPE_AGENT);
            R[row] = __builtin_amdgcn_rsqf(t * (1.f / D) + 1e-6f);
        }
        asm volatile("s_waitcnt lgkmcnt(0)" ::: "memory"); __builtin_amdgcn_s_barrier(); asm volatile("" ::: "memory");
#pragma unroll
        for (int ai = 0; ai < 2; ++ai)
#pragma unroll
            for (int m = 0; m < 4; ++m) {
                const int rl = ai * 128 + wr * 64 + m * 16 + fr; const float rs = R[rl];
                float* o = out + OUT_Y + (size_t)(u.pm * 256 + rl) * D + col0;
#pragma unroll
                for (int bj = 0; bj < 2; ++bj)
#pragma unroll
                    for (int n = 0; n < 2; ++n) { const int off = bj * 128 + n * 16; *(f32x4*)(o + off) = acc[ai][bj][m][n] * rs * *(const f32x4*)(fg + col0 + off); }
            }
    }
};

constexpr int AT_KS = 0, AT_KSTRIDE = 272, AT_VS = 64 * AT_KSTRIDE, AT_VSTRIDE = 144, AT_BUF = AT_VS + 128 * AT_VSTRIDE, AT_X = 2 * AT_BUF, AT_XSTRIDE = 132;
static_assert(AT_X + 4 * 32 * AT_XSTRIDE * 4 <= LDSCTL_OFF && (AT_X % 16) == 0, "attention LDS map");
__device__ __forceinline__ void attn_unit(Frame& F, int idx, bool lat, float lam) {
    int tid_ = F.tid; asm volatile("" : "+v"(tid_)); const int lane_ = tid_ & 63;
    int b, hh, qb, m0, nkeys, vlen; const bf16* Kb; const bf16* VT;
    if (!lat) { b = idx >> 4; hh = (idx >> 1) & 7; qb = idx & 1; m0 = b * SEQ + qb * 128; nkeys = SEQ; vlen = SEQ;
        Kb = (const bf16*)(F.ws + WS_KC) + (size_t)b * SEQ * D + hh * 128; VT = (const bf16*)(F.ws + WS_VTC) + (size_t)((b * NH + hh) * 128) * SEQ; }
    else { b = idx >> 6; hh = (idx >> 3) & 7; qb = idx & 7; m0 = MC + b * LSEQ + qb * 128; nkeys = KLAT; vlen = KLAT;
        Kb = (const bf16*)(F.ws + WS_KL) + (size_t)b * KLAT * D + hh * 128; VT = (const bf16*)(F.ws + WS_VTL) + (size_t)((b * NH + hh) * 128) * KLAT; }
    const int w = F.wave, qs = w >> 1, mp = w & 1, l31 = lane_ & 31, h5 = lane_ >> 5;
    const int kperm = (l31 & 3) + 4 * ((l31 >> 3) & 1) + 8 * ((l31 >> 2) & 1) + 16 * (l31 >> 4);
    LAS float* X = (LAS float*)(F.lds + AT_X);
    bf16x8 qf[4];
    { const bf16* qrow = (const bf16*)(F.ws + WS_Q) + (size_t)(m0 + qs * 32 + l31) * D + hh * 128 + mp * 64 + 8 * h5;
#pragma unroll
      for (int ks = 0; ks < 4; ++ks) qf[ks] = *(const bf16x8*)(qrow + 16 * ks); }
    f32x16 o[4];
#pragma unroll
    for (int i = 0; i < 4; ++i)
#pragma unroll
        for (int j = 0; j < 16; ++j) o[i][j] = 0.f;
    float mrun = -1e30f, lrun = 0.f;
    const int krow = tid_ >> 3, kch = tid_ & 7, vrow = tid_ >> 2, vch = tid_ & 3;
    const int ntile = nkeys / 64;
    const bf16* kp = Kb + (size_t)krow * D + kch * 8;
    const bf16* vp = VT + (size_t)vrow * vlen + vch * 8;
    LAS unsigned char* kd = F.lds + AT_KS + krow * AT_KSTRIDE + kch * 16;
    LAS unsigned char* vd = F.lds + AT_VS + vrow * AT_VSTRIDE + vch * 16;
    v4u k0 = *(const v4u*)kp, k1 = *(const v4u*)(kp + 64), v0 = *(const v4u*)vp, v1 = *(const v4u*)(vp + 32);
    __syncthreads();
    *(LAS v4u*)(kd) = k0; *(LAS v4u*)(kd + 128) = k1;
    *(LAS v4u*)(vd) = v0; *(LAS v4u*)(vd + 64) = v1;
    if (ntile > 1) { k0 = *(const v4u*)(kp + (size_t)64 * D); k1 = *(const v4u*)(kp + (size_t)64 * D + 64); v0 = *(const v4u*)(vp + 64); v1 = *(const v4u*)(vp + 96); }
    __syncthreads();
    for (int kt = 0; kt < ntile; ++kt) {
        const int bo = (kt & 1) * AT_BUF;
        LAS unsigned char* Ks = F.lds + AT_KS + bo; LAS unsigned char* Vs = F.lds + AT_VS + bo;
        if (kt + 1 < ntile) {
            const int bn = AT_BUF - bo;
            *(LAS v4u*)(kd + bn) = k0; *(LAS v4u*)(kd + bn + 128) = k1;
            *(LAS v4u*)(vd + bn) = v0; *(LAS v4u*)(vd + bn + 64) = v1;
            if (kt + 2 < ntile) { const bf16* kq = kp + (size_t)(kt + 2) * 64 * D; const bf16* vq = vp + (kt + 2) * 64;
                k0 = *(const v4u*)kq; k1 = *(const v4u*)(kq + 64); v0 = *(const v4u*)vq; v1 = *(const v4u*)(vq + 32); }
        }
        f32x16 s[2];
#pragma unroll
        for (int st = 0; st < 2; ++st) {
#pragma unroll
            for (int j = 0; j < 16; ++j) s[st][j] = 0.f;
#pragma unroll
            for (int ks = 0; ks < 4; ++ks) {
                const bf16x8 kf = *(const LAS bf16x8*)(Ks + (st * 32 + kperm) * AT_KSTRIDE + (mp * 64 + 16 * ks + 8 * h5) * 2);
                s[st] = __builtin_amdgcn_mfma_f32_32x32x16_bf16(kf, qf[ks], s[st], 0, 0, 0);
            }
        }
        float mx = s[0][0];
#pragma unroll
        for (int j = 0; j < 16; ++j) { mx = fmaxf(mx, s[0][j]); mx = fmaxf(mx, s[1][j]); }
        mx = fmaxf(mx, __shfl_xor(mx, 32));
        if (!__all(mx - mrun <= 8.f)) {
            const float mnew_ = fmaxf(mrun, mx), alpha = __builtin_amdgcn_exp2f(mrun - mnew_);
            mrun = mnew_; lrun *= alpha;
#pragma unroll
            for (int i = 0; i < 4; ++i) o[i] = o[i] * alpha;
        }
        const float mnew = mrun;
        float ps = 0.f;
#pragma unroll
        for (int st = 0; st < 2; ++st)
#pragma unroll
            for (int j = 0; j < 16; ++j) { const float p = __builtin_amdgcn_exp2f(s[st][j] - mnew); s[st][j] = p; ps += p; }
        lrun += ps;
        bf16x8 pf[2][2];
#pragma unroll
        for (int st = 0; st < 2; ++st)
#pragma unroll
            for (int s2 = 0; s2 < 2; ++s2) {
                v4u t; t.x = pk2(s[st][8 * s2 + 0], s[st][8 * s2 + 1]); t.y = pk2(s[st][8 * s2 + 2], s[st][8 * s2 + 3]); t.z = pk2(s[st][8 * s2 + 4], s[st][8 * s2 + 5]); t.w = pk2(s[st][8 * s2 + 6], s[st][8 * s2 + 7]);
                pf[st][s2] = __builtin_bit_cast(bf16x8, t);
            }
#pragma unroll
        for (int dvt = 0; dvt < 4; ++dvt)
#pragma unroll
            for (int st = 0; st < 2; ++st)
#pragma unroll
                for (int s2 = 0; s2 < 2; ++s2) {
                    const bf16x8 vf = *(const LAS bf16x8*)(Vs + (dvt * 32 + l31) * AT_VSTRIDE + (st * 32 + 16 * s2 + 8 * h5) * 2);
                    o[dvt] = __builtin_amdgcn_mfma_f32_32x32x16_bf16(vf, pf[st][s2], o[dvt], 0, 0, 0);
                }
        __syncthreads();
    }
    const float ltot = lrun + __shfl_xor(lrun, 32), inv = 1.f / ltot;
    LAS float* Xq = X + (qs * 32 + l31) * AT_XSTRIDE;
    if (mp == 1) {
#pragma unroll
        for (int dvt = 0; dvt < 4; ++dvt)
#pragma unroll
            for (int j = 0; j < 16; ++j) Xq[dvt * 32 + (j & 3) + 8 * (j >> 2) + 4 * h5] = o[dvt][j] * inv;
    }
    __syncthreads();
    if (mp == 0) {
        float ss = 0.f;
#pragma unroll
        for (int dvt = 0; dvt < 4; ++dvt)
#pragma unroll
            for (int j = 0; j < 16; ++j) { const float a = o[dvt][j] * inv - lam * Xq[dvt * 32 + (j & 3) + 8 * (j >> 2) + 4 * h5]; o[dvt][j] = a; ss += a * a; }
        ss += __shfl_xor(ss, 32);
        const float rstd = 0.8f / sqrtf(ss * (1.f / 128.f) + 1e-5f);
#pragma unroll
        for (int dvt = 0; dvt < 4; ++dvt)
#pragma unroll
            for (int j = 0; j < 16; ++j) Xq[dvt * 32 + (j & 3) + 8 * (j >> 2) + 4 * h5] = o[dvt][j] * rstd;
    }
    __syncthreads();
    {
        const float* sg = F.in[I_SUBG];
        const bf16* GA = (const bf16*)(F.ws + WS_GA); bf16* MIX = (bf16*)(F.ws + WS_MIX);
        const int d8 = (tid_ & 15) * 8;
        const f32x4 g0 = *(const f32x4*)(sg + d8), g1 = *(const f32x4*)(sg + d8 + 4);
#pragma unroll
        for (int p = 0; p < 4; ++p) {
            const int q = p * 32 + (tid_ >> 4), m = m0 + q;
            const LAS float* xr = X + q * AT_XSTRIDE + d8;
            const f32x4 a0 = *(const LAS f32x4*)xr, a1 = *(const LAS f32x4*)(xr + 4);
            const v4u ga = *(const v4u*)(GA + (size_t)m * D + hh * 128 + d8);
            v4u w;
            w.x = pk2(a0.x * g0.x * bflo(ga.x), a0.y * g0.y * bfhi(ga.x)); w.y = pk2(a0.z * g0.z * bflo(ga.y), a0.w * g0.w * bfhi(ga.y));
            w.z = pk2(a1.x * g1.x * bflo(ga.z), a1.y * g1.y * bfhi(ga.z)); w.w = pk2(a1.z * g1.z * bflo(ga.w), a1.w * g1.w * bfhi(ga.w));
            *(v4u*)(MIX + (size_t)m * DMIX + hh * 128 + d8) = w;
        }
    }
}

constexpr int SC_W2 = 0, SC_A2 = 16384, SC_TLW = 32768, SC_LA = 40960, SC_WD = 49152, SC_NKK = 57344, SC_BB = 65536, SC_KD = 73728, SC_R = 81920, SC_V = 90112, SC_Y = 98304, SC_BON = 106496;
template <int CTRL> __device__ __forceinline__ float dppf(float x) { return __builtin_bit_cast(float, __builtin_amdgcn_update_dpp(0, __builtin_bit_cast(int, x), CTRL, 0xf, 0xf, true)); }
__device__ __forceinline__ float reduce8(float v) { v += dppf<0xB1>(v); v += dppf<0x4E>(v); v += dppf<0x141>(v); return v; }
__device__ __forceinline__ float shift_load(const bf16* ub, const float* mu, int t, int T, int col) {
    const float u = bf2f(ub[col]);
    const float p = t > 0 ? bf2f(ub[col - DSH]) : 0.f;
    const float n = t < T - 1 ? bf2f(ub[col + DSH]) : 0.f;
    return u + mu[col] * (p - u) + mu[DSH + col] * (n - u);
}
__device__ __forceinline__ void scan_unit(Frame& F, int b, int hh, bool lat) {
    const int T = lat ? LSEQ : SEQ, m0 = lat ? MC + b * LSEQ : b * SEQ;
    const bf16* UB = (const bf16*)(F.ws + WS_UB); const bf16* GB = (const bf16*)(F.ws + WS_GB); bf16* MIX = (bf16*)(F.ws + WS_MIX);
    float* YB = F.out + OUT_Y;
    const float* mu = F.in[I_MU];
    LAS float* W2s = (LAS float*)(F.lds + SC_W2); LAS float* A2s = (LAS float*)(F.lds + SC_A2); LAS float* TLW = (LAS float*)(F.lds + SC_TLW); LAS float* LAs = (LAS float*)(F.lds + SC_LA);
    LAS float* WD = (LAS float*)(F.lds + SC_WD); LAS float* NKK = (LAS float*)(F.lds + SC_NKK); LAS float* BB = (LAS float*)(F.lds + SC_BB); LAS float* KD = (LAS float*)(F.lds + SC_KD);
    LAS float* RR = (LAS float*)(F.lds + SC_R); LAS float* VV = (LAS float*)(F.lds + SC_V); LAS float* YC = (LAS float*)(F.lds + SC_Y); LAS float* BON = (LAS float*)(F.lds + SC_BON);
    const int c = F.lane, hc = hh * 64 + c, row = F.wave * 8 + (F.lane >> 3), kq = F.lane & 7;
    const float kkc = F.in[I_KK][hc], kac = F.in[I_KA][hc], rkc = F.in[I_RK][hc];
    for (int d = 0; d < 2; ++d) {
        __syncthreads();
        for (int i = F.tid; i < 4096; i += NTHR) { const int j = i >> 6, cc = i & 63; W2s[i] = F.in[I_W2][(size_t)(d * 64 + j) * D + hh * 64 + cc]; A2s[i] = F.in[I_A2][(size_t)(d * 64 + j) * D + hh * 64 + cc]; }
        const float w0c = F.in[I_W0][d * D + hc], a0c = F.in[I_A0][d * D + hc];
        float S[8];
        if (lat) { const float* sp = F.in[I_ST] + ((size_t)((b * 2 + d) * NHB + hh) * 64 + row) * 64 + kq * 8;
            const f32x4 s0 = *(const f32x4*)sp, s1 = *(const f32x4*)(sp + 4); S[0] = s0.x; S[1] = s0.y; S[2] = s0.z; S[3] = s0.w; S[4] = s1.x; S[5] = s1.y; S[6] = s1.z; S[7] = s1.w; }
        else {
#pragma unroll
            for (int i = 0; i < 8; ++i) S[i] = 0.f; }
        const int nch = T / 32;
        for (int ch = 0; ch < nch; ++ch) {
            const int t0 = (d == 0 ? ch : nch - 1 - ch) * 32;
            __syncthreads();
            float r_[4], k_[4], v_[4];
#pragma unroll
            for (int i = 0; i < 4; ++i) {
                const int tt = F.wave * 4 + i, t = t0 + tt;
                const bf16* ub = UB + (size_t)(m0 + t) * DSH;
                r_[i] = shift_load(ub, mu, t, T, hc); k_[i] = shift_load(ub, mu, t, T, 1024 + hc); v_[i] = shift_load(ub, mu, t, T, 2048 + hc);
                const float lw = shift_load(ub, mu, t, T, 3072 + 64 * d + c), la = shift_load(ub, mu, t, T, 3200 + 64 * d + c);
                TLW[tt * 64 + c] = tanhf(lw); LAs[tt * 64 + c] = la;
            }
            __syncthreads();
            float zw[4], za[4];
#pragma unroll
            for (int i = 0; i < 4; ++i) { zw[i] = w0c; za[i] = a0c; }
            for (int j = 0; j < 64; j += 4) {
                f32x4 tw[4], ta[4];
#pragma unroll
                for (int i = 0; i < 4; ++i) { tw[i] = *(const LAS f32x4*)(TLW + (F.wave * 4 + i) * 64 + j); ta[i] = *(const LAS f32x4*)(LAs + (F.wave * 4 + i) * 64 + j); }
#pragma unroll
                for (int jj = 0; jj < 4; ++jj) { const float w2 = W2s[(j + jj) * 64 + c], a2 = A2s[(j + jj) * 64 + c];
#pragma unroll
                    for (int i = 0; i < 4; ++i) { zw[i] += tw[i][jj] * w2; za[i] += ta[i][jj] * a2; } }
            }
#pragma unroll
            for (int i = 0; i < 4; ++i) {
                const int tt = F.wave * 4 + i;
                const float dec = __expf(-0.60653065971f * sigmoidf_(zw[i])), a = sigmoidf_(za[i]);
                float kk = k_[i] * kkc; const float n2 = wave_sum(kk * kk); kk *= 1.f / sqrtf(n2 + 1e-12f);
                WD[tt * 64 + c] = dec; NKK[tt * 64 + c] = -kk; BB[tt * 64 + c] = kk * a; KD[tt * 64 + c] = k_[i] * (1.f + (a - 1.f) * kac); RR[tt * 64 + c] = r_[i]; VV[tt * 64 + c] = v_[i];
                if (d == 1) { const float bo = wave_sum(r_[i] * k_[i] * rkc); if (c == 0) BON[tt] = bo; }
            }
            __syncthreads();
            for (int s = 0; s < 32; ++s) {
                const int tt = d == 0 ? s : 31 - s; const int o = tt * 64 + kq * 8;
                const f32x4 w0 = *(const LAS f32x4*)(WD + o), w1 = *(const LAS f32x4*)(WD + o + 4), n0 = *(const LAS f32x4*)(NKK + o), n1 = *(const LAS f32x4*)(NKK + o + 4);
                const f32x4 b0 = *(const LAS f32x4*)(BB + o), b1 = *(const LAS f32x4*)(BB + o + 4), k0 = *(const LAS f32x4*)(KD + o), k1 = *(const LAS f32x4*)(KD + o + 4);
                const f32x4 r0 = *(const LAS f32x4*)(RR + o), r1 = *(const LAS f32x4*)(RR + o + 4);
                const float vv = VV[tt * 64 + row];
                float sa = (S[0] * n0.x + S[1] * n0.y) + (S[2] * n0.z + S[3] * n0.w) + (S[4] * n1.x + S[5] * n1.y) + (S[6] * n1.z + S[7] * n1.w);
                sa = reduce8(sa);
                S[0] = S[0] * w0.x + sa * b0.x + vv * k0.x; S[1] = S[1] * w0.y + sa * b0.y + vv * k0.y; S[2] = S[2] * w0.z + sa * b0.z + vv * k0.z; S[3] = S[3] * w0.w + sa * b0.w + vv * k0.w;
                S[4] = S[4] * w1.x + sa * b1.x + vv * k1.x; S[5] = S[5] * w1.y + sa * b1.y + vv * k1.y; S[6] = S[6] * w1.z + sa * b1.z + vv * k1.z; S[7] = S[7] * w1.w + sa * b1.w + vv * k1.w;
                float y = (S[0] * r0.x + S[1] * r0.y) + (S[2] * r0.z + S[3] * r0.w) + (S[4] * r1.x + S[5] * r1.y) + (S[6] * r1.z + S[7] * r1.w);
                y = reduce8(y);
                if (kq == 0) YC[tt * 64 + row] = y;
            }
            __syncthreads();
            {
                const int tt = F.tid >> 4, c4 = (F.tid & 15) * 4, m = m0 + t0 + tt;
                f32x4 y4 = *(const LAS f32x4*)(YC + tt * 64 + c4);
                float* gp = YB + (size_t)m * D + hh * 64 + c4;
                if (d == 0) *(f32x4*)gp = y4;
                else {
                    y4 += *(const f32x4*)gp;
                    float s1 = (y4.x + y4.y) + (y4.z + y4.w);
                    s1 += __shfl_xor(s1, 1); s1 += __shfl_xor(s1, 2); s1 += __shfl_xor(s1, 4); s1 += __shfl_xor(s1, 8);
                    const float mean = s1 * (1.f / 64.f);
                    const f32x4 dy = y4 - mean;
                    float s2 = (dy.x * dy.x + dy.y * dy.y) + (dy.z * dy.z + dy.w * dy.w);
                    s2 += __shfl_xor(s2, 1); s2 += __shfl_xor(s2, 2); s2 += __shfl_xor(s2, 4); s2 += __shfl_xor(s2, 8);
                    const float rstd = 1.f / sqrtf(s2 * (1.f / 64.f) + 64e-5f);
                    const f32x4 lg = *(const f32x4*)(F.in[I_LNG] + hh * 64 + c4), lb = *(const f32x4*)(F.in[I_LNB] + hh * 64 + c4);
                    const f32x4 vt = *(const LAS f32x4*)(VV + tt * 64 + c4);
                    const float bo = BON[tt];
                    const v2u gb = *(const v2u*)(GB + (size_t)m * D + hh * 64 + c4);
                    const f32x4 yn = dy * rstd * lg + lb + vt * bo;
                    v2u w; w.x = pk2(yn.x * bflo(gb.x), yn.y * bfhi(gb.x)); w.y = pk2(yn.z * bflo(gb.y), yn.w * bfhi(gb.y));
                    *(v2u*)(MIX + (size_t)m * DMIX + 1024 + hh * 64 + c4) = w;
                }
            }
        }
        if (!lat) { float* sp = F.out + OUT_ST + ((size_t)((b * 2 + d) * NHB + hh) * 64 + row) * 64 + kq * 8;
            *(f32x4*)sp = (f32x4){S[0], S[1], S[2], S[3]}; *(f32x4*)(sp + 4) = (f32x4){S[4], S[5], S[6], S[7]}; }
    }
}


constexpr int SG_ST = 144;
constexpr int G_AT = 0, G_RT = 9216, G_BH = 18432, G_KH = 26624, G_LAK = 34816, G_LBR = 36864, G_LKR = 38912, G_TM = 40960, G_GAM = 43008, G_PRIV = 44032;
constexpr int PW_TLW = 0, PW_LAB = 2304, PW_ZS = 4608, PW_LF = PW_ZS, PW_VT = PW_ZS + 1024, PW_SIZE = 8768, G_SIZE = G_PRIV + 4 * PW_SIZE;
constexpr int ZS_ST = 65, VT_ST = 40;
static_assert(2 * G_SIZE <= LDSCTL_OFF, "scan LDS map");
__device__ __forceinline__ bf16x8 mk8(v2u lo, v2u hi) { const v4u t = {lo.x, lo.y, hi.x, hi.y}; return __builtin_bit_cast(bf16x8, t); }
__device__ __forceinline__ bf16x8 pk8(f32x4 a, f32x4 b) { const v4u t = {pk2(a[0], a[1]), pk2(a[2], a[3]), pk2(b[0], b[1]), pk2(b[2], b[3])}; return __builtin_bit_cast(bf16x8, t); }
#define MFMA16(a, b, c) __builtin_amdgcn_mfma_f32_16x16x32_bf16(a, b, c, 0, 0, 0)
template <int CTRL> __device__ __forceinline__ float dpp_mov(float x) { return __builtin_bit_cast(float, __builtin_amdgcn_update_dpp(0, __builtin_bit_cast(int, x), CTRL, 0xf, 0xf, true)); }
__device__ __forceinline__ void wave_sum16(float (&v)[16], int lane) {
    float a8[8], a4[4], a2[2];
    { const bool bit = lane & 4;
#pragma unroll
      for (int m = 0; m < 8; ++m) { const float send = bit ? v[2 * m] : v[2 * m + 1], keep = bit ? v[2 * m + 1] : v[2 * m]; a8[m] = keep + dpp_mov<0x141>(send); } }
    { const bool bit = lane & 1;
#pragma unroll
      for (int m = 0; m < 4; ++m) { const float send = bit ? a8[2 * m] : a8[2 * m + 1], keep = bit ? a8[2 * m + 1] : a8[2 * m]; a4[m] = keep + dpp_mov<0xB1>(send); } }
    { const bool bit = lane & 2;
#pragma unroll
      for (int m = 0; m < 2; ++m) { const float send = bit ? a4[2 * m] : a4[2 * m + 1], keep = bit ? a4[2 * m + 1] : a4[2 * m]; a2[m] = keep + dpp_mov<0x4E>(send); } }
    float t;
    { const bool bit = lane & 8; const float send = bit ? a2[0] : a2[1], keep = bit ? a2[1] : a2[0]; t = keep + dpp_mov<0x128>(send); }
    t += __shfl_xor(t, 16); t += __shfl_xor(t, 32);
#pragma unroll
    for (int i = 0; i < 16; ++i) { constexpr int dummy = 0; const int src = ((i >> 1) & 1) + 2 * ((i >> 2) & 1) + 4 * (i & 1) + 8 * ((i >> 3) & 1);
        v[i] = __builtin_bit_cast(float, __builtin_amdgcn_readlane(__builtin_bit_cast(int, t), src)); }
}
__device__ __forceinline__ void load_shift16(const bf16* ubase, int T, int p0, int d, int col, float mA, float mB, float (&out)[16]) {
    float u[18];
#pragma unroll
    for (int j = 0; j < 18; ++j) { const int tj = d ? (T - p0 - j) : (p0 - 1 + j);
        if (j == 0 || j == 17) u[j] = (tj >= 0 && tj < T) ? bf2f(ubase[(size_t)tj * DSH + col]) : 0.f;
        else u[j] = bf2f(ubase[(size_t)tj * DSH + col]); }
#pragma unroll
    for (int i = 0; i < 16; ++i) out[i] = u[i + 1] + mA * (u[i] - u[i + 1]) + mB * (u[i + 2] - u[i + 1]);
}
__device__ __forceinline__ void scan_unit2(Frame& F, int b, int hh, bool lat) {
    const int T = lat ? LSEQ : SEQ, m0 = lat ? MC + b * LSEQ : b * SEQ, nch = T / 64;
    const int lane0 = F.lane, d = F.wave >> 2, w = F.wave & 3;
    int lane = lane0, c16 = lane & 15, g = lane >> 4, hc = hh * 64 + lane;
    LAS unsigned char* GB_ = F.lds + d * G_SIZE;
    LAS unsigned char* PW = GB_ + G_PRIV + w * PW_SIZE;
    const bf16* UB = (const bf16*)(F.ws + WS_UB) + (size_t)m0 * DSH; const bf16* GBp = (const bf16*)(F.ws + WS_GB); bf16* MIX = (bf16*)(F.ws + WS_MIX);
    float* YB = F.out + OUT_Y;
    const float* mu = F.in[I_MU];
    int cR = hc, cK = 1024 + hc, cV = 2048 + hc, cW = 3072 + 64 * d + lane, cA = 3200 + 64 * d + lane;
    const int oA = d ? DSH : 0, oB = d ? 0 : DSH;
    const float kkc = F.in[I_KK][hc], kac = F.in[I_KA][hc], rkc = F.in[I_RK][hc], w0c = F.in[I_W0][d * D + hc], a0c = F.in[I_A0][d * D + hc];
    const float lng = F.in[I_LNG][hc], lnb = F.in[I_LNB][hc];
    const v4u* wop0 = (const v4u*)(F.ws + WS_WOP) + (size_t)((d * 16 + hh) * 2) * 8 * 64;
    f32x4 S[4];
    const size_t st_off = ((size_t)((b * 2 + d) * NHB + hh) * 64 + 16 * w + c16) * 64 + 4 * g;
#pragma unroll
    for (int kt = 0; kt < 4; ++kt) S[kt] = lat ? *(const f32x4*)(F.in[I_ST] + st_off + 16 * kt) : (f32x4){0.f, 0.f, 0.f, 0.f};
    const v2u z2 = {0u, 0u};
    __syncthreads();
    for (int it = 0; it < nch; ++it) {
        const int p0 = it * 64 + w * 16;
        lane = lane0; asm volatile("" : "+v"(lane));
        c16 = lane & 15; g = lane >> 4; hc = hh * 64 + lane; cR = hc; cK = 1024 + hc; cV = 2048 + hc; cW = 3072 + 64 * d + lane; cA = 3200 + 64 * d + lane;
        const v4u* wop = wop0 + lane;
        float bon[16], v_[16];
        {
            float x_[16];
            load_shift16(UB, T, p0, d, cW, mu[oA + cW], mu[oB + cW], x_);
#pragma unroll
            for (int i = 0; i < 16; ++i) { const float e = __expf(2.f * x_[i]); *(LAS bf16*)(PW + PW_TLW + i * SG_ST + lane * 2) = (bf16)f2bf(1.f - 2.f / (e + 1.f)); }
            load_shift16(UB, T, p0, d, cA, mu[oA + cA], mu[oB + cA], x_);
#pragma unroll
            for (int i = 0; i < 16; ++i) *(LAS bf16*)(PW + PW_LAB + i * SG_ST + lane * 2) = (bf16)f2bf(x_[i]);
        }
        float lam[16], aa[16];
        {
            LAS float* Zs = (LAS float*)(PW + PW_ZS);
            {
                bf16x8 ta[2];
#pragma unroll
                for (int ks = 0; ks < 2; ++ks) ta[ks] = *(const LAS bf16x8*)(PW + PW_TLW + c16 * SG_ST + (32 * ks + 8 * g) * 2);
#pragma unroll
                for (int ct = 0; ct < 4; ++ct) { f32x4 z = {0.f, 0.f, 0.f, 0.f};
#pragma unroll
                    for (int ks = 0; ks < 2; ++ks) z = MFMA16(ta[ks], __builtin_bit_cast(bf16x8, wop[(ct * 2 + ks) * 64]), z);
#pragma unroll
                    for (int rg = 0; rg < 4; ++rg) Zs[(4 * g + rg) * ZS_ST + 16 * ct + c16] = z[rg]; }
                float l = 0.f;
#pragma unroll
                for (int i = 0; i < 16; ++i) { l += -0.60653065971f * sigmoidf_(w0c + Zs[i * ZS_ST + lane]); lam[i] = l; }
            }
            {
                bf16x8 tb[2];
#pragma unroll
                for (int ks = 0; ks < 2; ++ks) tb[ks] = *(const LAS bf16x8*)(PW + PW_LAB + c16 * SG_ST + (32 * ks + 8 * g) * 2);
#pragma unroll
                for (int ct = 0; ct < 4; ++ct) { f32x4 z = {0.f, 0.f, 0.f, 0.f};
#pragma unroll
                    for (int ks = 0; ks < 2; ++ks) z = MFMA16(tb[ks], __builtin_bit_cast(bf16x8, wop[512 + (ct * 2 + ks) * 64]), z);
#pragma unroll
                    for (int rg = 0; rg < 4; ++rg) Zs[(4 * g + rg) * ZS_ST + 16 * ct + c16] = z[rg]; }
#pragma unroll
                for (int i = 0; i < 16; ++i) aa[i] = sigmoidf_(a0c + Zs[i * ZS_ST + lane]);
            }
        }
        {
            float k_[16];
            load_shift16(UB, T, p0, d, cK, mu[oA + cK], mu[oB + cK], k_);
            {
                float n2[16];
#pragma unroll
                for (int i = 0; i < 16; ++i) { const float kk = k_[i] * kkc; n2[i] = kk * kk; }
                wave_sum16(n2, lane);
                unsigned bh[8], kh[8];
#pragma unroll
                for (int i = 0; i < 16; ++i) {
                    const float kk = k_[i] * kkc * (1.f / sqrtf(n2[i] + 1e-12f)), kd = k_[i] * (1.f + (aa[i] - 1.f) * kac), bb = kk * aa[i];
                    const float e1 = i ? __expf(lam[i - 1]) : 1.f, e2 = __expf(-lam[i]);
                    *(LAS bf16*)(GB_ + G_AT + (16 * w + i) * SG_ST + lane * 2) = (bf16)f2bf(-kk * e1);
                    const unsigned btb = f2bf(bb * e2), ktb = f2bf(kd * e2);
                    *(LAS bf16*)(PW + PW_TLW + i * SG_ST + lane * 2) = (bf16)btb;
                    *(LAS bf16*)(PW + PW_LAB + i * SG_ST + lane * 2) = (bf16)ktb;
                    if (i & 1) { bh[i >> 1] |= btb << 16; kh[i >> 1] |= ktb << 16; } else { bh[i >> 1] = btb; kh[i >> 1] = ktb; }
                }
#pragma unroll
                for (int q = 0; q < 4; ++q) {
                    *(LAS v2u*)(GB_ + G_BH + (w * 64 + lane) * 32 + 8 * q) = (v2u){bh[2 * q], bh[2 * q + 1]};
                    *(LAS v2u*)(GB_ + G_KH + (w * 64 + lane) * 32 + 8 * q) = (v2u){kh[2 * q], kh[2 * q + 1]};
                }
            }
            float r_[16];
            load_shift16(UB, T, p0, d, cR, mu[oA + cR], mu[oB + cR], r_);
#pragma unroll
            for (int i = 0; i < 16; ++i) { bon[i] = r_[i] * k_[i] * rkc; *(LAS bf16*)(GB_ + G_RT + (16 * w + i) * SG_ST + lane * 2) = (bf16)f2bf(r_[i] * __expf(lam[i])); }
            wave_sum16(bon, lane);
        }
        ((LAS float*)(GB_ + G_GAM))[w * 64 + lane] = __expf(lam[15]);
        {
            load_shift16(UB, T, p0, d, cV, mu[oA + cV], mu[oB + cV], v_);
            unsigned vt[8];
#pragma unroll
            for (int i = 0; i < 16; ++i) { const unsigned vtb = f2bf(v_[i]); if (i & 1) vt[i >> 1] |= vtb << 16; else vt[i >> 1] = vtb; v_[i] *= bon[i]; }
#pragma unroll
            for (int q = 0; q < 4; ++q) *(LAS v2u*)(PW + PW_VT + lane * VT_ST + 8 * q) = (v2u){vt[2 * q], vt[2 * q + 1]};
        }
        {
            bf16x8 fa[2], fr[2], fb[2], fk[2];
#pragma unroll
            for (int ks = 0; ks < 2; ++ks) {
                fa[ks] = *(const LAS bf16x8*)(GB_ + G_AT + (16 * w + c16) * SG_ST + (32 * ks + 8 * g) * 2); fr[ks] = *(const LAS bf16x8*)(GB_ + G_RT + (16 * w + c16) * SG_ST + (32 * ks + 8 * g) * 2);
                fb[ks] = *(const LAS bf16x8*)(PW + PW_TLW + c16 * SG_ST + (32 * ks + 8 * g) * 2); fk[ks] = *(const LAS bf16x8*)(PW + PW_LAB + c16 * SG_ST + (32 * ks + 8 * g) * 2);
            }
            f32x4 lab = {0.f, 0.f, 0.f, 0.f}, lak = lab, lbr = lab, lkr = lab;
#pragma unroll
            for (int ks = 0; ks < 2; ++ks) { lab = MFMA16(fa[ks], fb[ks], lab); lak = MFMA16(fa[ks], fk[ks], lak); lbr = MFMA16(fr[ks], fb[ks], lbr); lkr = MFMA16(fr[ks], fk[ks], lkr); }
            LAS float* Lf = (LAS float*)(PW + PW_LF);
#pragma unroll
            for (int rg = 0; rg < 4; ++rg) { const int i = 4 * g + rg, j = c16;
                Lf[i * 16 + j] = j < i ? lab[rg] : 0.f;
                *(LAS bf16*)(GB_ + G_LAK + (w * 16 + i) * 32 + j * 2) = (bf16)f2bf(j < i ? lak[rg] : 0.f);
                *(LAS bf16*)(GB_ + G_LBR + (w * 16 + i) * 32 + j * 2) = (bf16)f2bf(j <= i ? lbr[rg] : 0.f);
                *(LAS bf16*)(GB_ + G_LKR + (w * 16 + i) * 32 + j * 2) = (bf16)f2bf(j <= i ? lkr[rg] : 0.f); }
            float tm[16];
#pragma unroll
            for (int i = 0; i < 16; ++i) { float a = (i == c16) ? 1.f : 0.f;
#pragma unroll
                for (int j = 0; j < i; ++j) a += Lf[i * 16 + j] * tm[j];
                tm[i] = a; }
            if (lane < 16) {
#pragma unroll
                for (int i = 0; i < 16; ++i) *(LAS bf16*)(GB_ + G_TM + (w * 16 + i) * 32 + lane * 2) = (bf16)f2bf(tm[i]); }
        }
        __syncthreads();
        const bool first = it < nch / 2;
#pragma unroll 1
        for (int sc = 0; sc < 4; ++sc) {
            lane = lane0; asm volatile("" : "+v"(lane)); c16 = lane & 15; g = lane >> 4;
            const LAS unsigned char* at_p = GB_ + G_AT + (16 * sc + c16) * SG_ST + 8 * g;
            const LAS unsigned char* rt_p = GB_ + G_RT + (16 * sc + c16) * SG_ST + 8 * g;
            const LAS unsigned char* vt_p = GB_ + G_PRIV + sc * PW_SIZE + PW_VT + (16 * w + c16) * VT_ST + 8 * g;
            const bf16x8 sop0 = pk8(S[0], S[1]), sop1 = pk8(S[2], S[3]);
            const bf16x8 at0 = mk8(*(const LAS v2u*)(at_p), *(const LAS v2u*)(at_p + 32)), at1 = mk8(*(const LAS v2u*)(at_p + 64), *(const LAS v2u*)(at_p + 96));
            const bf16x8 rt0 = mk8(*(const LAS v2u*)(rt_p), *(const LAS v2u*)(rt_p + 32)), rt1 = mk8(*(const LAS v2u*)(rt_p + 64), *(const LAS v2u*)(rt_p + 96));
            const v2u vt2 = *(const LAS v2u*)vt_p;
            const bf16x8 alak = mk8(*(const LAS v2u*)(GB_ + G_LAK + (sc * 16 + c16) * 32 + 8 * g), z2);
            const bf16x8 atm = mk8(*(const LAS v2u*)(GB_ + G_TM + (sc * 16 + c16) * 32 + 8 * g), z2);
            const bf16x8 albk = mk8(*(const LAS v2u*)(GB_ + G_LBR + (sc * 16 + c16) * 32 + 8 * g), *(const LAS v2u*)(GB_ + G_LKR + (sc * 16 + c16) * 32 + 8 * g));
            f32x4 X = {0.f, 0.f, 0.f, 0.f};
            X = MFMA16(at0, sop0, X); X = MFMA16(at1, sop1, X); X = MFMA16(alak, mk8(vt2, z2), X);
            const v4u xo = {pk2(X[0], X[1]), pk2(X[2], X[3]), 0u, 0u};
            f32x4 U = {0.f, 0.f, 0.f, 0.f};
            U = MFMA16(atm, __builtin_bit_cast(bf16x8, xo), U);
            const v4u uo = {pk2(U[0], U[1]), pk2(U[2], U[3]), vt2.x, vt2.y};
            const bf16x8 uvop = __builtin_bit_cast(bf16x8, uo);
            float* yp[4];
#pragma unroll
            for (int rg = 0; rg < 4; ++rg) { const int p = it * 64 + sc * 16 + 4 * g + rg, t = d ? T - 1 - p : p; yp[rg] = YB + (size_t)(m0 + t) * D + hh * 64 + 16 * w + c16; }
            f32x4 Y = {0.f, 0.f, 0.f, 0.f};
            if (!first) {
#pragma unroll
                for (int rg = 0; rg < 4; ++rg) Y[rg] = *yp[rg]; }
            Y = MFMA16(rt0, sop0, Y); Y = MFMA16(rt1, sop1, Y); Y = MFMA16(albk, uvop, Y);
#pragma unroll
            for (int rg = 0; rg < 4; ++rg) *yp[rg] = Y[rg];
#pragma unroll
            for (int kt = 0; kt < 4; ++kt) {
                const bf16x8 abk = mk8(*(const LAS v2u*)(GB_ + G_BH + (sc * 64 + 16 * kt + c16) * 32 + 8 * g), *(const LAS v2u*)(GB_ + G_KH + (sc * 64 + 16 * kt + c16) * 32 + 8 * g));
                const f32x4 gm = *(const LAS f32x4*)(GB_ + G_GAM + (sc * 64 + 16 * kt + 4 * g) * 4);
                S[kt] = MFMA16(abk, uvop, S[kt]) * gm;
            }
        }
        __syncthreads();
        if (!first) {
            lane = lane0; asm volatile("" : "+v"(lane)); hc = hh * 64 + lane;
            float y_[16], s1[16];
#pragma unroll
            for (int i = 0; i < 16; ++i) { const int p = p0 + i, t = d ? T - 1 - p : p; y_[i] = YB[(size_t)(m0 + t) * D + hc]; s1[i] = y_[i]; }
            wave_sum16(s1, lane);
#pragma unroll
            for (int i = 0; i < 16; ++i) { y_[i] -= s1[i] * (1.f / 64.f); s1[i] = y_[i] * y_[i]; }
            wave_sum16(s1, lane);
#pragma unroll
            for (int i = 0; i < 16; ++i) { const int p = p0 + i, t = d ? T - 1 - p : p; const size_t m = (size_t)(m0 + t);
                const float yn = y_[i] * (1.f / sqrtf(s1[i] * (1.f / 64.f) + 64e-5f)) * lng + lnb + v_[i];
                MIX[m * DMIX + 1024 + hc] = (bf16)f2bf(yn * bf2f(GBp[m * D + hc])); }
        }
    }
    if (!lat) {
        float* sp = F.out + OUT_ST + st_off;
#pragma unroll
        for (int kt = 0; kt < 4; ++kt) *(f32x4*)(sp + 16 * kt) = S[kt];
    }
}


__device__ __forceinline__ void st_bf16(LAS unsigned char* p, float v) { *(LAS bf16*)p = (bf16)f2bf_hw(v); }
struct PfRows { unsigned off[3]; bool ok[3]; };
__device__ __forceinline__ PfRows pf_rows(int T, int p0, int d, int lane) {
    PfRows R;
#pragma unroll
    for (int q = 0; q < 3; ++q) { const int j = 8 * q + (lane >> 3), jj = j > 17 ? 17 : j, pj = p0 - 1 + jj; int tj = d ? T - 1 - pj : pj; R.ok[q] = tj >= 0 && tj < T; tj = R.ok[q] ? tj : 0;
        R.off[q] = (unsigned)tj * (unsigned)DSH + (unsigned)(lane & 7) * 8u; }
    return R;
}
__device__ __forceinline__ void pf_issue(const bf16* ubase, const PfRows& R, int colb, v4u (&r)[3]) {
#pragma unroll
    for (int q = 0; q < 3; ++q) { v4u x = *(const v4u*)(ubase + colb + R.off[q]); if (!R.ok[q]) x = (v4u){0u, 0u, 0u, 0u}; r[q] = x; }
}
__device__ __forceinline__ void pf_consume(LAS unsigned char* stg, const v4u (&r)[3], int lane, float mA, float mB, float (&out)[16]) {
#pragma unroll
    for (int q = 0; q < 3; ++q) *(LAS v4u*)(stg + (8 * q + (lane >> 3)) * SG_ST + (lane & 7) * 16) = r[q];
    asm volatile("" ::: "memory");
    float u[18];
#pragma unroll
    for (int j = 0; j < 18; ++j) u[j] = bf2f(*(const LAS bf16*)(stg + j * SG_ST + lane * 2));
    asm volatile("" ::: "memory");
    const float m0_ = 1.f - mA - mB;
#pragma unroll
    for (int i = 0; i < 16; ++i) out[i] = m0_ * u[i + 1] + mA * u[i] + mB * u[i + 2];
}
__device__ __forceinline__ void scan_unit3(Frame& F, int b, int hh, bool lat, const XcdBarrier* gbar = nullptr, int gbar_it = -1) {
    const int T = lat ? LSEQ : SEQ, m0 = lat ? MC + b * LSEQ : b * SEQ, nch = T / 64;
    int lane0 = F.lane; asm volatile("" : "+v"(lane0));
    const int d = F.wave >> 2, w = F.wave & 3;
    int lane = lane0, c16 = lane & 15, g = lane >> 4, hc = hh * 64 + lane;
    LAS unsigned char* GB_ = F.lds + d * G_SIZE;
    LAS unsigned char* PW = GB_ + G_PRIV + w * PW_SIZE;
    const bf16* UB = (const bf16*)(F.ws + WS_UB) + (size_t)m0 * DSH; const bf16* GBp = (const bf16*)(F.ws + WS_GB); bf16* MIX = (bf16*)(F.ws + WS_MIX);
    float* YB = F.out + OUT_Y;
    const float* mu = F.in[I_MU];
    const int cR = hh * 64, cK = 1024 + hh * 64, cV = 2048 + hh * 64, cW = 3072 + 64 * d, cA = 3200 + 64 * d;
    const int oA = d ? DSH : 0, oB = d ? 0 : DSH;
    const float kkc = F.in[I_KK][hc], kac = F.in[I_KA][hc], rkc = F.in[I_RK][hc], w0c = F.in[I_W0][d * D + hc], a0c = F.in[I_A0][d * D + hc];
    const float mWA = mu[oA + cW + lane], mWB = mu[oB + cW + lane], mAA = mu[oA + cA + lane], mAB = mu[oB + cA + lane], mKA = mu[oA + cK + lane], mKB = mu[oB + cK + lane];
    const float mRA = mu[oA + cR + lane], mRB = mu[oB + cR + lane], mVA = mu[oA + cV + lane], mVB = mu[oB + cV + lane];
    const v4u* wop0 = (const v4u*)(F.ws + WS_WOP) + (size_t)((d * 16 + hh) * 2) * 8 * 64;
    f32x4 S[4];
    { const size_t st_off = ((size_t)((b * 2 + d) * NHB + hh) * 64 + 16 * w + c16) * 64 + 4 * g;
#pragma unroll
    for (int kt = 0; kt < 4; ++kt) S[kt] = lat ? *(const f32x4*)(F.in[I_ST] + st_off + 16 * kt) : (f32x4){0.f, 0.f, 0.f, 0.f}; }
    const v2u z2 = {0u, 0u};
    v4u pW[3], pA[3], pK[3], pR[3], pV[3];
    { const PfRows R = pf_rows(T, w * 16, d, lane); pf_issue(UB, R, cW, pW); pf_issue(UB, R, cA, pA); pf_issue(UB, R, cK, pK); pf_issue(UB, R, cR, pR); pf_issue(UB, R, cV, pV); }
    __syncthreads();
    for (int it = 0; it < nch; ++it) {
        if (it == gbar_it) xcd_barrier(*gbar);
        const int p0 = it * 64 + w * 16;
        const bool first = it < nch / 2;
        lane = lane0; asm volatile("" : "+v"(lane));
        c16 = lane & 15; g = lane >> 4; hc = hh * 64 + lane;
        const v4u* wop = wop0 + lane;
        LAS unsigned char* stg = PW + PW_ZS;
        float bon[16], v_[16];
#ifndef SREP_PREP
#define SREP_PREP 1
#endif
#ifndef SREP_POST
#define SREP_POST 1
#endif
#ifndef SREP_B
#define SREP_B 1
#endif
#pragma unroll 1
        for (int rep_ = 0; rep_ < SREP_PREP; ++rep_) {
        {
            float x_[16];
            pf_consume(stg, pW, lane, mWA, mWB, x_);
#pragma unroll
            for (int i = 0; i < 16; ++i) { const float e = __expf(2.f * x_[i]); st_bf16(PW + PW_TLW + i * SG_ST + lane * 2, 1.f - 2.f * __builtin_amdgcn_rcpf(e + 1.f)); }
            pf_consume(stg, pA, lane, mAA, mAB, x_);
#pragma unroll
            for (int i = 0; i < 16; ++i) st_bf16(PW + PW_LAB + i * SG_ST + lane * 2, x_[i]);
        }
        float k_[16];
        pf_consume(stg, pK, lane, mKA, mKB, k_);
        asm volatile("" ::: "memory");
        float lam[16], aa[16];
        {
            LAS float* Zs = (LAS float*)(PW + PW_ZS);
            {
                bf16x8 ta[2];
#pragma unroll
                for (int ks = 0; ks < 2; ++ks) ta[ks] = *(const LAS bf16x8*)(PW + PW_TLW + c16 * SG_ST + (32 * ks + 8 * g) * 2);
#pragma unroll
                for (int ct = 0; ct < 4; ++ct) { f32x4 z = {0.f, 0.f, 0.f, 0.f};
#pragma unroll
                    for (int ks = 0; ks < 2; ++ks) z = MFMA16(ta[ks], __builtin_bit_cast(bf16x8, wop[(ct * 2 + ks) * 64]), z);
#pragma unroll
                    for (int rg = 0; rg < 4; ++rg) Zs[(4 * g + rg) * ZS_ST + 16 * ct + c16] = z[rg]; }
                float l = 0.f;
#pragma unroll
                for (int i = 0; i < 16; ++i) { l += -0.60653065971f * sigmoidf_(w0c + Zs[i * ZS_ST + lane]); lam[i] = l; }
            }
            asm volatile("" ::: "memory");
            {
                bf16x8 tb[2];
#pragma unroll
                for (int ks = 0; ks < 2; ++ks) tb[ks] = *(const LAS bf16x8*)(PW + PW_LAB + c16 * SG_ST + (32 * ks + 8 * g) * 2);
#pragma unroll
                for (int ct = 0; ct < 4; ++ct) { f32x4 z = {0.f, 0.f, 0.f, 0.f};
#pragma unroll
                    for (int ks = 0; ks < 2; ++ks) z = MFMA16(tb[ks], __builtin_bit_cast(bf16x8, wop[512 + (ct * 2 + ks) * 64]), z);
#pragma unroll
                    for (int rg = 0; rg < 4; ++rg) Zs[(4 * g + rg) * ZS_ST + 16 * ct + c16] = z[rg]; }
#pragma unroll
                for (int i = 0; i < 16; ++i) aa[i] = sigmoidf_(a0c + Zs[i * ZS_ST + lane]);
            }
        }
        {
            {
                float n2[16];
#pragma unroll
                for (int i = 0; i < 16; ++i) { const float kk = k_[i] * kkc; n2[i] = kk * kk; }
                wave_sum16(n2, lane);
                unsigned bh[8], kh[8];
                float e1 = 1.f;
#pragma unroll
                for (int i = 0; i < 16; i += 2) {
                    float bt2[2], kt2[2];
#pragma unroll
                    for (int e = 0; e < 2; ++e) {
                        const float kk = k_[i + e] * kkc * __builtin_amdgcn_rsqf(n2[i + e] + 1e-12f), kd = k_[i + e] * (1.f + (aa[i + e] - 1.f) * kac), bb = kk * aa[i + e];
                        const float e3 = __expf(lam[i + e]), e2 = __builtin_amdgcn_rcpf(e3);
                        lam[i + e] = e3;
                        st_bf16(GB_ + G_AT + (16 * w + i + e) * SG_ST + lane * 2, -kk * e1);
                        bt2[e] = bb * e2; kt2[e] = kd * e2; e1 = e3;
                    }
                    const unsigned bp = pk2(bt2[0], bt2[1]), kp = pk2(kt2[0], kt2[1]);
                    bh[i >> 1] = bp; kh[i >> 1] = kp;
                    *(LAS bf16*)(PW + PW_TLW + i * SG_ST + lane * 2) = (bf16)bp; *(LAS bf16*)(PW + PW_TLW + (i + 1) * SG_ST + lane * 2) = (bf16)(bp >> 16);
                    *(LAS bf16*)(PW + PW_LAB + i * SG_ST + lane * 2) = (bf16)kp; *(LAS bf16*)(PW + PW_LAB + (i + 1) * SG_ST + lane * 2) = (bf16)(kp >> 16);
                }
#pragma unroll
                for (int q = 0; q < 4; ++q) {
                    *(LAS v2u*)(GB_ + G_BH + (w * 64 + lane) * 32 + 8 * q) = (v2u){bh[2 * q], bh[2 * q + 1]};
                    *(LAS v2u*)(GB_ + G_KH + (w * 64 + lane) * 32 + 8 * q) = (v2u){kh[2 * q], kh[2 * q + 1]};
                }
            }
            float r_[16];
            pf_consume(stg, pR, lane, mRA, mRB, r_);
#pragma unroll
            for (int i = 0; i < 16; ++i) { bon[i] = r_[i] * k_[i] * rkc; st_bf16(GB_ + G_RT + (16 * w + i) * SG_ST + lane * 2, r_[i] * lam[i]); }
            wave_sum16(bon, lane);
        }
        ((LAS float*)(GB_ + G_GAM))[w * 64 + lane] = lam[15];
        {
            pf_consume(stg, pV, lane, mVA, mVB, v_);
            unsigned vt[8];
#pragma unroll
            for (int i = 0; i < 16; i += 2) { vt[i >> 1] = pk2(v_[i], v_[i + 1]); v_[i] *= bon[i]; v_[i + 1] *= bon[i + 1]; }
            asm volatile("" ::: "memory");
#pragma unroll
            for (int q = 0; q < 4; ++q) *(LAS v2u*)(PW + PW_VT + lane * VT_ST + 8 * q) = (v2u){vt[2 * q], vt[2 * q + 1]};
        }
        asm volatile("" ::: "memory");
        {
            bf16x8 fa[2], fr[2], fb[2], fk[2];
#pragma unroll
            for (int ks = 0; ks < 2; ++ks) {
                fa[ks] = *(const LAS bf16x8*)(GB_ + G_AT + (16 * w + c16) * SG_ST + (32 * ks + 8 * g) * 2); fr[ks] = *(const LAS bf16x8*)(GB_ + G_RT + (16 * w + c16) * SG_ST + (32 * ks + 8 * g) * 2);
                fb[ks] = *(const LAS bf16x8*)(PW + PW_TLW + c16 * SG_ST + (32 * ks + 8 * g) * 2); fk[ks] = *(const LAS bf16x8*)(PW + PW_LAB + c16 * SG_ST + (32 * ks + 8 * g) * 2);
            }
            f32x4 lab = {0.f, 0.f, 0.f, 0.f}, lak = lab, lbr = lab, lkr = lab;
#pragma unroll
            for (int ks = 0; ks < 2; ++ks) { lab = MFMA16(fa[ks], fb[ks], lab); lak = MFMA16(fa[ks], fk[ks], lak); lbr = MFMA16(fr[ks], fb[ks], lbr); lkr = MFMA16(fr[ks], fk[ks], lkr); }
            LAS float* Lf = (LAS float*)(PW + PW_LF);
#pragma unroll
            for (int rg = 0; rg < 4; ++rg) { const int i = 4 * g + rg, j = c16;
                Lf[i * 16 + j] = j < i ? lab[rg] : 0.f;
                st_bf16(GB_ + G_LAK + (w * 16 + i) * 32 + j * 2, j < i ? lak[rg] : 0.f);
                st_bf16(GB_ + G_LBR + (w * 16 + i) * 32 + j * 2, j <= i ? lbr[rg] : 0.f);
                st_bf16(GB_ + G_LKR + (w * 16 + i) * 32 + j * 2, j <= i ? lkr[rg] : 0.f); }
            float tm[16];
#pragma unroll
            for (int i = 0; i < 16; ++i) { float a = (i == c16) ? 1.f : 0.f;
#pragma unroll
                for (int j = 0; j < i; ++j) a += Lf[i * 16 + j] * tm[j];
                tm[i] = a; }
            if (lane < 16) {
#pragma unroll
                for (int i = 0; i < 16; ++i) st_bf16(GB_ + G_TM + (w * 16 + i) * 32 + lane * 2, tm[i]); }
        }
        }
        __syncthreads();
        if (it + 1 < nch) { const PfRows R = pf_rows(T, p0 + 64, d, lane); pf_issue(UB, R, cW, pW); pf_issue(UB, R, cA, pA); pf_issue(UB, R, cK, pK); pf_issue(UB, R, cR, pR); pf_issue(UB, R, cV, pV); }
        float yo[16];
        if (!first) {
#pragma unroll
            for (int i = 0; i < 16; ++i) { const int p = p0 + i, t = d ? T - 1 - p : p; yo[i] = YB[(size_t)(m0 + t) * D + hc]; } }
        {
            lane = lane0; asm volatile("" : "+v"(lane)); c16 = lane & 15; g = lane >> 4;
            const LAS unsigned char* at_b = GB_ + G_AT + c16 * SG_ST + 8 * g;
            const LAS unsigned char* rt_b = GB_ + G_RT + c16 * SG_ST + 8 * g;
            const LAS unsigned char* vt_b = GB_ + G_PRIV + PW_VT + (16 * w + c16) * VT_ST + 8 * g;
            const LAS unsigned char* l_b = GB_ + c16 * 32 + 8 * g;
            const LAS unsigned char* gm_b = GB_ + G_GAM + 16 * g;
            LAS float* yc_b = (LAS float*)(GB_ + G_PRIV + PW_TLW) + (4 * g) * ZS_ST + 16 * w + c16;
#pragma unroll
            for (int sc = 0; sc < 4; ++sc) {
                const LAS unsigned char* at_p = at_b + sc * 16 * SG_ST; const LAS unsigned char* rt_p = rt_b + sc * 16 * SG_ST;
                const bf16x8 sop0 = pk8(S[0], S[1]), sop1 = pk8(S[2], S[3]);
                const bf16x8 at0 = mk8(*(const LAS v2u*)(at_p), *(const LAS v2u*)(at_p + 32)), at1 = mk8(*(const LAS v2u*)(at_p + 64), *(const LAS v2u*)(at_p + 96));
                const bf16x8 rt0 = mk8(*(const LAS v2u*)(rt_p), *(const LAS v2u*)(rt_p + 32)), rt1 = mk8(*(const LAS v2u*)(rt_p + 64), *(const LAS v2u*)(rt_p + 96));
                const v2u vt2 = *(const LAS v2u*)(vt_b + sc * PW_SIZE);
                const bf16x8 alak = mk8(*(const LAS v2u*)(l_b + G_LAK + sc * 512), z2);
                const bf16x8 atm = mk8(*(const LAS v2u*)(l_b + G_TM + sc * 512), z2);
                const bf16x8 albk = mk8(*(const LAS v2u*)(l_b + G_LBR + sc * 512), *(const LAS v2u*)(l_b + G_LKR + sc * 512));
                f32x4 X = {0.f, 0.f, 0.f, 0.f}, Y = X;
                X = MFMA16(at0, sop0, X); Y = MFMA16(rt0, sop0, Y); X = MFMA16(at1, sop1, X); Y = MFMA16(rt1, sop1, Y); X = MFMA16(alak, mk8(vt2, z2), X);
                const v4u xo = {pk2(X[0], X[1]), pk2(X[2], X[3]), 0u, 0u};
                f32x4 U = {0.f, 0.f, 0.f, 0.f};
                U = MFMA16(atm, __builtin_bit_cast(bf16x8, xo), U);
                const v4u uo = {pk2(U[0], U[1]), pk2(U[2], U[3]), vt2.x, vt2.y};
                const bf16x8 uvop = __builtin_bit_cast(bf16x8, uo);
                Y = MFMA16(albk, uvop, Y);
#pragma unroll
                for (int kt = 0; kt < 4; ++kt) {
                    const bf16x8 abk = mk8(*(const LAS v2u*)(l_b + G_BH + (sc * 64 + 16 * kt) * 32), *(const LAS v2u*)(l_b + G_KH + (sc * 64 + 16 * kt) * 32));
                    const f32x4 gm = *(const LAS f32x4*)(gm_b + (sc * 64 + 16 * kt) * 4);
                    S[kt] = MFMA16(abk, uvop, S[kt]) * gm;
                }
                LAS float* yc = yc_b + sc * (PW_SIZE / 4);
#pragma unroll
                for (int rg = 0; rg < 4; ++rg) yc[rg * ZS_ST] = Y[rg];
            }
        }
        __syncthreads();
#pragma unroll 1
        for (int rep_ = 0; rep_ < SREP_POST; ++rep_)
        {
            lane = lane0; asm volatile("" : "+v"(lane)); hc = hh * 64 + lane;
            const LAS float* yc = (const LAS float*)(PW + PW_TLW);
            float y_[16];
#pragma unroll
            for (int i = 0; i < 16; ++i) y_[i] = yc[i * ZS_ST + lane];
            if (first) {
#pragma unroll
                for (int i = 0; i < 16; ++i) { const int p = p0 + i, t = d ? T - 1 - p : p; YB[(size_t)(m0 + t) * D + hc] = y_[i]; }
            } else {
                const float lng = F.in[I_LNG][hc], lnb = F.in[I_LNB][hc];
                unsigned short gb_[16];
#pragma unroll
                for (int i = 0; i < 16; ++i) { const int p = p0 + i, t = d ? T - 1 - p : p; gb_[i] = *(const unsigned short*)(GBp + (size_t)(m0 + t) * D + hc); }
                float s1[16];
#pragma unroll
                for (int i = 0; i < 16; ++i) { y_[i] += yo[i]; s1[i] = y_[i]; }
                wave_sum16(s1, lane);
#pragma unroll
                for (int i = 0; i < 16; ++i) { y_[i] -= s1[i] * (1.f / 64.f); s1[i] = y_[i] * y_[i]; }
                wave_sum16(s1, lane);
#pragma unroll
                for (int i = 0; i < 16; ++i) { const int p = p0 + i, t = d ? T - 1 - p : p; const size_t m = (size_t)(m0 + t);
                    const float yn = y_[i] * __builtin_amdgcn_rsqf(s1[i] * (1.f / 64.f) + 64e-5f) * lng + lnb + v_[i];
                    MIX[m * DMIX + 1024 + hc] = (bf16)f2bf_hw(yn * bf2f((bf16)gb_[i])); }
            }
        }
    }
    if (!lat) {
        lane = lane0; asm volatile("" : "+v"(lane)); c16 = lane & 15; g = lane >> 4;
        float* sp = F.out + OUT_ST + ((size_t)((b * 2 + d) * NHB + hh) * 64 + 16 * w + c16) * 64 + 4 * g;
#pragma unroll
        for (int kt = 0; kt < 4; ++kt) *(f32x4*)(sp + 16 * kt) = S[kt];
    }
}

template <int QW, int MASK> __device__ __forceinline__ void p3_mixers(Frame& F, const XcdBarrier& gbar) {
    float lam;
    { const float a = F.in[I_LQ1][F.lane] * F.in[I_LK1][F.lane], bq = F.in[I_LQ2][F.lane] * F.in[I_LK2][F.lane];
      lam = __expf(wave_sum(a)) - __expf(wave_sum(bq)) + 0.2f; }
    constexpr int N_SC = NBC * NHB, N_AL = NBL * NH * (LSEQ / 128), N_AC = NBC * NH * (SEQ / 128);
    constexpr int NU = N_AL + N_SC + N_AC;
    volatile LAS int* slot = (volatile LAS int*)(F.lds + MISC_OFF + 64);
    bool chain_first = (int)blockIdx.x < NLATB;
    for (;;) {
        int u, sb, sh, git = -1; bool slat = false, is_scan;
        if (chain_first) { chain_first = false; is_scan = true; slat = true; sb = (int)blockIdx.x / NHB; sh = (int)blockIdx.x % NHB; git = LAT_BAR_IT; u = 0; }
        else {
            __syncthreads();
            if (F.tid == 0) *slot = (int)__hip_atomic_fetch_add((unsigned*)(F.ctl + CW_Q3 + 64 * QW), 1u, RLX_AGENT);
            __syncthreads();
            u = *slot;
            if (u >= NU) break;
            is_scan = u < N_SC;
            sb = u / NHB; sh = u % NHB;
        }
        if (is_scan) { scan_unit3(F, sb, sh, slat, &gbar, git); continue; }
        { u -= N_SC; const bool lt = u < N_AL; if (!lt) u -= N_AL; attn_unit(F, u, lt, lam); }
    }
}

template <bool DUMMY> __device__ __forceinline__ void p5_final(Frame& F) {
    int ln = F.lane; asm volatile("" : "+v"(ln));
    const float* ssq = (const float*)(F.ws + WS_SSQ);
    const int gw = blockIdx.x * NWAVES + F.wave, NGW = F.G * NWAVES;
    for (int m = gw; m < M; m += NGW) {
        float s = ln < 16 ? ssq[(size_t)m * 16 + ln] : 0.f;
        s = wave_sum(s);
        const float rstd = 1.f / sqrtf(s * (1.f / D) + 1e-6f);
        float* yr = F.out + OUT_Y + (size_t)m * D;
#pragma unroll
        for (int j = 0; j < 4; ++j) { const int c = 4 * ln + 256 * j; const f32x4 v = *(const f32x4*)(yr + c), g = *(const f32x4*)(F.in[I_FG] + c); *(f32x4*)(yr + c) = DUMMY ? v : v * rstd * g; }
    }
}

__global__ void __launch_bounds__(NTHR, 2) hymba_fwd(Args args) {
    extern __shared__ __attribute__((aligned(16))) unsigned char lds[];
    Frame F;
    F.lds = (LAS unsigned char*)lds;
    F.MISC = (volatile LAS unsigned*)(F.lds + MISC_OFF);
    F.tid = threadIdx.x; F.lane = F.tid & 63; F.wave = __builtin_amdgcn_readfirstlane(F.tid >> 6);
    F.G = gridDim.x; F.in = args.in; F.out = args.out; F.ws = args.ws;
    F.ctl = (gu32*)(args.ws + WS_CTL);
    for (int u = F.tid; u < (LDS_BYTES - LDSCTL_OFF) / 4; u += NTHR) ((LAS unsigned*)(F.lds + LDSCTL_OFF))[u] = 0u;
    __syncthreads();
    XcdBarrier bar; bar.bar = (unsigned*)(F.ctl + CW_BAR); bar.x = 0; bar.st = nullptr;
    if (N_LAUNCHES != PER_PHASE) bar = xcd_barrier_post((unsigned*)(F.ctl + CW_BAR), F.MISC + 8);
#define GRID_BAR() do { if (N_LAUNCHES != PER_PHASE) xcd_barrier(bar); } while (0)
    const int lo = args.ph_lo, hi = args.ph_hi;
#define IN(k) (lo <= (k) && (k) < hi)
#define BOTH(k) (IN(k) && IN((k) + 1))
#ifndef REP0
#define REP0 1
#endif
#ifndef REP2
#define REP2 1
#endif
#ifndef REP3MASK
#define REP3MASK 0
#endif
#ifndef REP4
#define REP4 1
#endif
#define RELANE() do { int t_ = threadIdx.x; asm volatile("" : "+v"(t_)); F.tid = t_; F.lane = t_ & 63; } while (0)
    {
        f32x4 xv[5][4];
        p0_prologue(F); RELANE(); p1_load<0, 3>(F, xv); GRID_BAR();
        p1_load<3, 5>(F, xv); p1_norm(F, xv); GRID_BAR();
    }
    RELANE();
    if (IN(2)) {
        const pg8::Gemm g{(const bf16*)(F.ws + WS_XN), (const bf16*)(F.ws + WS_WIN), M, DIN, D};
        const EpiIn E{F.ws, F.out};
        const bool chain = (int)blockIdx.x < NLATB;
#pragma unroll 1
        for (int part = 0; part < 2; ++part) {
            if (part == 1 && chain) break;
            ListOrder S;
            if (part == 0) S.init(F.G, (int)blockIdx.x, 0, P2A_UNITS); else S.init(F.G - NLATB, (int)blockIdx.x - NLATB, P2A_UNITS, P2_UNITS);
            pg8::gemm_phase<EpiIn, ListOrder, true, true>(F.lds + RING_OFF, g, S, E);
            GRID_BAR();
        }
    }
    RELANE();
    if (IN(3)) { p3_mixers<0, 15>(F, bar); if (BOTH(3)) GRID_BAR(); }
    RELANE();
    if (IN(4)) {
        pg8::Gemm g{(const bf16*)(F.ws + WS_MIX), (const bf16*)(F.ws + WS_WOUT), M, D, DMIX}; pg8::StaticOrder S; S.init(M, D, F.G, (int)blockIdx.x);
        EpiOutFused E{F.ws, F.out, F.in[I_XP], F.in[I_XS], F.in[I_FG], F.ctl};
        pg8::gemm_phase<EpiOutFused, pg8::StaticOrder, false, true>(F.lds + RING_OFF, g, S, E);
    }
#undef IN
#undef BOTH
}

extern "C" void kernel_launch(void* const* d_in, const int* in_sizes, int n_in, void* d_out, int out_size, void* d_ws, size_t ws_size, hipStream_t stream) {
    static int grid = 0;
    if (grid == 0) {
        if (n_in != N_IN || out_size != OUT_END || ws_size < WS_END) { fprintf(stderr, "kernel_launch: unexpected sizes n_in %d out %d ws %zu\n", n_in, out_size, ws_size); grid = -1; return; }
        int dev = 0, cus = 0, per_cu = 0;
        if (hipGetDevice(&dev) != hipSuccess || hipDeviceGetAttribute(&cus, hipDeviceAttributeMultiprocessorCount, dev) != hipSuccess) { grid = -1; return; }
        if (hipFuncSetAttribute((const void*)hymba_fwd, hipFuncAttributeMaxDynamicSharedMemorySize, LDS_BYTES) != hipSuccess) { fprintf(stderr, "kernel_launch: hipFuncSetAttribute failed\n"); grid = -1; return; }
        if (hipOccupancyMaxActiveBlocksPerMultiprocessor(&per_cu, (const void*)hymba_fwd, NTHR, LDS_BYTES) != hipSuccess || per_cu < 1) { fprintf(stderr, "kernel_launch: occupancy query says %d\n", per_cu); per_cu = 1; }
        (void)hipGetLastError();
        grid = cus;
        if (grid != 256) { fprintf(stderr, "kernel_launch: built for a 256-CU device (got %d CUs)\n", cus); grid = -1; return; }
    }
    if (grid < 0) return;
    if (hipMemsetAsync((char*)d_ws + WS_CTL, 0, CTL_ZERO_BYTES, stream) != hipSuccess) return;
    Args a{};
    for (int i = 0; i < N_IN; ++i) a.in[i] = (const float*)d_in[i];
    a.out = (float*)d_out; a.ws = (unsigned char*)d_ws;
    a.ph_lo = 0; a.ph_hi = PER_PHASE; a.li = 0;
    hipLaunchKernelGGL(hymba_fwd, dim3(grid), dim3(NTHR), LDS_BYTES, stream, a);
}
```

```cpp
#include <hip/hip_runtime.h>
#include <cstdio>
#include <cstdint>

#ifndef MK_N_LAUNCHES
#define MK_N_LAUNCHES 1
#endif

namespace pg8 {
#define PG8_LAS __attribute__((address_space(3)))
typedef unsigned short bf16_t;
typedef short bf16x8 __attribute__((ext_vector_type(8)));
typedef float f32x4 __attribute__((ext_vector_type(4)));
typedef unsigned u32x4 __attribute__((ext_vector_type(4)));
constexpr int BM = 256, BK = 64, HALF = 128, HTB = HALF * BK * 2, STAGE_BYTES = 8 * HTB, NXCD = 8, WGM = 8;

__host__ __device__ __forceinline__ int lds_byte(int r, int c) { const int st = (r >> 4) * 2 + (c >> 5), rr = r & 15, cc = c & 31, ob = rr * 64 + cc * 2; return st * 1024 + (ob ^ (((ob >> 9) & 1) << 5)); }
__host__ __device__ __forceinline__ void stage_rc(int b, int& R, int& C) { const int st = b / 1024, sb = b % 1024, swz = sb ^ (((sb >> 9) & 1) << 5); R = (st >> 1) * 16 + swz / 64; C = (st & 1) * 32 + (swz % 64) / 2; }
__host__ __device__ __forceinline__ int perm32(int rho) { const int n = rho >> 4, i = rho & 15; return 8 * (i >> 2) + 4 * n + (i & 3); }

struct Unit { int pm, pn; };
struct Gemm { const bf16_t* A; const bf16_t* Bt; int M, N, K; };

struct StaticOrder {
    int nM, nN, nwg, G, c;
    __host__ __device__ void init(int M, int N, int G_, int c_) { nM = M / BM; nN = N / BM; nwg = nM * nN; G = G_; c = c_; }
    __host__ __device__ bool next(int i, Unit& u) const {
        const long L = (long)i * G + c; if (L >= nwg) return false;
        int wgid = (int)L; { const int q = nwg / NXCD, r = nwg % NXCD, xcd = wgid % NXCD, off = wgid / NXCD; wgid = (xcd < r ? xcd * (q + 1) : r * (q + 1) + (xcd - r) * q) + off; }
        const int nig = WGM * nN, gid = wgid / nig, fm = gid * WGM, gsz = (nM - fm) < WGM ? (nM - fm) : WGM;
        u.pm = fm + ((wgid % nig) % gsz); u.pn = (wgid % nig) / gsz; return true;
    }
    __device__ __forceinline__ void a_ready(const Unit&) const {}
    __device__ __forceinline__ void done(const Unit&) const {}
};

__device__ __forceinline__ unsigned cvt_pk_bf16(float lo, float hi) { unsigned r; asm volatile("v_cvt_pk_bf16_f32 %0, %1, %2" : "=v"(r) : "v"(lo), "v"(hi)); return r; }

template <class Epi, class Sched, bool ALIGN_EPI = false, bool SP2 = false>
__device__ __forceinline__ void gemm_phase(PG8_LAS unsigned char* lds, const Gemm g, const Sched& S, const Epi& E) {
    int tid = threadIdx.x; asm volatile("" : "+v"(tid));
    const int wid = __builtin_amdgcn_readfirstlane(tid >> 6), lane = tid & 63, wr = wid >> 2, wc = wid & 3, fr = lane & 15, fq = lane >> 4;
    const int K = g.K, nt = K / BK;
    unsigned voffA[2], voffB[2];
#pragma unroll
    for (int i = 0; i < 2; ++i) { int R, C; stage_rc(tid * 16 + i * 8192, R, C); const int Rb = Epi::PERM ? ((R & ~31) + perm32(R & 31)) : R;
        voffA[i] = (unsigned)(R * K + C) * 2u; voffB[i] = (unsigned)(Rb * K + C) * 2u; }
    const size_t kstep = (size_t)(BK * 2);
    const size_t hstep = (size_t)HALF * K * 2;
    const size_t tstep = 2 * hstep;
    const unsigned ldsw = (unsigned)wid * 1024u;
    const int aoff = lds_byte(wr * 64 + fr, fq * 8), boff = lds_byte(wc * 32 + fr, fq * 8);
#define PG8_SA(b, h) (((b) * 2 + (h)) * HTB)
#define PG8_SB(b, h) ((4 + (b) * 2 + (h)) * HTB)
#define PG8_STAGE(bufoff, gbase, voff) do { _Pragma("unroll") for (int _i = 0; _i < 2; ++_i) \
        __builtin_amdgcn_global_load_lds((const unsigned*)((const char*)(gbase) + (voff)[_i]), (PG8_LAS unsigned*)(lds + (bufoff) + ldsw + _i * 8192), 16, 0, 0); } while (0)
#define PG8_LDA(dst, b, h) do { _Pragma("unroll") for (int m = 0; m < 4; ++m) _Pragma("unroll") for (int k = 0; k < 2; ++k) dst[m][k] = *(const PG8_LAS bf16x8*)(lds + PG8_SA(b, h) + aoff + m * 2048 + k * 1024); } while (0)
#define PG8_LDB(dst, b, h) do { _Pragma("unroll") for (int n = 0; n < 2; ++n) _Pragma("unroll") for (int k = 0; k < 2; ++k) dst[n][k] = *(const PG8_LAS bf16x8*)(lds + PG8_SB(b, h) + boff + n * 2048 + k * 1024); } while (0)
#define PG8_MMA(ai, bj, At, Bt) do { __builtin_amdgcn_s_setprio(1); _Pragma("unroll") for (int m = 0; m < 4; ++m) _Pragma("unroll") for (int n = 0; n < 2; ++n) _Pragma("unroll") for (int k = 0; k < 2; ++k) \
        acc[ai][bj][m][n] = __builtin_amdgcn_mfma_f32_16x16x32_bf16(Bt[n][k], At[m][k], acc[ai][bj][m][n], 0, 0, 0); __builtin_amdgcn_s_setprio(0); } while (0)
#define PG8_WAIT_V(n) asm volatile("s_waitcnt vmcnt(" #n ")" ::: "memory")
#define PG8_WAIT_L(n) asm volatile("s_waitcnt lgkmcnt(" #n ")" ::: "memory")
#define PG8_BAR __builtin_amdgcn_s_barrier()
#define PG8_SCHED __builtin_amdgcn_sched_barrier(0)
    Unit cur, nxt; int ui = 0;
    if (!S.next(0, cur)) return;
    f32x4 acc[2][2][4][2];
#pragma unroll
    for (int a = 0; a < 2; ++a)
#pragma unroll
        for (int b = 0; b < 2; ++b)
#pragma unroll
            for (int m = 0; m < 4; ++m)
#pragma unroll
                for (int n = 0; n < 2; ++n) acc[a][b][m][n] = (f32x4){0.f, 0.f, 0.f, 0.f};
    bf16x8 At[4][2], B0[2][2], B1[2][2];
    const char* cA = (const char*)g.A + (size_t)cur.pm * tstep; const char* cB = (const char*)g.Bt + (size_t)cur.pn * tstep;
    S.a_ready(cur);
    if constexpr (SP2) {
        PG8_STAGE(PG8_SB(0, 0), cB, voffB); PG8_STAGE(PG8_SB(0, 1), cB + hstep, voffB); PG8_STAGE(PG8_SA(0, 0), cA, voffA); PG8_STAGE(PG8_SA(0, 1), cA + hstep, voffA);
        if (wr == 1) PG8_BAR;
        PG8_WAIT_V(2); PG8_BAR;
        PG8_STAGE(PG8_SB(1, 0), cB + kstep, voffB); PG8_STAGE(PG8_SA(1, 0), cA + kstep, voffA); PG8_STAGE(PG8_SB(1, 1), cB + hstep + kstep, voffB);
        PG8_WAIT_V(6); PG8_BAR;
    } else {
        PG8_STAGE(PG8_SB(0, 0), cB, voffB); PG8_STAGE(PG8_SA(0, 0), cA, voffA); PG8_STAGE(PG8_SB(0, 1), cB + hstep, voffB); PG8_STAGE(PG8_SA(0, 1), cA + hstep, voffA);
        if (wr == 1) PG8_BAR;
        PG8_WAIT_V(4); PG8_BAR;
        PG8_STAGE(PG8_SB(1, 0), cB + kstep, voffB); PG8_STAGE(PG8_SA(1, 0), cA + kstep, voffA); PG8_STAGE(PG8_SB(1, 1), cB + hstep + kstep, voffB);
        PG8_WAIT_V(6); PG8_BAR;
    }
    for (;;) {
        const bool has_next = S.next(ui + 1, nxt);
        const char* nA = has_next ? (const char*)g.A + (size_t)nxt.pm * tstep : cA; const char* nB = has_next ? (const char*)g.Bt + (size_t)nxt.pn * tstep : cB;
        for (int t = 0; t < nt; t += 2) {
            const bool last = (t == nt - 2);
            const char* a1 = cA + (size_t)(t + 1) * kstep;
            const char* a2 = last ? nA : cA + (size_t)(t + 2) * kstep; const char* b2 = last ? nB : cB + (size_t)(t + 2) * kstep;
            const char* a3 = a2 + kstep; const char* b3 = b2 + kstep;
            if (last && has_next) S.a_ready(nxt);
            if constexpr (SP2) {
            PG8_LDB(B0, 0, 0); PG8_LDB(B1, 0, 1); PG8_SCHED; PG8_LDA(At, 0, 0); PG8_STAGE(PG8_SA(1, 1), a1 + hstep, voffA);
            PG8_WAIT_V(8); PG8_WAIT_L(0); PG8_BAR; PG8_MMA(0, 0, At, B0); PG8_MMA(0, 1, At, B1); PG8_BAR; PG8_SCHED;
            PG8_LDA(At, 0, 1); PG8_STAGE(PG8_SB(0, 0), b2, voffB); PG8_STAGE(PG8_SB(0, 1), b2 + hstep, voffB); PG8_STAGE(PG8_SA(0, 0), a2, voffA);
            PG8_WAIT_V(8); PG8_WAIT_L(0); PG8_BAR; PG8_MMA(1, 0, At, B0); PG8_MMA(1, 1, At, B1); PG8_BAR; PG8_SCHED;
            PG8_LDB(B0, 1, 0); PG8_LDB(B1, 1, 1); PG8_SCHED; PG8_LDA(At, 1, 0); PG8_STAGE(PG8_SA(0, 1), a2 + hstep, voffA);
            PG8_WAIT_V(8); PG8_WAIT_L(0); PG8_BAR; PG8_MMA(0, 0, At, B0); PG8_MMA(0, 1, At, B1); PG8_BAR; PG8_SCHED;
            PG8_LDA(At, 1, 1); PG8_STAGE(PG8_SB(1, 0), b3, voffB); PG8_STAGE(PG8_SB(1, 1), b3 + hstep, voffB); PG8_STAGE(PG8_SA(1, 0), a3, voffA);
            PG8_WAIT_V(8); PG8_WAIT_L(0); PG8_BAR; PG8_MMA(1, 0, At, B0); PG8_MMA(1, 1, At, B1); PG8_BAR; PG8_SCHED;
            } else {
            PG8_LDB(B0, 0, 0); PG8_SCHED; PG8_LDA(At, 0, 0); PG8_STAGE(PG8_SA(1, 1), a1 + hstep, voffA);
            PG8_WAIT_L(8); PG8_BAR; PG8_WAIT_L(0); PG8_MMA(0, 0, At, B0); PG8_BAR; PG8_SCHED;
            PG8_LDB(B1, 0, 1); PG8_STAGE(PG8_SB(0, 0), b2, voffB);
            PG8_BAR; PG8_WAIT_L(0); PG8_MMA(0, 1, At, B1); PG8_BAR;
            PG8_LDA(At, 0, 1); PG8_STAGE(PG8_SA(0, 0), a2, voffA);
            PG8_BAR; PG8_WAIT_L(0); PG8_MMA(1, 0, At, B0); PG8_BAR; PG8_SCHED;
            PG8_STAGE(PG8_SB(0, 1), b2 + hstep, voffB);
            PG8_WAIT_V(6); PG8_BAR; PG8_MMA(1, 1, At, B1); PG8_BAR;
            PG8_LDB(B0, 1, 0); PG8_SCHED; PG8_LDA(At, 1, 0); PG8_STAGE(PG8_SA(0, 1), a2 + hstep, voffA);
            PG8_WAIT_L(8); PG8_BAR; PG8_WAIT_L(0); PG8_MMA(0, 0, At, B0); PG8_BAR; PG8_SCHED;
            PG8_LDB(B1, 1, 1); PG8_STAGE(PG8_SB(1, 0), b3, voffB);
            PG8_BAR; PG8_WAIT_L(0); PG8_MMA(0, 1, At, B1); PG8_BAR;
            PG8_LDA(At, 1, 1); PG8_STAGE(PG8_SA(1, 0), a3, voffA);
            PG8_BAR; PG8_WAIT_L(0); PG8_MMA(1, 0, At, B0); PG8_BAR; PG8_SCHED;
            PG8_STAGE(PG8_SB(1, 1), b3 + hstep, voffB);
            PG8_WAIT_V(6); PG8_BAR; PG8_MMA(1, 1, At, B1); PG8_BAR;
            }
        }
        if constexpr (ALIGN_EPI) { if (wr == 0) PG8_BAR; }
        if constexpr (!Epi::AFTER_DRAIN) { E(acc, cur, wr, wc, fr, fq); S.done(cur); }
        if (!has_next) break;
#pragma unroll
        for (int a = 0; a < 2; ++a)
#pragma unroll
            for (int b = 0; b < 2; ++b)
#pragma unroll
                for (int m = 0; m < 4; ++m)
#pragma unroll
                    for (int n = 0; n < 2; ++n) acc[a][b][m][n] = (f32x4){0.f, 0.f, 0.f, 0.f};
        cur = nxt; cA = nA; cB = nB; ++ui;
        if constexpr (ALIGN_EPI) { if (wr == 1) PG8_BAR; }
    }
    PG8_WAIT_V(0);
    if constexpr (!ALIGN_EPI) { if (wr == 0) PG8_BAR; }
    PG8_BAR;
    if constexpr (Epi::AFTER_DRAIN) { E.fused(acc, cur, wr, wc, fr, fq, lds, wid, lane); S.done(cur); }
#undef PG8_SA
#undef PG8_SB
#undef PG8_STAGE
#undef PG8_LDA
#undef PG8_LDB
#undef PG8_MMA
#undef PG8_WAIT_V
#undef PG8_WAIT_L
#undef PG8_BAR
#undef PG8_SCHED
}
}

constexpr int NWAVES = 8, NTHR = 512;
constexpr int N_LAUNCHES = MK_N_LAUNCHES;
constexpr int PER_PHASE = 6;
constexpr int D = 1024, NBC = 32, SEQ = 256, NBL = 2, LSEQ = 1024, PAST = 512, KLAT = PAST + LSEQ;
constexpr int MC = NBC * SEQ, ML = NBL * LSEQ, M = MC + ML;
constexpr int DIN = 8448, DMIX = 2048, DSH = 3328, NH = 8, NHB = 16;
constexpr int OUT_Y = 0, OUT_CK = M * D, OUT_CV = OUT_CK + MC * D, OUT_ST = OUT_CV + MC * D, OUT_END = OUT_ST + NBC * 2 * NHB * 64 * 64;

enum { I_XP = 0, I_XS, I_CK, I_CV, I_ST, I_C, I_CCTX, I_NG, I_WADA, I_BADA, I_WIN, I_LQ1, I_LK1, I_LQ2, I_LK2, I_SUBG, I_MU, I_W0, I_W2, I_A0, I_A2, I_KK, I_KA, I_RK, I_LNG, I_LNB, I_WOUT, I_FG, N_IN };

constexpr size_t MiB = 1u << 20;
constexpr size_t WS_CTL = 0, CTL_ZERO_BYTES = 1 * MiB;
constexpr size_t WS_MODP = 1 * MiB;
constexpr size_t WS_MODF = WS_MODP + 640 * 1024;
constexpr size_t WS_ROPE = WS_MODF + 64 * 1024;
constexpr size_t WS_SSQ = 2 * MiB;
constexpr size_t WS_WOP = 3 * MiB;
constexpr size_t WS_WIN = 4 * MiB;
constexpr size_t WS_WOUT = 21 * MiB;
constexpr size_t WS_XN = 25 * MiB;
constexpr size_t WS_Q = 45 * MiB;
constexpr size_t WS_KC = 65 * MiB;
constexpr size_t WS_KL = 81 * MiB;
constexpr size_t WS_VTC = 87 * MiB;
constexpr size_t WS_VTL = 103 * MiB;
constexpr size_t WS_GA = 109 * MiB;
constexpr size_t WS_GB = 129 * MiB;
constexpr size_t WS_UB = 149 * MiB;
constexpr size_t WS_MIX = 214 * MiB;
constexpr size_t WS_END = 254 * MiB;
constexpr int CW_BAR = 4096;
constexpr int CW_Q3 = 64;

constexpr int RING_OFF = 0, RING_BYTES = 131072, ROPE_LDS = RING_OFF + RING_BYTES;
constexpr int LDS_BYTES = 163840;
constexpr int LDSCTL_OFF = LDS_BYTES - 1024, MISC_OFF = LDSCTL_OFF + 320;

#define GAS __attribute__((address_space(1)))
#define LAS __attribute__((address_space(3)))
typedef unsigned short bf16;
typedef unsigned v4u __attribute__((ext_vector_type(4)));
typedef unsigned v2u __attribute__((ext_vector_type(2)));
typedef float f32x4 __attribute__((ext_vector_type(4)));
typedef float f32x16 __attribute__((ext_vector_type(16)));
typedef short bf16x8 __attribute__((ext_vector_type(8)));
typedef GAS unsigned gu32;
#define RLX_AGENT __ATOMIC_RELAXED, __HIP_MEMORY_SCOPE_AGENT
#define LDS_WAIT() asm volatile("s_waitcnt lgkmcnt(0)" ::: "memory")
#define VM_WAIT() asm volatile("s_waitcnt vmcnt(0)" ::: "memory")
__device__ __forceinline__ unsigned f2bf(float f) { unsigned u = __builtin_bit_cast(unsigned, f); return (u + 0x7fffu + ((u >> 16) & 1u)) >> 16; }
typedef float f32x2_t __attribute__((ext_vector_type(2)));
typedef __bf16 bf16x2_t __attribute__((ext_vector_type(2)));
__device__ __forceinline__ unsigned pk2(float lo, float hi) { const f32x2_t f = {lo, hi}; return __builtin_bit_cast(unsigned, __builtin_convertvector(f, bf16x2_t)); }
__device__ __forceinline__ unsigned f2bf_hw(float f) { return pk2(f, f); }
__device__ __forceinline__ float bf2f(unsigned b) { return __builtin_bit_cast(float, b << 16); }
__device__ __forceinline__ float bflo(unsigned w) { return __builtin_bit_cast(float, w << 16); }
__device__ __forceinline__ float bfhi(unsigned w) { return __builtin_bit_cast(float, w & 0xffff0000u); }
__device__ __forceinline__ float sigmoidf_(float x) { return __builtin_amdgcn_rcpf(1.f + __expf(-x)); }
__device__ __forceinline__ float siluf_(float x) { return x * __builtin_amdgcn_rcpf(1.f + __expf(-x)); }

#define XB_TMO      128
#define XB_XCNT(j)  (256  + 64 * (j))
#define XB_XSUB(j)  (1280 + 64 * (j))
#define XB_XGEN(j)  (2304 + 64 * (j))
#define XB_TOP      3328
#define XB_TOPGEN   3392
#define XCD_BAR_WORDS 3456
#define XB_SPIN_CAP (1u << 18)
__device__ __forceinline__ unsigned xb_ld(unsigned* p)              { return __hip_atomic_load(p, __ATOMIC_RELAXED, __HIP_MEMORY_SCOPE_AGENT); }
__device__ __forceinline__ unsigned xb_add(unsigned* p, unsigned v) { return __hip_atomic_fetch_add(p, v, __ATOMIC_RELAXED, __HIP_MEMORY_SCOPE_AGENT); }
__device__ __forceinline__ unsigned xb_xcc_id() { return (unsigned)__builtin_amdgcn_s_getreg((3 << 11) | 20) & 0xFu; }
#define XB_SPIN(cond, bar) do { unsigned _sp = 0; while (cond) { __builtin_amdgcn_s_sleep(1); \
    if ((++_sp & 255u) == 0u) { if (xb_ld(&(bar)[XB_TMO])) break; if (_sp > XB_SPIN_CAP) { atomicAdd(&(bar)[XB_TMO], 1u); break; } } } } while (0)
struct XcdBarrier { unsigned* bar; unsigned x; volatile LAS unsigned* st; };
__device__ __forceinline__ XcdBarrier xcd_barrier_post(unsigned* bar, volatile LAS unsigned* st) {
    XcdBarrier b; b.bar = bar; b.x = xb_xcc_id(); b.st = st;
    if (threadIdx.x == 0) (void)xb_add(&bar[XB_XCNT(b.x)], 1u);
    return b;
}
__device__ __forceinline__ void xcd_barrier_complete(unsigned* bar, unsigned x, unsigned& nloc, unsigned& nx) {
    const unsigned G = gridDim.x * gridDim.y * gridDim.z;
    unsigned sum, cnt, mine, sp = 0u;
    for (;;) {
        sum = 0u; cnt = 0u; mine = 0u;
#pragma unroll
        for (unsigned j = 0; j < 16; ++j) { const unsigned c = xb_ld(&bar[XB_XCNT(j)]); sum += c; cnt += (c > 0u) ? 1u : 0u; mine = (j == x) ? c : mine; }
        if (sum == G) break;
        __builtin_amdgcn_s_sleep(1);
        if ((++sp & 255u) == 0u) { if (xb_ld(&bar[XB_TMO])) break; if (sp > XB_SPIN_CAP) { atomicAdd(&bar[XB_TMO], 1u); break; } }
    }
    nloc = mine > 0u ? mine : 1u; nx = cnt > 0u ? cnt : 1u;
}
__device__ __forceinline__ void xcd_barrier(const XcdBarrier& b) {
    asm volatile("s_waitcnt vmcnt(0)" ::: "memory");
    __syncthreads();
    if (threadIdx.x == 0) {
        unsigned* bar = b.bar;
        __builtin_amdgcn_s_waitcnt(0);
        unsigned nloc = b.st[0], nx = b.st[1];
        if (nloc == 0u) { xcd_barrier_complete(bar, b.x, nloc, nx); b.st[0] = nloc; b.st[1] = nx; }
        const unsigned old = xb_add(&bar[XB_XSUB(b.x)], 1u);
        const unsigned gen = old / nloc;
        if (old + 1u == (gen + 1u) * nloc) {
            __builtin_amdgcn_fence(__ATOMIC_RELEASE, "agent");
            asm volatile("s_waitcnt vmcnt(0)" ::: "memory");
            const unsigned og = xb_add(&bar[XB_TOP], 1u);
            const unsigned tg = og / nx;
            if (og + 1u == (tg + 1u) * nx) xb_add(&bar[XB_TOPGEN], 1u);
            else XB_SPIN(xb_ld(&bar[XB_TOPGEN]) == tg, bar);
            __builtin_amdgcn_fence(__ATOMIC_ACQUIRE, "agent");
            xb_add(&bar[XB_XGEN(b.x)], 1u);
            asm volatile("s_waitcnt vmcnt(0)" ::: "memory");
        } else {
            XB_SPIN(xb_ld(&bar[XB_XGEN(b.x)]) == gen, bar);
            __builtin_amdgcn_fence(__ATOMIC_ACQUIRE, "agent");
            asm volatile("s_waitcnt vmcnt(0)" ::: "memory");
        }
    }
    __syncthreads();
}

struct Args { const float* in[N_IN]; float* out; unsigned char* ws; int ph_lo, ph_hi, li, pad; };
struct Frame {
    LAS unsigned char* lds;
    volatile LAS unsigned* MISC;
    gu32* ctl;
    int tid, lane, wave, G;
    const float* const* in;
    float* out; unsigned char* ws;
};
__device__ __forceinline__ float wave_sum(float v) {
#pragma unroll
    for (int o = 1; o < 64; o <<= 1) v += __shfl_xor(v, o);
    return v;
}
__device__ __forceinline__ const float* xrow_ptr(const Frame& F, int m) { return m < MC ? F.in[I_XP] + (size_t)m * D : F.in[I_XS] + (size_t)(m - MC) * D; }

__device__ __forceinline__ void p0_transpose_item(const float* W, int K, int N, bf16* WT, LAS float* scr, int item, int lane) {
    const int nblk = N / 32, kb = item / nblk, nb = item % nblk, k0 = 64 * kb, n0 = 32 * nb;
#pragma unroll 4
    for (int i = 0; i < 32; ++i) { const int kk = 2 * i + (lane >> 5); scr[kk * 33 + (lane & 31)] = W[(size_t)(k0 + kk) * N + n0 + (lane & 31)]; }
    LDS_WAIT(); asm volatile("" ::: "memory");
    const int c = lane & 7;
#pragma unroll
    for (int j = 0; j < 4; ++j) { const int n = (lane >> 3) + 8 * j; const LAS float* s = scr + (8 * c) * 33 + n;
        v4u o; o.x = pk2(s[0 * 33], s[1 * 33]); o.y = pk2(s[2 * 33], s[3 * 33]); o.z = pk2(s[4 * 33], s[5 * 33]); o.w = pk2(s[6 * 33], s[7 * 33]);
        *(GAS v4u*)(WT + (size_t)(n0 + n) * K + k0 + 8 * c) = o; }
    LDS_WAIT(); asm volatile("" ::: "memory");
}
__device__ __forceinline__ void p0_prologue(Frame& F) {
    LAS float* scr = (LAS float*)(F.lds + RING_OFF + F.wave * 16384);
    const int gw = blockIdx.x * NWAVES + F.wave, NGW = F.G * NWAVES;
    bf16* WinT = (bf16*)(F.ws + WS_WIN); bf16* WoutT = (bf16*)(F.ws + WS_WOUT);
    constexpr int I_IN = (D / 64) * (DIN / 32), I_OUT = (DMIX / 64) * (D / 32), I_MOD = 16 * 12, I_CV_ = NBL * NH * (PAST / 64);
    {
        const int e = ((int)blockIdx.x - (F.G - 2)) * NTHR + F.tid;
        if (e >= 0 && e < 1024) { float* rp = (float*)(F.ws + WS_ROPE); const int pos = e >> 4, i = e & 15; const double inv = pow(10000.0, -(double)i / 16.0), ang = (double)pos * inv; rp[e] = (float)cos(ang); rp[1024 + e] = (float)sin(ang); }
    }
    {
        const int r = NGW - 1 - gw;
        if (r < I_MOD) {
            const int kc = r / 12, nb = r % 12, n0 = nb * 256 + 4 * F.lane;
            const float* wa = F.in[I_WADA] + (size_t)(kc * 64) * 3072 + n0;
            f32x4 a0 = {0.f, 0.f, 0.f, 0.f}, a1 = a0, a2 = a0;
#pragma unroll 16
            for (int k = 0; k < 64; ++k) {
                const f32x4 w = *(const f32x4*)(wa + (size_t)k * 3072);
                const float s0 = siluf_(F.in[I_CCTX][kc * 64 + k]), s1 = siluf_(F.in[I_C][kc * 64 + k]), s2 = siluf_(F.in[I_C][D + kc * 64 + k]);
                a0 += w * s0; a1 += w * s1; a2 += w * s2;
            }
            float* mp = (float*)(F.ws + WS_MODP) + (size_t)kc * 3 * 3072 + n0;
            *(f32x4*)(mp) = a0; *(f32x4*)(mp + 3072) = a1; *(f32x4*)(mp + 2 * 3072) = a2;
        } else if (r < I_MOD + I_CV_) {
            const int q_ = r - I_MOD, tb = q_ % (PAST / 64), hh = (q_ / (PAST / 64)) % NH, b = q_ / (NH * (PAST / 64));
            const float* src = F.in[I_CV] + ((size_t)(b * PAST + tb * 64 + F.lane) * NH + hh) * 128;
            bf16* dst = (bf16*)(F.ws + WS_VTL) + (size_t)((b * NH + hh) * 128) * KLAT + tb * 64 + F.lane;
#pragma unroll 1
            for (int dv0 = 0; dv0 < 128; dv0 += 32) {
                f32x4 v[8];
#pragma unroll
                for (int q = 0; q < 8; ++q) v[q] = *(const f32x4*)(src + dv0 + 4 * q);
#pragma unroll
                for (int q = 0; q < 8; ++q) { const int dv = dv0 + 4 * q;
                    dst[(size_t)(dv + 0) * KLAT] = (bf16)f2bf(v[q].x); dst[(size_t)(dv + 1) * KLAT] = (bf16)f2bf(v[q].y); dst[(size_t)(dv + 2) * KLAT] = (bf16)f2bf(v[q].z); dst[(size_t)(dv + 3) * KLAT] = (bf16)f2bf(v[q].w); }
            }
        }
    }
    for (int it = gw; it < I_IN + I_OUT; it += NGW) {
        if (it < I_IN) p0_transpose_item(F.in[I_WIN], D, DIN, WinT, scr, it, F.lane);
        else p0_transpose_item(F.in[I_WOUT], DMIX, D, WoutT, scr, it - I_IN, F.lane);
    }
    for (int idx = blockIdx.x * NTHR + F.tid; idx < 2 * 16 * 2 * 4 * 2 * 64; idx += F.G * NTHR) {
        const int ln = idx & 63, ks = (idx >> 6) & 1, ct = (idx >> 7) & 3, mat = (idx >> 9) & 1, hh = (idx >> 10) & 15, dd = idx >> 14;
        const float* src = F.in[mat ? I_A2 : I_W2] + (size_t)(dd * 64 + 32 * ks + 8 * (ln >> 4)) * D + hh * 64 + 16 * ct + (ln & 15);
        v4u o; o.x = pk2(src[0], src[D]); o.y = pk2(src[2 * D], src[3 * D]); o.z = pk2(src[4 * D], src[5 * D]); o.w = pk2(src[6 * D], src[7 * D]);
        ((v4u*)(F.ws + WS_WOP))[idx] = o;
    }
    bf16* KL = (bf16*)(F.ws + WS_KL);
    for (int i = blockIdx.x * NTHR + F.tid; i < NBL * PAST * D / 8; i += F.G * NTHR) {
        const int e = i * 8, b = e / (PAST * D), rem = e % (PAST * D);
        const f32x4 v0 = *(const f32x4*)(F.in[I_CK] + e), v1 = *(const f32x4*)(F.in[I_CK] + e + 4);
        v4u o; o.x = pk2(v0.x, v0.y); o.y = pk2(v0.z, v0.w); o.z = pk2(v1.x, v1.y); o.w = pk2(v1.z, v1.w);
        *(v4u*)(KL + (size_t)b * KLAT * D + rem) = o;
    }
}

template <int I0, int I1> __device__ __forceinline__ void p1_load(Frame& F, f32x4 (&v)[5][4]) {
#pragma unroll
    for (int i = I0; i < I1; ++i) { const float* xr = xrow_ptr(F, ((int)blockIdx.x + 256 * i) * 8 + F.wave);
#pragma unroll
        for (int j = 0; j < 4; ++j) v[i][j] = *(const f32x4*)(xr + 4 * F.lane + 256 * j); }
}
__device__ __forceinline__ void p1_norm(Frame& F, f32x4 (&v)[5][4]) {
    LAS float* modL = (LAS float*)(F.lds + RING_OFF);
    const float* modp = (const float*)(F.ws + WS_MODP);
    const float* bada = F.in[I_BADA];
    int mrow[5];
#pragma unroll
    for (int i = 0; i < 5; ++i) mrow[i] = ((int)blockIdx.x + 256 * i) * 8 + F.wave;
    if (blockIdx.x < 36 && F.tid < 256) {
        const int idx = blockIdx.x * 256 + F.tid, ci = idx / 3072, n = idx % 3072;
        float pt[16];
#pragma unroll
        for (int kc = 0; kc < 16; ++kc) pt[kc] = modp[(size_t)(kc * 3 + ci) * 3072 + n];
#pragma unroll
        for (int kc = 0; kc < 16; ++kc) asm volatile("" : "+v"(pt[kc]));
        float s = bada[n];
#pragma unroll
        for (int kc = 0; kc < 16; ++kc) s += pt[kc];
        ((float*)(F.ws + WS_MODF))[idx] = s;
    }
    {
        const int cil = 1 + (int)blockIdx.x / 128;
#pragma unroll 1
        for (int e = F.tid; e < 4096; e += 2 * NTHR) {
            float pt[2][16], s[2];
#pragma unroll
            for (int h = 0; h < 2; ++h) { const int e2 = e + h * NTHR, n = e2 & 2047, ci = e2 < 2048 ? 0 : cil; s[h] = bada[n];
#pragma unroll
                for (int kc = 0; kc < 16; ++kc) pt[h][kc] = modp[(size_t)(kc * 3 + ci) * 3072 + n]; }
#pragma unroll
            for (int h = 0; h < 2; ++h)
#pragma unroll
                for (int kc = 0; kc < 16; ++kc) asm volatile("" : "+v"(pt[h][kc]));
#pragma unroll
            for (int h = 0; h < 2; ++h) {
#pragma unroll
                for (int kc = 0; kc < 16; ++kc) s[h] += pt[h][kc];
                modL[e + h * NTHR] = s[h]; }
        }
    }
    __syncthreads();
    bf16* XN = (bf16*)(F.ws + WS_XN);
    f32x4 gn[4];
#pragma unroll
    for (int j = 0; j < 4; ++j) gn[j] = *(const f32x4*)(F.in[I_NG] + 4 * F.lane + 256 * j);
#pragma unroll
    for (int i = 0; i < 5; ++i) {
        float ss = 0.f;
#pragma unroll
        for (int j = 0; j < 4; ++j) ss += (v[i][j].x * v[i][j].x + v[i][j].y * v[i][j].y) + (v[i][j].z * v[i][j].z + v[i][j].w * v[i][j].w);
        const float rstd = __builtin_amdgcn_rsqf(wave_sum(ss) * (1.f / D) + 1e-6f);
        const LAS float* ml = modL + (i == 4 ? 2048 : 0);
#pragma unroll
        for (int j = 0; j < 4; ++j) {
            const int c = 4 * F.lane + 256 * j;
            const f32x4 sh = *(const LAS f32x4*)(ml + c), sc = *(const LAS f32x4*)(ml + 1024 + c);
            const f32x4 h = (v[i][j] * rstd) * gn[j] * (sc + 1.0f) + sh;
            v2u o; o.x = pk2(h.x, h.y); o.y = pk2(h.z, h.w);
            *(v2u*)(XN + (size_t)mrow[i] * D + c) = o;
        }
    }
}

struct EpiIn {
    static constexpr bool PERM = true, AFTER_DRAIN = false;
    unsigned char* ws; float* out; const LAS float* rope;
    __device__ __forceinline__ void operator()(const f32x4 (&acc)[2][2][4][2], const pg8::Unit& u, int wr, int wc, int fr, int fq) const {
        const int pn = u.pn; const bool lat = u.pm >= MC / 256;
        constexpr float QS = 0.125f * 1.44269504088896f;
#pragma unroll
        for (int ai = 0; ai < 2; ++ai)
#pragma unroll
            for (int m = 0; m < 4; ++m) {
                const int r = u.pm * 256 + ai * 128 + wr * 64 + m * 16 + fr;
#pragma unroll
                for (int bj = 0; bj < 2; ++bj) {
                    const int c = pn * 256 + bj * 128 + wc * 32 + 8 * fq;
                    f32x4 v0 = acc[ai][bj][m][0], v1 = acc[ai][bj][m][1];
                    if (pn < 8) {
                        const bool isq = pn < 4; const int cc = isq ? c : c - 1024;
                        if (lat) {
                            const int t = (r - MC) & (LSEQ - 1), pos = (wc & 1) ? (t & 63) : (t >> 6);
                            const LAS float* cp = rope + pos * 16 + 8 * (fq & 1);
                            const f32x4 c0 = *(const LAS f32x4*)cp, c1 = *(const LAS f32x4*)(cp + 4), s0 = *(const LAS f32x4*)(cp + 1024), s1 = *(const LAS f32x4*)(cp + 1028);
                            f32x4 p0, p1;
#pragma unroll
                            for (int j = 0; j < 4; ++j) { p0[j] = __shfl_xor(v0[j], 32); p1[j] = __shfl_xor(v1[j], 32); }
                            const float sg = (fq & 2) ? 1.f : -1.f;
                            v0 = v0 * c0 + (p0 * s0) * sg; v1 = v1 * c1 + (p1 * s1) * sg;
                        }
                        if (isq) { v0 = v0 * QS; v1 = v1 * QS; }
                        else if (!lat) { float* o = out + OUT_CK + (size_t)r * D + cc; *(f32x4*)o = v0; *(f32x4*)(o + 4) = v1; }
                        v4u w; w.x = pk2(v0[0], v0[1]); w.y = pk2(v0[2], v0[3]); w.z = pk2(v1[0], v1[1]); w.w = pk2(v1[2], v1[3]);
                        bf16* dst;
                        if (isq) dst = (bf16*)(ws + WS_Q) + (size_t)r * D + cc;
                        else if (!lat) dst = (bf16*)(ws + WS_KC) + (size_t)r * D + cc;
                        else { const int b = (r - MC) >> 10, t = (r - MC) & (LSEQ - 1); dst = (bf16*)(ws + WS_KL) + ((size_t)b * KLAT + PAST + t) * D + cc; }
                        *(v4u*)dst = w;
                    } else if (pn < 12) {
                        const int cc = c - 2048, hh = cc >> 7, dv = cc & 127;
                        bf16* dst;
                        if (!lat) { float* o = out + OUT_CV + (size_t)r * D + cc; *(f32x4*)o = v0; *(f32x4*)(o + 4) = v1;
                            const int b = r >> 8, t = r & 255; dst = (bf16*)(ws + WS_VTC) + (size_t)((b * NH + hh) * 128 + dv) * SEQ + t;
#pragma unroll
                            for (int j = 0; j < 4; ++j) { dst[(size_t)j * SEQ] = (bf16)f2bf(v0[j]); dst[(size_t)(4 + j) * SEQ] = (bf16)f2bf(v1[j]); }
                        } else { const int b = (r - MC) >> 10, t = (r - MC) & (LSEQ - 1); dst = (bf16*)(ws + WS_VTL) + (size_t)((b * NH + hh) * 128 + dv) * KLAT + PAST + t;
#pragma unroll
                            for (int j = 0; j < 4; ++j) { dst[(size_t)j * KLAT] = (bf16)f2bf(v0[j]); dst[(size_t)(4 + j) * KLAT] = (bf16)f2bf(v1[j]); }
                        }
                    } else if (pn < 16 || pn >= 29) {
                        bf16* dst = pn < 16 ? (bf16*)(ws + WS_GA) + (size_t)r * D + (c - 3072) : (bf16*)(ws + WS_GB) + (size_t)r * D + (c - 7424);
                        v4u w; w.x = pk2(siluf_(v0[0]), siluf_(v0[1])); w.y = pk2(siluf_(v0[2]), siluf_(v0[3])); w.z = pk2(siluf_(v1[0]), siluf_(v1[1])); w.w = pk2(siluf_(v1[2]), siluf_(v1[3]));
                        *(v4u*)dst = w;
                    } else {
                        v4u w; w.x = pk2(v0[0], v0[1]); w.y = pk2(v0[2], v0[3]); w.z = pk2(v1[0], v1[1]); w.w = pk2(v1[2], v1[3]);
                        *(v4u*)((bf16*)(ws + WS_UB) + (size_t)r * DSH + (c - 4096)) = w;
                    }
                }
            }
    }
};

constexpr int NLATB = 32;
constexpr int LAT_UNITS = (ML / 256) * (DIN / 256);
constexpr int P2A_UNITS = 512, P2_UNITS = (M / 256) * (DIN / 256);
constexpr int LAT_BAR_IT = 6;
struct ListOrder {
    int G, v, lo, hi;
    __device__ void init(int G_, int c_, int lo_, int hi_) { G = G_; v = (G_ % 8 == 0) ? (c_ % 8) * (G_ / 8) + c_ / 8 : c_; lo = lo_; hi = hi_; }
    __device__ bool next(int i, pg8::Unit& u) const {
        int L = lo + i * G + v; if (L >= hi) return false;
        if (L < LAT_UNITS) { u.pn = L >> 3; u.pm = MC / 256 + (L & 7); return true; }
        L -= LAT_UNITS;
        const int grp = L / (8 * (DIN / 256)), r = L % (8 * (DIN / 256)); u.pn = r >> 3; u.pm = grp * 8 + (r & 7); return true;
    }
    __device__ __forceinline__ void a_ready(const pg8::Unit&) const {}
    __device__ __forceinline__ void done(const pg8::Unit&) const {}
};

constexpr size_t WS_XCH = WS_SSQ;
constexpr int CW_PANEL = 8192;
struct EpiOutFused {
    static constexpr bool PERM = false, AFTER_DRAIN = true;
    unsigned char* ws; float* out; const float* xp; const float* xs; const float* fg; gu32* ctl;
    __device__ __forceinline__ void fused(f32x4 (&acc)[2][2][4][2], const pg8::Unit& u, int wr, int wc, int fr, int fq, PG8_LAS unsigned char* lds, int wid, int lane) const {
        const float* modf = (const float*)(ws + WS_MODF);
        PG8_LAS float* P = (PG8_LAS float*)lds;
        PG8_LAS float* R = (PG8_LAS float*)(lds + 4096);
        const int col0 = u.pn * 256 + wc * 32 + 4 * fq;
#pragma unroll
        for (int ai = 0; ai < 2; ++ai)
#pragma unroll
            for (int m = 0; m < 4; ++m) {
                const int rl = ai * 128 + wr * 64 + m * 16 + fr, r = u.pm * 256 + rl;
                const int ci = r < MC ? 0 : 1 + ((r - MC) >> 10);
                const float* xr = (r < MC ? xp + (size_t)r * D : xs + (size_t)(r - MC) * D) + col0;
                const float* gt = modf + ci * 3072 + 2048 + col0;
                float ss = 0.f;
#pragma unroll
                for (int bj = 0; bj < 2; ++bj)
#pragma unroll
                    for (int n = 0; n < 2; ++n) {
                        const int off = bj * 128 + n * 16;
                        const f32x4 y = *(const f32x4*)(xr + off) + *(const f32x4*)(gt + off) * acc[ai][bj][m][n];
                        acc[ai][bj][m][n] = y;
                        ss += (y.x * y.x + y.y * y.y) + (y.z * y.z + y.w * y.w);
                    }
                ss += __shfl_xor(ss, 16); ss += __shfl_xor(ss, 32);
                if (fq == 0) P[rl * 4 + wc] = ss;
            }
        asm volatile("s_waitcnt lgkmcnt(0)" ::: "memory"); __builtin_amdgcn_s_barrier(); asm volatile("" ::: "memory");
        const int row = wid * 32 + (lane & 31);
        float* xbuf = (float*)(ws + WS_XCH) + ((size_t)(u.pm * 256 + row) * 4);
        if (lane < 32) {
            const f32x4 p = *(const PG8_LAS f32x4*)(P + row * 4);
            __hip_atomic_store(xbuf + u.pn, (p.x + p.y) + (p.z + p.w), __ATOMIC_RELAXED, __HIP_MEMORY_SCOPE_AGENT);
        }
        asm volatile("s_waitcnt vmcnt(0)" ::: "memory");
        unsigned* cnt = (unsigned*)(ctl + CW_PANEL + 64 * u.pm);
        if (lane == 0) __hip_atomic_fetch_add(cnt, 1u, __ATOMIC_RELAXED, __HIP_MEMORY_SCOPE_AGENT);
        if (wid == 0) {
            unsigned sp = 0;
            while ((unsigned)__builtin_amdgcn_readfirstlane(__hip_atomic_load(cnt, __ATOMIC_RELAXED, __HIP_MEMORY_SCOPE_AGENT)) < 32u) { __builtin_amdgcn_s_sleep(2); if (++sp > (1u << 20)) break; }
            __builtin_amdgcn_fence(__ATOMIC_ACQUIRE, "agent");
        }
        asm volatile("s_waitcnt vmcnt(0) lgkmcnt(0)" ::: "memory"); __builtin_amdgcn_s_barrier(); asm volatile("" ::: "memory");
        if (lane < 32) {
            float t = 0.f;
#pragma unroll
            for (int q = 0; q < 4; ++q) t += __hip_atomic_load(xbuf + q, __ATOMIC_RELAXED, __HIP_MEMORY_SCOPE_AGENT);
            R[row] = __builtin_amdgcn_rsqf(t * (1.f / D) + 1e-6f);
        }
        asm volatile("s_waitcnt lgkmcnt(0)" ::: "memory"); __builtin_amdgcn_s_barrier(); asm volatile("" ::: "memory");
        f32x4 fgv[2][2];
#pragma unroll
        for (int bj = 0; bj < 2; ++bj)
#pragma unroll
            for (int n = 0; n < 2; ++n) fgv[bj][n] = *(const f32x4*)(fg + col0 + bj * 128 + n * 16);
#pragma unroll
        for (int ai = 0; ai < 2; ++ai)
#pragma unroll
            for (int m = 0; m < 4; ++m) {
                const int rl = ai * 128 + wr * 64 + m * 16 + fr; const float rs = R[rl];
                float* o = out + OUT_Y + (size_t)(u.pm * 256 + rl) * D + col0;
#pragma unroll
                for (int bj = 0; bj < 2; ++bj)
#pragma unroll
                    for (int n = 0; n < 2; ++n) { const int off = bj * 128 + n * 16; *(f32x4*)(o + off) = acc[ai][bj][m][n] * rs * fgv[bj][n]; }
            }
    }
};

constexpr int AT_KS = 0, AT_KSTRIDE = 272, AT_VS = 64 * AT_KSTRIDE, AT_VSTRIDE = 144, AT_BUF = AT_VS + 128 * AT_VSTRIDE, AT_X = 2 * AT_BUF, AT_XSTRIDE = 132;
static_assert(AT_X + 4 * 32 * AT_XSTRIDE * 4 <= LDSCTL_OFF && (AT_X % 16) == 0, "attention LDS map");
__device__ __forceinline__ void attn_unit(Frame& F, int idx, bool lat, float lam) {
    int tid_ = F.tid; asm volatile("" : "+v"(tid_)); const int lane_ = tid_ & 63;
    int b, hh, qb, m0, nkeys, vlen; const bf16* Kb; const bf16* VT;
    if (!lat) { b = idx >> 4; hh = (idx >> 1) & 7; qb = idx & 1; m0 = b * SEQ + qb * 128; nkeys = SEQ; vlen = SEQ;
        Kb = (const bf16*)(F.ws + WS_KC) + (size_t)b * SEQ * D + hh * 128; VT = (const bf16*)(F.ws + WS_VTC) + (size_t)((b * NH + hh) * 128) * SEQ; }
    else { b = idx >> 6; hh = (idx >> 3) & 7; qb = idx & 7; m0 = MC + b * LSEQ + qb * 128; nkeys = KLAT; vlen = KLAT;
        Kb = (const bf16*)(F.ws + WS_KL) + (size_t)b * KLAT * D + hh * 128; VT = (const bf16*)(F.ws + WS_VTL) + (size_t)((b * NH + hh) * 128) * KLAT; }
    const int w = F.wave, qs = w >> 1, mp = w & 1, l31 = lane_ & 31, h5 = lane_ >> 5;
    const int kperm = (l31 & 3) + 4 * ((l31 >> 3) & 1) + 8 * ((l31 >> 2) & 1) + 16 * (l31 >> 4);
    LAS float* X = (LAS float*)(F.lds + AT_X);
    bf16x8 qf[4];
    { const bf16* qrow = (const bf16*)(F.ws + WS_Q) + (size_t)(m0 + qs * 32 + l31) * D + hh * 128 + mp * 64 + 8 * h5;
#pragma unroll
      for (int ks = 0; ks < 4; ++ks) qf[ks] = *(const bf16x8*)(qrow + 16 * ks); }
    f32x16 o[4];
#pragma unroll
    for (int i = 0; i < 4; ++i)
#pragma unroll
        for (int j = 0; j < 16; ++j) o[i][j] = 0.f;
    float mrun = -1e30f, lrun = 0.f;
    const int krow = tid_ >> 3, kch = tid_ & 7, vrow = tid_ >> 2, vch = tid_ & 3;
    const int ntile = nkeys / 64;
    const bf16* kp = Kb + (size_t)krow * D + kch * 8;
    const bf16* vp = VT + (size_t)vrow * vlen + vch * 8;
    LAS unsigned char* kd = F.lds + AT_KS + krow * AT_KSTRIDE + kch * 16;
    LAS unsigned char* vd = F.lds + AT_VS + vrow * AT_VSTRIDE + vch * 16;
    v4u k0 = *(const v4u*)kp, k1 = *(const v4u*)(kp + 64), v0 = *(const v4u*)vp, v1 = *(const v4u*)(vp + 32);
    __syncthreads();
    *(LAS v4u*)(kd) = k0; *(LAS v4u*)(kd + 128) = k1;
    *(LAS v4u*)(vd) = v0; *(LAS v4u*)(vd + 64) = v1;
    if (ntile > 1) { k0 = *(const v4u*)(kp + (size_t)64 * D); k1 = *(const v4u*)(kp + (size_t)64 * D + 64); v0 = *(const v4u*)(vp + 64); v1 = *(const v4u*)(vp + 96); }
    __syncthreads();
    for (int kt = 0; kt < ntile; ++kt) {
        const int bo = (kt & 1) * AT_BUF;
        LAS unsigned char* Ks = F.lds + AT_KS + bo; LAS unsigned char* Vs = F.lds + AT_VS + bo;
        if (kt + 1 < ntile) {
            const int bn = AT_BUF - bo;
            *(LAS v4u*)(kd + bn) = k0; *(LAS v4u*)(kd + bn + 128) = k1;
            *(LAS v4u*)(vd + bn) = v0; *(LAS v4u*)(vd + bn + 64) = v1;
            if (kt + 2 < ntile) { const bf16* kq = kp + (size_t)(kt + 2) * 64 * D; const bf16* vq = vp + (kt + 2) * 64;
                k0 = *(const v4u*)kq; k1 = *(const v4u*)(kq + 64); v0 = *(const v4u*)vq; v1 = *(const v4u*)(vq + 32); }
        }
        f32x16 s[2];
#pragma unroll
        for (int st = 0; st < 2; ++st) {
#pragma unroll
            for (int j = 0; j < 16; ++j) s[st][j] = 0.f;
#pragma unroll
            for (int ks = 0; ks < 4; ++ks) {
                const bf16x8 kf = *(const LAS bf16x8*)(Ks + (st * 32 + kperm) * AT_KSTRIDE + (mp * 64 + 16 * ks + 8 * h5) * 2);
                s[st] = __builtin_amdgcn_mfma_f32_32x32x16_bf16(kf, qf[ks], s[st], 0, 0, 0);
            }
        }
        float mx = s[0][0];
#pragma unroll
        for (int j = 0; j < 16; ++j) { mx = fmaxf(mx, s[0][j]); mx = fmaxf(mx, s[1][j]); }
        mx = fmaxf(mx, __shfl_xor(mx, 32));
        if (!__all(mx - mrun <= 8.f)) {
            const float mnew_ = fmaxf(mrun, mx), alpha = __builtin_amdgcn_exp2f(mrun - mnew_);
            mrun = mnew_; lrun *= alpha;
#pragma unroll
            for (int i = 0; i < 4; ++i) o[i] = o[i] * alpha;
        }
        const float mnew = mrun;
        float ps = 0.f;
#pragma unroll
        for (int st = 0; st < 2; ++st)
#pragma unroll
            for (int j = 0; j < 16; ++j) { const float p = __builtin_amdgcn_exp2f(s[st][j] - mnew); s[st][j] = p; ps += p; }
        lrun += ps;
        bf16x8 pf[2][2];
#pragma unroll
        for (int st = 0; st < 2; ++st)
#pragma unroll
            for (int s2 = 0; s2 < 2; ++s2) {
                v4u t; t.x = pk2(s[st][8 * s2 + 0], s[st][8 * s2 + 1]); t.y = pk2(s[st][8 * s2 + 2], s[st][8 * s2 + 3]); t.z = pk2(s[st][8 * s2 + 4], s[st][8 * s2 + 5]); t.w = pk2(s[st][8 * s2 + 6], s[st][8 * s2 + 7]);
                pf[st][s2] = __builtin_bit_cast(bf16x8, t);
            }
#pragma unroll
        for (int dvt = 0; dvt < 4; ++dvt)
#pragma unroll
            for (int st = 0; st < 2; ++st)
#pragma unroll
                for (int s2 = 0; s2 < 2; ++s2) {
                    const bf16x8 vf = *(const LAS bf16x8*)(Vs + (dvt * 32 + l31) * AT_VSTRIDE + (st * 32 + 16 * s2 + 8 * h5) * 2);
                    o[dvt] = __builtin_amdgcn_mfma_f32_32x32x16_bf16(vf, pf[st][s2], o[dvt], 0, 0, 0);
                }
        __syncthreads();
    }
    v4u gav[4];
    {
        const bf16* GA = (const bf16*)(F.ws + WS_GA);
#pragma unroll
        for (int p = 0; p < 4; ++p) gav[p] = *(const v4u*)(GA + (size_t)(m0 + p * 32 + (tid_ >> 4)) * D + hh * 128 + (tid_ & 15) * 8);
    }
    const float ltot = lrun + __shfl_xor(lrun, 32), inv = 1.f / ltot;
    LAS float* Xq = X + (qs * 32 + l31) * AT_XSTRIDE;
    if (mp == 1) {
#pragma unroll
        for (int dvt = 0; dvt < 4; ++dvt)
#pragma unroll
            for (int j = 0; j < 16; ++j) Xq[dvt * 32 + (j & 3) + 8 * (j >> 2) + 4 * h5] = o[dvt][j] * inv;
    }
    __syncthreads();
    if (mp == 0) {
        float ss = 0.f;
#pragma unroll
        for (int dvt = 0; dvt < 4; ++dvt)
#pragma unroll
            for (int j = 0; j < 16; ++j) { const float a = o[dvt][j] * inv - lam * Xq[dvt * 32 + (j & 3) + 8 * (j >> 2) + 4 * h5]; o[dvt][j] = a; ss += a * a; }
        ss += __shfl_xor(ss, 32);
        const float rstd = 0.8f / sqrtf(ss * (1.f / 128.f) + 1e-5f);
#pragma unroll
        for (int dvt = 0; dvt < 4; ++dvt)
#pragma unroll
            for (int j = 0; j < 16; ++j) Xq[dvt * 32 + (j & 3) + 8 * (j >> 2) + 4 * h5] = o[dvt][j] * rstd;
    }
    __syncthreads();
    {
        const float* sg = F.in[I_SUBG];
        bf16* MIX = (bf16*)(F.ws + WS_MIX);
        const int d8 = (tid_ & 15) * 8;
        const f32x4 g0 = *(const f32x4*)(sg + d8), g1 = *(const f32x4*)(sg + d8 + 4);
#pragma unroll
        for (int p = 0; p < 4; ++p) {
            const int q = p * 32 + (tid_ >> 4), m = m0 + q;
            const LAS float* xr = X + q * AT_XSTRIDE + d8;
            const f32x4 a0 = *(const LAS f32x4*)xr, a1 = *(const LAS f32x4*)(xr + 4);
            const v4u ga = gav[p];
            v4u w;
            w.x = pk2(a0.x * g0.x * bflo(ga.x), a0.y * g0.y * bfhi(ga.x)); w.y = pk2(a0.z * g0.z * bflo(ga.y), a0.w * g0.w * bfhi(ga.y));
            w.z = pk2(a1.x * g1.x * bflo(ga.z), a1.y * g1.y * bfhi(ga.z)); w.w = pk2(a1.z * g1.z * bflo(ga.w), a1.w * g1.w * bfhi(ga.w));
            *(v4u*)(MIX + (size_t)m * DMIX + hh * 128 + d8) = w;
        }
    }
}

constexpr int SC_W2 = 0, SC_A2 = 16384, SC_TLW = 32768, SC_LA = 40960, SC_WD = 49152, SC_NKK = 57344, SC_BB = 65536, SC_KD = 73728, SC_R = 81920, SC_V = 90112, SC_Y = 98304, SC_BON = 106496;
template <int CTRL> __device__ __forceinline__ float dppf(float x) { return __builtin_bit_cast(float, __builtin_amdgcn_update_dpp(0, __builtin_bit_cast(int, x), CTRL, 0xf, 0xf, true)); }
__device__ __forceinline__ float reduce8(float v) { v += dppf<0xB1>(v); v += dppf<0x4E>(v); v += dppf<0x141>(v); return v; }
__device__ __forceinline__ float shift_load(const bf16* ub, const float* mu, int t, int T, int col) {
    const float u = bf2f(ub[col]);
    const float p = t > 0 ? bf2f(ub[col - DSH]) : 0.f;
    const float n = t < T - 1 ? bf2f(ub[col + DSH]) : 0.f;
    return u + mu[col] * (p - u) + mu[DSH + col] * (n - u);
}
__device__ __forceinline__ void scan_unit(Frame& F, int b, int hh, bool lat) {
    const int T = lat ? LSEQ : SEQ, m0 = lat ? MC + b * LSEQ : b * SEQ;
    const bf16* UB = (const bf16*)(F.ws + WS_UB); const bf16* GB = (const bf16*)(F.ws + WS_GB); bf16* MIX = (bf16*)(F.ws + WS_MIX);
    float* YB = F.out + OUT_Y;
    const float* mu = F.in[I_MU];
    LAS float* W2s = (LAS float*)(F.lds + SC_W2); LAS float* A2s = (LAS float*)(F.lds + SC_A2); LAS float* TLW = (LAS float*)(F.lds + SC_TLW); LAS float* LAs = (LAS float*)(F.lds + SC_LA);
    LAS float* WD = (LAS float*)(F.lds + SC_WD); LAS float* NKK = (LAS float*)(F.lds + SC_NKK); LAS float* BB = (LAS float*)(F.lds + SC_BB); LAS float* KD = (LAS float*)(F.lds + SC_KD);
    LAS float* RR = (LAS float*)(F.lds + SC_R); LAS float* VV = (LAS float*)(F.lds + SC_V); LAS float* YC = (LAS float*)(F.lds + SC_Y); LAS float* BON = (LAS float*)(F.lds + SC_BON);
    const int c = F.lane, hc = hh * 64 + c, row = F.wave * 8 + (F.lane >> 3), kq = F.lane & 7;
    const float kkc = F.in[I_KK][hc], kac = F.in[I_KA][hc], rkc = F.in[I_RK][hc];
    for (int d = 0; d < 2; ++d) {
        __syncthreads();
        for (int i = F.tid; i < 4096; i += NTHR) { const int j = i >> 6, cc = i & 63; W2s[i] = F.in[I_W2][(size_t)(d * 64 + j) * D + hh * 64 + cc]; A2s[i] = F.in[I_A2][(size_t)(d * 64 + j) * D + hh * 64 + cc]; }
        const float w0c = F.in[I_W0][d * D + hc], a0c = F.in[I_A0][d * D + hc];
        float S[8];
        if (lat) { const float* sp = F.in[I_ST] + ((size_t)((b * 2 + d) * NHB + hh) * 64 + row) * 64 + kq * 8;
            const f32x4 s0 = *(const f32x4*)sp, s1 = *(const f32x4*)(sp + 4); S[0] = s0.x; S[1] = s0.y; S[2] = s0.z; S[3] = s0.w; S[4] = s1.x; S[5] = s1.y; S[6] = s1.z; S[7] = s1.w; }
        else {
#pragma unroll
            for (int i = 0; i < 8; ++i) S[i] = 0.f; }
        const int nch = T / 32;
        for (int ch = 0; ch < nch; ++ch) {
            const int t0 = (d == 0 ? ch : nch - 1 - ch) * 32;
            __syncthreads();
            float r_[4], k_[4], v_[4];
#pragma unroll
            for (int i = 0; i < 4; ++i) {
                const int tt = F.wave * 4 + i, t = t0 + tt;
                const bf16* ub = UB + (size_t)(m0 + t) * DSH;
                r_[i] = shift_load(ub, mu, t, T, hc); k_[i] = shift_load(ub, mu, t, T, 1024 + hc); v_[i] = shift_load(ub, mu, t, T, 2048 + hc);
                const float lw = shift_load(ub, mu, t, T, 3072 + 64 * d + c), la = shift_load(ub, mu, t, T, 3200 + 64 * d + c);
                TLW[tt * 64 + c] = tanhf(lw); LAs[tt * 64 + c] = la;
            }
            __syncthreads();
            float zw[4], za[4];
#pragma unroll
            for (int i = 0; i < 4; ++i) { zw[i] = w0c; za[i] = a0c; }
            for (int j = 0; j < 64; j += 4) {
                f32x4 tw[4], ta[4];
#pragma unroll
                for (int i = 0; i < 4; ++i) { tw[i] = *(const LAS f32x4*)(TLW + (F.wave * 4 + i) * 64 + j); ta[i] = *(const LAS f32x4*)(LAs + (F.wave * 4 + i) * 64 + j); }
#pragma unroll
                for (int jj = 0; jj < 4; ++jj) { const float w2 = W2s[(j + jj) * 64 + c], a2 = A2s[(j + jj) * 64 + c];
#pragma unroll
                    for (int i = 0; i < 4; ++i) { zw[i] += tw[i][jj] * w2; za[i] += ta[i][jj] * a2; } }
            }
#pragma unroll
            for (int i = 0; i < 4; ++i) {
                const int tt = F.wave * 4 + i;
                const float dec = __expf(-0.60653065971f * sigmoidf_(zw[i])), a = sigmoidf_(za[i]);
                float kk = k_[i] * kkc; const float n2 = wave_sum(kk * kk); kk *= 1.f / sqrtf(n2 + 1e-12f);
                WD[tt * 64 + c] = dec; NKK[tt * 64 + c] = -kk; BB[tt * 64 + c] = kk * a; KD[tt * 64 + c] = k_[i] * (1.f + (a - 1.f) * kac); RR[tt * 64 + c] = r_[i]; VV[tt * 64 + c] = v_[i];
                if (d == 1) { const float bo = wave_sum(r_[i] * k_[i] * rkc); if (c == 0) BON[tt] = bo; }
            }
            __syncthreads();
            for (int s = 0; s < 32; ++s) {
                const int tt = d == 0 ? s : 31 - s; const int o = tt * 64 + kq * 8;
                const f32x4 w0 = *(const LAS f32x4*)(WD + o), w1 = *(const LAS f32x4*)(WD + o + 4), n0 = *(const LAS f32x4*)(NKK + o), n1 = *(const LAS f32x4*)(NKK + o + 4);
                const f32x4 b0 = *(const LAS f32x4*)(BB + o), b1 = *(const LAS f32x4*)(BB + o + 4), k0 = *(const LAS f32x4*)(KD + o), k1 = *(const LAS f32x4*)(KD + o + 4);
                const f32x4 r0 = *(const LAS f32x4*)(RR + o), r1 = *(const LAS f32x4*)(RR + o + 4);
                const float vv = VV[tt * 64 + row];
                float sa = (S[0] * n0.x + S[1] * n0.y) + (S[2] * n0.z + S[3] * n0.w) + (S[4] * n1.x + S[5] * n1.y) + (S[6] * n1.z + S[7] * n1.w);
                sa = reduce8(sa);
                S[0] = S[0] * w0.x + sa * b0.x + vv * k0.x; S[1] = S[1] * w0.y + sa * b0.y + vv * k0.y; S[2] = S[2] * w0.z + sa * b0.z + vv * k0.z; S[3] = S[3] * w0.w + sa * b0.w + vv * k0.w;
                S[4] = S[4] * w1.x + sa * b1.x + vv * k1.x; S[5] = S[5] * w1.y + sa * b1.y + vv * k1.y; S[6] = S[6] * w1.z + sa * b1.z + vv * k1.z; S[7] = S[7] * w1.w + sa * b1.w + vv * k1.w;
                float y = (S[0] * r0.x + S[1] * r0.y) + (S[2] * r0.z + S[3] * r0.w) + (S[4] * r1.x + S[5] * r1.y) + (S[6] * r1.z + S[7] * r1.w);
                y = reduce8(y);
                if (kq == 0) YC[tt * 64 + row] = y;
            }
            __syncthreads();
            {
                const int tt = F.tid >> 4, c4 = (F.tid & 15) * 4, m = m0 + t0 + tt;
                f32x4 y4 = *(const LAS f32x4*)(YC + tt * 64 + c4);
                float* gp = YB + (size_t)m * D + hh * 64 + c4;
                if (d == 0) *(f32x4*)gp = y4;
                else {
                    y4 += *(const f32x4*)gp;
                    float s1 = (y4.x + y4.y) + (y4.z + y4.w);
                    s1 += __shfl_xor(s1, 1); s1 += __shfl_xor(s1, 2); s1 += __shfl_xor(s1, 4); s1 += __shfl_xor(s1, 8);
                    const float mean = s1 * (1.f / 64.f);
                    const f32x4 dy = y4 - mean;
                    float s2 = (dy.x * dy.x + dy.y * dy.y) + (dy.z * dy.z + dy.w * dy.w);
                    s2 += __shfl_xor(s2, 1); s2 += __shfl_xor(s2, 2); s2 += __shfl_xor(s2, 4); s2 += __shfl_xor(s2, 8);
                    const float rstd = 1.f / sqrtf(s2 * (1.f / 64.f) + 64e-5f);
                    const f32x4 lg = *(const f32x4*)(F.in[I_LNG] + hh * 64 + c4), lb = *(const f32x4*)(F.in[I_LNB] + hh * 64 + c4);
                    const f32x4 vt = *(const LAS f32x4*)(VV + tt * 64 + c4);
                    const float bo = BON[tt];
                    const v2u gb = *(const v2u*)(GB + (size_t)m * D + hh * 64 + c4);
                    const f32x4 yn = dy * rstd * lg + lb + vt * bo;
                    v2u w; w.x = pk2(yn.x * bflo(gb.x), yn.y * bfhi(gb.x)); w.y = pk2(yn.z * bflo(gb.y), yn.w * bfhi(gb.y));
                    *(v2u*)(MIX + (size_t)m * DMIX + 1024 + hh * 64 + c4) = w;
                }
            }
        }
        if (!lat) { float* sp = F.out + OUT_ST + ((size_t)((b * 2 + d) * NHB + hh) * 64 + row) * 64 + kq * 8;
            *(f32x4*)sp = (f32x4){S[0], S[1], S[2], S[3]}; *(f32x4*)(sp + 4) = (f32x4){S[4], S[5], S[6], S[7]}; }
    }
}


constexpr int SG_ST = 144;
constexpr int G_AT = 0, G_RT = 9216, G_BH = 18432, G_KH = 26624, G_LAK = 34816, G_LBR = 36864, G_LKR = 38912, G_TM = 40960, G_GAM = 43008, G_PRIV = 44032;
constexpr int PW_TLW = 0, PW_LAB = 2304, PW_ZS = 4608, PW_LF = PW_ZS, PW_VT = PW_ZS + 1024, PW_SIZE = 8768, G_SIZE = G_PRIV + 4 * PW_SIZE;
constexpr int ZS_ST = 65, VT_ST = 40;
static_assert(2 * G_SIZE <= LDSCTL_OFF, "scan LDS map");
__device__ __forceinline__ bf16x8 mk8(v2u lo, v2u hi) { const v4u t = {lo.x, lo.y, hi.x, hi.y}; return __builtin_bit_cast(bf16x8, t); }
__device__ __forceinline__ bf16x8 pk8(f32x4 a, f32x4 b) { const v4u t = {pk2(a[0], a[1]), pk2(a[2], a[3]), pk2(b[0], b[1]), pk2(b[2], b[3])}; return __builtin_bit_cast(bf16x8, t); }
#define MFMA16(a, b, c) __builtin_amdgcn_mfma_f32_16x16x32_bf16(a, b, c, 0, 0, 0)
template <int CTRL> __device__ __forceinline__ float dpp_mov(float x) { return __builtin_bit_cast(float, __builtin_amdgcn_update_dpp(0, __builtin_bit_cast(int, x), CTRL, 0xf, 0xf, true)); }
__device__ __forceinline__ void wave_sum16(float (&v)[16], int lane) {
    float a8[8], a4[4], a2[2];
    { const bool bit = lane & 4;
#pragma unroll
      for (int m = 0; m < 8; ++m) { const float send = bit ? v[2 * m] : v[2 * m + 1], keep = bit ? v[2 * m + 1] : v[2 * m]; a8[m] = keep + dpp_mov<0x141>(send); } }
    { const bool bit = lane & 1;
#pragma unroll
      for (int m = 0; m < 4; ++m) { const float send = bit ? a8[2 * m] : a8[2 * m + 1], keep = bit ? a8[2 * m + 1] : a8[2 * m]; a4[m] = keep + dpp_mov<0xB1>(send); } }
    { const bool bit = lane & 2;
#pragma unroll
      for (int m = 0; m < 2; ++m) { const float send = bit ? a4[2 * m] : a4[2 * m + 1], keep = bit ? a4[2 * m + 1] : a4[2 * m]; a2[m] = keep + dpp_mov<0x4E>(send); } }
    float t;
    { const bool bit = lane & 8; const float send = bit ? a2[0] : a2[1], keep = bit ? a2[1] : a2[0]; t = keep + dpp_mov<0x128>(send); }
    t += __shfl_xor(t, 16); t += __shfl_xor(t, 32);
#pragma unroll
    for (int i = 0; i < 16; ++i) { constexpr int dummy = 0; const int src = ((i >> 1) & 1) + 2 * ((i >> 2) & 1) + 4 * (i & 1) + 8 * ((i >> 3) & 1);
        v[i] = __builtin_bit_cast(float, __builtin_amdgcn_readlane(__builtin_bit_cast(int, t), src)); }
}
__device__ __forceinline__ void load_shift16(const bf16* ubase, int T, int p0, int d, int col, float mA, float mB, float (&out)[16]) {
    float u[18];
#pragma unroll
    for (int j = 0; j < 18; ++j) { const int tj = d ? (T - p0 - j) : (p0 - 1 + j);
        if (j == 0 || j == 17) u[j] = (tj >= 0 && tj < T) ? bf2f(ubase[(size_t)tj * DSH + col]) : 0.f;
        else u[j] = bf2f(ubase[(size_t)tj * DSH + col]); }
#pragma unroll
    for (int i = 0; i < 16; ++i) out[i] = u[i + 1] + mA * (u[i] - u[i + 1]) + mB * (u[i + 2] - u[i + 1]);
}
__device__ __forceinline__ void scan_unit2(Frame& F, int b, int hh, bool lat) {
    const int T = lat ? LSEQ : SEQ, m0 = lat ? MC + b * LSEQ : b * SEQ, nch = T / 64;
    const int lane0 = F.lane, d = F.wave >> 2, w = F.wave & 3;
    int lane = lane0, c16 = lane & 15, g = lane >> 4, hc = hh * 64 + lane;
    LAS unsigned char* GB_ = F.lds + d * G_SIZE;
    LAS unsigned char* PW = GB_ + G_PRIV + w * PW_SIZE;
    const bf16* UB = (const bf16*)(F.ws + WS_UB) + (size_t)m0 * DSH; const bf16* GBp = (const bf16*)(F.ws + WS_GB); bf16* MIX = (bf16*)(F.ws + WS_MIX);
    float* YB = F.out + OUT_Y;
    const float* mu = F.in[I_MU];
    int cR = hc, cK = 1024 + hc, cV = 2048 + hc, cW = 3072 + 64 * d + lane, cA = 3200 + 64 * d + lane;
    const int oA = d ? DSH : 0, oB = d ? 0 : DSH;
    const float kkc = F.in[I_KK][hc], kac = F.in[I_KA][hc], rkc = F.in[I_RK][hc], w0c = F.in[I_W0][d * D + hc], a0c = F.in[I_A0][d * D + hc];
    const float lng = F.in[I_LNG][hc], lnb = F.in[I_LNB][hc];
    const v4u* wop0 = (const v4u*)(F.ws + WS_WOP) + (size_t)((d * 16 + hh) * 2) * 8 * 64;
    f32x4 S[4];
    const size_t st_off = ((size_t)((b * 2 + d) * NHB + hh) * 64 + 16 * w + c16) * 64 + 4 * g;
#pragma unroll
    for (int kt = 0; kt < 4; ++kt) S[kt] = lat ? *(const f32x4*)(F.in[I_ST] + st_off + 16 * kt) : (f32x4){0.f, 0.f, 0.f, 0.f};
    const v2u z2 = {0u, 0u};
    __syncthreads();
    for (int it = 0; it < nch; ++it) {
        const int p0 = it * 64 + w * 16;
        lane = lane0; asm volatile("" : "+v"(lane));
        c16 = lane & 15; g = lane >> 4; hc = hh * 64 + lane; cR = hc; cK = 1024 + hc; cV = 2048 + hc; cW = 3072 + 64 * d + lane; cA = 3200 + 64 * d + lane;
        const v4u* wop = wop0 + lane;
        float bon[16], v_[16];
        {
            float x_[16];
            load_shift16(UB, T, p0, d, cW, mu[oA + cW], mu[oB + cW], x_);
#pragma unroll
            for (int i = 0; i < 16; ++i) { const float e = __expf(2.f * x_[i]); *(LAS bf16*)(PW + PW_TLW + i * SG_ST + lane * 2) = (bf16)f2bf(1.f - 2.f / (e + 1.f)); }
            load_shift16(UB, T, p0, d, cA, mu[oA + cA], mu[oB + cA], x_);
#pragma unroll
            for (int i = 0; i < 16; ++i) *(LAS bf16*)(PW + PW_LAB + i * SG_ST + lane * 2) = (bf16)f2bf(x_[i]);
        }
        float lam[16], aa[16];
        {
            LAS float* Zs = (LAS float*)(PW + PW_ZS);
            {
                bf16x8 ta[2];
#pragma unroll
                for (int ks = 0; ks < 2; ++ks) ta[ks] = *(const LAS bf16x8*)(PW + PW_TLW + c16 * SG_ST + (32 * ks + 8 * g) * 2);
#pragma unroll
                for (int ct = 0; ct < 4; ++ct) { f32x4 z = {0.f, 0.f, 0.f, 0.f};
#pragma unroll
                    for (int ks = 0; ks < 2; ++ks) z = MFMA16(ta[ks], __builtin_bit_cast(bf16x8, wop[(ct * 2 + ks) * 64]), z);
#pragma unroll
                    for (int rg = 0; rg < 4; ++rg) Zs[(4 * g + rg) * ZS_ST + 16 * ct + c16] = z[rg]; }
                float l = 0.f;
#pragma unroll
                for (int i = 0; i < 16; ++i) { l += -0.60653065971f * sigmoidf_(w0c + Zs[i * ZS_ST + lane]); lam[i] = l; }
            }
            {
                bf16x8 tb[2];
#pragma unroll
                for (int ks = 0; ks < 2; ++ks) tb[ks] = *(const LAS bf16x8*)(PW + PW_LAB + c16 * SG_ST + (32 * ks + 8 * g) * 2);
#pragma unroll
                for (int ct = 0; ct < 4; ++ct) { f32x4 z = {0.f, 0.f, 0.f, 0.f};
#pragma unroll
                    for (int ks = 0; ks < 2; ++ks) z = MFMA16(tb[ks], __builtin_bit_cast(bf16x8, wop[512 + (ct * 2 + ks) * 64]), z);
#pragma unroll
                    for (int rg = 0; rg < 4; ++rg) Zs[(4 * g + rg) * ZS_ST + 16 * ct + c16] = z[rg]; }
#pragma unroll
                for (int i = 0; i < 16; ++i) aa[i] = sigmoidf_(a0c + Zs[i * ZS_ST + lane]);
            }
        }
        {
            float k_[16];
            load_shift16(UB, T, p0, d, cK, mu[oA + cK], mu[oB + cK], k_);
            {
                float n2[16];
#pragma unroll
                for (int i = 0; i < 16; ++i) { const float kk = k_[i] * kkc; n2[i] = kk * kk; }
                wave_sum16(n2, lane);
                unsigned bh[8], kh[8];
#pragma unroll
                for (int i = 0; i < 16; ++i) {
                    const float kk = k_[i] * kkc * (1.f / sqrtf(n2[i] + 1e-12f)), kd = k_[i] * (1.f + (aa[i] - 1.f) * kac), bb = kk * aa[i];
                    const float e1 = i ? __expf(lam[i - 1]) : 1.f, e2 = __expf(-lam[i]);
                    *(LAS bf16*)(GB_ + G_AT + (16 * w + i) * SG_ST + lane * 2) = (bf16)f2bf(-kk * e1);
                    const unsigned btb = f2bf(bb * e2), ktb = f2bf(kd * e2);
                    *(LAS bf16*)(PW + PW_TLW + i * SG_ST + lane * 2) = (bf16)btb;
                    *(LAS bf16*)(PW + PW_LAB + i * SG_ST + lane * 2) = (bf16)ktb;
                    if (i & 1) { bh[i >> 1] |= btb << 16; kh[i >> 1] |= ktb << 16; } else { bh[i >> 1] = btb; kh[i >> 1] = ktb; }
                }
#pragma unroll
                for (int q = 0; q < 4; ++q) {
                    *(LAS v2u*)(GB_ + G_BH + (w * 64 + lane) * 32 + 8 * q) = (v2u){bh[2 * q], bh[2 * q + 1]};
                    *(LAS v2u*)(GB_ + G_KH + (w * 64 + lane) * 32 + 8 * q) = (v2u){kh[2 * q], kh[2 * q + 1]};
                }
            }
            float r_[16];
            load_shift16(UB, T, p0, d, cR, mu[oA + cR], mu[oB + cR], r_);
#pragma unroll
            for (int i = 0; i < 16; ++i) { bon[i] = r_[i] * k_[i] * rkc; *(LAS bf16*)(GB_ + G_RT + (16 * w + i) * SG_ST + lane * 2) = (bf16)f2bf(r_[i] * __expf(lam[i])); }
            wave_sum16(bon, lane);
        }
        ((LAS float*)(GB_ + G_GAM))[w * 64 + lane] = __expf(lam[15]);
        {
            load_shift16(UB, T, p0, d, cV, mu[oA + cV], mu[oB + cV], v_);
            unsigned vt[8];
#pragma unroll
            for (int i = 0; i < 16; ++i) { const unsigned vtb = f2bf(v_[i]); if (i & 1) vt[i >> 1] |= vtb << 16; else vt[i >> 1] = vtb; v_[i] *= bon[i]; }
#pragma unroll
            for (int q = 0; q < 4; ++q) *(LAS v2u*)(PW + PW_VT + lane * VT_ST + 8 * q) = (v2u){vt[2 * q], vt[2 * q + 1]};
        }
        {
            bf16x8 fa[2], fr[2], fb[2], fk[2];
#pragma unroll
            for (int ks = 0; ks < 2; ++ks) {
                fa[ks] = *(const LAS bf16x8*)(GB_ + G_AT + (16 * w + c16) * SG_ST + (32 * ks + 8 * g) * 2); fr[ks] = *(const LAS bf16x8*)(GB_ + G_RT + (16 * w + c16) * SG_ST + (32 * ks + 8 * g) * 2);
                fb[ks] = *(const LAS bf16x8*)(PW + PW_TLW + c16 * SG_ST + (32 * ks + 8 * g) * 2); fk[ks] = *(const LAS bf16x8*)(PW + PW_LAB + c16 * SG_ST + (32 * ks + 8 * g) * 2);
            }
            f32x4 lab = {0.f, 0.f, 0.f, 0.f}, lak = lab, lbr = lab, lkr = lab;
#pragma unroll
            for (int ks = 0; ks < 2; ++ks) { lab = MFMA16(fa[ks], fb[ks], lab); lak = MFMA16(fa[ks], fk[ks], lak); lbr = MFMA16(fr[ks], fb[ks], lbr); lkr = MFMA16(fr[ks], fk[ks], lkr); }
            LAS float* Lf = (LAS float*)(PW + PW_LF);
#pragma unroll
            for (int rg = 0; rg < 4; ++rg) { const int i = 4 * g + rg, j = c16;
                Lf[i * 16 + j] = j < i ? lab[rg] : 0.f;
                *(LAS bf16*)(GB_ + G_LAK + (w * 16 + i) * 32 + j * 2) = (bf16)f2bf(j < i ? lak[rg] : 0.f);
                *(LAS bf16*)(GB_ + G_LBR + (w * 16 + i) * 32 + j * 2) = (bf16)f2bf(j <= i ? lbr[rg] : 0.f);
                *(LAS bf16*)(GB_ + G_LKR + (w * 16 + i) * 32 + j * 2) = (bf16)f2bf(j <= i ? lkr[rg] : 0.f); }
            float tm[16];
#pragma unroll
            for (int i = 0; i < 16; ++i) { float a = (i == c16) ? 1.f : 0.f;
#pragma unroll
                for (int j = 0; j < i; ++j) a += Lf[i * 16 + j] * tm[j];
                tm[i] = a; }
            if (lane < 16) {
#pragma unroll
                for (int i = 0; i < 16; ++i) *(LAS bf16*)(GB_ + G_TM + (w * 16 + i) * 32 + lane * 2) = (bf16)f2bf(tm[i]); }
        }
        __syncthreads();
        const bool first = it < nch / 2;
#pragma unroll 1
        for (int sc = 0; sc < 4; ++sc) {
            lane = lane0; asm volatile("" : "+v"(lane)); c16 = lane & 15; g = lane >> 4;
            const LAS unsigned char* at_p = GB_ + G_AT + (16 * sc + c16) * SG_ST + 8 * g;
            const LAS unsigned char* rt_p = GB_ + G_RT + (16 * sc + c16) * SG_ST + 8 * g;
            const LAS unsigned char* vt_p = GB_ + G_PRIV + sc * PW_SIZE + PW_VT + (16 * w + c16) * VT_ST + 8 * g;
            const bf16x8 sop0 = pk8(S[0], S[1]), sop1 = pk8(S[2], S[3]);
            const bf16x8 at0 = mk8(*(const LAS v2u*)(at_p), *(const LAS v2u*)(at_p + 32)), at1 = mk8(*(const LAS v2u*)(at_p + 64), *(const LAS v2u*)(at_p + 96));
            const bf16x8 rt0 = mk8(*(const LAS v2u*)(rt_p), *(const LAS v2u*)(rt_p + 32)), rt1 = mk8(*(const LAS v2u*)(rt_p + 64), *(const LAS v2u*)(rt_p + 96));
            const v2u vt2 = *(const LAS v2u*)vt_p;
            const bf16x8 alak = mk8(*(const LAS v2u*)(GB_ + G_LAK + (sc * 16 + c16) * 32 + 8 * g), z2);
            const bf16x8 atm = mk8(*(const LAS v2u*)(GB_ + G_TM + (sc * 16 + c16) * 32 + 8 * g), z2);
            const bf16x8 albk = mk8(*(const LAS v2u*)(GB_ + G_LBR + (sc * 16 + c16) * 32 + 8 * g), *(const LAS v2u*)(GB_ + G_LKR + (sc * 16 + c16) * 32 + 8 * g));
            f32x4 X = {0.f, 0.f, 0.f, 0.f};
            X = MFMA16(at0, sop0, X); X = MFMA16(at1, sop1, X); X = MFMA16(alak, mk8(vt2, z2), X);
            const v4u xo = {pk2(X[0], X[1]), pk2(X[2], X[3]), 0u, 0u};
            f32x4 U = {0.f, 0.f, 0.f, 0.f};
            U = MFMA16(atm, __builtin_bit_cast(bf16x8, xo), U);
            const v4u uo = {pk2(U[0], U[1]), pk2(U[2], U[3]), vt2.x, vt2.y};
            const bf16x8 uvop = __builtin_bit_cast(bf16x8, uo);
            float* yp[4];
#pragma unroll
            for (int rg = 0; rg < 4; ++rg) { const int p = it * 64 + sc * 16 + 4 * g + rg, t = d ? T - 1 - p : p; yp[rg] = YB + (size_t)(m0 + t) * D + hh * 64 + 16 * w + c16; }
            f32x4 Y = {0.f, 0.f, 0.f, 0.f};
            if (!first) {
#pragma unroll
                for (int rg = 0; rg < 4; ++rg) Y[rg] = *yp[rg]; }
            Y = MFMA16(rt0, sop0, Y); Y = MFMA16(rt1, sop1, Y); Y = MFMA16(albk, uvop, Y);
#pragma unroll
            for (int rg = 0; rg < 4; ++rg) *yp[rg] = Y[rg];
#pragma unroll
            for (int kt = 0; kt < 4; ++kt) {
                const bf16x8 abk = mk8(*(const LAS v2u*)(GB_ + G_BH + (sc * 64 + 16 * kt + c16) * 32 + 8 * g), *(const LAS v2u*)(GB_ + G_KH + (sc * 64 + 16 * kt + c16) * 32 + 8 * g));
                const f32x4 gm = *(const LAS f32x4*)(GB_ + G_GAM + (sc * 64 + 16 * kt + 4 * g) * 4);
                S[kt] = MFMA16(abk, uvop, S[kt]) * gm;
            }
        }
        __syncthreads();
        if (!first) {
            lane = lane0; asm volatile("" : "+v"(lane)); hc = hh * 64 + lane;
            float y_[16], s1[16];
#pragma unroll
            for (int i = 0; i < 16; ++i) { const int p = p0 + i, t = d ? T - 1 - p : p; y_[i] = YB[(size_t)(m0 + t) * D + hc]; s1[i] = y_[i]; }
            wave_sum16(s1, lane);
#pragma unroll
            for (int i = 0; i < 16; ++i) { y_[i] -= s1[i] * (1.f / 64.f); s1[i] = y_[i] * y_[i]; }
            wave_sum16(s1, lane);
#pragma unroll
            for (int i = 0; i < 16; ++i) { const int p = p0 + i, t = d ? T - 1 - p : p; const size_t m = (size_t)(m0 + t);
                const float yn = y_[i] * (1.f / sqrtf(s1[i] * (1.f / 64.f) + 64e-5f)) * lng + lnb + v_[i];
                MIX[m * DMIX + 1024 + hc] = (bf16)f2bf(yn * bf2f(GBp[m * D + hc])); }
        }
    }
    if (!lat) {
        float* sp = F.out + OUT_ST + st_off;
#pragma unroll
        for (int kt = 0; kt < 4; ++kt) *(f32x4*)(sp + 16 * kt) = S[kt];
    }
}


__device__ __forceinline__ void st_bf16(LAS unsigned char* p, float v) { *(LAS bf16*)p = (bf16)f2bf_hw(v); }
struct PfRows { unsigned off[3]; bool ok[3]; };
__device__ __forceinline__ PfRows pf_rows(int T, int p0, int d, int lane) {
    PfRows R;
#pragma unroll
    for (int q = 0; q < 3; ++q) { const int j = 8 * q + (lane >> 3), jj = j > 17 ? 17 : j, pj = p0 - 1 + jj; int tj = d ? T - 1 - pj : pj; R.ok[q] = tj >= 0 && tj < T; tj = R.ok[q] ? tj : 0;
        R.off[q] = (unsigned)tj * (unsigned)DSH + (unsigned)(lane & 7) * 8u; }
    return R;
}
__device__ __forceinline__ void pf_issue(const bf16* ubase, const PfRows& R, int colb, v4u (&r)[3]) {
#pragma unroll
    for (int q = 0; q < 3; ++q) { v4u x = *(const v4u*)(ubase + colb + R.off[q]); if (!R.ok[q]) x = (v4u){0u, 0u, 0u, 0u}; r[q] = x; }
}
__device__ __forceinline__ void pf_consume(LAS unsigned char* stg, const v4u (&r)[3], int lane, float mA, float mB, float (&out)[16]) {
#pragma unroll
    for (int q = 0; q < 3; ++q) *(LAS v4u*)(stg + (8 * q + (lane >> 3)) * SG_ST + (lane & 7) * 16) = r[q];
    asm volatile("" ::: "memory");
    float u[18];
#pragma unroll
    for (int j = 0; j < 18; ++j) u[j] = bf2f(*(const LAS bf16*)(stg + j * SG_ST + lane * 2));
    asm volatile("" ::: "memory");
    const float m0_ = 1.f - mA - mB;
#pragma unroll
    for (int i = 0; i < 16; ++i) out[i] = m0_ * u[i + 1] + mA * u[i] + mB * u[i + 2];
}
__device__ __forceinline__ void scan_unit3(Frame& F, int b, int hh, bool lat, const XcdBarrier* gbar = nullptr, int gbar_it = -1) {
    const int T = lat ? LSEQ : SEQ, m0 = lat ? MC + b * LSEQ : b * SEQ, nch = T / 64;
    int lane0 = F.lane; asm volatile("" : "+v"(lane0));
    const int d = F.wave >> 2, w = F.wave & 3;
    int lane = lane0, c16 = lane & 15, g = lane >> 4, hc = hh * 64 + lane;
    LAS unsigned char* GB_ = F.lds + d * G_SIZE;
    LAS unsigned char* PW = GB_ + G_PRIV + w * PW_SIZE;
    const bf16* UB = (const bf16*)(F.ws + WS_UB) + (size_t)m0 * DSH; const bf16* GBp = (const bf16*)(F.ws + WS_GB); bf16* MIX = (bf16*)(F.ws + WS_MIX);
    float* YB = F.out + OUT_Y;
    const float* mu = F.in[I_MU];
    const int cR = hh * 64, cK = 1024 + hh * 64, cV = 2048 + hh * 64, cW = 3072 + 64 * d, cA = 3200 + 64 * d;
    const int oA = d ? DSH : 0, oB = d ? 0 : DSH;
    const float kkc = F.in[I_KK][hc], kac = F.in[I_KA][hc], rkc = F.in[I_RK][hc], w0c = F.in[I_W0][d * D + hc], a0c = F.in[I_A0][d * D + hc];
    const float mWA = mu[oA + cW + lane], mWB = mu[oB + cW + lane], mAA = mu[oA + cA + lane], mAB = mu[oB + cA + lane], mKA = mu[oA + cK + lane], mKB = mu[oB + cK + lane];
    const float mRA = mu[oA + cR + lane], mRB = mu[oB + cR + lane], mVA = mu[oA + cV + lane], mVB = mu[oB + cV + lane];
    const v4u* wop0 = (const v4u*)(F.ws + WS_WOP) + (size_t)((d * 16 + hh) * 2) * 8 * 64;
    f32x4 S[4];
    { const size_t st_off = ((size_t)((b * 2 + d) * NHB + hh) * 64 + 16 * w + c16) * 64 + 4 * g;
#pragma unroll
    for (int kt = 0; kt < 4; ++kt) S[kt] = lat ? *(const f32x4*)(F.in[I_ST] + st_off + 16 * kt) : (f32x4){0.f, 0.f, 0.f, 0.f}; }
    const v2u z2 = {0u, 0u};
    v4u pW[3], pA[3], pK[3], pR[3], pV[3];
    { const PfRows R = pf_rows(T, w * 16, d, lane); pf_issue(UB, R, cW, pW); pf_issue(UB, R, cA, pA); pf_issue(UB, R, cK, pK); pf_issue(UB, R, cR, pR); pf_issue(UB, R, cV, pV); }
    __syncthreads();
    for (int it = 0; it < nch; ++it) {
        if (it == gbar_it) xcd_barrier(*gbar);
        const int p0 = it * 64 + w * 16;
        const bool first = it < nch / 2;
        lane = lane0; asm volatile("" : "+v"(lane));
        c16 = lane & 15; g = lane >> 4; hc = hh * 64 + lane;
        const v4u* wop = wop0 + lane;
        LAS unsigned char* stg = PW + PW_ZS;
        float bon[16], v_[16];
#ifndef SREP_PREP
#define SREP_PREP 1
#endif
#ifndef SREP_POST
#define SREP_POST 1
#endif
#ifndef SREP_B
#define SREP_B 1
#endif
#pragma unroll 1
        for (int rep_ = 0; rep_ < SREP_PREP; ++rep_) {
        {
            float x_[16];
            pf_consume(stg, pW, lane, mWA, mWB, x_);
#pragma unroll
            for (int i = 0; i < 16; ++i) { const float e = __expf(2.f * x_[i]); st_bf16(PW + PW_TLW + i * SG_ST + lane * 2, 1.f - 2.f * __builtin_amdgcn_rcpf(e + 1.f)); }
            pf_consume(stg, pA, lane, mAA, mAB, x_);
#pragma unroll
            for (int i = 0; i < 16; ++i) st_bf16(PW + PW_LAB + i * SG_ST + lane * 2, x_[i]);
        }
        float k_[16];
        pf_consume(stg, pK, lane, mKA, mKB, k_);
        asm volatile("" ::: "memory");
        float lam[16], aa[16];
        {
            LAS float* Zs = (LAS float*)(PW + PW_ZS);
            {
                bf16x8 ta[2];
#pragma unroll
                for (int ks = 0; ks < 2; ++ks) ta[ks] = *(const LAS bf16x8*)(PW + PW_TLW + c16 * SG_ST + (32 * ks + 8 * g) * 2);
#pragma unroll
                for (int ct = 0; ct < 4; ++ct) { f32x4 z = {0.f, 0.f, 0.f, 0.f};
#pragma unroll
                    for (int ks = 0; ks < 2; ++ks) z = MFMA16(ta[ks], __builtin_bit_cast(bf16x8, wop[(ct * 2 + ks) * 64]), z);
#pragma unroll
                    for (int rg = 0; rg < 4; ++rg) Zs[(4 * g + rg) * ZS_ST + 16 * ct + c16] = z[rg]; }
                float l = 0.f;
#pragma unroll
                for (int i = 0; i < 16; ++i) { l += -0.60653065971f * sigmoidf_(w0c + Zs[i * ZS_ST + lane]); lam[i] = l; }
            }
            asm volatile("" ::: "memory");
            {
                bf16x8 tb[2];
#pragma unroll
                for (int ks = 0; ks < 2; ++ks) tb[ks] = *(const LAS bf16x8*)(PW + PW_LAB + c16 * SG_ST + (32 * ks + 8 * g) * 2);
#pragma unroll
                for (int ct = 0; ct < 4; ++ct) { f32x4 z = {0.f, 0.f, 0.f, 0.f};
#pragma unroll
                    for (int ks = 0; ks < 2; ++ks) z = MFMA16(tb[ks], __builtin_bit_cast(bf16x8, wop[512 + (ct * 2 + ks) * 64]), z);
#pragma unroll
                    for (int rg = 0; rg < 4; ++rg) Zs[(4 * g + rg) * ZS_ST + 16 * ct + c16] = z[rg]; }
#pragma unroll
                for (int i = 0; i < 16; ++i) aa[i] = sigmoidf_(a0c + Zs[i * ZS_ST + lane]);
            }
        }
        {
            {
                float n2[16];
#pragma unroll
                for (int i = 0; i < 16; ++i) { const float kk = k_[i] * kkc; n2[i] = kk * kk; }
                wave_sum16(n2, lane);
                unsigned bh[8], kh[8];
                float e1 = 1.f;
#pragma unroll
                for (int i = 0; i < 16; i += 2) {
                    float bt2[2], kt2[2];
#pragma unroll
                    for (int e = 0; e < 2; ++e) {
                        const float kk = k_[i + e] * kkc * __builtin_amdgcn_rsqf(n2[i + e] + 1e-12f), kd = k_[i + e] * (1.f + (aa[i + e] - 1.f) * kac), bb = kk * aa[i + e];
                        const float e3 = __expf(lam[i + e]), e2 = __builtin_amdgcn_rcpf(e3);
                        lam[i + e] = e3;
                        st_bf16(GB_ + G_AT + (16 * w + i + e) * SG_ST + lane * 2, -kk * e1);
                        bt2[e] = bb * e2; kt2[e] = kd * e2; e1 = e3;
                    }
                    const unsigned bp = pk2(bt2[0], bt2[1]), kp = pk2(kt2[0], kt2[1]);
                    bh[i >> 1] = bp; kh[i >> 1] = kp;
                    *(LAS bf16*)(PW + PW_TLW + i * SG_ST + lane * 2) = (bf16)bp; *(LAS bf16*)(PW + PW_TLW + (i + 1) * SG_ST + lane * 2) = (bf16)(bp >> 16);
                    *(LAS bf16*)(PW + PW_LAB + i * SG_ST + lane * 2) = (bf16)kp; *(LAS bf16*)(PW + PW_LAB + (i + 1) * SG_ST + lane * 2) = (bf16)(kp >> 16);
                }
#pragma unroll
                for (int q = 0; q < 4; ++q) {
                    *(LAS v2u*)(GB_ + G_BH + (w * 64 + lane) * 32 + 8 * q) = (v2u){bh[2 * q], bh[2 * q + 1]};
                    *(LAS v2u*)(GB_ + G_KH + (w * 64 + lane) * 32 + 8 * q) = (v2u){kh[2 * q], kh[2 * q + 1]};
                }
            }
            float r_[16];
            pf_consume(stg, pR, lane, mRA, mRB, r_);
#pragma unroll
            for (int i = 0; i < 16; ++i) { bon[i] = r_[i] * k_[i] * rkc; st_bf16(GB_ + G_RT + (16 * w + i) * SG_ST + lane * 2, r_[i] * lam[i]); }
            wave_sum16(bon, lane);
        }
        ((LAS float*)(GB_ + G_GAM))[w * 64 + lane] = lam[15];
        {
            pf_consume(stg, pV, lane, mVA, mVB, v_);
            unsigned vt[8];
#pragma unroll
            for (int i = 0; i < 16; i += 2) { vt[i >> 1] = pk2(v_[i], v_[i + 1]); v_[i] *= bon[i]; v_[i + 1] *= bon[i + 1]; }
            asm volatile("" ::: "memory");
#pragma unroll
            for (int q = 0; q < 4; ++q) *(LAS v2u*)(PW + PW_VT + lane * VT_ST + 8 * q) = (v2u){vt[2 * q], vt[2 * q + 1]};
        }
        asm volatile("" ::: "memory");
        {
            bf16x8 fa[2], fr[2], fb[2], fk[2];
#pragma unroll
            for (int ks = 0; ks < 2; ++ks) {
                fa[ks] = *(const LAS bf16x8*)(GB_ + G_AT + (16 * w + c16) * SG_ST + (32 * ks + 8 * g) * 2); fr[ks] = *(const LAS bf16x8*)(GB_ + G_RT + (16 * w + c16) * SG_ST + (32 * ks + 8 * g) * 2);
                fb[ks] = *(const LAS bf16x8*)(PW + PW_TLW + c16 * SG_ST + (32 * ks + 8 * g) * 2); fk[ks] = *(const LAS bf16x8*)(PW + PW_LAB + c16 * SG_ST + (32 * ks + 8 * g) * 2);
            }
            f32x4 lab = {0.f, 0.f, 0.f, 0.f}, lak = lab, lbr = lab, lkr = lab;
#pragma unroll
            for (int ks = 0; ks < 2; ++ks) { lab = MFMA16(fa[ks], fb[ks], lab); lak = MFMA16(fa[ks], fk[ks], lak); lbr = MFMA16(fr[ks], fb[ks], lbr); lkr = MFMA16(fr[ks], fk[ks], lkr); }
            LAS float* Lf = (LAS float*)(PW + PW_LF);
#pragma unroll
            for (int rg = 0; rg < 4; ++rg) { const int i = 4 * g + rg, j = c16;
                Lf[i * 16 + j] = j < i ? lab[rg] : 0.f;
                st_bf16(GB_ + G_LAK + (w * 16 + i) * 32 + j * 2, j < i ? lak[rg] : 0.f);
                st_bf16(GB_ + G_LBR + (w * 16 + i) * 32 + j * 2, j <= i ? lbr[rg] : 0.f);
                st_bf16(GB_ + G_LKR + (w * 16 + i) * 32 + j * 2, j <= i ? lkr[rg] : 0.f); }
            float tm[16];
#pragma unroll
            for (int i = 0; i < 16; ++i) { float a = (i == c16) ? 1.f : 0.f;
#pragma unroll
                for (int j = 0; j < i; ++j) a += Lf[i * 16 + j] * tm[j];
                tm[i] = a; }
            if (lane < 16) {
#pragma unroll
                for (int i = 0; i < 16; ++i) st_bf16(GB_ + G_TM + (w * 16 + i) * 32 + lane * 2, tm[i]); }
        }
        }
        __syncthreads();
        if (it + 1 < nch) { const PfRows R = pf_rows(T, p0 + 64, d, lane); pf_issue(UB, R, cW, pW); pf_issue(UB, R, cA, pA); pf_issue(UB, R, cK, pK); pf_issue(UB, R, cR, pR); pf_issue(UB, R, cV, pV); }
        float yo[16];
        if (!first) {
#pragma unroll
            for (int i = 0; i < 16; ++i) { const int p = p0 + i, t = d ? T - 1 - p : p; yo[i] = YB[(size_t)(m0 + t) * D + hc]; } }
        {
            lane = lane0; asm volatile("" : "+v"(lane)); c16 = lane & 15; g = lane >> 4;
            const LAS unsigned char* at_b = GB_ + G_AT + c16 * SG_ST + 8 * g;
            const LAS unsigned char* rt_b = GB_ + G_RT + c16 * SG_ST + 8 * g;
            const LAS unsigned char* vt_b = GB_ + G_PRIV + PW_VT + (16 * w + c16) * VT_ST + 8 * g;
            const LAS unsigned char* l_b = GB_ + c16 * 32 + 8 * g;
            const LAS unsigned char* gm_b = GB_ + G_GAM + 16 * g;
            LAS float* yc_b = (LAS float*)(GB_ + G_PRIV + PW_TLW) + (4 * g) * ZS_ST + 16 * w + c16;
#pragma unroll
            for (int sc = 0; sc < 4; ++sc) {
                const LAS unsigned char* at_p = at_b + sc * 16 * SG_ST; const LAS unsigned char* rt_p = rt_b + sc * 16 * SG_ST;
                const bf16x8 sop0 = pk8(S[0], S[1]), sop1 = pk8(S[2], S[3]);
                const bf16x8 at0 = mk8(*(const LAS v2u*)(at_p), *(const LAS v2u*)(at_p + 32)), at1 = mk8(*(const LAS v2u*)(at_p + 64), *(const LAS v2u*)(at_p + 96));
                const bf16x8 rt0 = mk8(*(const LAS v2u*)(rt_p), *(const LAS v2u*)(rt_p + 32)), rt1 = mk8(*(const LAS v2u*)(rt_p + 64), *(const LAS v2u*)(rt_p + 96));
                const v2u vt2 = *(const LAS v2u*)(vt_b + sc * PW_SIZE);
                const bf16x8 alak = mk8(*(const LAS v2u*)(l_b + G_LAK + sc * 512), z2);
                const bf16x8 atm = mk8(*(const LAS v2u*)(l_b + G_TM + sc * 512), z2);
                const bf16x8 albk = mk8(*(const LAS v2u*)(l_b + G_LBR + sc * 512), *(const LAS v2u*)(l_b + G_LKR + sc * 512));
                f32x4 X = {0.f, 0.f, 0.f, 0.f}, Y = X;
                X = MFMA16(at0, sop0, X); Y = MFMA16(rt0, sop0, Y); X = MFMA16(at1, sop1, X); Y = MFMA16(rt1, sop1, Y); X = MFMA16(alak, mk8(vt2, z2), X);
                const v4u xo = {pk2(X[0], X[1]), pk2(X[2], X[3]), 0u, 0u};
                f32x4 U = {0.f, 0.f, 0.f, 0.f};
                U = MFMA16(atm, __builtin_bit_cast(bf16x8, xo), U);
                const v4u uo = {pk2(U[0], U[1]), pk2(U[2], U[3]), vt2.x, vt2.y};
                const bf16x8 uvop = __builtin_bit_cast(bf16x8, uo);
                Y = MFMA16(albk, uvop, Y);
#pragma unroll
                for (int kt = 0; kt < 4; ++kt) {
                    const bf16x8 abk = mk8(*(const LAS v2u*)(l_b + G_BH + (sc * 64 + 16 * kt) * 32), *(const LAS v2u*)(l_b + G_KH + (sc * 64 + 16 * kt) * 32));
                    const f32x4 gm = *(const LAS f32x4*)(gm_b + (sc * 64 + 16 * kt) * 4);
                    S[kt] = MFMA16(abk, uvop, S[kt]) * gm;
                }
                LAS float* yc = yc_b + sc * (PW_SIZE / 4);
#pragma unroll
                for (int rg = 0; rg < 4; ++rg) yc[rg * ZS_ST] = Y[rg];
            }
        }
        __syncthreads();
#pragma unroll 1
        for (int rep_ = 0; rep_ < SREP_POST; ++rep_)
        {
            lane = lane0; asm volatile("" : "+v"(lane)); hc = hh * 64 + lane;
            const LAS float* yc = (const LAS float*)(PW + PW_TLW);
            float y_[16];
#pragma unroll
            for (int i = 0; i < 16; ++i) y_[i] = yc[i * ZS_ST + lane];
            if (first) {
#pragma unroll
                for (int i = 0; i < 16; ++i) { const int p = p0 + i, t = d ? T - 1 - p : p; YB[(size_t)(m0 + t) * D + hc] = y_[i]; }
            } else {
                const float lng = F.in[I_LNG][hc], lnb = F.in[I_LNB][hc];
                unsigned short gb_[16];
#pragma unroll
                for (int i = 0; i < 16; ++i) { const int p = p0 + i, t = d ? T - 1 - p : p; gb_[i] = *(const unsigned short*)(GBp + (size_t)(m0 + t) * D + hc); }
                float s1[16];
#pragma unroll
                for (int i = 0; i < 16; ++i) { y_[i] += yo[i]; s1[i] = y_[i]; }
                wave_sum16(s1, lane);
#pragma unroll
                for (int i = 0; i < 16; ++i) { y_[i] -= s1[i] * (1.f / 64.f); s1[i] = y_[i] * y_[i]; }
                wave_sum16(s1, lane);
#pragma unroll
                for (int i = 0; i < 16; ++i) { const int p = p0 + i, t = d ? T - 1 - p : p; const size_t m = (size_t)(m0 + t);
                    const float yn = y_[i] * __builtin_amdgcn_rsqf(s1[i] * (1.f / 64.f) + 64e-5f) * lng + lnb + v_[i];
                    MIX[m * DMIX + 1024 + hc] = (bf16)f2bf_hw(yn * bf2f((bf16)gb_[i])); }
            }
        }
    }
    if (!lat) {
        lane = lane0; asm volatile("" : "+v"(lane)); c16 = lane & 15; g = lane >> 4;
        float* sp = F.out + OUT_ST + ((size_t)((b * 2 + d) * NHB + hh) * 64 + 16 * w + c16) * 64 + 4 * g;
#pragma unroll
        for (int kt = 0; kt < 4; ++kt) *(f32x4*)(sp + 16 * kt) = S[kt];
    }
}

template <int QW, int MASK> __device__ __forceinline__ void p3_mixers(Frame& F, const XcdBarrier& gbar) {
    float lam;
    { const float a = F.in[I_LQ1][F.lane] * F.in[I_LK1][F.lane], bq = F.in[I_LQ2][F.lane] * F.in[I_LK2][F.lane];
      lam = __expf(wave_sum(a)) - __expf(wave_sum(bq)) + 0.2f; }
    constexpr int N_SC = NBC * NHB, N_AL = NBL * NH * (LSEQ / 128), N_AC = NBC * NH * (SEQ / 128);
    constexpr int NU = N_AL + N_SC + N_AC;
    volatile LAS int* slot = (volatile LAS int*)(F.lds + MISC_OFF + 64);
    bool chain_first = (int)blockIdx.x < NLATB;
    for (;;) {
        int u, sb, sh, git = -1; bool slat = false, is_scan;
        if (chain_first) { chain_first = false; is_scan = true; slat = true; sb = (int)blockIdx.x / NHB; sh = (int)blockIdx.x % NHB; git = LAT_BAR_IT; u = 0; }
        else {
            __syncthreads();
            if (F.tid == 0) *slot = (int)__hip_atomic_fetch_add((unsigned*)(F.ctl + CW_Q3 + 64 * QW), 1u, RLX_AGENT);
            __syncthreads();
            u = *slot;
            if (u >= NU) break;
            is_scan = u < N_SC;
            sb = u / NHB; sh = u % NHB;
        }
        if (is_scan) { scan_unit3(F, sb, sh, slat, &gbar, git); continue; }
        { u -= N_SC; const bool lt = u < N_AL; if (!lt) u -= N_AL; attn_unit(F, u, lt, lam); }
    }
}

template <bool DUMMY> __device__ __forceinline__ void p5_final(Frame& F) {
    int ln = F.lane; asm volatile("" : "+v"(ln));
    const float* ssq = (const float*)(F.ws + WS_SSQ);
    const int gw = blockIdx.x * NWAVES + F.wave, NGW = F.G * NWAVES;
    for (int m = gw; m < M; m += NGW) {
        float s = ln < 16 ? ssq[(size_t)m * 16 + ln] : 0.f;
        s = wave_sum(s);
        const float rstd = 1.f / sqrtf(s * (1.f / D) + 1e-6f);
        float* yr = F.out + OUT_Y + (size_t)m * D;
#pragma unroll
        for (int j = 0; j < 4; ++j) { const int c = 4 * ln + 256 * j; const f32x4 v = *(const f32x4*)(yr + c), g = *(const f32x4*)(F.in[I_FG] + c); *(f32x4*)(yr + c) = DUMMY ? v : v * rstd * g; }
    }
}

__global__ void __launch_bounds__(NTHR, 2) hymba_fwd(Args args) {
    extern __shared__ __attribute__((aligned(16))) unsigned char lds[];
    Frame F;
    F.lds = (LAS unsigned char*)lds;
    F.MISC = (volatile LAS unsigned*)(F.lds + MISC_OFF);
    F.tid = threadIdx.x; F.lane = F.tid & 63; F.wave = __builtin_amdgcn_readfirstlane(F.tid >> 6);
    F.G = gridDim.x; F.in = args.in; F.out = args.out; F.ws = args.ws;
    F.ctl = (gu32*)(args.ws + WS_CTL);
    for (int u = F.tid; u < (LDS_BYTES - LDSCTL_OFF) / 4; u += NTHR) ((LAS unsigned*)(F.lds + LDSCTL_OFF))[u] = 0u;
    __syncthreads();
    XcdBarrier bar; bar.bar = (unsigned*)(F.ctl + CW_BAR); bar.x = 0; bar.st = nullptr;
    if (N_LAUNCHES != PER_PHASE) bar = xcd_barrier_post((unsigned*)(F.ctl + CW_BAR), F.MISC + 8);
#define GRID_BAR() do { if (N_LAUNCHES != PER_PHASE) xcd_barrier(bar); } while (0)
    const int lo = args.ph_lo, hi = args.ph_hi;
#define IN(k) (lo <= (k) && (k) < hi)
#define BOTH(k) (IN(k) && IN((k) + 1))
#ifndef REP0
#define REP0 1
#endif
#ifndef REP2
#define REP2 1
#endif
#ifndef REP3MASK
#define REP3MASK 0
#endif
#ifndef REP4
#define REP4 1
#endif
#define RELANE() do { int t_ = threadIdx.x; asm volatile("" : "+v"(t_)); F.tid = t_; F.lane = t_ & 63; } while (0)
    {
        f32x4 xv[5][4];
        p0_prologue(F); RELANE(); p1_load<0, 3>(F, xv); GRID_BAR();
        p1_load<3, 5>(F, xv); p1_norm(F, xv); GRID_BAR();
    }
    RELANE();
    if (IN(2)) {
        const pg8::Gemm g{(const bf16*)(F.ws + WS_XN), (const bf16*)(F.ws + WS_WIN), M, DIN, D};
        {
            const f32x4 rv = *(const f32x4*)((const float*)(F.ws + WS_ROPE) + 4 * F.tid);
            *(LAS f32x4*)(F.lds + ROPE_LDS + 16 * F.tid) = rv;
            __syncthreads();
        }
        const EpiIn E{F.ws, F.out, (const LAS float*)(F.lds + ROPE_LDS)};
        const bool chain = (int)blockIdx.x < NLATB;
#pragma unroll 1
        for (int part = 0; part < 2; ++part) {
            if (part == 1 && chain) break;
            ListOrder S;
            if (part == 0) S.init(F.G, (int)blockIdx.x, 0, P2A_UNITS); else S.init(F.G - NLATB, (int)blockIdx.x - NLATB, P2A_UNITS, P2_UNITS);
            pg8::gemm_phase<EpiIn, ListOrder, true, true>(F.lds + RING_OFF, g, S, E);
            GRID_BAR();
        }
    }
    RELANE();
    if (IN(3)) { p3_mixers<0, 15>(F, bar); if (BOTH(3)) GRID_BAR(); }
    RELANE();
    if (IN(4)) {
        pg8::Gemm g{(const bf16*)(F.ws + WS_MIX), (const bf16*)(F.ws + WS_WOUT), M, D, DMIX}; pg8::StaticOrder S; S.init(M, D, F.G, (int)blockIdx.x);
        EpiOutFused E{F.ws, F.out, F.in[I_XP], F.in[I_XS], F.in[I_FG], F.ctl};
        pg8::gemm_phase<EpiOutFused, pg8::StaticOrder, false, true>(F.lds + RING_OFF, g, S, E);
    }
#undef IN
#undef BOTH
}

extern "C" void kernel_launch(void* const* d_in, const int* in_sizes, int n_in, void* d_out, int out_size, void* d_ws, size_t ws_size, hipStream_t stream) {
    static int grid = 0;
    if (grid == 0) {
        if (n_in != N_IN || out_size != OUT_END || ws_size < WS_END) { fprintf(stderr, "kernel_launch: unexpected sizes n_in %d out %d ws %zu\n", n_in, out_size, ws_size); grid = -1; return; }
        int dev = 0, cus = 0, per_cu = 0;
        if (hipGetDevice(&dev) != hipSuccess || hipDeviceGetAttribute(&cus, hipDeviceAttributeMultiprocessorCount, dev) != hipSuccess) { grid = -1; return; }
        if (hipFuncSetAttribute((const void*)hymba_fwd, hipFuncAttributeMaxDynamicSharedMemorySize, LDS_BYTES) != hipSuccess) { fprintf(stderr, "kernel_launch: hipFuncSetAttribute failed\n"); grid = -1; return; }
        if (hipOccupancyMaxActiveBlocksPerMultiprocessor(&per_cu, (const void*)hymba_fwd, NTHR, LDS_BYTES) != hipSuccess || per_cu < 1) { fprintf(stderr, "kernel_launch: occupancy query says %d\n", per_cu); per_cu = 1; }
        (void)hipGetLastError();
        grid = cus;
        if (grid != 256) { fprintf(stderr, "kernel_launch: built for a 256-CU device (got %d CUs)\n", cus); grid = -1; return; }
    }
    if (grid < 0) return;
    if (hipMemsetAsync((char*)d_ws + WS_CTL, 0, CTL_ZERO_BYTES, stream) != hipSuccess) return;
    Args a{};
    for (int i = 0; i < N_IN; ++i) a.in[i] = (const float*)d_in[i];
    a.out = (float*)d_out; a.ws = (unsigned char*)d_ws;
    a.ph_lo = 0; a.ph_hi = PER_PHASE; a.li = 0;
    hipLaunchKernelGGL(hymba_fwd, dim3(grid), dim3(NTHR), LDS_BYTES, stream, a);
}
```

```cpp
#include <hip/hip_runtime.h>
#include <cstdio>
#include <cstdint>

#ifndef MK_N_LAUNCHES
#define MK_N_LAUNCHES 1
#endif

namespace pg8 {
#define PG8_LAS __attribute__((address_space(3)))
typedef unsigned short bf16_t;
typedef short bf16x8 __attribute__((ext_vector_type(8)));
typedef float f32x4 __attribute__((ext_vector_type(4)));
typedef unsigned u32x4 __attribute__((ext_vector_type(4)));
constexpr int BM = 256, BK = 64, HALF = 128, HTB = HALF * BK * 2, STAGE_BYTES = 8 * HTB, NXCD = 8, WGM = 8;

__host__ __device__ __forceinline__ int lds_byte(int r, int c) { const int st = (r >> 4) * 2 + (c >> 5), rr = r & 15, cc = c & 31, ob = rr * 64 + cc * 2; return st * 1024 + (ob ^ (((ob >> 9) & 1) << 5)); }
__host__ __device__ __forceinline__ void stage_rc(int b, int& R, int& C) { const int st = b / 1024, sb = b % 1024, swz = sb ^ (((sb >> 9) & 1) << 5); R = (st >> 1) * 16 + swz / 64; C = (st & 1) * 32 + (swz % 64) / 2; }
__host__ __device__ __forceinline__ int perm32(int rho) { const int n = rho >> 4, i = rho & 15; return 8 * (i >> 2) + 4 * n + (i & 3); }

struct Unit { int pm, pn; };
struct Gemm { const bf16_t* A; const bf16_t* Bt; int M, N, K; };

struct StaticOrder {
    int nM, nN, nwg, G, c;
    __host__ __device__ void init(int M, int N, int G_, int c_) { nM = M / BM; nN = N / BM; nwg = nM * nN; G = G_; c = c_; }
    __host__ __device__ bool next(int i, Unit& u) const {
        const long L = (long)i * G + c; if (L >= nwg) return false;
        int wgid = (int)L; { const int q = nwg / NXCD, r = nwg % NXCD, xcd = wgid % NXCD, off = wgid / NXCD; wgid = (xcd < r ? xcd * (q + 1) : r * (q + 1) + (xcd - r) * q) + off; }
        const int nig = WGM * nN, gid = wgid / nig, fm = gid * WGM, gsz = (nM - fm) < WGM ? (nM - fm) : WGM;
        u.pm = fm + ((wgid % nig) % gsz); u.pn = (wgid % nig) / gsz; return true;
    }
    __device__ __forceinline__ void a_ready(const Unit&) const {}
    __device__ __forceinline__ void done(const Unit&) const {}
};

__device__ __forceinline__ unsigned cvt_pk_bf16(float lo, float hi) { unsigned r; asm volatile("v_cvt_pk_bf16_f32 %0, %1, %2" : "=v"(r) : "v"(lo), "v"(hi)); return r; }

template <class Epi, class Sched, bool ALIGN_EPI = false, bool SP2 = false>
__device__ __forceinline__ void gemm_phase(PG8_LAS unsigned char* lds, const Gemm g, const Sched& S, const Epi& E) {
    int tid = threadIdx.x; asm volatile("" : "+v"(tid));
    const int wid = __builtin_amdgcn_readfirstlane(tid >> 6), lane = tid & 63, wr = wid >> 2, wc = wid & 3, fr = lane & 15, fq = lane >> 4;
    const int K = g.K, nt = K / BK;
    unsigned voffA[2], voffB[2];
#pragma unroll
    for (int i = 0; i < 2; ++i) { int R, C; stage_rc(tid * 16 + i * 8192, R, C); const int Rb = Epi::PERM ? ((R & ~31) + perm32(R & 31)) : R;
        voffA[i] = (unsigned)(R * K + C) * 2u; voffB[i] = (unsigned)(Rb * K + C) * 2u; }
    const size_t kstep = (size_t)(BK * 2);
    const size_t hstep = (size_t)HALF * K * 2;
    const size_t tstep = 2 * hstep;
    const unsigned ldsw = (unsigned)wid * 1024u;
    const int aoff = lds_byte(wr * 64 + fr, fq * 8), boff = lds_byte(wc * 32 + fr, fq * 8);
#define PG8_SA(b, h) (((b) * 2 + (h)) * HTB)
#define PG8_SB(b, h) ((4 + (b) * 2 + (h)) * HTB)
#define PG8_STAGE(bufoff, gbase, voff) do { _Pragma("unroll") for (int _i = 0; _i < 2; ++_i) \
        __builtin_amdgcn_global_load_lds((const unsigned*)((const char*)(gbase) + (voff)[_i]), (PG8_LAS unsigned*)(lds + (bufoff) + ldsw + _i * 8192), 16, 0, 0); } while (0)
#define PG8_LDA(dst, b, h) do { _Pragma("unroll") for (int m = 0; m < 4; ++m) _Pragma("unroll") for (int k = 0; k < 2; ++k) dst[m][k] = *(const PG8_LAS bf16x8*)(lds + PG8_SA(b, h) + aoff + m * 2048 + k * 1024); } while (0)
#define PG8_LDB(dst, b, h) do { _Pragma("unroll") for (int n = 0; n < 2; ++n) _Pragma("unroll") for (int k = 0; k < 2; ++k) dst[n][k] = *(const PG8_LAS bf16x8*)(lds + PG8_SB(b, h) + boff + n * 2048 + k * 1024); } while (0)
#define PG8_MMA(ai, bj, At, Bt) do { __builtin_amdgcn_s_setprio(1); _Pragma("unroll") for (int m = 0; m < 4; ++m) _Pragma("unroll") for (int n = 0; n < 2; ++n) _Pragma("unroll") for (int k = 0; k < 2; ++k) \
        acc[ai][bj][m][n] = __builtin_amdgcn_mfma_f32_16x16x32_bf16(Bt[n][k], At[m][k], acc[ai][bj][m][n], 0, 0, 0); __builtin_amdgcn_s_setprio(0); } while (0)
#define PG8_WAIT_V(n) asm volatile("s_waitcnt vmcnt(" #n ")" ::: "memory")
#define PG8_WAIT_L(n) asm volatile("s_waitcnt lgkmcnt(" #n ")" ::: "memory")
#define PG8_BAR __builtin_amdgcn_s_barrier()
#define PG8_SCHED __builtin_amdgcn_sched_barrier(0)
    Unit cur, nxt; int ui = 0;
    if (!S.next(0, cur)) return;
    f32x4 acc[2][2][4][2];
#pragma unroll
    for (int a = 0; a < 2; ++a)
#pragma unroll
        for (int b = 0; b < 2; ++b)
#pragma unroll
            for (int m = 0; m < 4; ++m)
#pragma unroll
                for (int n = 0; n < 2; ++n) acc[a][b][m][n] = (f32x4){0.f, 0.f, 0.f, 0.f};
    bf16x8 At[4][2], B0[2][2], B1[2][2];
    const char* cA = (const char*)g.A + (size_t)cur.pm * tstep; const char* cB = (const char*)g.Bt + (size_t)cur.pn * tstep;
    S.a_ready(cur);
    if constexpr (SP2) {
        PG8_STAGE(PG8_SB(0, 0), cB, voffB); PG8_STAGE(PG8_SB(0, 1), cB + hstep, voffB); PG8_STAGE(PG8_SA(0, 0), cA, voffA); PG8_STAGE(PG8_SA(0, 1), cA + hstep, voffA);
        if (wr == 1) PG8_BAR;
        PG8_WAIT_V(2); PG8_BAR;
        PG8_STAGE(PG8_SB(1, 0), cB + kstep, voffB); PG8_STAGE(PG8_SA(1, 0), cA + kstep, voffA); PG8_STAGE(PG8_SB(1, 1), cB + hstep + kstep, voffB);
        PG8_WAIT_V(6); PG8_BAR;
    } else {
        PG8_STAGE(PG8_SB(0, 0), cB, voffB); PG8_STAGE(PG8_SA(0, 0), cA, voffA); PG8_STAGE(PG8_SB(0, 1), cB + hstep, voffB); PG8_STAGE(PG8_SA(0, 1), cA + hstep, voffA);
        if (wr == 1) PG8_BAR;
        PG8_WAIT_V(4); PG8_BAR;
        PG8_STAGE(PG8_SB(1, 0), cB + kstep, voffB); PG8_STAGE(PG8_SA(1, 0), cA + kstep, voffA); PG8_STAGE(PG8_SB(1, 1), cB + hstep + kstep, voffB);
        PG8_WAIT_V(6); PG8_BAR;
    }
    for (;;) {
        const bool has_next = S.next(ui + 1, nxt);
        const char* nA = has_next ? (const char*)g.A + (size_t)nxt.pm * tstep : cA; const char* nB = has_next ? (const char*)g.Bt + (size_t)nxt.pn * tstep : cB;
        for (int t = 0; t < nt; t += 2) {
            const bool last = (t == nt - 2);
            const char* a1 = cA + (size_t)(t + 1) * kstep;
            const char* a2 = last ? nA : cA + (size_t)(t + 2) * kstep; const char* b2 = last ? nB : cB + (size_t)(t + 2) * kstep;
            const char* a3 = a2 + kstep; const char* b3 = b2 + kstep;
            if (last && has_next) S.a_ready(nxt);
            if constexpr (SP2) {
            PG8_LDB(B0, 0, 0); PG8_LDB(B1, 0, 1); PG8_SCHED; PG8_LDA(At, 0, 0); PG8_STAGE(PG8_SA(1, 1), a1 + hstep, voffA);
            PG8_WAIT_V(8); PG8_WAIT_L(0); PG8_BAR; PG8_MMA(0, 0, At, B0); PG8_MMA(0, 1, At, B1); PG8_BAR; PG8_SCHED;
            PG8_LDA(At, 0, 1); PG8_STAGE(PG8_SB(0, 0), b2, voffB); PG8_STAGE(PG8_SB(0, 1), b2 + hstep, voffB); PG8_STAGE(PG8_SA(0, 0), a2, voffA);
            PG8_WAIT_V(8); PG8_WAIT_L(0); PG8_BAR; PG8_MMA(1, 0, At, B0); PG8_MMA(1, 1, At, B1); PG8_BAR; PG8_SCHED;
            PG8_LDB(B0, 1, 0); PG8_LDB(B1, 1, 1); PG8_SCHED; PG8_LDA(At, 1, 0); PG8_STAGE(PG8_SA(0, 1), a2 + hstep, voffA);
            PG8_WAIT_V(8); PG8_WAIT_L(0); PG8_BAR; PG8_MMA(0, 0, At, B0); PG8_MMA(0, 1, At, B1); PG8_BAR; PG8_SCHED;
            PG8_LDA(At, 1, 1); PG8_STAGE(PG8_SB(1, 0), b3, voffB); PG8_STAGE(PG8_SB(1, 1), b3 + hstep, voffB); PG8_STAGE(PG8_SA(1, 0), a3, voffA);
            PG8_WAIT_V(8); PG8_WAIT_L(0); PG8_BAR; PG8_MMA(1, 0, At, B0); PG8_MMA(1, 1, At, B1); PG8_BAR; PG8_SCHED;
            } else {
            PG8_LDB(B0, 0, 0); PG8_SCHED; PG8_LDA(At, 0, 0); PG8_STAGE(PG8_SA(1, 1), a1 + hstep, voffA);
            PG8_WAIT_L(8); PG8_BAR; PG8_WAIT_L(0); PG8_MMA(0, 0, At, B0); PG8_BAR; PG8_SCHED;
            PG8_LDB(B1, 0, 1); PG8_STAGE(PG8_SB(0, 0), b2, voffB);
            PG8_BAR; PG8_WAIT_L(0); PG8_MMA(0, 1, At, B1); PG8_BAR;
            PG8_LDA(At, 0, 1); PG8_STAGE(PG8_SA(0, 0), a2, voffA);
            PG8_BAR; PG8_WAIT_L(0); PG8_MMA(1, 0, At, B0); PG8_BAR; PG8_SCHED;
            PG8_STAGE(PG8_SB(0, 1), b2 + hstep, voffB);
            PG8_WAIT_V(6); PG8_BAR; PG8_MMA(1, 1, At, B1); PG8_BAR;
            PG8_LDB(B0, 1, 0); PG8_SCHED; PG8_LDA(At, 1, 0); PG8_STAGE(PG8_SA(0, 1), a2 + hstep, voffA);
            PG8_WAIT_L(8); PG8_BAR; PG8_WAIT_L(0); PG8_MMA(0, 0, At, B0); PG8_BAR; PG8_SCHED;
            PG8_LDB(B1, 1, 1); PG8_STAGE(PG8_SB(1, 0), b3, voffB);
            PG8_BAR; PG8_WAIT_L(0); PG8_MMA(0, 1, At, B1); PG8_BAR;
            PG8_LDA(At, 1, 1); PG8_STAGE(PG8_SA(1, 0), a3, voffA);
            PG8_BAR; PG8_WAIT_L(0); PG8_MMA(1, 0, At, B0); PG8_BAR; PG8_SCHED;
            PG8_STAGE(PG8_SB(1, 1), b3 + hstep, voffB);
            PG8_WAIT_V(6); PG8_BAR; PG8_MMA(1, 1, At, B1); PG8_BAR;
            }
        }
        if constexpr (ALIGN_EPI) { if (wr == 0) PG8_BAR; }
        if constexpr (!Epi::AFTER_DRAIN) { E(acc, cur, wr, wc, fr, fq); S.done(cur); }
        if (!has_next) break;
#pragma unroll
        for (int a = 0; a < 2; ++a)
#pragma unroll
            for (int b = 0; b < 2; ++b)
#pragma unroll
                for (int m = 0; m < 4; ++m)
#pragma unroll
                    for (int n = 0; n < 2; ++n) acc[a][b][m][n] = (f32x4){0.f, 0.f, 0.f, 0.f};
        cur = nxt; cA = nA; cB = nB; ++ui;
        if constexpr (ALIGN_EPI) { if (wr == 1) PG8_BAR; }
    }
    PG8_WAIT_V(0);
    if constexpr (!ALIGN_EPI) { if (wr == 0) PG8_BAR; }
    PG8_BAR;
    if constexpr (Epi::AFTER_DRAIN) { E.fused(acc, cur, wr, wc, fr, fq, lds, wid, lane); S.done(cur); }
#undef PG8_SA
#undef PG8_SB
#undef PG8_STAGE
#undef PG8_LDA
#undef PG8_LDB
#undef PG8_MMA
#undef PG8_WAIT_V
#undef PG8_WAIT_L
#undef PG8_BAR
#undef PG8_SCHED
}
}

constexpr int NWAVES = 8, NTHR = 512;
constexpr int N_LAUNCHES = MK_N_LAUNCHES;
constexpr int PER_PHASE = 6;
constexpr int D = 1024, NBC = 32, SEQ = 256, NBL = 2, LSEQ = 1024, PAST = 512, KLAT = PAST + LSEQ;
constexpr int MC = NBC * SEQ, ML = NBL * LSEQ, M = MC + ML;
constexpr int DIN = 8448, DMIX = 2048, DSH = 3328, NH = 8, NHB = 16;
constexpr int OUT_Y = 0, OUT_CK = M * D, OUT_CV = OUT_CK + MC * D, OUT_ST = OUT_CV + MC * D, OUT_END = OUT_ST + NBC * 2 * NHB * 64 * 64;

enum { I_XP = 0, I_XS, I_CK, I_CV, I_ST, I_C, I_CCTX, I_NG, I_WADA, I_BADA, I_WIN, I_LQ1, I_LK1, I_LQ2, I_LK2, I_SUBG, I_MU, I_W0, I_W2, I_A0, I_A2, I_KK, I_KA, I_RK, I_LNG, I_LNB, I_WOUT, I_FG, N_IN };

constexpr size_t MiB = 1u << 20;
constexpr size_t WS_CTL = 0, CTL_ZERO_BYTES = 1 * MiB;
constexpr size_t WS_MODP = 1 * MiB;
constexpr size_t WS_MODF = WS_MODP + 640 * 1024;
constexpr size_t WS_ROPE = WS_MODF + 64 * 1024;
constexpr size_t WS_SSQ = 2 * MiB;
constexpr size_t WS_WOP = 3 * MiB;
constexpr size_t WS_WIN = 4 * MiB;
constexpr size_t WS_WOUT = 21 * MiB;
constexpr size_t WS_XN = 25 * MiB;
constexpr size_t WS_Q = 45 * MiB;
constexpr size_t WS_KC = 65 * MiB;
constexpr size_t WS_KL = 81 * MiB;
constexpr size_t WS_VTC = 87 * MiB;
constexpr size_t WS_VTL = 103 * MiB;
constexpr size_t WS_GA = 109 * MiB;
constexpr size_t WS_GB = 129 * MiB;
constexpr size_t WS_UB = 149 * MiB;
constexpr size_t WS_MIX = 214 * MiB;
constexpr size_t WS_END = 254 * MiB;
constexpr int CW_BAR = 4096;
constexpr int CW_Q3 = 64;

constexpr int RING_OFF = 0, RING_BYTES = 131072, ROPE_LDS = RING_OFF + RING_BYTES;
constexpr int LDS_BYTES = 163840;
constexpr int LDSCTL_OFF = LDS_BYTES - 1024, MISC_OFF = LDSCTL_OFF + 320;

#define GAS __attribute__((address_space(1)))
#define LAS __attribute__((address_space(3)))
typedef unsigned short bf16;
typedef unsigned v4u __attribute__((ext_vector_type(4)));
typedef unsigned v2u __attribute__((ext_vector_type(2)));
typedef float f32x4 __attribute__((ext_vector_type(4)));
typedef float f32x16 __attribute__((ext_vector_type(16)));
typedef short bf16x8 __attribute__((ext_vector_type(8)));
typedef GAS unsigned gu32;
#define RLX_AGENT __ATOMIC_RELAXED, __HIP_MEMORY_SCOPE_AGENT
#define LDS_WAIT() asm volatile("s_waitcnt lgkmcnt(0)" ::: "memory")
#define VM_WAIT() asm volatile("s_waitcnt vmcnt(0)" ::: "memory")
__device__ __forceinline__ unsigned f2bf(float f) { unsigned u = __builtin_bit_cast(unsigned, f); return (u + 0x7fffu + ((u >> 16) & 1u)) >> 16; }
typedef float f32x2_t __attribute__((ext_vector_type(2)));
typedef __bf16 bf16x2_t __attribute__((ext_vector_type(2)));
__device__ __forceinline__ unsigned pk2(float lo, float hi) { const f32x2_t f = {lo, hi}; return __builtin_bit_cast(unsigned, __builtin_convertvector(f, bf16x2_t)); }
__device__ __forceinline__ unsigned f2bf_hw(float f) { return pk2(f, f); }
__device__ __forceinline__ float bf2f(unsigned b) { return __builtin_bit_cast(float, b << 16); }
__device__ __forceinline__ float bflo(unsigned w) { return __builtin_bit_cast(float, w << 16); }
__device__ __forceinline__ float bfhi(unsigned w) { return __builtin_bit_cast(float, w & 0xffff0000u); }
__device__ __forceinline__ float sigmoidf_(float x) { return __builtin_amdgcn_rcpf(1.f + __expf(-x)); }
__device__ __forceinline__ float siluf_(float x) { return x * __builtin_amdgcn_rcpf(1.f + __expf(-x)); }

#define XB_TMO      128
#define XB_XCNT(j)  (256  + 64 * (j))
#define XB_XSUB(j)  (1280 + 64 * (j))
#define XB_XGEN(j)  (2304 + 64 * (j))
#define XB_TOP      3328
#define XB_TOPGEN   3392
#define XCD_BAR_WORDS 3456
#define XB_SPIN_CAP (1u << 18)
__device__ __forceinline__ unsigned xb_ld(unsigned* p)              { return __hip_atomic_load(p, __ATOMIC_RELAXED, __HIP_MEMORY_SCOPE_AGENT); }
__device__ __forceinline__ unsigned xb_add(unsigned* p, unsigned v) { return __hip_atomic_fetch_add(p, v, __ATOMIC_RELAXED, __HIP_MEMORY_SCOPE_AGENT); }
__device__ __forceinline__ unsigned xb_xcc_id() { return (unsigned)__builtin_amdgcn_s_getreg((3 << 11) | 20) & 0xFu; }
#define XB_SPIN(cond, bar) do { unsigned _sp = 0; while (cond) { __builtin_amdgcn_s_sleep(1); \
    if ((++_sp & 255u) == 0u) { if (xb_ld(&(bar)[XB_TMO])) break; if (_sp > XB_SPIN_CAP) { atomicAdd(&(bar)[XB_TMO], 1u); break; } } } } while (0)
struct XcdBarrier { unsigned* bar; unsigned x; volatile LAS unsigned* st; };
__device__ __forceinline__ XcdBarrier xcd_barrier_post(unsigned* bar, volatile LAS unsigned* st) {
    XcdBarrier b; b.bar = bar; b.x = xb_xcc_id(); b.st = st;
    if (threadIdx.x == 0) (void)xb_add(&bar[XB_XCNT(b.x)], 1u);
    return b;
}
__device__ __forceinline__ void xcd_barrier_complete(unsigned* bar, unsigned x, unsigned& nloc, unsigned& nx) {
    const unsigned G = gridDim.x * gridDim.y * gridDim.z;
    unsigned sum, cnt, mine, sp = 0u;
    for (;;) {
        sum = 0u; cnt = 0u; mine = 0u;
#pragma unroll
        for (unsigned j = 0; j < 16; ++j) { const unsigned c = xb_ld(&bar[XB_XCNT(j)]); sum += c; cnt += (c > 0u) ? 1u : 0u; mine = (j == x) ? c : mine; }
        if (sum == G) break;
        __builtin_amdgcn_s_sleep(1);
        if ((++sp & 255u) == 0u) { if (xb_ld(&bar[XB_TMO])) break; if (sp > XB_SPIN_CAP) { atomicAdd(&bar[XB_TMO], 1u); break; } }
    }
    nloc = mine > 0u ? mine : 1u; nx = cnt > 0u ? cnt : 1u;
}
__device__ __forceinline__ void xcd_barrier(const XcdBarrier& b) {
    asm volatile("s_waitcnt vmcnt(0)" ::: "memory");
    __syncthreads();
    if (threadIdx.x == 0) {
        unsigned* bar = b.bar;
        __builtin_amdgcn_s_waitcnt(0);
        unsigned nloc = b.st[0], nx = b.st[1];
        if (nloc == 0u) { xcd_barrier_complete(bar, b.x, nloc, nx); b.st[0] = nloc; b.st[1] = nx; }
        const unsigned old = xb_add(&bar[XB_XSUB(b.x)], 1u);
        const unsigned gen = old / nloc;
        if (old + 1u == (gen + 1u) * nloc) {
            __builtin_amdgcn_fence(__ATOMIC_RELEASE, "agent");
            asm volatile("s_waitcnt vmcnt(0)" ::: "memory");
            const unsigned og = xb_add(&bar[XB_TOP], 1u);
            const unsigned tg = og / nx;
            if (og + 1u == (tg + 1u) * nx) xb_add(&bar[XB_TOPGEN], 1u);
            else XB_SPIN(xb_ld(&bar[XB_TOPGEN]) == tg, bar);
            __builtin_amdgcn_fence(__ATOMIC_ACQUIRE, "agent");
            xb_add(&bar[XB_XGEN(b.x)], 1u);
            asm volatile("s_waitcnt vmcnt(0)" ::: "memory");
        } else {
            XB_SPIN(xb_ld(&bar[XB_XGEN(b.x)]) == gen, bar);
            __builtin_amdgcn_fence(__ATOMIC_ACQUIRE, "agent");
            asm volatile("s_waitcnt vmcnt(0)" ::: "memory");
        }
    }
    __syncthreads();
}

struct Args { const float* in[N_IN]; float* out; unsigned char* ws; int ph_lo, ph_hi, li, pad; };
struct Frame {
    LAS unsigned char* lds;
    volatile LAS unsigned* MISC;
    gu32* ctl;
    int tid, lane, wave, G;
    const float* const* in;
    float* out; unsigned char* ws;
};
__device__ __forceinline__ float wave_sum(float v) {
#pragma unroll
    for (int o = 1; o < 64; o <<= 1) v += __shfl_xor(v, o);
    return v;
}
__device__ __forceinline__ const float* xrow_ptr(const Frame& F, int m) { return m < MC ? F.in[I_XP] + (size_t)m * D : F.in[I_XS] + (size_t)(m - MC) * D; }

__device__ __forceinline__ void p0_transpose_item(const float* W, int K, int N, bf16* WT, LAS float* scr, int item, int lane) {
    const int nblk = N / 32, kb = item / nblk, nb = item % nblk, k0 = 64 * kb, n0 = 32 * nb;
#pragma unroll 4
    for (int i = 0; i < 32; ++i) { const int kk = 2 * i + (lane >> 5); scr[kk * 33 + (lane & 31)] = W[(size_t)(k0 + kk) * N + n0 + (lane & 31)]; }
    LDS_WAIT(); asm volatile("" ::: "memory");
    const int c = lane & 7;
#pragma unroll
    for (int j = 0; j < 4; ++j) { const int n = (lane >> 3) + 8 * j; const LAS float* s = scr + (8 * c) * 33 + n;
        v4u o; o.x = pk2(s[0 * 33], s[1 * 33]); o.y = pk2(s[2 * 33], s[3 * 33]); o.z = pk2(s[4 * 33], s[5 * 33]); o.w = pk2(s[6 * 33], s[7 * 33]);
        *(GAS v4u*)(WT + (size_t)(n0 + n) * K + k0 + 8 * c) = o; }
    LDS_WAIT(); asm volatile("" ::: "memory");
}
__device__ __forceinline__ void p0_prologue(Frame& F) {
    LAS float* scr = (LAS float*)(F.lds + RING_OFF + F.wave * 16384);
    const int gw = blockIdx.x * NWAVES + F.wave, NGW = F.G * NWAVES;
    bf16* WinT = (bf16*)(F.ws + WS_WIN); bf16* WoutT = (bf16*)(F.ws + WS_WOUT);
    constexpr int I_IN = (D / 64) * (DIN / 32), I_OUT = (DMIX / 64) * (D / 32), I_MOD = 16 * 12, I_CV_ = NBL * NH * (PAST / 64);
    {
        const int e = ((int)blockIdx.x - (F.G - 2)) * NTHR + F.tid;
        if (e >= 0 && e < 1024) { float* rp = (float*)(F.ws + WS_ROPE); const int pos = e >> 4, i = e & 15; const double inv = pow(10000.0, -(double)i / 16.0), ang = (double)pos * inv; rp[e] = (float)cos(ang); rp[1024 + e] = (float)sin(ang); }
    }
    {
        const int r = NGW - 1 - gw;
        if (r < I_MOD) {
            const int kc = r / 12, nb = r % 12, n0 = nb * 256 + 4 * F.lane;
            const float* wa = F.in[I_WADA] + (size_t)(kc * 64) * 3072 + n0;
            f32x4 a0 = {0.f, 0.f, 0.f, 0.f}, a1 = a0, a2 = a0;
#pragma unroll 16
            for (int k = 0; k < 64; ++k) {
                const f32x4 w = *(const f32x4*)(wa + (size_t)k * 3072);
                const float s0 = siluf_(F.in[I_CCTX][kc * 64 + k]), s1 = siluf_(F.in[I_C][kc * 64 + k]), s2 = siluf_(F.in[I_C][D + kc * 64 + k]);
                a0 += w * s0; a1 += w * s1; a2 += w * s2;
            }
            float* mp = (float*)(F.ws + WS_MODP) + (size_t)kc * 3 * 3072 + n0;
            *(f32x4*)(mp) = a0; *(f32x4*)(mp + 3072) = a1; *(f32x4*)(mp + 2 * 3072) = a2;
        } else if (r < I_MOD + I_CV_) {
            const int q_ = r - I_MOD, tb = q_ % (PAST / 64), hh = (q_ / (PAST / 64)) % NH, b = q_ / (NH * (PAST / 64));
            const float* src = F.in[I_CV] + ((size_t)(b * PAST + tb * 64 + F.lane) * NH + hh) * 128;
            bf16* dst = (bf16*)(F.ws + WS_VTL) + (size_t)((b * NH + hh) * 128) * KLAT + tb * 64 + F.lane;
#pragma unroll 1
            for (int dv0 = 0; dv0 < 128; dv0 += 32) {
                f32x4 v[8];
#pragma unroll
                for (int q = 0; q < 8; ++q) v[q] = *(const f32x4*)(src + dv0 + 4 * q);
#pragma unroll
                for (int q = 0; q < 8; ++q) { const int dv = dv0 + 4 * q;
                    dst[(size_t)(dv + 0) * KLAT] = (bf16)f2bf(v[q].x); dst[(size_t)(dv + 1) * KLAT] = (bf16)f2bf(v[q].y); dst[(size_t)(dv + 2) * KLAT] = (bf16)f2bf(v[q].z); dst[(size_t)(dv + 3) * KLAT] = (bf16)f2bf(v[q].w); }
            }
        }
    }
    for (int it = gw; it < I_IN + I_OUT; it += NGW) {
        if (it < I_IN) p0_transpose_item(F.in[I_WIN], D, DIN, WinT, scr, it, F.lane);
        else p0_transpose_item(F.in[I_WOUT], DMIX, D, WoutT, scr, it - I_IN, F.lane);
    }
    for (int idx = blockIdx.x * NTHR + F.tid; idx < 2 * 16 * 2 * 4 * 2 * 64; idx += F.G * NTHR) {
        const int ln = idx & 63, ks = (idx >> 6) & 1, ct = (idx >> 7) & 3, mat = (idx >> 9) & 1, hh = (idx >> 10) & 15, dd = idx >> 14;
        const float* src = F.in[mat ? I_A2 : I_W2] + (size_t)(dd * 64 + 32 * ks + 8 * (ln >> 4)) * D + hh * 64 + 16 * ct + (ln & 15);
        v4u o; o.x = pk2(src[0], src[D]); o.y = pk2(src[2 * D], src[3 * D]); o.z = pk2(src[4 * D], src[5 * D]); o.w = pk2(src[6 * D], src[7 * D]);
        ((v4u*)(F.ws + WS_WOP))[idx] = o;
    }
    bf16* KL = (bf16*)(F.ws + WS_KL);
    for (int i = blockIdx.x * NTHR + F.tid; i < NBL * PAST * D / 8; i += F.G * NTHR) {
        const int e = i * 8, b = e / (PAST * D), rem = e % (PAST * D);
        const f32x4 v0 = *(const f32x4*)(F.in[I_CK] + e), v1 = *(const f32x4*)(F.in[I_CK] + e + 4);
        v4u o; o.x = pk2(v0.x, v0.y); o.y = pk2(v0.z, v0.w); o.z = pk2(v1.x, v1.y); o.w = pk2(v1.z, v1.w);
        *(v4u*)(KL + (size_t)b * KLAT * D + rem) = o;
    }
}

template <int I0, int I1> __device__ __forceinline__ void p1_load(Frame& F, f32x4 (&v)[5][4]) {
#pragma unroll
    for (int i = I0; i < I1; ++i) { const float* xr = xrow_ptr(F, ((int)blockIdx.x + 256 * i) * 8 + F.wave);
#pragma unroll
        for (int j = 0; j < 4; ++j) v[i][j] = *(const f32x4*)(xr + 4 * F.lane + 256 * j); }
}
__device__ __forceinline__ void p1_norm(Frame& F, f32x4 (&v)[5][4]) {
    LAS float* modL = (LAS float*)(F.lds + RING_OFF);
    const float* modp = (const float*)(F.ws + WS_MODP);
    const float* bada = F.in[I_BADA];
    int mrow[5];
#pragma unroll
    for (int i = 0; i < 5; ++i) mrow[i] = ((int)blockIdx.x + 256 * i) * 8 + F.wave;
    if (blockIdx.x < 36 && F.tid < 256) {
        const int idx = blockIdx.x * 256 + F.tid, ci = idx / 3072, n = idx % 3072;
        float pt[16];
#pragma unroll
        for (int kc = 0; kc < 16; ++kc) pt[kc] = modp[(size_t)(kc * 3 + ci) * 3072 + n];
#pragma unroll
        for (int kc = 0; kc < 16; ++kc) asm volatile("" : "+v"(pt[kc]));
        float s = bada[n];
#pragma unroll
        for (int kc = 0; kc < 16; ++kc) s += pt[kc];
        ((float*)(F.ws + WS_MODF))[idx] = s;
    }
    {
        const int cil = 1 + (int)blockIdx.x / 128;
#pragma unroll 1
        for (int e = F.tid; e < 4096; e += 2 * NTHR) {
            float pt[2][16], s[2];
#pragma unroll
            for (int h = 0; h < 2; ++h) { const int e2 = e + h * NTHR, n = e2 & 2047, ci = e2 < 2048 ? 0 : cil; s[h] = bada[n];
#pragma unroll
                for (int kc = 0; kc < 16; ++kc) pt[h][kc] = modp[(size_t)(kc * 3 + ci) * 3072 + n]; }
#pragma unroll
            for (int h = 0; h < 2; ++h)
#pragma unroll
                for (int kc = 0; kc < 16; ++kc) asm volatile("" : "+v"(pt[h][kc]));
#pragma unroll
            for (int h = 0; h < 2; ++h) {
#pragma unroll
                for (int kc = 0; kc < 16; ++kc) s[h] += pt[h][kc];
                modL[e + h * NTHR] = s[h]; }
        }
    }
    __syncthreads();
    bf16* XN = (bf16*)(F.ws + WS_XN);
    f32x4 gn[4];
#pragma unroll
    for (int j = 0; j < 4; ++j) gn[j] = *(const f32x4*)(F.in[I_NG] + 4 * F.lane + 256 * j);
#pragma unroll
    for (int i = 0; i < 5; ++i) {
        float ss = 0.f;
#pragma unroll
        for (int j = 0; j < 4; ++j) ss += (v[i][j].x * v[i][j].x + v[i][j].y * v[i][j].y) + (v[i][j].z * v[i][j].z + v[i][j].w * v[i][j].w);
        const float rstd = __builtin_amdgcn_rsqf(wave_sum(ss) * (1.f / D) + 1e-6f);
        const LAS float* ml = modL + (i == 4 ? 2048 : 0);
#pragma unroll
        for (int j = 0; j < 4; ++j) {
            const int c = 4 * F.lane + 256 * j;
            const f32x4 sh = *(const LAS f32x4*)(ml + c), sc = *(const LAS f32x4*)(ml + 1024 + c);
            const f32x4 h = (v[i][j] * rstd) * gn[j] * (sc + 1.0f) + sh;
            v2u o; o.x = pk2(h.x, h.y); o.y = pk2(h.z, h.w);
            *(v2u*)(XN + (size_t)mrow[i] * D + c) = o;
        }
    }
}

struct EpiIn {
    static constexpr bool PERM = true, AFTER_DRAIN = false;
    unsigned char* ws; float* out; const LAS float* rope;
    __device__ __forceinline__ void operator()(const f32x4 (&acc)[2][2][4][2], const pg8::Unit& u, int wr, int wc, int fr, int fq) const {
        const int pn = u.pn; const bool lat = u.pm >= MC / 256;
        constexpr float QS = 0.125f * 1.44269504088896f;
#pragma unroll
        for (int ai = 0; ai < 2; ++ai)
#pragma unroll
            for (int m = 0; m < 4; ++m) {
                const int r = u.pm * 256 + ai * 128 + wr * 64 + m * 16 + fr;
#pragma unroll
                for (int bj = 0; bj < 2; ++bj) {
                    const int c = pn * 256 + bj * 128 + wc * 32 + 8 * fq;
                    f32x4 v0 = acc[ai][bj][m][0], v1 = acc[ai][bj][m][1];
                    if (pn < 8) {
                        const bool isq = pn < 4; const int cc = isq ? c : c - 1024;
                        if (lat) {
                            const int t = (r - MC) & (LSEQ - 1), pos = (wc & 1) ? (t & 63) : (t >> 6);
                            const LAS float* cp = rope + pos * 16 + 8 * (fq & 1);
                            const f32x4 c0 = *(const LAS f32x4*)cp, c1 = *(const LAS f32x4*)(cp + 4), s0 = *(const LAS f32x4*)(cp + 1024), s1 = *(const LAS f32x4*)(cp + 1028);
                            f32x4 p0, p1;
#pragma unroll
                            for (int j = 0; j < 4; ++j) { p0[j] = __shfl_xor(v0[j], 32); p1[j] = __shfl_xor(v1[j], 32); }
                            const float sg = (fq & 2) ? 1.f : -1.f;
                            v0 = v0 * c0 + (p0 * s0) * sg; v1 = v1 * c1 + (p1 * s1) * sg;
                        }
                        if (isq) { v0 = v0 * QS; v1 = v1 * QS; }
                        else if (!lat) { float* o = out + OUT_CK + (size_t)r * D + cc; *(f32x4*)o = v0; *(f32x4*)(o + 4) = v1; }
                        v4u w; w.x = pk2(v0[0], v0[1]); w.y = pk2(v0[2], v0[3]); w.z = pk2(v1[0], v1[1]); w.w = pk2(v1[2], v1[3]);
                        bf16* dst;
                        if (isq) dst = (bf16*)(ws + WS_Q) + (size_t)r * D + cc;
                        else if (!lat) dst = (bf16*)(ws + WS_KC) + (size_t)r * D + cc;
                        else { const int b = (r - MC) >> 10, t = (r - MC) & (LSEQ - 1); dst = (bf16*)(ws + WS_KL) + ((size_t)b * KLAT + PAST + t) * D + cc; }
                        *(v4u*)dst = w;
                    } else if (pn < 12) {
                        const int cc = c - 2048, hh = cc >> 7, dv = cc & 127;
                        bf16* dst;
                        if (!lat) { float* o = out + OUT_CV + (size_t)r * D + cc; *(f32x4*)o = v0; *(f32x4*)(o + 4) = v1;
                            const int b = r >> 8, t = r & 255; dst = (bf16*)(ws + WS_VTC) + (size_t)((b * NH + hh) * 128 + dv) * SEQ + t;
#pragma unroll
                            for (int j = 0; j < 4; ++j) { dst[(size_t)j * SEQ] = (bf16)f2bf(v0[j]); dst[(size_t)(4 + j) * SEQ] = (bf16)f2bf(v1[j]); }
                        } else { const int b = (r - MC) >> 10, t = (r - MC) & (LSEQ - 1); dst = (bf16*)(ws + WS_VTL) + (size_t)((b * NH + hh) * 128 + dv) * KLAT + PAST + t;
#pragma unroll
                            for (int j = 0; j < 4; ++j) { dst[(size_t)j * KLAT] = (bf16)f2bf(v0[j]); dst[(size_t)(4 + j) * KLAT] = (bf16)f2bf(v1[j]); }
                        }
                    } else if (pn < 16 || pn >= 29) {
                        bf16* dst = pn < 16 ? (bf16*)(ws + WS_GA) + (size_t)r * D + (c - 3072) : (bf16*)(ws + WS_GB) + (size_t)r * D + (c - 7424);
                        v4u w; w.x = pk2(siluf_(v0[0]), siluf_(v0[1])); w.y = pk2(siluf_(v0[2]), siluf_(v0[3])); w.z = pk2(siluf_(v1[0]), siluf_(v1[1])); w.w = pk2(siluf_(v1[2]), siluf_(v1[3]));
                        *(v4u*)dst = w;
                    } else {
                        v4u w; w.x = pk2(v0[0], v0[1]); w.y = pk2(v0[2], v0[3]); w.z = pk2(v1[0], v1[1]); w.w = pk2(v1[2], v1[3]);
                        *(v4u*)((bf16*)(ws + WS_UB) + (size_t)r * DSH + (c - 4096)) = w;
                    }
                }
            }
    }
};

constexpr int NLATB = 32;
constexpr int LAT_UNITS = (ML / 256) * (DIN / 256);
constexpr int P2A_UNITS = 512, P2_UNITS = (M / 256) * (DIN / 256);
constexpr int LAT_BAR_IT = 6;
struct ListOrder {
    int G, v, lo, hi;
    __device__ void init(int G_, int c_, int lo_, int hi_) { G = G_; v = (G_ % 8 == 0) ? (c_ % 8) * (G_ / 8) + c_ / 8 : c_; lo = lo_; hi = hi_; }
    __device__ bool next(int i, pg8::Unit& u) const {
        int L = lo + i * G + v; if (L >= hi) return false;
        if (L < LAT_UNITS) { u.pn = L >> 3; u.pm = MC / 256 + (L & 7); return true; }
        L -= LAT_UNITS;
        const int grp = L / (8 * (DIN / 256)), r = L % (8 * (DIN / 256)); u.pn = r >> 3; u.pm = grp * 8 + (r & 7); return true;
    }
    __device__ __forceinline__ void a_ready(const pg8::Unit&) const {}
    __device__ __forceinline__ void done(const pg8::Unit&) const {}
};

constexpr size_t WS_XCH = WS_SSQ;
constexpr int CW_PANEL = 8192;
struct EpiOutFused {
    static constexpr bool PERM = false, AFTER_DRAIN = true;
    unsigned char* ws; float* out; const float* xp; const float* xs; const float* fg; gu32* ctl;
    __device__ __forceinline__ void fused(f32x4 (&acc)[2][2][4][2], const pg8::Unit& u, int wr, int wc, int fr, int fq, PG8_LAS unsigned char* lds, int wid, int lane) const {
        const float* modf = (const float*)(ws + WS_MODF);
        PG8_LAS float* P = (PG8_LAS float*)lds;
        PG8_LAS float* R = (PG8_LAS float*)(lds + 4096);
        const int col0 = u.pn * 256 + wc * 32 + 4 * fq;
#pragma unroll
        for (int ai = 0; ai < 2; ++ai)
#pragma unroll
            for (int m = 0; m < 4; ++m) {
                const int rl = ai * 128 + wr * 64 + m * 16 + fr, r = u.pm * 256 + rl;
                const int ci = r < MC ? 0 : 1 + ((r - MC) >> 10);
                const float* xr = (r < MC ? xp + (size_t)r * D : xs + (size_t)(r - MC) * D) + col0;
                const float* gt = modf + ci * 3072 + 2048 + col0;
                float ss = 0.f;
#pragma unroll
                for (int bj = 0; bj < 2; ++bj)
#pragma unroll
                    for (int n = 0; n < 2; ++n) {
                        const int off = bj * 128 + n * 16;
                        const f32x4 y = *(const f32x4*)(xr + off) + *(const f32x4*)(gt + off) * acc[ai][bj][m][n];
                        acc[ai][bj][m][n] = y;
                        ss += (y.x * y.x + y.y * y.y) + (y.z * y.z + y.w * y.w);
                    }
                ss += __shfl_xor(ss, 16); ss += __shfl_xor(ss, 32);
                if (fq == 0) P[rl * 4 + wc] = ss;
            }
        asm volatile("s_waitcnt lgkmcnt(0)" ::: "memory"); __builtin_amdgcn_s_barrier(); asm volatile("" ::: "memory");
        const int row = wid * 32 + (lane & 31);
        float* xbuf = (float*)(ws + WS_XCH) + ((size_t)(u.pm * 256 + row) * 4);
        if (lane < 32) {
            const f32x4 p = *(const PG8_LAS f32x4*)(P + row * 4);
            __hip_atomic_store(xbuf + u.pn, (p.x + p.y) + (p.z + p.w), __ATOMIC_RELAXED, __HIP_MEMORY_SCOPE_AGENT);
        }
        asm volatile("s_waitcnt vmcnt(0)" ::: "memory");
        unsigned* cnt = (unsigned*)(ctl + CW_PANEL + 64 * u.pm);
        if (lane == 0) __hip_atomic_fetch_add(cnt, 1u, __ATOMIC_RELAXED, __HIP_MEMORY_SCOPE_AGENT);
        if (wid == 0) {
            unsigned sp = 0;
            while ((unsigned)__builtin_amdgcn_readfirstlane(__hip_atomic_load(cnt, __ATOMIC_RELAXED, __HIP_MEMORY_SCOPE_AGENT)) < 32u) { __builtin_amdgcn_s_sleep(2); if (++sp > (1u << 20)) break; }
            __builtin_amdgcn_fence(__ATOMIC_ACQUIRE, "agent");
        }
        asm volatile("s_waitcnt vmcnt(0) lgkmcnt(0)" ::: "memory"); __builtin_amdgcn_s_barrier(); asm volatile("" ::: "memory");
        if (lane < 32) {
            float t = 0.f;
#pragma unroll
            for (int q = 0; q < 4; ++q) t += __hip_atomic_load(xbuf + q, __ATOMIC_RELAXED, __HIP_MEMORY_SCOPE_AGENT);
            R[row] = __builtin_amdgcn_rsqf(t * (1.f / D) + 1e-6f);
        }
        asm volatile("s_waitcnt lgkmcnt(0)" ::: "memory"); __builtin_amdgcn_s_barrier(); asm volatile("" ::: "memory");
        f32x4 fgv[2][2];
#pragma unroll
        for (int bj = 0; bj < 2; ++bj)
#pragma unroll
            for (int n = 0; n < 2; ++n) fgv[bj][n] = *(const f32x4*)(fg + col0 + bj * 128 + n * 16);
#pragma unroll
        for (int ai = 0; ai < 2; ++ai)
#pragma unroll
            for (int m = 0; m < 4; ++m) {
                const int rl = ai * 128 + wr * 64 + m * 16 + fr; const float rs = R[rl];
                float* o = out + OUT_Y + (size_t)(u.pm * 256 + rl) * D + col0;
#pragma unroll
                for (int bj = 0; bj < 2; ++bj)
#pragma unroll
                    for (int n = 0; n < 2; ++n) { const int off = bj * 128 + n * 16; *(f32x4*)(o + off) = acc[ai][bj][m][n] * rs * fgv[bj][n]; }
            }
    }
};

constexpr int AT_KS = 0, AT_KSTRIDE = 272, AT_VS = 64 * AT_KSTRIDE, AT_VSTRIDE = 144, AT_BUF = AT_VS + 128 * AT_VSTRIDE, AT_X = 2 * AT_BUF, AT_XSTRIDE = 132;
static_assert(AT_X + 4 * 32 * AT_XSTRIDE * 4 <= LDSCTL_OFF && (AT_X % 16) == 0, "attention LDS map");
__device__ __forceinline__ void attn_unit(Frame& F, int idx, bool lat, float lam) {
    int tid_ = F.tid; asm volatile("" : "+v"(tid_)); const int lane_ = tid_ & 63;
    int b, hh, qb, m0, nkeys, vlen; const bf16* Kb; const bf16* VT;
    if (!lat) { b = idx >> 4; hh = (idx >> 1) & 7; qb = idx & 1; m0 = b * SEQ + qb * 128; nkeys = SEQ; vlen = SEQ;
        Kb = (const bf16*)(F.ws + WS_KC) + (size_t)b * SEQ * D + hh * 128; VT = (const bf16*)(F.ws + WS_VTC) + (size_t)((b * NH + hh) * 128) * SEQ; }
    else { b = idx >> 6; hh = (idx >> 3) & 7; qb = idx & 7; m0 = MC + b * LSEQ + qb * 128; nkeys = KLAT; vlen = KLAT;
        Kb = (const bf16*)(F.ws + WS_KL) + (size_t)b * KLAT * D + hh * 128; VT = (const bf16*)(F.ws + WS_VTL) + (size_t)((b * NH + hh) * 128) * KLAT; }
    const int w = F.wave, qs = w >> 1, mp = w & 1, l31 = lane_ & 31, h5 = lane_ >> 5;
    const int kperm = (l31 & 3) + 4 * ((l31 >> 3) & 1) + 8 * ((l31 >> 2) & 1) + 16 * (l31 >> 4);
    LAS float* X = (LAS float*)(F.lds + AT_X);
    bf16x8 qf[4];
    { const bf16* qrow = (const bf16*)(F.ws + WS_Q) + (size_t)(m0 + qs * 32 + l31) * D + hh * 128 + mp * 64 + 8 * h5;
#pragma unroll
      for (int ks = 0; ks < 4; ++ks) qf[ks] = *(const bf16x8*)(qrow + 16 * ks); }
    f32x16 o[4];
#pragma unroll
    for (int i = 0; i < 4; ++i)
#pragma unroll
        for (int j = 0; j < 16; ++j) o[i][j] = 0.f;
    float mrun = -1e30f, lrun = 0.f;
    const int krow = tid_ >> 3, kch = tid_ & 7, vrow = tid_ >> 2, vch = tid_ & 3;
    const int ntile = nkeys / 64;
    const bf16* kp = Kb + (size_t)krow * D + kch * 8;
    const bf16* vp = VT + (size_t)vrow * vlen + vch * 8;
    LAS unsigned char* kd = F.lds + AT_KS + krow * AT_KSTRIDE + kch * 16;
    LAS unsigned char* vd = F.lds + AT_VS + vrow * AT_VSTRIDE + vch * 16;
    v4u k0 = *(const v4u*)kp, k1 = *(const v4u*)(kp + 64), v0 = *(const v4u*)vp, v1 = *(const v4u*)(vp + 32);
    __syncthreads();
    *(LAS v4u*)(kd) = k0; *(LAS v4u*)(kd + 128) = k1;
    *(LAS v4u*)(vd) = v0; *(LAS v4u*)(vd + 64) = v1;
    if (ntile > 1) { k0 = *(const v4u*)(kp + (size_t)64 * D); k1 = *(const v4u*)(kp + (size_t)64 * D + 64); v0 = *(const v4u*)(vp + 64); v1 = *(const v4u*)(vp + 96); }
    __syncthreads();
    for (int kt = 0; kt < ntile; ++kt) {
        const int bo = (kt & 1) * AT_BUF;
        LAS unsigned char* Ks = F.lds + AT_KS + bo; LAS unsigned char* Vs = F.lds + AT_VS + bo;
        if (kt + 1 < ntile) {
            const int bn = AT_BUF - bo;
            *(LAS v4u*)(kd + bn) = k0; *(LAS v4u*)(kd + bn + 128) = k1;
            *(LAS v4u*)(vd + bn) = v0; *(LAS v4u*)(vd + bn + 64) = v1;
            if (kt + 2 < ntile) { const bf16* kq = kp + (size_t)(kt + 2) * 64 * D; const bf16* vq = vp + (kt + 2) * 64;
                k0 = *(const v4u*)kq; k1 = *(const v4u*)(kq + 64); v0 = *(const v4u*)vq; v1 = *(const v4u*)(vq + 32); }
        }
        f32x16 s[2];
#pragma unroll
        for (int st = 0; st < 2; ++st) {
#pragma unroll
            for (int j = 0; j < 16; ++j) s[st][j] = 0.f;
#pragma unroll
            for (int ks = 0; ks < 4; ++ks) {
                const bf16x8 kf = *(const LAS bf16x8*)(Ks + (st * 32 + kperm) * AT_KSTRIDE + (mp * 64 + 16 * ks + 8 * h5) * 2);
                s[st] = __builtin_amdgcn_mfma_f32_32x32x16_bf16(kf, qf[ks], s[st], 0, 0, 0);
            }
        }
        float mx = s[0][0];
#pragma unroll
        for (int j = 0; j < 16; ++j) { mx = fmaxf(mx, s[0][j]); mx = fmaxf(mx, s[1][j]); }
        mx = fmaxf(mx, __shfl_xor(mx, 32));
        if (!__all(mx - mrun <= 8.f)) {
            const float mnew_ = fmaxf(mrun, mx), alpha = __builtin_amdgcn_exp2f(mrun - mnew_);
            mrun = mnew_; lrun *= alpha;
#pragma unroll
            for (int i = 0; i < 4; ++i) o[i] = o[i] * alpha;
        }
        const float mnew = mrun;
        float ps = 0.f;
#pragma unroll
        for (int st = 0; st < 2; ++st)
#pragma unroll
            for (int j = 0; j < 16; ++j) { const float p = __builtin_amdgcn_exp2f(s[st][j] - mnew); s[st][j] = p; ps += p; }
        lrun += ps;
        bf16x8 pf[2][2];
#pragma unroll
        for (int st = 0; st < 2; ++st)
#pragma unroll
            for (int s2 = 0; s2 < 2; ++s2) {
                v4u t; t.x = pk2(s[st][8 * s2 + 0], s[st][8 * s2 + 1]); t.y = pk2(s[st][8 * s2 + 2], s[st][8 * s2 + 3]); t.z = pk2(s[st][8 * s2 + 4], s[st][8 * s2 + 5]); t.w = pk2(s[st][8 * s2 + 6], s[st][8 * s2 + 7]);
                pf[st][s2] = __builtin_bit_cast(bf16x8, t);
            }
#pragma unroll
        for (int dvt = 0; dvt < 4; ++dvt)
#pragma unroll
            for (int st = 0; st < 2; ++st)
#pragma unroll
                for (int s2 = 0; s2 < 2; ++s2) {
                    const bf16x8 vf = *(const LAS bf16x8*)(Vs + (dvt * 32 + l31) * AT_VSTRIDE + (st * 32 + 16 * s2 + 8 * h5) * 2);
                    o[dvt] = __builtin_amdgcn_mfma_f32_32x32x16_bf16(vf, pf[st][s2], o[dvt], 0, 0, 0);
                }
        __syncthreads();
    }
    v4u gav[4];
    {
        const bf16* GA = (const bf16*)(F.ws + WS_GA);
#pragma unroll
        for (int p = 0; p < 4; ++p) gav[p] = *(const v4u*)(GA + (size_t)(m0 + p * 32 + (tid_ >> 4)) * D + hh * 128 + (tid_ & 15) * 8);
    }
    const float ltot = lrun + __shfl_xor(lrun, 32), inv = 1.f / ltot;
    LAS float* Xq = X + (qs * 32 + l31) * AT_XSTRIDE;
    if (mp == 1) {
#pragma unroll
        for (int dvt = 0; dvt < 4; ++dvt)
#pragma unroll
            for (int j = 0; j < 16; ++j) Xq[dvt * 32 + (j & 3) + 8 * (j >> 2) + 4 * h5] = o[dvt][j] * inv;
    }
    __syncthreads();
    if (mp == 0) {
        float ss = 0.f;
#pragma unroll
        for (int dvt = 0; dvt < 4; ++dvt)
#pragma unroll
            for (int j = 0; j < 16; ++j) { const float a = o[dvt][j] * inv - lam * Xq[dvt * 32 + (j & 3) + 8 * (j >> 2) + 4 * h5]; o[dvt][j] = a; ss += a * a; }
        ss += __shfl_xor(ss, 32);
        const float rstd = 0.8f / sqrtf(ss * (1.f / 128.f) + 1e-5f);
#pragma unroll
        for (int dvt = 0; dvt < 4; ++dvt)
#pragma unroll
            for (int j = 0; j < 16; ++j) Xq[dvt * 32 + (j & 3) + 8 * (j >> 2) + 4 * h5] = o[dvt][j] * rstd;
    }
    __syncthreads();
    {
        const float* sg = F.in[I_SUBG];
        bf16* MIX = (bf16*)(F.ws + WS_MIX);
        const int d8 = (tid_ & 15) * 8;
        const f32x4 g0 = *(const f32x4*)(sg + d8), g1 = *(const f32x4*)(sg + d8 + 4);
#pragma unroll
        for (int p = 0; p < 4; ++p) {
            const int q = p * 32 + (tid_ >> 4), m = m0 + q;
            const LAS float* xr = X + q * AT_XSTRIDE + d8;
            const f32x4 a0 = *(const LAS f32x4*)xr, a1 = *(const LAS f32x4*)(xr + 4);
            const v4u ga = gav[p];
            v4u w;
            w.x = pk2(a0.x * g0.x * bflo(ga.x), a0.y * g0.y * bfhi(ga.x)); w.y = pk2(a0.z * g0.z * bflo(ga.y), a0.w * g0.w * bfhi(ga.y));
            w.z = pk2(a1.x * g1.x * bflo(ga.z), a1.y * g1.y * bfhi(ga.z)); w.w = pk2(a1.z * g1.z * bflo(ga.w), a1.w * g1.w * bfhi(ga.w));
            *(v4u*)(MIX + (size_t)m * DMIX + hh * 128 + d8) = w;
        }
    }
}

constexpr int SC_W2 = 0, SC_A2 = 16384, SC_TLW = 32768, SC_LA = 40960, SC_WD = 49152, SC_NKK = 57344, SC_BB = 65536, SC_KD = 73728, SC_R = 81920, SC_V = 90112, SC_Y = 98304, SC_BON = 106496;
template <int CTRL> __device__ __forceinline__ float dppf(float x) { return __builtin_bit_cast(float, __builtin_amdgcn_update_dpp(0, __builtin_bit_cast(int, x), CTRL, 0xf, 0xf, true)); }
__device__ __forceinline__ float reduce8(float v) { v += dppf<0xB1>(v); v += dppf<0x4E>(v); v += dppf<0x141>(v); return v; }
__device__ __forceinline__ float shift_load(const bf16* ub, const float* mu, int t, int T, int col) {
    const float u = bf2f(ub[col]);
    const float p = t > 0 ? bf2f(ub[col - DSH]) : 0.f;
    const float n = t < T - 1 ? bf2f(ub[col + DSH]) : 0.f;
    return u + mu[col] * (p - u) + mu[DSH + col] * (n - u);
}
__device__ __forceinline__ void scan_unit(Frame& F, int b, int hh, bool lat) {
    const int T = lat ? LSEQ : SEQ, m0 = lat ? MC + b * LSEQ : b * SEQ;
    const bf16* UB = (const bf16*)(F.ws + WS_UB); const bf16* GB = (const bf16*)(F.ws + WS_GB); bf16* MIX = (bf16*)(F.ws + WS_MIX);
    float* YB = F.out + OUT_Y;
    const float* mu = F.in[I_MU];
    LAS float* W2s = (LAS float*)(F.lds + SC_W2); LAS float* A2s = (LAS float*)(F.lds + SC_A2); LAS float* TLW = (LAS float*)(F.lds + SC_TLW); LAS float* LAs = (LAS float*)(F.lds + SC_LA);
    LAS float* WD = (LAS float*)(F.lds + SC_WD); LAS float* NKK = (LAS float*)(F.lds + SC_NKK); LAS float* BB = (LAS float*)(F.lds + SC_BB); LAS float* KD = (LAS float*)(F.lds + SC_KD);
    LAS float* RR = (LAS float*)(F.lds + SC_R); LAS float* VV = (LAS float*)(F.lds + SC_V); LAS float* YC = (LAS float*)(F.lds + SC_Y); LAS float* BON = (LAS float*)(F.lds + SC_BON);
    const int c = F.lane, hc = hh * 64 + c, row = F.wave * 8 + (F.lane >> 3), kq = F.lane & 7;
    const float kkc = F.in[I_KK][hc], kac = F.in[I_KA][hc], rkc = F.in[I_RK][hc];
    for (int d = 0; d < 2; ++d) {
        __syncthreads();
        for (int i = F.tid; i < 4096; i += NTHR) { const int j = i >> 6, cc = i & 63; W2s[i] = F.in[I_W2][(size_t)(d * 64 + j) * D + hh * 64 + cc]; A2s[i] = F.in[I_A2][(size_t)(d * 64 + j) * D + hh * 64 + cc]; }
        const float w0c = F.in[I_W0][d * D + hc], a0c = F.in[I_A0][d * D + hc];
        float S[8];
        if (lat) { const float* sp = F.in[I_ST] + ((size_t)((b * 2 + d) * NHB + hh) * 64 + row) * 64 + kq * 8;
            const f32x4 s0 = *(const f32x4*)sp, s1 = *(const f32x4*)(sp + 4); S[0] = s0.x; S[1] = s0.y; S[2] = s0.z; S[3] = s0.w; S[4] = s1.x; S[5] = s1.y; S[6] = s1.z; S[7] = s1.w; }
        else {
#pragma unroll
            for (int i = 0; i < 8; ++i) S[i] = 0.f; }
        const int nch = T / 32;
        for (int ch = 0; ch < nch; ++ch) {
            const int t0 = (d == 0 ? ch : nch - 1 - ch) * 32;
            __syncthreads();
            float r_[4], k_[4], v_[4];
#pragma unroll
            for (int i = 0; i < 4; ++i) {
                const int tt = F.wave * 4 + i, t = t0 + tt;
                const bf16* ub = UB + (size_t)(m0 + t) * DSH;
                r_[i] = shift_load(ub, mu, t, T, hc); k_[i] = shift_load(ub, mu, t, T, 1024 + hc); v_[i] = shift_load(ub, mu, t, T, 2048 + hc);
                const float lw = shift_load(ub, mu, t, T, 3072 + 64 * d + c), la = shift_load(ub, mu, t, T, 3200 + 64 * d + c);
                TLW[tt * 64 + c] = tanhf(lw); LAs[tt * 64 + c] = la;
            }
            __syncthreads();
            float zw[4], za[4];
#pragma unroll
            for (int i = 0; i < 4; ++i) { zw[i] = w0c; za[i] = a0c; }
            for (int j = 0; j < 64; j += 4) {
                f32x4 tw[4], ta[4];
#pragma unroll
                for (int i = 0; i < 4; ++i) { tw[i] = *(const LAS f32x4*)(TLW + (F.wave * 4 + i) * 64 + j); ta[i] = *(const LAS f32x4*)(LAs + (F.wave * 4 + i) * 64 + j); }
#pragma unroll
                for (int jj = 0; jj < 4; ++jj) { const float w2 = W2s[(j + jj) * 64 + c], a2 = A2s[(j + jj) * 64 + c];
#pragma unroll
                    for (int i = 0; i < 4; ++i) { zw[i] += tw[i][jj] * w2; za[i] += ta[i][jj] * a2; } }
            }
#pragma unroll
            for (int i = 0; i < 4; ++i) {
                const int tt = F.wave * 4 + i;
                const float dec = __expf(-0.60653065971f * sigmoidf_(zw[i])), a = sigmoidf_(za[i]);
                float kk = k_[i] * kkc; const float n2 = wave_sum(kk * kk); kk *= 1.f / sqrtf(n2 + 1e-12f);
                WD[tt * 64 + c] = dec; NKK[tt * 64 + c] = -kk; BB[tt * 64 + c] = kk * a; KD[tt * 64 + c] = k_[i] * (1.f + (a - 1.f) * kac); RR[tt * 64 + c] = r_[i]; VV[tt * 64 + c] = v_[i];
                if (d == 1) { const float bo = wave_sum(r_[i] * k_[i] * rkc); if (c == 0) BON[tt] = bo; }
            }
            __syncthreads();
            for (int s = 0; s < 32; ++s) {
                const int tt = d == 0 ? s : 31 - s; const int o = tt * 64 + kq * 8;
                const f32x4 w0 = *(const LAS f32x4*)(WD + o), w1 = *(const LAS f32x4*)(WD + o + 4), n0 = *(const LAS f32x4*)(NKK + o), n1 = *(const LAS f32x4*)(NKK + o + 4);
                const f32x4 b0 = *(const LAS f32x4*)(BB + o), b1 = *(const LAS f32x4*)(BB + o + 4), k0 = *(const LAS f32x4*)(KD + o), k1 = *(const LAS f32x4*)(KD + o + 4);
                const f32x4 r0 = *(const LAS f32x4*)(RR + o), r1 = *(const LAS f32x4*)(RR + o + 4);
                const float vv = VV[tt * 64 + row];
                float sa = (S[0] * n0.x + S[1] * n0.y) + (S[2] * n0.z + S[3] * n0.w) + (S[4] * n1.x + S[5] * n1.y) + (S[6] * n1.z + S[7] * n1.w);
                sa = reduce8(sa);
                S[0] = S[0] * w0.x + sa * b0.x + vv * k0.x; S[1] = S[1] * w0.y + sa * b0.y + vv * k0.y; S[2] = S[2] * w0.z + sa * b0.z + vv * k0.z; S[3] = S[3] * w0.w + sa * b0.w + vv * k0.w;
                S[4] = S[4] * w1.x + sa * b1.x + vv * k1.x; S[5] = S[5] * w1.y + sa * b1.y + vv * k1.y; S[6] = S[6] * w1.z + sa * b1.z + vv * k1.z; S[7] = S[7] * w1.w + sa * b1.w + vv * k1.w;
                float y = (S[0] * r0.x + S[1] * r0.y) + (S[2] * r0.z + S[3] * r0.w) + (S[4] * r1.x + S[5] * r1.y) + (S[6] * r1.z + S[7] * r1.w);
                y = reduce8(y);
                if (kq == 0) YC[tt * 64 + row] = y;
            }
            __syncthreads();
            {
                const int tt = F.tid >> 4, c4 = (F.tid & 15) * 4, m = m0 + t0 + tt;
                f32x4 y4 = *(const LAS f32x4*)(YC + tt * 64 + c4);
                float* gp = YB + (size_t)m * D + hh * 64 + c4;
                if (d == 0) *(f32x4*)gp = y4;
                else {
                    y4 += *(const f32x4*)gp;
                    float s1 = (y4.x + y4.y) + (y4.z + y4.w);
                    s1 += __shfl_xor(s1, 1); s1 += __shfl_xor(s1, 2); s1 += __shfl_xor(s1, 4); s1 += __shfl_xor(s1, 8);
                    const float mean = s1 * (1.f / 64.f);
                    const f32x4 dy = y4 - mean;
                    float s2 = (dy.x * dy.x + dy.y * dy.y) + (dy.z * dy.z + dy.w * dy.w);
                    s2 += __shfl_xor(s2, 1); s2 += __shfl_xor(s2, 2); s2 += __shfl_xor(s2, 4); s2 += __shfl_xor(s2, 8);
                    const float rstd = 1.f / sqrtf(s2 * (1.f / 64.f) + 64e-5f);
                    const f32x4 lg = *(const f32x4*)(F.in[I_LNG] + hh * 64 + c4), lb = *(const f32x4*)(F.in[I_LNB] + hh * 64 + c4);
                    const f32x4 vt = *(const LAS f32x4*)(VV + tt * 64 + c4);
                    const float bo = BON[tt];
                    const v2u gb = *(const v2u*)(GB + (size_t)m * D + hh * 64 + c4);
                    const f32x4 yn = dy * rstd * lg + lb + vt * bo;
                    v2u w; w.x = pk2(yn.x * bflo(gb.x), yn.y * bfhi(gb.x)); w.y = pk2(yn.z * bflo(gb.y), yn.w * bfhi(gb.y));
                    *(v2u*)(MIX + (size_t)m * DMIX + 1024 + hh * 64 + c4) = w;
                }
            }
        }
        if (!lat) { float* sp = F.out + OUT_ST + ((size_t)((b * 2 + d) * NHB + hh) * 64 + row) * 64 + kq * 8;
            *(f32x4*)sp = (f32x4){S[0], S[1], S[2], S[3]}; *(f32x4*)(sp + 4) = (f32x4){S[4], S[5], S[6], S[7]}; }
    }
}


constexpr int SG_ST = 144;
constexpr int G_AT = 0, G_RT = 9216, G_BH = 18432, G_KH = 26624, G_LAK = 34816, G_LBR = 36864, G_LKR = 38912, G_TM = 40960, G_GAM = 43008, G_PRIV = 44032;
constexpr int PW_TLW = 0, PW_LAB = 2304, PW_ZS = 4608, PW_LF = PW_ZS, PW_VT = PW_ZS + 1024, PW_SIZE = 8768, G_SIZE = G_PRIV + 4 * PW_SIZE;
constexpr int ZS_ST = 65, VT_ST = 40;
static_assert(2 * G_SIZE <= LDSCTL_OFF, "scan LDS map");
__device__ __forceinline__ bf16x8 mk8(v2u lo, v2u hi) { const v4u t = {lo.x, lo.y, hi.x, hi.y}; return __builtin_bit_cast(bf16x8, t); }
__device__ __forceinline__ bf16x8 pk8(f32x4 a, f32x4 b) { const v4u t = {pk2(a[0], a[1]), pk2(a[2], a[3]), pk2(b[0], b[1]), pk2(b[2], b[3])}; return __builtin_bit_cast(bf16x8, t); }
#define MFMA16(a, b, c) __builtin_amdgcn_mfma_f32_16x16x32_bf16(a, b, c, 0, 0, 0)
template <int CTRL> __device__ __forceinline__ float dpp_mov(float x) { return __builtin_bit_cast(float, __builtin_amdgcn_update_dpp(0, __builtin_bit_cast(int, x), CTRL, 0xf, 0xf, true)); }
__device__ __forceinline__ void wave_sum16(float (&v)[16], int lane) {
    float a8[8], a4[4], a2[2];
    { const bool bit = lane & 4;
#pragma unroll
      for (int m = 0; m < 8; ++m) { const float send = bit ? v[2 * m] : v[2 * m + 1], keep = bit ? v[2 * m + 1] : v[2 * m]; a8[m] = keep + dpp_mov<0x141>(send); } }
    { const bool bit = lane & 1;
#pragma unroll
      for (int m = 0; m < 4; ++m) { const float send = bit ? a8[2 * m] : a8[2 * m + 1], keep = bit ? a8[2 * m + 1] : a8[2 * m]; a4[m] = keep + dpp_mov<0xB1>(send); } }
    { const bool bit = lane & 2;
#pragma unroll
      for (int m = 0; m < 2; ++m) { const float send = bit ? a4[2 * m] : a4[2 * m + 1], keep = bit ? a4[2 * m + 1] : a4[2 * m]; a2[m] = keep + dpp_mov<0x4E>(send); } }
    float t;
    { const bool bit = lane & 8; const float send = bit ? a2[0] : a2[1], keep = bit ? a2[1] : a2[0]; t = keep + dpp_mov<0x128>(send); }
    t += __shfl_xor(t, 16); t += __shfl_xor(t, 32);
#pragma unroll
    for (int i = 0; i < 16; ++i) { constexpr int dummy = 0; const int src = ((i >> 1) & 1) + 2 * ((i >> 2) & 1) + 4 * (i & 1) + 8 * ((i >> 3) & 1);
        v[i] = __builtin_bit_cast(float, __builtin_amdgcn_readlane(__builtin_bit_cast(int, t), src)); }
}
__device__ __forceinline__ void load_shift16(const bf16* ubase, int T, int p0, int d, int col, float mA, float mB, float (&out)[16]) {
    float u[18];
#pragma unroll
    for (int j = 0; j < 18; ++j) { const int tj = d ? (T - p0 - j) : (p0 - 1 + j);
        if (j == 0 || j == 17) u[j] = (tj >= 0 && tj < T) ? bf2f(ubase[(size_t)tj * DSH + col]) : 0.f;
        else u[j] = bf2f(ubase[(size_t)tj * DSH + col]); }
#pragma unroll
    for (int i = 0; i < 16; ++i) out[i] = u[i + 1] + mA * (u[i] - u[i + 1]) + mB * (u[i + 2] - u[i + 1]);
}
__device__ __forceinline__ void scan_unit2(Frame& F, int b, int hh, bool lat) {
    const int T = lat ? LSEQ : SEQ, m0 = lat ? MC + b * LSEQ : b * SEQ, nch = T / 64;
    const int lane0 = F.lane, d = F.wave >> 2, w = F.wave & 3;
    int lane = lane0, c16 = lane & 15, g = lane >> 4, hc = hh * 64 + lane;
    LAS unsigned char* GB_ = F.lds + d * G_SIZE;
    LAS unsigned char* PW = GB_ + G_PRIV + w * PW_SIZE;
    const bf16* UB = (const bf16*)(F.ws + WS_UB) + (size_t)m0 * DSH; const bf16* GBp = (const bf16*)(F.ws + WS_GB); bf16* MIX = (bf16*)(F.ws + WS_MIX);
    float* YB = F.out + OUT_Y;
    const float* mu = F.in[I_MU];
    int cR = hc, cK = 1024 + hc, cV = 2048 + hc, cW = 3072 + 64 * d + lane, cA = 3200 + 64 * d + lane;
    const int oA = d ? DSH : 0, oB = d ? 0 : DSH;
    const float kkc = F.in[I_KK][hc], kac = F.in[I_KA][hc], rkc = F.in[I_RK][hc], w0c = F.in[I_W0][d * D + hc], a0c = F.in[I_A0][d * D + hc];
    const float lng = F.in[I_LNG][hc], lnb = F.in[I_LNB][hc];
    const v4u* wop0 = (const v4u*)(F.ws + WS_WOP) + (size_t)((d * 16 + hh) * 2) * 8 * 64;
    f32x4 S[4];
    const size_t st_off = ((size_t)((b * 2 + d) * NHB + hh) * 64 + 16 * w + c16) * 64 + 4 * g;
#pragma unroll
    for (int kt = 0; kt < 4; ++kt) S[kt] = lat ? *(const f32x4*)(F.in[I_ST] + st_off + 16 * kt) : (f32x4){0.f, 0.f, 0.f, 0.f};
    const v2u z2 = {0u, 0u};
    __syncthreads();
    for (int it = 0; it < nch; ++it) {
        const int p0 = it * 64 + w * 16;
        lane = lane0; asm volatile("" : "+v"(lane));
        c16 = lane & 15; g = lane >> 4; hc = hh * 64 + lane; cR = hc; cK = 1024 + hc; cV = 2048 + hc; cW = 3072 + 64 * d + lane; cA = 3200 + 64 * d + lane;
        const v4u* wop = wop0 + lane;
        float bon[16], v_[16];
        {
            float x_[16];
            load_shift16(UB, T, p0, d, cW, mu[oA + cW], mu[oB + cW], x_);
#pragma unroll
            for (int i = 0; i < 16; ++i) { const float e = __expf(2.f * x_[i]); *(LAS bf16*)(PW + PW_TLW + i * SG_ST + lane * 2) = (bf16)f2bf(1.f - 2.f / (e + 1.f)); }
            load_shift16(UB, T, p0, d, cA, mu[oA + cA], mu[oB + cA], x_);
#pragma unroll
            for (int i = 0; i < 16; ++i) *(LAS bf16*)(PW + PW_LAB + i * SG_ST + lane * 2) = (bf16)f2bf(x_[i]);
        }
        float lam[16], aa[16];
        {
            LAS float* Zs = (LAS float*)(PW + PW_ZS);
            {
                bf16x8 ta[2];
#pragma unroll
                for (int ks = 0; ks < 2; ++ks) ta[ks] = *(const LAS bf16x8*)(PW + PW_TLW + c16 * SG_ST + (32 * ks + 8 * g) * 2);
#pragma unroll
                for (int ct = 0; ct < 4; ++ct) { f32x4 z = {0.f, 0.f, 0.f, 0.f};
#pragma unroll
                    for (int ks = 0; ks < 2; ++ks) z = MFMA16(ta[ks], __builtin_bit_cast(bf16x8, wop[(ct * 2 + ks) * 64]), z);
#pragma unroll
                    for (int rg = 0; rg < 4; ++rg) Zs[(4 * g + rg) * ZS_ST + 16 * ct + c16] = z[rg]; }
                float l = 0.f;
#pragma unroll
                for (int i = 0; i < 16; ++i) { l += -0.60653065971f * sigmoidf_(w0c + Zs[i * ZS_ST + lane]); lam[i] = l; }
            }
            {
                bf16x8 tb[2];
#pragma unroll
                for (int ks = 0; ks < 2; ++ks) tb[ks] = *(const LAS bf16x8*)(PW + PW_LAB + c16 * SG_ST + (32 * ks + 8 * g) * 2);
#pragma unroll
                for (int ct = 0; ct < 4; ++ct) { f32x4 z = {0.f, 0.f, 0.f, 0.f};
#pragma unroll
                    for (int ks = 0; ks < 2; ++ks) z = MFMA16(tb[ks], __builtin_bit_cast(bf16x8, wop[512 + (ct * 2 + ks) * 64]), z);
#pragma unroll
                    for (int rg = 0; rg < 4; ++rg) Zs[(4 * g + rg) * ZS_ST + 16 * ct + c16] = z[rg]; }
#pragma unroll
                for (int i = 0; i < 16; ++i) aa[i] = sigmoidf_(a0c + Zs[i * ZS_ST + lane]);
            }
        }
        {
            float k_[16];
            load_shift16(UB, T, p0, d, cK, mu[oA + cK], mu[oB + cK], k_);
            {
                float n2[16];
#pragma unroll
                for (int i = 0; i < 16; ++i) { const float kk = k_[i] * kkc; n2[i] = kk * kk; }
                wave_sum16(n2, lane);
                unsigned bh[8], kh[8];
#pragma unroll
                for (int i = 0; i < 16; ++i) {
                    const float kk = k_[i] * kkc * (1.f / sqrtf(n2[i] + 1e-12f)), kd = k_[i] * (1.f + (aa[i] - 1.f) * kac), bb = kk * aa[i];
                    const float e1 = i ? __expf(lam[i - 1]) : 1.f, e2 = __expf(-lam[i]);
                    *(LAS bf16*)(GB_ + G_AT + (16 * w + i) * SG_ST + lane * 2) = (bf16)f2bf(-kk * e1);
                    const unsigned btb = f2bf(bb * e2), ktb = f2bf(kd * e2);
                    *(LAS bf16*)(PW + PW_TLW + i * SG_ST + lane * 2) = (bf16)btb;
                    *(LAS bf16*)(PW + PW_LAB + i * SG_ST + lane * 2) = (bf16)ktb;
                    if (i & 1) { bh[i >> 1] |= btb << 16; kh[i >> 1] |= ktb << 16; } else { bh[i >> 1] = btb; kh[i >> 1] = ktb; }
                }
#pragma unroll
                for (int q = 0; q < 4; ++q) {
                    *(LAS v2u*)(GB_ + G_BH + (w * 64 + lane) * 32 + 8 * q) = (v2u){bh[2 * q], bh[2 * q + 1]};
                    *(LAS v2u*)(GB_ + G_KH + (w * 64 + lane) * 32 + 8 * q) = (v2u){kh[2 * q], kh[2 * q + 1]};
                }
            }
            float r_[16];
            load_shift16(UB, T, p0, d, cR, mu[oA + cR], mu[oB + cR], r_);
#pragma unroll
            for (int i = 0; i < 16; ++i) { bon[i] = r_[i] * k_[i] * rkc; *(LAS bf16*)(GB_ + G_RT + (16 * w + i) * SG_ST + lane * 2) = (bf16)f2bf(r_[i] * __expf(lam[i])); }
            wave_sum16(bon, lane);
        }
        ((LAS float*)(GB_ + G_GAM))[w * 64 + lane] = __expf(lam[15]);
        {
            load_shift16(UB, T, p0, d, cV, mu[oA + cV], mu[oB + cV], v_);
            unsigned vt[8];
#pragma unroll
            for (int i = 0; i < 16; ++i) { const unsigned vtb = f2bf(v_[i]); if (i & 1) vt[i >> 1] |= vtb << 16; else vt[i >> 1] = vtb; v_[i] *= bon[i]; }
#pragma unroll
            for (int q = 0; q < 4; ++q) *(LAS v2u*)(PW + PW_VT + lane * VT_ST + 8 * q) = (v2u){vt[2 * q], vt[2 * q + 1]};
        }
        {
            bf16x8 fa[2], fr[2], fb[2], fk[2];
#pragma unroll
            for (int ks = 0; ks < 2; ++ks) {
                fa[ks] = *(const LAS bf16x8*)(GB_ + G_AT + (16 * w + c16) * SG_ST + (32 * ks + 8 * g) * 2); fr[ks] = *(const LAS bf16x8*)(GB_ + G_RT + (16 * w + c16) * SG_ST + (32 * ks + 8 * g) * 2);
                fb[ks] = *(const LAS bf16x8*)(PW + PW_TLW + c16 * SG_ST + (32 * ks + 8 * g) * 2); fk[ks] = *(const LAS bf16x8*)(PW + PW_LAB + c16 * SG_ST + (32 * ks + 8 * g) * 2);
            }
            f32x4 lab = {0.f, 0.f, 0.f, 0.f}, lak = lab, lbr = lab, lkr = lab;
#pragma unroll
            for (int ks = 0; ks < 2; ++ks) { lab = MFMA16(fa[ks], fb[ks], lab); lak = MFMA16(fa[ks], fk[ks], lak); lbr = MFMA16(fr[ks], fb[ks], lbr); lkr = MFMA16(fr[ks], fk[ks], lkr); }
            LAS float* Lf = (LAS float*)(PW + PW_LF);
#pragma unroll
            for (int rg = 0; rg < 4; ++rg) { const int i = 4 * g + rg, j = c16;
                Lf[i * 16 + j] = j < i ? lab[rg] : 0.f;
                *(LAS bf16*)(GB_ + G_LAK + (w * 16 + i) * 32 + j * 2) = (bf16)f2bf(j < i ? lak[rg] : 0.f);
                *(LAS bf16*)(GB_ + G_LBR + (w * 16 + i) * 32 + j * 2) = (bf16)f2bf(j <= i ? lbr[rg] : 0.f);
                *(LAS bf16*)(GB_ + G_LKR + (w * 16 + i) * 32 + j * 2) = (bf16)f2bf(j <= i ? lkr[rg] : 0.f); }
            float tm[16];
#pragma unroll
            for (int i = 0; i < 16; ++i) { float a = (i == c16) ? 1.f : 0.f;
#pragma unroll
                for (int j = 0; j < i; ++j) a += Lf[i * 16 + j] * tm[j];
                tm[i] = a; }
            if (lane < 16) {
#pragma unroll
                for (int i = 0; i < 16; ++i) *(LAS bf16*)(GB_ + G_TM + (w * 16 + i) * 32 + lane * 2) = (bf16)f2bf(tm[i]); }
        }
        __syncthreads();
        const bool first = it < nch / 2;
#pragma unroll 1
        for (int sc = 0; sc < 4; ++sc) {
            lane = lane0; asm volatile("" : "+v"(lane)); c16 = lane & 15; g = lane >> 4;
            const LAS unsigned char* at_p = GB_ + G_AT + (16 * sc + c16) * SG_ST + 8 * g;
            const LAS unsigned char* rt_p = GB_ + G_RT + (16 * sc + c16) * SG_ST + 8 * g;
            const LAS unsigned char* vt_p = GB_ + G_PRIV + sc * PW_SIZE + PW_VT + (16 * w + c16) * VT_ST + 8 * g;
            const bf16x8 sop0 = pk8(S[0], S[1]), sop1 = pk8(S[2], S[3]);
            const bf16x8 at0 = mk8(*(const LAS v2u*)(at_p), *(const LAS v2u*)(at_p + 32)), at1 = mk8(*(const LAS v2u*)(at_p + 64), *(const LAS v2u*)(at_p + 96));
            const bf16x8 rt0 = mk8(*(const LAS v2u*)(rt_p), *(const LAS v2u*)(rt_p + 32)), rt1 = mk8(*(const LAS v2u*)(rt_p + 64), *(const LAS v2u*)(rt_p + 96));
            const v2u vt2 = *(const LAS v2u*)vt_p;
            const bf16x8 alak = mk8(*(const LAS v2u*)(GB_ + G_LAK + (sc * 16 + c16) * 32 + 8 * g), z2);
            const bf16x8 atm = mk8(*(const LAS v2u*)(GB_ + G_TM + (sc * 16 + c16) * 32 + 8 * g), z2);
            const bf16x8 albk = mk8(*(const LAS v2u*)(GB_ + G_LBR + (sc * 16 + c16) * 32 + 8 * g), *(const LAS v2u*)(GB_ + G_LKR + (sc * 16 + c16) * 32 + 8 * g));
            f32x4 X = {0.f, 0.f, 0.f, 0.f};
            X = MFMA16(at0, sop0, X); X = MFMA16(at1, sop1, X); X = MFMA16(alak, mk8(vt2, z2), X);
            const v4u xo = {pk2(X[0], X[1]), pk2(X[2], X[3]), 0u, 0u};
            f32x4 U = {0.f, 0.f, 0.f, 0.f};
            U = MFMA16(atm, __builtin_bit_cast(bf16x8, xo), U);
            const v4u uo = {pk2(U[0], U[1]), pk2(U[2], U[3]), vt2.x, vt2.y};
            const bf16x8 uvop = __builtin_bit_cast(bf16x8, uo);
            float* yp[4];
#pragma unroll
            for (int rg = 0; rg < 4; ++rg) { const int p = it * 64 + sc * 16 + 4 * g + rg, t = d ? T - 1 - p : p; yp[rg] = YB + (size_t)(m0 + t) * D + hh * 64 + 16 * w + c16; }
            f32x4 Y = {0.f, 0.f, 0.f, 0.f};
            if (!first) {
#pragma unroll
                for (int rg = 0; rg < 4; ++rg) Y[rg] = *yp[rg]; }
            Y = MFMA16(rt0, sop0, Y); Y = MFMA16(rt1, sop1, Y); Y = MFMA16(albk, uvop, Y);
#pragma unroll
            for (int rg = 0; rg < 4; ++rg) *yp[rg] = Y[rg];
#pragma unroll
            for (int kt = 0; kt < 4; ++kt) {
                const bf16x8 abk = mk8(*(const LAS v2u*)(GB_ + G_BH + (sc * 64 + 16 * kt + c16) * 32 + 8 * g), *(const LAS v2u*)(GB_ + G_KH + (sc * 64 + 16 * kt + c16) * 32 + 8 * g));
                const f32x4 gm = *(const LAS f32x4*)(GB_ + G_GAM + (sc * 64 + 16 * kt + 4 * g) * 4);
                S[kt] = MFMA16(abk, uvop, S[kt]) * gm;
            }
        }
        __syncthreads();
        if (!first) {
            lane = lane0; asm volatile("" : "+v"(lane)); hc = hh * 64 + lane;
            float y_[16], s1[16];
#pragma unroll
            for (int i = 0; i < 16; ++i) { const int p = p0 + i, t = d ? T - 1 - p : p; y_[i] = YB[(size_t)(m0 + t) * D + hc]; s1[i] = y_[i]; }
            wave_sum16(s1, lane);
#pragma unroll
            for (int i = 0; i < 16; ++i) { y_[i] -= s1[i] * (1.f / 64.f); s1[i] = y_[i] * y_[i]; }
            wave_sum16(s1, lane);
#pragma unroll
            for (int i = 0; i < 16; ++i) { const int p = p0 + i, t = d ? T - 1 - p : p; const size_t m = (size_t)(m0 + t);
                const float yn = y_[i] * (1.f / sqrtf(s1[i] * (1.f / 64.f) + 64e-5f)) * lng + lnb + v_[i];
                MIX[m * DMIX + 1024 + hc] = (bf16)f2bf(yn * bf2f(GBp[m * D + hc])); }
        }
    }
    if (!lat) {
        float* sp = F.out + OUT_ST + st_off;
#pragma unroll
        for (int kt = 0; kt < 4; ++kt) *(f32x4*)(sp + 16 * kt) = S[kt];
    }
}


__device__ __forceinline__ void st_bf16(LAS unsigned char* p, float v) { *(LAS bf16*)p = (bf16)f2bf_hw(v); }
struct PfRows { unsigned off[3]; bool ok[3]; };
__device__ __forceinline__ PfRows pf_rows(int T, int p0, int d, int lane) {
    PfRows R;
#pragma unroll
    for (int q = 0; q < 3; ++q) { const int j = 8 * q + (lane >> 3), jj = j > 17 ? 17 : j, pj = p0 - 1 + jj; int tj = d ? T - 1 - pj : pj; R.ok[q] = tj >= 0 && tj < T; tj = R.ok[q] ? tj : 0;
        R.off[q] = (unsigned)tj * (unsigned)DSH + (unsigned)(lane & 7) * 8u; }
    return R;
}
__device__ __forceinline__ void pf_issue(const bf16* ubase, const PfRows& R, int colb, v4u (&r)[3]) {
#pragma unroll
    for (int q = 0; q < 3; ++q) { v4u x = *(const v4u*)(ubase + colb + R.off[q]); if (!R.ok[q]) x = (v4u){0u, 0u, 0u, 0u}; r[q] = x; }
}
__device__ __forceinline__ void pf_consume(LAS unsigned char* stg, const v4u (&r)[3], int lane, float mA, float mB, float (&out)[16]) {
#pragma unroll
    for (int q = 0; q < 3; ++q) *(LAS v4u*)(stg + (8 * q + (lane >> 3)) * SG_ST + (lane & 7) * 16) = r[q];
    asm volatile("" ::: "memory");
    float u[18];
#pragma unroll
    for (int j = 0; j < 18; ++j) u[j] = bf2f(*(const LAS bf16*)(stg + j * SG_ST + lane * 2));
    asm volatile("" ::: "memory");
    const float m0_ = 1.f - mA - mB;
#pragma unroll
    for (int i = 0; i < 16; ++i) out[i] = m0_ * u[i + 1] + mA * u[i] + mB * u[i + 2];
}
__device__ __forceinline__ void scan_unit3(Frame& F, int b, int hh, bool lat, const XcdBarrier* gbar = nullptr, int gbar_it = -1) {
    const int T = lat ? LSEQ : SEQ, m0 = lat ? MC + b * LSEQ : b * SEQ, nch = T / 64;
    int lane0 = F.lane; asm volatile("" : "+v"(lane0));
    const int d = F.wave >> 2, w = F.wave & 3;
    int lane = lane0, c16 = lane & 15, g = lane >> 4, hc = hh * 64 + lane;
    LAS unsigned char* GB_ = F.lds + d * G_SIZE;
    LAS unsigned char* PW = GB_ + G_PRIV + w * PW_SIZE;
    const bf16* UB = (const bf16*)(F.ws + WS_UB) + (size_t)m0 * DSH; const bf16* GBp = (const bf16*)(F.ws + WS_GB); bf16* MIX = (bf16*)(F.ws + WS_MIX);
    float* YB = F.out + OUT_Y;
    const float* mu = F.in[I_MU];
    const int cR = hh * 64, cK = 1024 + hh * 64, cV = 2048 + hh * 64, cW = 3072 + 64 * d, cA = 3200 + 64 * d;
    const int oA = d ? DSH : 0, oB = d ? 0 : DSH;
    const float kkc = F.in[I_KK][hc], kac = F.in[I_KA][hc], rkc = F.in[I_RK][hc], w0c = F.in[I_W0][d * D + hc], a0c = F.in[I_A0][d * D + hc];
    const float mWA = mu[oA + cW + lane], mWB = mu[oB + cW + lane], mAA = mu[oA + cA + lane], mAB = mu[oB + cA + lane], mKA = mu[oA + cK + lane], mKB = mu[oB + cK + lane];
    const float mRA = mu[oA + cR + lane], mRB = mu[oB + cR + lane], mVA = mu[oA + cV + lane], mVB = mu[oB + cV + lane];
    const v4u* wop0 = (const v4u*)(F.ws + WS_WOP) + (size_t)((d * 16 + hh) * 2) * 8 * 64;
    f32x4 S[4];
    { const size_t st_off = ((size_t)((b * 2 + d) * NHB + hh) * 64 + 16 * w + c16) * 64 + 4 * g;
#pragma unroll
    for (int kt = 0; kt < 4; ++kt) S[kt] = lat ? *(const f32x4*)(F.in[I_ST] + st_off + 16 * kt) : (f32x4){0.f, 0.f, 0.f, 0.f}; }
    const v2u z2 = {0u, 0u};
    v4u pW[3], pA[3], pK[3], pR[3], pV[3];
    { const PfRows R = pf_rows(T, w * 16, d, lane); pf_issue(UB, R, cW, pW); pf_issue(UB, R, cA, pA); pf_issue(UB, R, cK, pK); pf_issue(UB, R, cR, pR); pf_issue(UB, R, cV, pV); }
    __syncthreads();
    for (int it = 0; it < nch; ++it) {
        if (it == gbar_it) xcd_barrier(*gbar);
        const int p0 = it * 64 + w * 16;
        const bool first = it < nch / 2;
        lane = lane0; asm volatile("" : "+v"(lane));
        c16 = lane & 15; g = lane >> 4; hc = hh * 64 + lane;
        const v4u* wop = wop0 + lane;
        LAS unsigned char* stg = PW + PW_ZS;
        float bon[16], v_[16];
#ifndef SREP_PREP
#define SREP_PREP 1
#endif
#ifndef SREP_POST
#define SREP_POST 1
#endif
#ifndef SREP_B
#define SREP_B 1
#endif
#pragma unroll 1
        for (int rep_ = 0; rep_ < SREP_PREP; ++rep_) {
        {
            float x_[16];
            pf_consume(stg, pW, lane, mWA, mWB, x_);
#pragma unroll
            for (int i = 0; i < 16; ++i) { const float e = __expf(2.f * x_[i]); st_bf16(PW + PW_TLW + i * SG_ST + lane * 2, 1.f - 2.f * __builtin_amdgcn_rcpf(e + 1.f)); }
            pf_consume(stg, pA, lane, mAA, mAB, x_);
#pragma unroll
            for (int i = 0; i < 16; ++i) st_bf16(PW + PW_LAB + i * SG_ST + lane * 2, x_[i]);
        }
        float k_[16];
        pf_consume(stg, pK, lane, mKA, mKB, k_);
        asm volatile("" ::: "memory");
        float lam[16], aa[16];
        {
            LAS float* Zs = (LAS float*)(PW + PW_ZS);
            {
                bf16x8 ta[2];
#pragma unroll
                for (int ks = 0; ks < 2; ++ks) ta[ks] = *(const LAS bf16x8*)(PW + PW_TLW + c16 * SG_ST + (32 * ks + 8 * g) * 2);
#pragma unroll
                for (int ct = 0; ct < 4; ++ct) { f32x4 z = {0.f, 0.f, 0.f, 0.f};
#pragma unroll
                    for (int ks = 0; ks < 2; ++ks) z = MFMA16(ta[ks], __builtin_bit_cast(bf16x8, wop[(ct * 2 + ks) * 64]), z);
#pragma unroll
                    for (int rg = 0; rg < 4; ++rg) Zs[(4 * g + rg) * ZS_ST + 16 * ct + c16] = z[rg]; }
                float l = 0.f;
#pragma unroll
                for (int i = 0; i < 16; ++i) { l += -0.60653065971f * sigmoidf_(w0c + Zs[i * ZS_ST + lane]); lam[i] = l; }
            }
            asm volatile("" ::: "memory");
            {
                bf16x8 tb[2];
#pragma unroll
                for (int ks = 0; ks < 2; ++ks) tb[ks] = *(const LAS bf16x8*)(PW + PW_LAB + c16 * SG_ST + (32 * ks + 8 * g) * 2);
#pragma unroll
                for (int ct = 0; ct < 4; ++ct) { f32x4 z = {0.f, 0.f, 0.f, 0.f};
#pragma unroll
                    for (int ks = 0; ks < 2; ++ks) z = MFMA16(tb[ks], __builtin_bit_cast(bf16x8, wop[512 + (ct * 2 + ks) * 64]), z);
#pragma unroll
                    for (int rg = 0; rg < 4; ++rg) Zs[(4 * g + rg) * ZS_ST + 16 * ct + c16] = z[rg]; }
#pragma unroll
                for (int i = 0; i < 16; ++i) aa[i] = sigmoidf_(a0c + Zs[i * ZS_ST + lane]);
            }
        }
        {
            {
                float n2[16];
#pragma unroll
                for (int i = 0; i < 16; ++i) { const float kk = k_[i] * kkc; n2[i] = kk * kk; }
                wave_sum16(n2, lane);
                unsigned bh[8], kh[8];
                float e1 = 1.f;
#pragma unroll
                for (int i = 0; i < 16; i += 2) {
                    float bt2[2], kt2[2];
#pragma unroll
                    for (int e = 0; e < 2; ++e) {
                        const float kk = k_[i + e] * kkc * __builtin_amdgcn_rsqf(n2[i + e] + 1e-12f), kd = k_[i + e] * (1.f + (aa[i + e] - 1.f) * kac), bb = kk * aa[i + e];
                        const float e3 = __expf(lam[i + e]), e2 = __builtin_amdgcn_rcpf(e3);
                        lam[i + e] = e3;
                        st_bf16(GB_ + G_AT + (16 * w + i + e) * SG_ST + lane * 2, -kk * e1);
                        bt2[e] = bb * e2; kt2[e] = kd * e2; e1 = e3;
                    }
                    const unsigned bp = pk2(bt2[0], bt2[1]), kp = pk2(kt2[0], kt2[1]);
                    bh[i >> 1] = bp; kh[i >> 1] = kp;
                    *(LAS bf16*)(PW + PW_TLW + i * SG_ST + lane * 2) = (bf16)bp; *(LAS bf16*)(PW + PW_TLW + (i + 1) * SG_ST + lane * 2) = (bf16)(bp >> 16);
                    *(LAS bf16*)(PW + PW_LAB + i * SG_ST + lane * 2) = (bf16)kp; *(LAS bf16*)(PW + PW_LAB + (i + 1) * SG_ST + lane * 2) = (bf16)(kp >> 16);
                }
#pragma unroll
                for (int q = 0; q < 4; ++q) {
                    *(LAS v2u*)(GB_ + G_BH + (w * 64 + lane) * 32 + 8 * q) = (v2u){bh[2 * q], bh[2 * q + 1]};
                    *(LAS v2u*)(GB_ + G_KH + (w * 64 + lane) * 32 + 8 * q) = (v2u){kh[2 * q], kh[2 * q + 1]};
                }
            }
            float r_[16];
            pf_consume(stg, pR, lane, mRA, mRB, r_);
#pragma unroll
            for (int i = 0; i < 16; ++i) { bon[i] = r_[i] * k_[i] * rkc; st_bf16(GB_ + G_RT + (16 * w + i) * SG_ST + lane * 2, r_[i] * lam[i]); }
            wave_sum16(bon, lane);
        }
        ((LAS float*)(GB_ + G_GAM))[w * 64 + lane] = lam[15];
        {
            pf_consume(stg, pV, lane, mVA, mVB, v_);
            unsigned vt[8];
#pragma unroll
            for (int i = 0; i < 16; i += 2) { vt[i >> 1] = pk2(v_[i], v_[i + 1]); v_[i] *= bon[i]; v_[i + 1] *= bon[i + 1]; }
            asm volatile("" ::: "memory");
#pragma unroll
            for (int q = 0; q < 4; ++q) *(LAS v2u*)(PW + PW_VT + lane * VT_ST + 8 * q) = (v2u){vt[2 * q], vt[2 * q + 1]};
        }
        asm volatile("" ::: "memory");
        {
            bf16x8 fa[2], fr[2], fb[2], fk[2];
#pragma unroll
            for (int ks = 0; ks < 2; ++ks) {
                fa[ks] = *(const LAS bf16x8*)(GB_ + G_AT + (16 * w + c16) * SG_ST + (32 * ks + 8 * g) * 2); fr[ks] = *(const LAS bf16x8*)(GB_ + G_RT + (16 * w + c16) * SG_ST + (32 * ks + 8 * g) * 2);
                fb[ks] = *(const LAS bf16x8*)(PW + PW_TLW + c16 * SG_ST + (32 * ks + 8 * g) * 2); fk[ks] = *(const LAS bf16x8*)(PW + PW_LAB + c16 * SG_ST + (32 * ks + 8 * g) * 2);
            }
            f32x4 lab = {0.f, 0.f, 0.f, 0.f}, lak = lab, lbr = lab, lkr = lab;
#pragma unroll
            for (int ks = 0; ks < 2; ++ks) { lab = MFMA16(fa[ks], fb[ks], lab); lak = MFMA16(fa[ks], fk[ks], lak); lbr = MFMA16(fr[ks], fb[ks], lbr); lkr = MFMA16(fr[ks], fk[ks], lkr); }
            LAS float* Lf = (LAS float*)(PW + PW_LF);
#pragma unroll
            for (int rg = 0; rg < 4; ++rg) { const int i = 4 * g + rg, j = c16;
                Lf[i * 16 + j] = j < i ? lab[rg] : 0.f;
                st_bf16(GB_ + G_LAK + (w * 16 + i) * 32 + j * 2, j < i ? lak[rg] : 0.f);
                st_bf16(GB_ + G_LBR + (w * 16 + i) * 32 + j * 2, j <= i ? lbr[rg] : 0.f);
                st_bf16(GB_ + G_LKR + (w * 16 + i) * 32 + j * 2, j <= i ? lkr[rg] : 0.f); }
            float tm[16];
#pragma unroll
            for (int i = 0; i < 16; ++i) { float a = (i == c16) ? 1.f : 0.f;
#pragma unroll
                for (int j = 0; j < i; ++j) a += Lf[i * 16 + j] * tm[j];
                tm[i] = a; }
            if (lane < 16) {
#pragma unroll
                for (int i = 0; i < 16; ++i) st_bf16(GB_ + G_TM + (w * 16 + i) * 32 + lane * 2, tm[i]); }
        }
        }
        __syncthreads();
        const PfRows PR = pf_rows(T, p0 + 64, d, lane);
        const float* yop = YB + (size_t)(m0 + (d ? T - 1 - p0 : p0)) * D + hc; const long ystep = d ? -(long)D : (long)D;
        float yo[16];
        {
            lane = lane0; asm volatile("" : "+v"(lane)); c16 = lane & 15; g = lane >> 4;
            const LAS unsigned char* at_b = GB_ + G_AT + c16 * SG_ST + 8 * g;
            const LAS unsigned char* rt_b = GB_ + G_RT + c16 * SG_ST + 8 * g;
            const LAS unsigned char* vt_b = GB_ + G_PRIV + PW_VT + (16 * w + c16) * VT_ST + 8 * g;
            const LAS unsigned char* l_b = GB_ + c16 * 32 + 8 * g;
            const LAS unsigned char* gm_b = GB_ + G_GAM + 16 * g;
            LAS float* yc_b = (LAS float*)(GB_ + G_PRIV + PW_TLW) + (4 * g) * ZS_ST + 16 * w + c16;
#pragma unroll
            for (int sc = 0; sc < 4; ++sc) {
                if (sc == 0) { pf_issue(UB, PR, cW, pW); pf_issue(UB, PR, cA, pA); }
                if (sc == 1) { pf_issue(UB, PR, cK, pK); pf_issue(UB, PR, cR, pR); }
                if (sc == 2) { pf_issue(UB, PR, cV, pV);
#pragma unroll
                    for (int i = 0; i < 6; ++i) yo[i] = yop[i * ystep]; }
                if (sc == 3) {
#pragma unroll
                    for (int i = 6; i < 16; ++i) yo[i] = yop[i * ystep]; }
                const LAS unsigned char* at_p = at_b + sc * 16 * SG_ST; const LAS unsigned char* rt_p = rt_b + sc * 16 * SG_ST;
                const bf16x8 sop0 = pk8(S[0], S[1]), sop1 = pk8(S[2], S[3]);
                const bf16x8 at0 = mk8(*(const LAS v2u*)(at_p), *(const LAS v2u*)(at_p + 32)), at1 = mk8(*(const LAS v2u*)(at_p + 64), *(const LAS v2u*)(at_p + 96));
                const bf16x8 rt0 = mk8(*(const LAS v2u*)(rt_p), *(const LAS v2u*)(rt_p + 32)), rt1 = mk8(*(const LAS v2u*)(rt_p + 64), *(const LAS v2u*)(rt_p + 96));
                const v2u vt2 = *(const LAS v2u*)(vt_b + sc * PW_SIZE);
                const bf16x8 alak = mk8(*(const LAS v2u*)(l_b + G_LAK + sc * 512), z2);
                const bf16x8 atm = mk8(*(const LAS v2u*)(l_b + G_TM + sc * 512), z2);
                const bf16x8 albk = mk8(*(const LAS v2u*)(l_b + G_LBR + sc * 512), *(const LAS v2u*)(l_b + G_LKR + sc * 512));
                f32x4 X = {0.f, 0.f, 0.f, 0.f}, Y = X;
                X = MFMA16(at0, sop0, X); Y = MFMA16(rt0, sop0, Y); X = MFMA16(at1, sop1, X); Y = MFMA16(rt1, sop1, Y); X = MFMA16(alak, mk8(vt2, z2), X);
                const v4u xo = {pk2(X[0], X[1]), pk2(X[2], X[3]), 0u, 0u};
                f32x4 U = {0.f, 0.f, 0.f, 0.f};
                U = MFMA16(atm, __builtin_bit_cast(bf16x8, xo), U);
                const v4u uo = {pk2(U[0], U[1]), pk2(U[2], U[3]), vt2.x, vt2.y};
                const bf16x8 uvop = __builtin_bit_cast(bf16x8, uo);
                Y = MFMA16(albk, uvop, Y);
#pragma unroll
                for (int kt = 0; kt < 4; ++kt) {
                    const bf16x8 abk = mk8(*(const LAS v2u*)(l_b + G_BH + (sc * 64 + 16 * kt) * 32), *(const LAS v2u*)(l_b + G_KH + (sc * 64 + 16 * kt) * 32));
                    const f32x4 gm = *(const LAS f32x4*)(gm_b + (sc * 64 + 16 * kt) * 4);
                    S[kt] = MFMA16(abk, uvop, S[kt]) * gm;
                }
                LAS float* yc = yc_b + sc * (PW_SIZE / 4);
#pragma unroll
                for (int rg = 0; rg < 4; ++rg) yc[rg * ZS_ST] = Y[rg];
            }
        }
        __syncthreads();
#pragma unroll 1
        for (int rep_ = 0; rep_ < SREP_POST; ++rep_)
        {
            lane = lane0; asm volatile("" : "+v"(lane)); hc = hh * 64 + lane;
            const LAS float* yc = (const LAS float*)(PW + PW_TLW);
            float y_[16];
#pragma unroll
            for (int i = 0; i < 16; ++i) y_[i] = yc[i * ZS_ST + lane];
            if (first) {
#pragma unroll
                for (int i = 0; i < 16; ++i) { const int p = p0 + i, t = d ? T - 1 - p : p; YB[(size_t)(m0 + t) * D + hc] = y_[i]; }
            } else {
                const float lng = F.in[I_LNG][hc], lnb = F.in[I_LNB][hc];
                unsigned short gb_[16];
#pragma unroll
                for (int i = 0; i < 16; ++i) { const int p = p0 + i, t = d ? T - 1 - p : p; gb_[i] = *(const unsigned short*)(GBp + (size_t)(m0 + t) * D + hc); }
                float s1[16];
#pragma unroll
                for (int i = 0; i < 16; ++i) { y_[i] += yo[i]; s1[i] = y_[i]; }
                wave_sum16(s1, lane);
#pragma unroll
                for (int i = 0; i < 16; ++i) { y_[i] -= s1[i] * (1.f / 64.f); s1[i] = y_[i] * y_[i]; }
                wave_sum16(s1, lane);
#pragma unroll
                for (int i = 0; i < 16; ++i) { const int p = p0 + i, t = d ? T - 1 - p : p; const size_t m = (size_t)(m0 + t);
                    const float yn = y_[i] * __builtin_amdgcn_rsqf(s1[i] * (1.f / 64.f) + 64e-5f) * lng + lnb + v_[i];
                    MIX[m * DMIX + 1024 + hc] = (bf16)f2bf_hw(yn * bf2f((bf16)gb_[i])); }
            }
        }
    }
    if (!lat) {
        lane = lane0; asm volatile("" : "+v"(lane)); c16 = lane & 15; g = lane >> 4;
        float* sp = F.out + OUT_ST + ((size_t)((b * 2 + d) * NHB + hh) * 64 + 16 * w + c16) * 64 + 4 * g;
#pragma unroll
        for (int kt = 0; kt < 4; ++kt) *(f32x4*)(sp + 16 * kt) = S[kt];
    }
}

template <int QW, int MASK> __device__ __forceinline__ void p3_mixers(Frame& F, const XcdBarrier& gbar) {
    float lam;
    { const float a = F.in[I_LQ1][F.lane] * F.in[I_LK1][F.lane], bq = F.in[I_LQ2][F.lane] * F.in[I_LK2][F.lane];
      lam = __expf(wave_sum(a)) - __expf(wave_sum(bq)) + 0.2f; }
    constexpr int N_SC = NBC * NHB, N_AL = NBL * NH * (LSEQ / 128), N_AC = NBC * NH * (SEQ / 128);
    constexpr int NU = N_AL + N_SC + N_AC;
    volatile LAS int* slot = (volatile LAS int*)(F.lds + MISC_OFF + 64);
    bool chain_first = (int)blockIdx.x < NLATB;
    for (;;) {
        int u, sb, sh, git = -1; bool slat = false, is_scan;
        if (chain_first) { chain_first = false; is_scan = true; slat = true; sb = (int)blockIdx.x / NHB; sh = (int)blockIdx.x % NHB; git = LAT_BAR_IT; u = 0; }
        else {
            __syncthreads();
            if (F.tid == 0) *slot = (int)__hip_atomic_fetch_add((unsigned*)(F.ctl + CW_Q3 + 64 * QW), 1u, RLX_AGENT);
            __syncthreads();
            u = *slot;
            if (u >= NU) break;
            is_scan = u < N_SC;
            sb = u / NHB; sh = u % NHB;
        }
        if (is_scan) { scan_unit3(F, sb, sh, slat, &gbar, git); continue; }
        { u -= N_SC; const bool lt = u < N_AL; if (!lt) u -= N_AL; attn_unit(F, u, lt, lam); }
    }
}

template <bool DUMMY> __device__ __forceinline__ void p5_final(Frame& F) {
    int ln = F.lane; asm volatile("" : "+v"(ln));
    const float* ssq = (const float*)(F.ws + WS_SSQ);
    const int gw = blockIdx.x * NWAVES + F.wave, NGW = F.G * NWAVES;
    for (int m = gw; m < M; m += NGW) {
        float s = ln < 16 ? ssq[(size_t)m * 16 + ln] : 0.f;
        s = wave_sum(s);
        const float rstd = 1.f / sqrtf(s * (1.f / D) + 1e-6f);
        float* yr = F.out + OUT_Y + (size_t)m * D;
#pragma unroll
        for (int j = 0; j < 4; ++j) { const int c = 4 * ln + 256 * j; const f32x4 v = *(const f32x4*)(yr + c), g = *(const f32x4*)(F.in[I_FG] + c); *(f32x4*)(yr + c) = DUMMY ? v : v * rstd * g; }
    }
}

__global__ void __launch_bounds__(NTHR, 2) hymba_fwd(Args args) {
    extern __shared__ __attribute__((aligned(16))) unsigned char lds[];
    Frame F;
    F.lds = (LAS unsigned char*)lds;
    F.MISC = (volatile LAS unsigned*)(F.lds + MISC_OFF);
    F.tid = threadIdx.x; F.lane = F.tid & 63; F.wave = __builtin_amdgcn_readfirstlane(F.tid >> 6);
    F.G = gridDim.x; F.in = args.in; F.out = args.out; F.ws = args.ws;
    F.ctl = (gu32*)(args.ws + WS_CTL);
    for (int u = F.tid; u < (LDS_BYTES - LDSCTL_OFF) / 4; u += NTHR) ((LAS unsigned*)(F.lds + LDSCTL_OFF))[u] = 0u;
    __syncthreads();
    XcdBarrier bar; bar.bar = (unsigned*)(F.ctl + CW_BAR); bar.x = 0; bar.st = nullptr;
    if (N_LAUNCHES != PER_PHASE) bar = xcd_barrier_post((unsigned*)(F.ctl + CW_BAR), F.MISC + 8);
#define GRID_BAR() do { if (N_LAUNCHES != PER_PHASE) xcd_barrier(bar); } while (0)
    const int lo = args.ph_lo, hi = args.ph_hi;
#define IN(k) (lo <= (k) && (k) < hi)
#define BOTH(k) (IN(k) && IN((k) + 1))
#ifndef REP0
#define REP0 1
#endif
#ifndef REP2
#define REP2 1
#endif
#ifndef REP3MASK
#define REP3MASK 0
#endif
#ifndef REP4
#define REP4 1
#endif
#define RELANE() do { int t_ = threadIdx.x; asm volatile("" : "+v"(t_)); F.tid = t_; F.lane = t_ & 63; } while (0)
    {
        f32x4 xv[5][4];
        p0_prologue(F); RELANE(); p1_load<0, 3>(F, xv); GRID_BAR();
        p1_load<3, 5>(F, xv); p1_norm(F, xv); GRID_BAR();
    }
    RELANE();
    if (IN(2)) {
        const pg8::Gemm g{(const bf16*)(F.ws + WS_XN), (const bf16*)(F.ws + WS_WIN), M, DIN, D};
        {
            const f32x4 rv = *(const f32x4*)((const float*)(F.ws + WS_ROPE) + 4 * F.tid);
            *(LAS f32x4*)(F.lds + ROPE_LDS + 16 * F.tid) = rv;
            __syncthreads();
        }
        const EpiIn E{F.ws, F.out, (const LAS float*)(F.lds + ROPE_LDS)};
        const bool chain = (int)blockIdx.x < NLATB;
#pragma unroll 1
        for (int part = 0; part < 2; ++part) {
            if (part == 1 && chain) break;
            ListOrder S;
            if (part == 0) S.init(F.G, (int)blockIdx.x, 0, P2A_UNITS); else S.init(F.G - NLATB, (int)blockIdx.x - NLATB, P2A_UNITS, P2_UNITS);
            pg8::gemm_phase<EpiIn, ListOrder, true, true>(F.lds + RING_OFF, g, S, E);
            GRID_BAR();
        }
    }
    RELANE();
    if (IN(3)) { p3_mixers<0, 15>(F, bar); if (BOTH(3)) GRID_BAR(); }
    RELANE();
    if (IN(4)) {
        pg8::Gemm g{(const bf16*)(F.ws + WS_MIX), (const bf16*)(F.ws + WS_WOUT), M, D, DMIX}; pg8::StaticOrder S; S.init(M, D, F.G, (int)blockIdx.x);
        EpiOutFused E{F.ws, F.out, F.in[I_XP], F.in[I_XS], F.in[I_FG], F.ctl};
        pg8::gemm_phase<EpiOutFused, pg8::StaticOrder, false, true>(F.lds + RING_OFF, g, S, E);
    }
#undef IN
#undef BOTH
}

extern "C" void kernel_launch(void* const* d_in, const int* in_sizes, int n_in, void* d_out, int out_size, void* d_ws, size_t ws_size, hipStream_t stream) {
    static int grid = 0;
    if (grid == 0) {
        if (n_in != N_IN || out_size != OUT_END || ws_size < WS_END) { fprintf(stderr, "kernel_launch: unexpected sizes n_in %d out %d ws %zu\n", n_in, out_size, ws_size); grid = -1; return; }
        int dev = 0, cus = 0, per_cu = 0;
        if (hipGetDevice(&dev) != hipSuccess || hipDeviceGetAttribute(&cus, hipDeviceAttributeMultiprocessorCount, dev) != hipSuccess) { grid = -1; return; }
        if (hipFuncSetAttribute((const void*)hymba_fwd, hipFuncAttributeMaxDynamicSharedMemorySize, LDS_BYTES) != hipSuccess) { fprintf(stderr, "kernel_launch: hipFuncSetAttribute failed\n"); grid = -1; return; }
        if (hipOccupancyMaxActiveBlocksPerMultiprocessor(&per_cu, (const void*)hymba_fwd, NTHR, LDS_BYTES) != hipSuccess || per_cu < 1) { fprintf(stderr, "kernel_launch: occupancy query says %d\n", per_cu); per_cu = 1; }
        (void)hipGetLastError();
        grid = cus;
        if (grid != 256) { fprintf(stderr, "kernel_launch: built for a 256-CU device (got %d CUs)\n", cus); grid = -1; return; }
    }
    if (grid < 0) return;
    if (hipMemsetAsync((char*)d_ws + WS_CTL, 0, CTL_ZERO_BYTES, stream) != hipSuccess) return;
    Args a{};
    for (int i = 0; i < N_IN; ++i) a.in[i] = (const float*)d_in[i];
    a.out = (float*)d_out; a.ws = (unsigned char*)d_ws;
    a.ph_lo = 0; a.ph_hi = PER_PHASE; a.li = 0;
    hipLaunchKernelGGL(hymba_fwd, dim3(grid), dim3(NTHR), LDS_BYTES, stream, a);
}
```

```cpp
#include <hip/hip_runtime.h>
#include <cstdio>
#include <cstdint>

#ifndef MK_N_LAUNCHES
#define MK_N_LAUNCHES 1
#endif

namespace pg8 {
#define PG8_LAS __attribute__((address_space(3)))
typedef unsigned short bf16_t;
typedef short bf16x8 __attribute__((ext_vector_type(8)));
typedef float f32x4 __attribute__((ext_vector_type(4)));
typedef unsigned u32x4 __attribute__((ext_vector_type(4)));
constexpr int BM = 256, BK = 64, HALF = 128, HTB = HALF * BK * 2, STAGE_BYTES = 8 * HTB, NXCD = 8, WGM = 8;

__host__ __device__ __forceinline__ int lds_byte(int r, int c) { const int st = (r >> 4) * 2 + (c >> 5), rr = r & 15, cc = c & 31, ob = rr * 64 + cc * 2; return st * 1024 + (ob ^ (((ob >> 9) & 1) << 5)); }
__host__ __device__ __forceinline__ void stage_rc(int b, int& R, int& C) { const int st = b / 1024, sb = b % 1024, swz = sb ^ (((sb >> 9) & 1) << 5); R = (st >> 1) * 16 + swz / 64; C = (st & 1) * 32 + (swz % 64) / 2; }
__host__ __device__ __forceinline__ int perm32(int rho) { const int n = rho >> 4, i = rho & 15; return 8 * (i >> 2) + 4 * n + (i & 3); }

struct Unit { int pm, pn; };
struct Gemm { const bf16_t* A; const bf16_t* Bt; int M, N, K; };

struct StaticOrder {
    int nM, nN, nwg, G, c;
    __host__ __device__ void init(int M, int N, int G_, int c_) { nM = M / BM; nN = N / BM; nwg = nM * nN; G = G_; c = c_; }
    __host__ __device__ bool next(int i, Unit& u) const {
        const long L = (long)i * G + c; if (L >= nwg) return false;
        int wgid = (int)L; { const int q = nwg / NXCD, r = nwg % NXCD, xcd = wgid % NXCD, off = wgid / NXCD; wgid = (xcd < r ? xcd * (q + 1) : r * (q + 1) + (xcd - r) * q) + off; }
        const int nig = WGM * nN, gid = wgid / nig, fm = gid * WGM, gsz = (nM - fm) < WGM ? (nM - fm) : WGM;
        u.pm = fm + ((wgid % nig) % gsz); u.pn = (wgid % nig) / gsz; return true;
    }
    __device__ __forceinline__ void a_ready(const Unit&) const {}
    __device__ __forceinline__ void done(const Unit&) const {}
};

__device__ __forceinline__ unsigned cvt_pk_bf16(float lo, float hi) { unsigned r; asm volatile("v_cvt_pk_bf16_f32 %0, %1, %2" : "=v"(r) : "v"(lo), "v"(hi)); return r; }

template <class Epi, class Sched, bool ALIGN_EPI = false, bool SP2 = false>
__device__ __forceinline__ void gemm_phase(PG8_LAS unsigned char* lds, const Gemm g, const Sched& S, const Epi& E) {
    int tid = threadIdx.x; asm volatile("" : "+v"(tid));
    const int wid = __builtin_amdgcn_readfirstlane(tid >> 6), lane = tid & 63, wr = wid >> 2, wc = wid & 3, fr = lane & 15, fq = lane >> 4;
    const int K = g.K, nt = K / BK;
    unsigned voffA[2], voffB[2];
#pragma unroll
    for (int i = 0; i < 2; ++i) { int R, C; stage_rc(tid * 16 + i * 8192, R, C); const int Rb = Epi::PERM ? ((R & ~31) + perm32(R & 31)) : R;
        voffA[i] = (unsigned)(R * K + C) * 2u; voffB[i] = (unsigned)(Rb * K + C) * 2u; }
    const size_t kstep = (size_t)(BK * 2);
    const size_t hstep = (size_t)HALF * K * 2;
    const size_t tstep = 2 * hstep;
    const unsigned ldsw = (unsigned)wid * 1024u;
    const int aoff = lds_byte(wr * 64 + fr, fq * 8), boff = lds_byte(wc * 32 + fr, fq * 8);
#define PG8_SA(b, h) (((b) * 2 + (h)) * HTB)
#define PG8_SB(b, h) ((4 + (b) * 2 + (h)) * HTB)
#define PG8_STAGE(bufoff, gbase, voff) do { _Pragma("unroll") for (int _i = 0; _i < 2; ++_i) \
        __builtin_amdgcn_global_load_lds((const unsigned*)((const char*)(gbase) + (voff)[_i]), (PG8_LAS unsigned*)(lds + (bufoff) + ldsw + _i * 8192), 16, 0, 0); } while (0)
#define PG8_LDA(dst, b, h) do { _Pragma("unroll") for (int m = 0; m < 4; ++m) _Pragma("unroll") for (int k = 0; k < 2; ++k) dst[m][k] = *(const PG8_LAS bf16x8*)(lds + PG8_SA(b, h) + aoff + m * 2048 + k * 1024); } while (0)
#define PG8_LDB(dst, b, h) do { _Pragma("unroll") for (int n = 0; n < 2; ++n) _Pragma("unroll") for (int k = 0; k < 2; ++k) dst[n][k] = *(const PG8_LAS bf16x8*)(lds + PG8_SB(b, h) + boff + n * 2048 + k * 1024); } while (0)
#define PG8_MMA(ai, bj, At, Bt) do { __builtin_amdgcn_s_setprio(1); _Pragma("unroll") for (int m = 0; m < 4; ++m) _Pragma("unroll") for (int n = 0; n < 2; ++n) _Pragma("unroll") for (int k = 0; k < 2; ++k) \
        acc[ai][bj][m][n] = __builtin_amdgcn_mfma_f32_16x16x32_bf16(Bt[n][k], At[m][k], acc[ai][bj][m][n], 0, 0, 0); __builtin_amdgcn_s_setprio(0); } while (0)
#define PG8_WAIT_V(n) asm volatile("s_waitcnt vmcnt(" #n ")" ::: "memory")
#define PG8_WAIT_L(n) asm volatile("s_waitcnt lgkmcnt(" #n ")" ::: "memory")
#define PG8_BAR __builtin_amdgcn_s_barrier()
#define PG8_SCHED __builtin_amdgcn_sched_barrier(0)
    Unit cur, nxt; int ui = 0;
    if (!S.next(0, cur)) return;
    f32x4 acc[2][2][4][2];
#pragma unroll
    for (int a = 0; a < 2; ++a)
#pragma unroll
        for (int b = 0; b < 2; ++b)
#pragma unroll
            for (int m = 0; m < 4; ++m)
#pragma unroll
                for (int n = 0; n < 2; ++n) acc[a][b][m][n] = (f32x4){0.f, 0.f, 0.f, 0.f};
    bf16x8 At[4][2], B0[2][2], B1[2][2];
    const char* cA = (const char*)g.A + (size_t)cur.pm * tstep; const char* cB = (const char*)g.Bt + (size_t)cur.pn * tstep;
    S.a_ready(cur);
    if constexpr (SP2) {
        PG8_STAGE(PG8_SB(0, 0), cB, voffB); PG8_STAGE(PG8_SB(0, 1), cB + hstep, voffB); PG8_STAGE(PG8_SA(0, 0), cA, voffA); PG8_STAGE(PG8_SA(0, 1), cA + hstep, voffA);
        if (wr == 1) PG8_BAR;
        PG8_WAIT_V(2); PG8_BAR;
        PG8_STAGE(PG8_SB(1, 0), cB + kstep, voffB); PG8_STAGE(PG8_SA(1, 0), cA + kstep, voffA); PG8_STAGE(PG8_SB(1, 1), cB + hstep + kstep, voffB);
        PG8_WAIT_V(6); PG8_BAR;
    } else {
        PG8_STAGE(PG8_SB(0, 0), cB, voffB); PG8_STAGE(PG8_SA(0, 0), cA, voffA); PG8_STAGE(PG8_SB(0, 1), cB + hstep, voffB); PG8_STAGE(PG8_SA(0, 1), cA + hstep, voffA);
        if (wr == 1) PG8_BAR;
        PG8_WAIT_V(4); PG8_BAR;
        PG8_STAGE(PG8_SB(1, 0), cB + kstep, voffB); PG8_STAGE(PG8_SA(1, 0), cA + kstep, voffA); PG8_STAGE(PG8_SB(1, 1), cB + hstep + kstep, voffB);
        PG8_WAIT_V(6); PG8_BAR;
    }
    for (;;) {
        const bool has_next = S.next(ui + 1, nxt);
        const char* nA = has_next ? (const char*)g.A + (size_t)nxt.pm * tstep : cA; const char* nB = has_next ? (const char*)g.Bt + (size_t)nxt.pn * tstep : cB;
        for (int t = 0; t < nt; t += 2) {
            const bool last = (t == nt - 2);
            const char* a1 = cA + (size_t)(t + 1) * kstep;
            const char* a2 = last ? nA : cA + (size_t)(t + 2) * kstep; const char* b2 = last ? nB : cB + (size_t)(t + 2) * kstep;
            const char* a3 = a2 + kstep; const char* b3 = b2 + kstep;
            if (last && has_next) S.a_ready(nxt);
            if constexpr (SP2) {
            PG8_LDB(B0, 0, 0); PG8_LDB(B1, 0, 1); PG8_SCHED; PG8_LDA(At, 0, 0); PG8_STAGE(PG8_SA(1, 1), a1 + hstep, voffA);
            PG8_WAIT_V(8); PG8_WAIT_L(0); PG8_BAR; PG8_MMA(0, 0, At, B0); PG8_MMA(0, 1, At, B1); PG8_BAR; PG8_SCHED;
            PG8_LDA(At, 0, 1); PG8_STAGE(PG8_SB(0, 0), b2, voffB); PG8_STAGE(PG8_SB(0, 1), b2 + hstep, voffB); PG8_STAGE(PG8_SA(0, 0), a2, voffA);
            PG8_WAIT_V(8); PG8_WAIT_L(0); PG8_BAR; PG8_MMA(1, 0, At, B0); PG8_MMA(1, 1, At, B1); PG8_BAR; PG8_SCHED;
            PG8_LDB(B0, 1, 0); PG8_LDB(B1, 1, 1); PG8_SCHED; PG8_LDA(At, 1, 0); PG8_STAGE(PG8_SA(0, 1), a2 + hstep, voffA);
            PG8_WAIT_V(8); PG8_WAIT_L(0); PG8_BAR; PG8_MMA(0, 0, At, B0); PG8_MMA(0, 1, At, B1); PG8_BAR; PG8_SCHED;
            PG8_LDA(At, 1, 1); PG8_STAGE(PG8_SB(1, 0), b3, voffB); PG8_STAGE(PG8_SB(1, 1), b3 + hstep, voffB); PG8_STAGE(PG8_SA(1, 0), a3, voffA);
            PG8_WAIT_V(8); PG8_WAIT_L(0); PG8_BAR; PG8_MMA(1, 0, At, B0); PG8_MMA(1, 1, At, B1); PG8_BAR; PG8_SCHED;
            } else {
            PG8_LDB(B0, 0, 0); PG8_SCHED; PG8_LDA(At, 0, 0); PG8_STAGE(PG8_SA(1, 1), a1 + hstep, voffA);
            PG8_WAIT_L(8); PG8_BAR; PG8_WAIT_L(0); PG8_MMA(0, 0, At, B0); PG8_BAR; PG8_SCHED;
            PG8_LDB(B1, 0, 1); PG8_STAGE(PG8_SB(0, 0), b2, voffB);
            PG8_BAR; PG8_WAIT_L(0); PG8_MMA(0, 1, At, B1); PG8_BAR;
            PG8_LDA(At, 0, 1); PG8_STAGE(PG8_SA(0, 0), a2, voffA);
            PG8_BAR; PG8_WAIT_L(0); PG8_MMA(1, 0, At, B0); PG8_BAR; PG8_SCHED;
            PG8_STAGE(PG8_SB(0, 1), b2 + hstep, voffB);
            PG8_WAIT_V(6); PG8_BAR; PG8_MMA(1, 1, At, B1); PG8_BAR;
            PG8_LDB(B0, 1, 0); PG8_SCHED; PG8_LDA(At, 1, 0); PG8_STAGE(PG8_SA(0, 1), a2 + hstep, voffA);
            PG8_WAIT_L(8); PG8_BAR; PG8_WAIT_L(0); PG8_MMA(0, 0, At, B0); PG8_BAR; PG8_SCHED;
            PG8_LDB(B1, 1, 1); PG8_STAGE(PG8_SB(1, 0), b3, voffB);
            PG8_BAR; PG8_WAIT_L(0); PG8_MMA(0, 1, At, B1); PG8_BAR;
            PG8_LDA(At, 1, 1); PG8_STAGE(PG8_SA(1, 0), a3, voffA);
            PG8_BAR; PG8_WAIT_L(0); PG8_MMA(1, 0, At, B0); PG8_BAR; PG8_SCHED;
            PG8_STAGE(PG8_SB(1, 1), b3 + hstep, voffB);
            PG8_WAIT_V(6); PG8_BAR; PG8_MMA(1, 1, At, B1); PG8_BAR;
            }
        }
        if constexpr (ALIGN_EPI) { if (wr == 0) PG8_BAR; }
        if constexpr (!Epi::AFTER_DRAIN) { E(acc, cur, wr, wc, fr, fq); S.done(cur); }
        if (!has_next) break;
#pragma unroll
        for (int a = 0; a < 2; ++a)
#pragma unroll
            for (int b = 0; b < 2; ++b)
#pragma unroll
                for (int m = 0; m < 4; ++m)
#pragma unroll
                    for (int n = 0; n < 2; ++n) acc[a][b][m][n] = (f32x4){0.f, 0.f, 0.f, 0.f};
        cur = nxt; cA = nA; cB = nB; ++ui;
        if constexpr (ALIGN_EPI) { if (wr == 1) PG8_BAR; }
    }
    PG8_WAIT_V(0);
    if constexpr (!ALIGN_EPI) { if (wr == 0) PG8_BAR; }
    PG8_BAR;
    if constexpr (Epi::AFTER_DRAIN) { E.fused(acc, cur, wr, wc, fr, fq, lds, wid, lane); S.done(cur); }
#undef PG8_SA
#undef PG8_SB
#undef PG8_STAGE
#undef PG8_LDA
#undef PG8_LDB
#undef PG8_MMA
#undef PG8_WAIT_V
#undef PG8_WAIT_L
#undef PG8_BAR
#undef PG8_SCHED
}
}

constexpr int NWAVES = 8, NTHR = 512;
constexpr int N_LAUNCHES = MK_N_LAUNCHES;
constexpr int PER_PHASE = 6;
constexpr int D = 1024, NBC = 32, SEQ = 256, NBL = 2, LSEQ = 1024, PAST = 512, KLAT = PAST + LSEQ;
constexpr int MC = NBC * SEQ, ML = NBL * LSEQ, M = MC + ML;
constexpr int DIN = 8448, DMIX = 2048, DSH = 3328, NH = 8, NHB = 16;
constexpr int OUT_Y = 0, OUT_CK = M * D, OUT_CV = OUT_CK + MC * D, OUT_ST = OUT_CV + MC * D, OUT_END = OUT_ST + NBC * 2 * NHB * 64 * 64;

enum { I_XP = 0, I_XS, I_CK, I_CV, I_ST, I_C, I_CCTX, I_NG, I_WADA, I_BADA, I_WIN, I_LQ1, I_LK1, I_LQ2, I_LK2, I_SUBG, I_MU, I_W0, I_W2, I_A0, I_A2, I_KK, I_KA, I_RK, I_LNG, I_LNB, I_WOUT, I_FG, N_IN };

constexpr size_t MiB = 1u << 20;
constexpr size_t WS_CTL = 0, CTL_ZERO_BYTES = 1 * MiB;
constexpr size_t WS_MODP = 1 * MiB;
constexpr size_t WS_MODF = WS_MODP + 640 * 1024;
constexpr size_t WS_ROPE = WS_MODF + 64 * 1024;
constexpr size_t WS_SSQ = 2 * MiB;
constexpr size_t WS_WOP = 3 * MiB;
constexpr size_t WS_WIN = 4 * MiB;
constexpr size_t WS_WOUT = 21 * MiB;
constexpr size_t WS_XN = 25 * MiB;
constexpr size_t WS_Q = 45 * MiB;
constexpr size_t WS_KC = 65 * MiB;
constexpr size_t WS_KL = 81 * MiB;
constexpr size_t WS_VTC = 87 * MiB;
constexpr size_t WS_VTL = 103 * MiB;
constexpr size_t WS_GA = 109 * MiB;
constexpr size_t WS_GB = 129 * MiB;
constexpr size_t WS_UB = 149 * MiB;
constexpr size_t WS_MIX = 214 * MiB;
constexpr size_t WS_END = 254 * MiB;
constexpr int CW_BAR = 4096;
constexpr int CW_Q3 = 64;

constexpr int RING_OFF = 0, RING_BYTES = 131072, ROPE_LDS = RING_OFF + RING_BYTES;
constexpr int LDS_BYTES = 163840;
constexpr int LDSCTL_OFF = LDS_BYTES - 1024, MISC_OFF = LDSCTL_OFF + 320;

#define GAS __attribute__((address_space(1)))
#define LAS __attribute__((address_space(3)))
typedef unsigned short bf16;
typedef unsigned v4u __attribute__((ext_vector_type(4)));
typedef unsigned v2u __attribute__((ext_vector_type(2)));
typedef float f32x4 __attribute__((ext_vector_type(4)));
typedef float f32x16 __attribute__((ext_vector_type(16)));
typedef short bf16x8 __attribute__((ext_vector_type(8)));
typedef GAS unsigned gu32;
#define RLX_AGENT __ATOMIC_RELAXED, __HIP_MEMORY_SCOPE_AGENT
#define LDS_WAIT() asm volatile("s_waitcnt lgkmcnt(0)" ::: "memory")
#define VM_WAIT() asm volatile("s_waitcnt vmcnt(0)" ::: "memory")
__device__ __forceinline__ unsigned f2bf(float f) { unsigned u = __builtin_bit_cast(unsigned, f); return (u + 0x7fffu + ((u >> 16) & 1u)) >> 16; }
typedef float f32x2_t __attribute__((ext_vector_type(2)));
typedef __bf16 bf16x2_t __attribute__((ext_vector_type(2)));
__device__ __forceinline__ unsigned pk2(float lo, float hi) { const f32x2_t f = {lo, hi}; return __builtin_bit_cast(unsigned, __builtin_convertvector(f, bf16x2_t)); }
__device__ __forceinline__ unsigned f2bf_hw(float f) { return pk2(f, f); }
__device__ __forceinline__ float bf2f(unsigned b) { return __builtin_bit_cast(float, b << 16); }
__device__ __forceinline__ float bflo(unsigned w) { return __builtin_bit_cast(float, w << 16); }
__device__ __forceinline__ float bfhi(unsigned w) { return __builtin_bit_cast(float, w & 0xffff0000u); }
__device__ __forceinline__ float sigmoidf_(float x) { return __builtin_amdgcn_rcpf(1.f + __expf(-x)); }
__device__ __forceinline__ float sigmoid2_(float x2) { return __builtin_amdgcn_rcpf(1.f + __builtin_amdgcn_exp2f(-x2)); }
__device__ __forceinline__ float siluf_(float x) { return x * __builtin_amdgcn_rcpf(1.f + __expf(-x)); }

#define XB_TMO      128
#define XB_XCNT(j)  (256  + 64 * (j))
#define XB_XSUB(j)  (1280 + 64 * (j))
#define XB_XGEN(j)  (2304 + 64 * (j))
#define XB_TOP      3328
#define XB_TOPGEN   3392
#define XCD_BAR_WORDS 3456
#define XB_SPIN_CAP (1u << 18)
__device__ __forceinline__ unsigned xb_ld(unsigned* p)              { return __hip_atomic_load(p, __ATOMIC_RELAXED, __HIP_MEMORY_SCOPE_AGENT); }
__device__ __forceinline__ unsigned xb_add(unsigned* p, unsigned v) { return __hip_atomic_fetch_add(p, v, __ATOMIC_RELAXED, __HIP_MEMORY_SCOPE_AGENT); }
__device__ __forceinline__ unsigned xb_xcc_id() { return (unsigned)__builtin_amdgcn_s_getreg((3 << 11) | 20) & 0xFu; }
#define XB_SPIN(cond, bar) do { unsigned _sp = 0; while (cond) { __builtin_amdgcn_s_sleep(1); \
    if ((++_sp & 255u) == 0u) { if (xb_ld(&(bar)[XB_TMO])) break; if (_sp > XB_SPIN_CAP) { atomicAdd(&(bar)[XB_TMO], 1u); break; } } } } while (0)
struct XcdBarrier { unsigned* bar; unsigned x; volatile LAS unsigned* st; };
__device__ __forceinline__ XcdBarrier xcd_barrier_post(unsigned* bar, volatile LAS unsigned* st) {
    XcdBarrier b; b.bar = bar; b.x = xb_xcc_id(); b.st = st;
    if (threadIdx.x == 0) (void)xb_add(&bar[XB_XCNT(b.x)], 1u);
    return b;
}
__device__ __forceinline__ void xcd_barrier_complete(unsigned* bar, unsigned x, unsigned& nloc, unsigned& nx) {
    const unsigned G = gridDim.x * gridDim.y * gridDim.z;
    unsigned sum, cnt, mine, sp = 0u;
    for (;;) {
        sum = 0u; cnt = 0u; mine = 0u;
#pragma unroll
        for (unsigned j = 0; j < 16; ++j) { const unsigned c = xb_ld(&bar[XB_XCNT(j)]); sum += c; cnt += (c > 0u) ? 1u : 0u; mine = (j == x) ? c : mine; }
        if (sum == G) break;
        __builtin_amdgcn_s_sleep(1);
        if ((++sp & 255u) == 0u) { if (xb_ld(&bar[XB_TMO])) break; if (sp > XB_SPIN_CAP) { atomicAdd(&bar[XB_TMO], 1u); break; } }
    }
    nloc = mine > 0u ? mine : 1u; nx = cnt > 0u ? cnt : 1u;
}
__device__ __forceinline__ void xcd_barrier(const XcdBarrier& b) {
    asm volatile("s_waitcnt vmcnt(0)" ::: "memory");
    __syncthreads();
    if (threadIdx.x == 0) {
        unsigned* bar = b.bar;
        __builtin_amdgcn_s_waitcnt(0);
        unsigned nloc = b.st[0], nx = b.st[1];
        if (nloc == 0u) { xcd_barrier_complete(bar, b.x, nloc, nx); b.st[0] = nloc; b.st[1] = nx; }
        const unsigned old = xb_add(&bar[XB_XSUB(b.x)], 1u);
        const unsigned gen = old / nloc;
        if (old + 1u == (gen + 1u) * nloc) {
            __builtin_amdgcn_fence(__ATOMIC_RELEASE, "agent");
            asm volatile("s_waitcnt vmcnt(0)" ::: "memory");
            const unsigned og = xb_add(&bar[XB_TOP], 1u);
            const unsigned tg = og / nx;
            if (og + 1u == (tg + 1u) * nx) xb_add(&bar[XB_TOPGEN], 1u);
            else XB_SPIN(xb_ld(&bar[XB_TOPGEN]) == tg, bar);
            __builtin_amdgcn_fence(__ATOMIC_ACQUIRE, "agent");
            xb_add(&bar[XB_XGEN(b.x)], 1u);
            asm volatile("s_waitcnt vmcnt(0)" ::: "memory");
        } else {
            XB_SPIN(xb_ld(&bar[XB_XGEN(b.x)]) == gen, bar);
            __builtin_amdgcn_fence(__ATOMIC_ACQUIRE, "agent");
            asm volatile("s_waitcnt vmcnt(0)" ::: "memory");
        }
    }
    __syncthreads();
}

struct Args { const float* in[N_IN]; float* out; unsigned char* ws; int ph_lo, ph_hi, li, pad; };
struct Frame {
    LAS unsigned char* lds;
    volatile LAS unsigned* MISC;
    gu32* ctl;
    int tid, lane, wave, G;
    const float* const* in;
    float* out; unsigned char* ws;
};
__device__ __forceinline__ float wave_sum(float v) {
#pragma unroll
    for (int o = 1; o < 64; o <<= 1) v += __shfl_xor(v, o);
    return v;
}
__device__ __forceinline__ const float* xrow_ptr(const Frame& F, int m) { return m < MC ? F.in[I_XP] + (size_t)m * D : F.in[I_XS] + (size_t)(m - MC) * D; }

__device__ __forceinline__ void p0_transpose_item(const float* W, int K, int N, bf16* WT, LAS float* scr, int item, int lane) {
    const int nblk = N / 32, kb = item / nblk, nb = item % nblk, k0 = 64 * kb, n0 = 32 * nb;
#pragma unroll 4
    for (int i = 0; i < 32; ++i) { const int kk = 2 * i + (lane >> 5); scr[kk * 33 + (lane & 31)] = W[(size_t)(k0 + kk) * N + n0 + (lane & 31)]; }
    LDS_WAIT(); asm volatile("" ::: "memory");
    const int c = lane & 7;
#pragma unroll
    for (int j = 0; j < 4; ++j) { const int n = (lane >> 3) + 8 * j; const LAS float* s = scr + (8 * c) * 33 + n;
        v4u o; o.x = pk2(s[0 * 33], s[1 * 33]); o.y = pk2(s[2 * 33], s[3 * 33]); o.z = pk2(s[4 * 33], s[5 * 33]); o.w = pk2(s[6 * 33], s[7 * 33]);
        *(GAS v4u*)(WT + (size_t)(n0 + n) * K + k0 + 8 * c) = o; }
    LDS_WAIT(); asm volatile("" ::: "memory");
}
__device__ __forceinline__ void p0_prologue(Frame& F) {
    LAS float* scr = (LAS float*)(F.lds + RING_OFF + F.wave * 16384);
    const int gw = blockIdx.x * NWAVES + F.wave, NGW = F.G * NWAVES;
    bf16* WinT = (bf16*)(F.ws + WS_WIN); bf16* WoutT = (bf16*)(F.ws + WS_WOUT);
    constexpr int I_IN = (D / 64) * (DIN / 32), I_OUT = (DMIX / 64) * (D / 32), I_MOD = 16 * 12, I_CV_ = NBL * NH * (PAST / 64);
    {
        const int e = ((int)blockIdx.x - (F.G - 2)) * NTHR + F.tid;
        if (e >= 0 && e < 1024) { float* rp = (float*)(F.ws + WS_ROPE); const int pos = e >> 4, i = e & 15; const double inv = pow(10000.0, -(double)i / 16.0), ang = (double)pos * inv; rp[e] = (float)cos(ang); rp[1024 + e] = (float)sin(ang); }
    }
    {
        const int r = NGW - 1 - gw;
        if (r < I_MOD) {
            const int kc = r / 12, nb = r % 12, n0 = nb * 256 + 4 * F.lane;
            const float* wa = F.in[I_WADA] + (size_t)(kc * 64) * 3072 + n0;
            f32x4 a0 = {0.f, 0.f, 0.f, 0.f}, a1 = a0, a2 = a0;
#pragma unroll 16
            for (int k = 0; k < 64; ++k) {
                const f32x4 w = *(const f32x4*)(wa + (size_t)k * 3072);
                const float s0 = siluf_(F.in[I_CCTX][kc * 64 + k]), s1 = siluf_(F.in[I_C][kc * 64 + k]), s2 = siluf_(F.in[I_C][D + kc * 64 + k]);
                a0 += w * s0; a1 += w * s1; a2 += w * s2;
            }
            float* mp = (float*)(F.ws + WS_MODP) + (size_t)kc * 3 * 3072 + n0;
            *(f32x4*)(mp) = a0; *(f32x4*)(mp + 3072) = a1; *(f32x4*)(mp + 2 * 3072) = a2;
        } else if (r < I_MOD + I_CV_) {
            const int q_ = r - I_MOD, tb = q_ % (PAST / 64), hh = (q_ / (PAST / 64)) % NH, b = q_ / (NH * (PAST / 64));
            const float* src = F.in[I_CV] + ((size_t)(b * PAST + tb * 64 + F.lane) * NH + hh) * 128;
            bf16* dst = (bf16*)(F.ws + WS_VTL) + (size_t)((b * NH + hh) * 128) * KLAT + tb * 64 + F.lane;
#pragma unroll 1
            for (int dv0 = 0; dv0 < 128; dv0 += 32) {
                f32x4 v[8];
#pragma unroll
                for (int q = 0; q < 8; ++q) v[q] = *(const f32x4*)(src + dv0 + 4 * q);
#pragma unroll
                for (int q = 0; q < 8; ++q) { const int dv = dv0 + 4 * q;
                    dst[(size_t)(dv + 0) * KLAT] = (bf16)f2bf(v[q].x); dst[(size_t)(dv + 1) * KLAT] = (bf16)f2bf(v[q].y); dst[(size_t)(dv + 2) * KLAT] = (bf16)f2bf(v[q].z); dst[(size_t)(dv + 3) * KLAT] = (bf16)f2bf(v[q].w); }
            }
        }
    }
    for (int it = gw; it < I_IN + I_OUT; it += NGW) {
        if (it < I_IN) p0_transpose_item(F.in[I_WIN], D, DIN, WinT, scr, it, F.lane);
        else p0_transpose_item(F.in[I_WOUT], DMIX, D, WoutT, scr, it - I_IN, F.lane);
    }
    for (int idx = blockIdx.x * NTHR + F.tid; idx < 2 * 16 * 2 * 4 * 2 * 64; idx += F.G * NTHR) {
        const int ln = idx & 63, ks = (idx >> 6) & 1, ct = (idx >> 7) & 3, mat = (idx >> 9) & 1, hh = (idx >> 10) & 15, dd = idx >> 14;
        const float* src = F.in[mat ? I_A2 : I_W2] + (size_t)(dd * 64 + 32 * ks + 8 * (ln >> 4)) * D + hh * 64 + 16 * ct + (ln & 15);
        constexpr float L2E = 1.44269504088896f;
        v4u o; o.x = pk2(src[0] * L2E, src[D] * L2E); o.y = pk2(src[2 * D] * L2E, src[3 * D] * L2E); o.z = pk2(src[4 * D] * L2E, src[5 * D] * L2E); o.w = pk2(src[6 * D] * L2E, src[7 * D] * L2E);
        ((v4u*)(F.ws + WS_WOP))[idx] = o;
    }
    bf16* KL = (bf16*)(F.ws + WS_KL);
    for (int i = blockIdx.x * NTHR + F.tid; i < NBL * PAST * D / 8; i += F.G * NTHR) {
        const int e = i * 8, b = e / (PAST * D), rem = e % (PAST * D);
        const f32x4 v0 = *(const f32x4*)(F.in[I_CK] + e), v1 = *(const f32x4*)(F.in[I_CK] + e + 4);
        v4u o; o.x = pk2(v0.x, v0.y); o.y = pk2(v0.z, v0.w); o.z = pk2(v1.x, v1.y); o.w = pk2(v1.z, v1.w);
        *(v4u*)(KL + (size_t)b * KLAT * D + rem) = o;
    }
}

template <int I0, int I1> __device__ __forceinline__ void p1_load(Frame& F, f32x4 (&v)[5][4]) {
#pragma unroll
    for (int i = I0; i < I1; ++i) { const float* xr = xrow_ptr(F, ((int)blockIdx.x + 256 * i) * 8 + F.wave);
#pragma unroll
        for (int j = 0; j < 4; ++j) v[i][j] = *(const f32x4*)(xr + 4 * F.lane + 256 * j); }
}
__device__ __forceinline__ void p1_norm(Frame& F, f32x4 (&v)[5][4]) {
    LAS float* modL = (LAS float*)(F.lds + RING_OFF);
    const float* modp = (const float*)(F.ws + WS_MODP);
    const float* bada = F.in[I_BADA];
    int mrow[5];
#pragma unroll
    for (int i = 0; i < 5; ++i) mrow[i] = ((int)blockIdx.x + 256 * i) * 8 + F.wave;
    if (blockIdx.x < 36 && F.tid < 256) {
        const int idx = blockIdx.x * 256 + F.tid, ci = idx / 3072, n = idx % 3072;
        float pt[16];
#pragma unroll
        for (int kc = 0; kc < 16; ++kc) pt[kc] = modp[(size_t)(kc * 3 + ci) * 3072 + n];
#pragma unroll
        for (int kc = 0; kc < 16; ++kc) asm volatile("" : "+v"(pt[kc]));
        float s = bada[n];
#pragma unroll
        for (int kc = 0; kc < 16; ++kc) s += pt[kc];
        ((float*)(F.ws + WS_MODF))[idx] = s;
    }
    {
        const int cil = 1 + (int)blockIdx.x / 128;
#pragma unroll 1
        for (int e = F.tid; e < 4096; e += 2 * NTHR) {
            float pt[2][16], s[2];
#pragma unroll
            for (int h = 0; h < 2; ++h) { const int e2 = e + h * NTHR, n = e2 & 2047, ci = e2 < 2048 ? 0 : cil; s[h] = bada[n];
#pragma unroll
                for (int kc = 0; kc < 16; ++kc) pt[h][kc] = modp[(size_t)(kc * 3 + ci) * 3072 + n]; }
#pragma unroll
            for (int h = 0; h < 2; ++h)
#pragma unroll
                for (int kc = 0; kc < 16; ++kc) asm volatile("" : "+v"(pt[h][kc]));
#pragma unroll
            for (int h = 0; h < 2; ++h) {
#pragma unroll
                for (int kc = 0; kc < 16; ++kc) s[h] += pt[h][kc];
                modL[e + h * NTHR] = s[h]; }
        }
    }
    __syncthreads();
    bf16* XN = (bf16*)(F.ws + WS_XN);
    f32x4 gn[4];
#pragma unroll
    for (int j = 0; j < 4; ++j) gn[j] = *(const f32x4*)(F.in[I_NG] + 4 * F.lane + 256 * j);
#pragma unroll
    for (int i = 0; i < 5; ++i) {
        float ss = 0.f;
#pragma unroll
        for (int j = 0; j < 4; ++j) ss += (v[i][j].x * v[i][j].x + v[i][j].y * v[i][j].y) + (v[i][j].z * v[i][j].z + v[i][j].w * v[i][j].w);
        const float rstd = __builtin_amdgcn_rsqf(wave_sum(ss) * (1.f / D) + 1e-6f);
        const LAS float* ml = modL + (i == 4 ? 2048 : 0);
#pragma unroll
        for (int j = 0; j < 4; ++j) {
            const int c = 4 * F.lane + 256 * j;
            const f32x4 sh = *(const LAS f32x4*)(ml + c), sc = *(const LAS f32x4*)(ml + 1024 + c);
            const f32x4 h = (v[i][j] * rstd) * gn[j] * (sc + 1.0f) + sh;
            v2u o; o.x = pk2(h.x, h.y); o.y = pk2(h.z, h.w);
            *(v2u*)(XN + (size_t)mrow[i] * D + c) = o;
        }
    }
}

struct EpiIn {
    static constexpr bool PERM = true, AFTER_DRAIN = false;
    unsigned char* ws; float* out; const LAS float* rope;
    __device__ __forceinline__ void operator()(const f32x4 (&acc)[2][2][4][2], const pg8::Unit& u, int wr, int wc, int fr, int fq) const {
        const int pn = u.pn; const bool lat = u.pm >= MC / 256;
        constexpr float QS = 0.125f * 1.44269504088896f;
#pragma unroll
        for (int ai = 0; ai < 2; ++ai)
#pragma unroll
            for (int m = 0; m < 4; ++m) {
                const int r = u.pm * 256 + ai * 128 + wr * 64 + m * 16 + fr;
#pragma unroll
                for (int bj = 0; bj < 2; ++bj) {
                    const int c = pn * 256 + bj * 128 + wc * 32 + 8 * fq;
                    f32x4 v0 = acc[ai][bj][m][0], v1 = acc[ai][bj][m][1];
                    if (pn < 8) {
                        const bool isq = pn < 4; const int cc = isq ? c : c - 1024;
                        if (lat) {
                            const int t = (r - MC) & (LSEQ - 1), pos = (wc & 1) ? (t & 63) : (t >> 6);
                            const LAS float* cp = rope + pos * 16 + 8 * (fq & 1);
                            const f32x4 c0 = *(const LAS f32x4*)cp, c1 = *(const LAS f32x4*)(cp + 4), s0 = *(const LAS f32x4*)(cp + 1024), s1 = *(const LAS f32x4*)(cp + 1028);
                            f32x4 p0, p1;
#pragma unroll
                            for (int j = 0; j < 4; ++j) { p0[j] = __shfl_xor(v0[j], 32); p1[j] = __shfl_xor(v1[j], 32); }
                            const float sg = (fq & 2) ? 1.f : -1.f;
                            v0 = v0 * c0 + (p0 * s0) * sg; v1 = v1 * c1 + (p1 * s1) * sg;
                        }
                        if (isq) { v0 = v0 * QS; v1 = v1 * QS; }
                        else if (!lat) { float* o = out + OUT_CK + (size_t)r * D + cc; *(f32x4*)o = v0; *(f32x4*)(o + 4) = v1; }
                        v4u w; w.x = pk2(v0[0], v0[1]); w.y = pk2(v0[2], v0[3]); w.z = pk2(v1[0], v1[1]); w.w = pk2(v1[2], v1[3]);
                        bf16* dst;
                        if (isq) dst = (bf16*)(ws + WS_Q) + (size_t)r * D + cc;
                        else if (!lat) dst = (bf16*)(ws + WS_KC) + (size_t)r * D + cc;
                        else { const int b = (r - MC) >> 10, t = (r - MC) & (LSEQ - 1); dst = (bf16*)(ws + WS_KL) + ((size_t)b * KLAT + PAST + t) * D + cc; }
                        *(v4u*)dst = w;
                    } else if (pn < 12) {
                        const int cc = c - 2048, hh = cc >> 7, dv = cc & 127;
                        bf16* dst;
                        if (!lat) { float* o = out + OUT_CV + (size_t)r * D + cc; *(f32x4*)o = v0; *(f32x4*)(o + 4) = v1;
                            const int b = r >> 8, t = r & 255; dst = (bf16*)(ws + WS_VTC) + (size_t)((b * NH + hh) * 128 + dv) * SEQ + t;
#pragma unroll
                            for (int j = 0; j < 4; ++j) { dst[(size_t)j * SEQ] = (bf16)f2bf(v0[j]); dst[(size_t)(4 + j) * SEQ] = (bf16)f2bf(v1[j]); }
                        } else { const int b = (r - MC) >> 10, t = (r - MC) & (LSEQ - 1); dst = (bf16*)(ws + WS_VTL) + (size_t)((b * NH + hh) * 128 + dv) * KLAT + PAST + t;
#pragma unroll
                            for (int j = 0; j < 4; ++j) { dst[(size_t)j * KLAT] = (bf16)f2bf(v0[j]); dst[(size_t)(4 + j) * KLAT] = (bf16)f2bf(v1[j]); }
                        }
                    } else if (pn < 16 || pn >= 29) {
                        bf16* dst = pn < 16 ? (bf16*)(ws + WS_GA) + (size_t)r * D + (c - 3072) : (bf16*)(ws + WS_GB) + (size_t)r * D + (c - 7424);
                        v4u w; w.x = pk2(siluf_(v0[0]), siluf_(v0[1])); w.y = pk2(siluf_(v0[2]), siluf_(v0[3])); w.z = pk2(siluf_(v1[0]), siluf_(v1[1])); w.w = pk2(siluf_(v1[2]), siluf_(v1[3]));
                        *(v4u*)dst = w;
                    } else {
                        v4u w; w.x = pk2(v0[0], v0[1]); w.y = pk2(v0[2], v0[3]); w.z = pk2(v1[0], v1[1]); w.w = pk2(v1[2], v1[3]);
                        *(v4u*)((bf16*)(ws + WS_UB) + (size_t)r * DSH + (c - 4096)) = w;
                    }
                }
            }
    }
};

constexpr int NLATB = 32;
constexpr int LAT_UNITS = (ML / 256) * (DIN / 256);
constexpr int P2A_UNITS = 512, P2_UNITS = (M / 256) * (DIN / 256);
constexpr int LAT_BAR_IT = 6;
struct ListOrder {
    int G, v, lo, hi;
    __device__ void init(int G_, int c_, int lo_, int hi_) { G = G_; v = (G_ % 8 == 0) ? (c_ % 8) * (G_ / 8) + c_ / 8 : c_; lo = lo_; hi = hi_; }
    __device__ bool next(int i, pg8::Unit& u) const {
        int L = lo + i * G + v; if (L >= hi) return false;
        if (L < LAT_UNITS) { u.pn = L >> 3; u.pm = MC / 256 + (L & 7); return true; }
        L -= LAT_UNITS;
        const int grp = L / (8 * (DIN / 256)), r = L % (8 * (DIN / 256)); u.pn = r >> 3; u.pm = grp * 8 + (r & 7); return true;
    }
    __device__ __forceinline__ void a_ready(const pg8::Unit&) const {}
    __device__ __forceinline__ void done(const pg8::Unit&) const {}
};

constexpr size_t WS_XCH = WS_SSQ;
constexpr int CW_PANEL = 8192;
struct EpiOutFused {
    static constexpr bool PERM = false, AFTER_DRAIN = true;
    unsigned char* ws; float* out; const float* xp; const float* xs; const float* fg; gu32* ctl;
    __device__ __forceinline__ void fused(f32x4 (&acc)[2][2][4][2], const pg8::Unit& u, int wr, int wc, int fr, int fq, PG8_LAS unsigned char* lds, int wid, int lane) const {
        const float* modf = (const float*)(ws + WS_MODF);
        PG8_LAS float* P = (PG8_LAS float*)lds;
        PG8_LAS float* R = (PG8_LAS float*)(lds + 4096);
        const int col0 = u.pn * 256 + wc * 32 + 4 * fq;
#pragma unroll
        for (int ai = 0; ai < 2; ++ai)
#pragma unroll
            for (int m = 0; m < 4; ++m) {
                const int rl = ai * 128 + wr * 64 + m * 16 + fr, r = u.pm * 256 + rl;
                const int ci = r < MC ? 0 : 1 + ((r - MC) >> 10);
                const float* xr = (r < MC ? xp + (size_t)r * D : xs + (size_t)(r - MC) * D) + col0;
                const float* gt = modf + ci * 3072 + 2048 + col0;
                float ss = 0.f;
#pragma unroll
                for (int bj = 0; bj < 2; ++bj)
#pragma unroll
                    for (int n = 0; n < 2; ++n) {
                        const int off = bj * 128 + n * 16;
                        const f32x4 y = *(const f32x4*)(xr + off) + *(const f32x4*)(gt + off) * acc[ai][bj][m][n];
                        acc[ai][bj][m][n] = y;
                        ss += (y.x * y.x + y.y * y.y) + (y.z * y.z + y.w * y.w);
                    }
                ss += __shfl_xor(ss, 16); ss += __shfl_xor(ss, 32);
                if (fq == 0) P[rl * 4 + wc] = ss;
            }
        asm volatile("s_waitcnt lgkmcnt(0)" ::: "memory"); __builtin_amdgcn_s_barrier(); asm volatile("" ::: "memory");
        const int row = wid * 32 + (lane & 31);
        float* xbuf = (float*)(ws + WS_XCH) + ((size_t)(u.pm * 256 + row) * 4);
        if (lane < 32) {
            const f32x4 p = *(const PG8_LAS f32x4*)(P + row * 4);
            __hip_atomic_store(xbuf + u.pn, (p.x + p.y) + (p.z + p.w), __ATOMIC_RELAXED, __HIP_MEMORY_SCOPE_AGENT);
        }
        asm volatile("s_waitcnt vmcnt(0)" ::: "memory");
        unsigned* cnt = (unsigned*)(ctl + CW_PANEL + 64 * u.pm);
        if (lane == 0) __hip_atomic_fetch_add(cnt, 1u, __ATOMIC_RELAXED, __HIP_MEMORY_SCOPE_AGENT);
        if (wid == 0) {
            unsigned sp = 0;
            while ((unsigned)__builtin_amdgcn_readfirstlane(__hip_atomic_load(cnt, __ATOMIC_RELAXED, __HIP_MEMORY_SCOPE_AGENT)) < 32u) { __builtin_amdgcn_s_sleep(2); if (++sp > (1u << 20)) break; }
            __builtin_amdgcn_fence(__ATOMIC_ACQUIRE, "agent");
        }
        asm volatile("s_waitcnt vmcnt(0) lgkmcnt(0)" ::: "memory"); __builtin_amdgcn_s_barrier(); asm volatile("" ::: "memory");
        if (lane < 32) {
            float t = 0.f;
#pragma unroll
            for (int q = 0; q < 4; ++q) t += __hip_atomic_load(xbuf + q, __ATOMIC_RELAXED, __HIP_MEMORY_SCOPE_AGENT);
            R[row] = __builtin_amdgcn_rsqf(t * (1.f / D) + 1e-6f);
        }
        asm volatile("s_waitcnt lgkmcnt(0)" ::: "memory"); __builtin_amdgcn_s_barrier(); asm volatile("" ::: "memory");
        f32x4 fgv[2][2];
#pragma unroll
        for (int bj = 0; bj < 2; ++bj)
#pragma unroll
            for (int n = 0; n < 2; ++n) fgv[bj][n] = *(const f32x4*)(fg + col0 + bj * 128 + n * 16);
#pragma unroll
        for (int ai = 0; ai < 2; ++ai)
#pragma unroll
            for (int m = 0; m < 4; ++m) {
                const int rl = ai * 128 + wr * 64 + m * 16 + fr; const float rs = R[rl];
                float* o = out + OUT_Y + (size_t)(u.pm * 256 + rl) * D + col0;
#pragma unroll
                for (int bj = 0; bj < 2; ++bj)
#pragma unroll
                    for (int n = 0; n < 2; ++n) { const int off = bj * 128 + n * 16; *(f32x4*)(o + off) = acc[ai][bj][m][n] * rs * fgv[bj][n]; }
            }
    }
};

constexpr int AT_KS = 0, AT_KSTRIDE = 272, AT_VS = 64 * AT_KSTRIDE, AT_VSTRIDE = 144, AT_BUF = AT_VS + 128 * AT_VSTRIDE, AT_X = 2 * AT_BUF, AT_XSTRIDE = 132;
static_assert(AT_X + 4 * 32 * AT_XSTRIDE * 4 <= LDSCTL_OFF && (AT_X % 16) == 0, "attention LDS map");
__device__ __forceinline__ void attn_unit(Frame& F, int idx, bool lat, float lam) {
    int tid_ = F.tid; asm volatile("" : "+v"(tid_)); const int lane_ = tid_ & 63;
    int b, hh, qb, m0, nkeys, vlen; const bf16* Kb; const bf16* VT;
    if (!lat) { b = idx >> 4; hh = (idx >> 1) & 7; qb = idx & 1; m0 = b * SEQ + qb * 128; nkeys = SEQ; vlen = SEQ;
        Kb = (const bf16*)(F.ws + WS_KC) + (size_t)b * SEQ * D + hh * 128; VT = (const bf16*)(F.ws + WS_VTC) + (size_t)((b * NH + hh) * 128) * SEQ; }
    else { b = idx >> 6; hh = (idx >> 3) & 7; qb = idx & 7; m0 = MC + b * LSEQ + qb * 128; nkeys = KLAT; vlen = KLAT;
        Kb = (const bf16*)(F.ws + WS_KL) + (size_t)b * KLAT * D + hh * 128; VT = (const bf16*)(F.ws + WS_VTL) + (size_t)((b * NH + hh) * 128) * KLAT; }
    const int w = F.wave, qs = w >> 1, mp = w & 1, l31 = lane_ & 31, h5 = lane_ >> 5;
    const int kperm = (l31 & 3) + 4 * ((l31 >> 3) & 1) + 8 * ((l31 >> 2) & 1) + 16 * (l31 >> 4);
    LAS float* X = (LAS float*)(F.lds + AT_X);
    bf16x8 qf[4];
    { const bf16* qrow = (const bf16*)(F.ws + WS_Q) + (size_t)(m0 + qs * 32 + l31) * D + hh * 128 + mp * 64 + 8 * h5;
#pragma unroll
      for (int ks = 0; ks < 4; ++ks) qf[ks] = *(const bf16x8*)(qrow + 16 * ks); }
    f32x16 o[4];
#pragma unroll
    for (int i = 0; i < 4; ++i)
#pragma unroll
        for (int j = 0; j < 16; ++j) o[i][j] = 0.f;
    float mrun = -1e30f, lrun = 0.f;
    const int krow = tid_ >> 3, kch = tid_ & 7, vrow = tid_ >> 2, vch = tid_ & 3;
    const int ntile = nkeys / 64;
    const bf16* kp = Kb + (size_t)krow * D + kch * 8;
    const bf16* vp = VT + (size_t)vrow * vlen + vch * 8;
    LAS unsigned char* kd = F.lds + AT_KS + krow * AT_KSTRIDE + kch * 16;
    LAS unsigned char* vd = F.lds + AT_VS + vrow * AT_VSTRIDE + vch * 16;
    v4u k0 = *(const v4u*)kp, k1 = *(const v4u*)(kp + 64), v0 = *(const v4u*)vp, v1 = *(const v4u*)(vp + 32);
    __syncthreads();
    *(LAS v4u*)(kd) = k0; *(LAS v4u*)(kd + 128) = k1;
    *(LAS v4u*)(vd) = v0; *(LAS v4u*)(vd + 64) = v1;
    if (ntile > 1) { k0 = *(const v4u*)(kp + (size_t)64 * D); k1 = *(const v4u*)(kp + (size_t)64 * D + 64); v0 = *(const v4u*)(vp + 64); v1 = *(const v4u*)(vp + 96); }
    __syncthreads();
    for (int kt = 0; kt < ntile; ++kt) {
        const int bo = (kt & 1) * AT_BUF;
        LAS unsigned char* Ks = F.lds + AT_KS + bo; LAS unsigned char* Vs = F.lds + AT_VS + bo;
        if (kt + 1 < ntile) {
            const int bn = AT_BUF - bo;
            *(LAS v4u*)(kd + bn) = k0; *(LAS v4u*)(kd + bn + 128) = k1;
            *(LAS v4u*)(vd + bn) = v0; *(LAS v4u*)(vd + bn + 64) = v1;
            if (kt + 2 < ntile) { const bf16* kq = kp + (size_t)(kt + 2) * 64 * D; const bf16* vq = vp + (kt + 2) * 64;
                k0 = *(const v4u*)kq; k1 = *(const v4u*)(kq + 64); v0 = *(const v4u*)vq; v1 = *(const v4u*)(vq + 32); }
        }
        f32x16 s[2];
#pragma unroll
        for (int st = 0; st < 2; ++st) {
#pragma unroll
            for (int j = 0; j < 16; ++j) s[st][j] = 0.f;
#pragma unroll
            for (int ks = 0; ks < 4; ++ks) {
                const bf16x8 kf = *(const LAS bf16x8*)(Ks + (st * 32 + kperm) * AT_KSTRIDE + (mp * 64 + 16 * ks + 8 * h5) * 2);
                s[st] = __builtin_amdgcn_mfma_f32_32x32x16_bf16(kf, qf[ks], s[st], 0, 0, 0);
            }
        }
        float mx = s[0][0];
#pragma unroll
        for (int j = 0; j < 16; ++j) { mx = fmaxf(mx, s[0][j]); mx = fmaxf(mx, s[1][j]); }
        mx = fmaxf(mx, __shfl_xor(mx, 32));
        if (!__all(mx - mrun <= 8.f)) {
            const float mnew_ = fmaxf(mrun, mx), alpha = __builtin_amdgcn_exp2f(mrun - mnew_);
            mrun = mnew_; lrun *= alpha;
#pragma unroll
            for (int i = 0; i < 4; ++i) o[i] = o[i] * alpha;
        }
        const float mnew = mrun;
        float ps = 0.f;
#pragma unroll
        for (int st = 0; st < 2; ++st)
#pragma unroll
            for (int j = 0; j < 16; ++j) { const float p = __builtin_amdgcn_exp2f(s[st][j] - mnew); s[st][j] = p; ps += p; }
        lrun += ps;
        bf16x8 pf[2][2];
#pragma unroll
        for (int st = 0; st < 2; ++st)
#pragma unroll
            for (int s2 = 0; s2 < 2; ++s2) {
                v4u t; t.x = pk2(s[st][8 * s2 + 0], s[st][8 * s2 + 1]); t.y = pk2(s[st][8 * s2 + 2], s[st][8 * s2 + 3]); t.z = pk2(s[st][8 * s2 + 4], s[st][8 * s2 + 5]); t.w = pk2(s[st][8 * s2 + 6], s[st][8 * s2 + 7]);
                pf[st][s2] = __builtin_bit_cast(bf16x8, t);
            }
#pragma unroll
        for (int dvt = 0; dvt < 4; ++dvt)
#pragma unroll
            for (int st = 0; st < 2; ++st)
#pragma unroll
                for (int s2 = 0; s2 < 2; ++s2) {
                    const bf16x8 vf = *(const LAS bf16x8*)(Vs + (dvt * 32 + l31) * AT_VSTRIDE + (st * 32 + 16 * s2 + 8 * h5) * 2);
                    o[dvt] = __builtin_amdgcn_mfma_f32_32x32x16_bf16(vf, pf[st][s2], o[dvt], 0, 0, 0);
                }
        __syncthreads();
    }
    v4u gav[4];
    {
        const bf16* GA = (const bf16*)(F.ws + WS_GA);
#pragma unroll
        for (int p = 0; p < 4; ++p) gav[p] = *(const v4u*)(GA + (size_t)(m0 + p * 32 + (tid_ >> 4)) * D + hh * 128 + (tid_ & 15) * 8);
    }
    const float ltot = lrun + __shfl_xor(lrun, 32), inv = 1.f / ltot;
    LAS float* Xq = X + (qs * 32 + l31) * AT_XSTRIDE;
    if (mp == 1) {
#pragma unroll
        for (int dvt = 0; dvt < 4; ++dvt)
#pragma unroll
            for (int j = 0; j < 16; ++j) Xq[dvt * 32 + (j & 3) + 8 * (j >> 2) + 4 * h5] = o[dvt][j] * inv;
    }
    __syncthreads();
    if (mp == 0) {
        float ss = 0.f;
#pragma unroll
        for (int dvt = 0; dvt < 4; ++dvt)
#pragma unroll
            for (int j = 0; j < 16; ++j) { const float a = o[dvt][j] * inv - lam * Xq[dvt * 32 + (j & 3) + 8 * (j >> 2) + 4 * h5]; o[dvt][j] = a; ss += a * a; }
        ss += __shfl_xor(ss, 32);
        const float rstd = 0.8f / sqrtf(ss * (1.f / 128.f) + 1e-5f);
#pragma unroll
        for (int dvt = 0; dvt < 4; ++dvt)
#pragma unroll
            for (int j = 0; j < 16; ++j) Xq[dvt * 32 + (j & 3) + 8 * (j >> 2) + 4 * h5] = o[dvt][j] * rstd;
    }
    __syncthreads();
    {
        const float* sg = F.in[I_SUBG];
        bf16* MIX = (bf16*)(F.ws + WS_MIX);
        const int d8 = (tid_ & 15) * 8;
        const f32x4 g0 = *(const f32x4*)(sg + d8), g1 = *(const f32x4*)(sg + d8 + 4);
#pragma unroll
        for (int p = 0; p < 4; ++p) {
            const int q = p * 32 + (tid_ >> 4), m = m0 + q;
            const LAS float* xr = X + q * AT_XSTRIDE + d8;
            const f32x4 a0 = *(const LAS f32x4*)xr, a1 = *(const LAS f32x4*)(xr + 4);
            const v4u ga = gav[p];
            v4u w;
            w.x = pk2(a0.x * g0.x * bflo(ga.x), a0.y * g0.y * bfhi(ga.x)); w.y = pk2(a0.z * g0.z * bflo(ga.y), a0.w * g0.w * bfhi(ga.y));
            w.z = pk2(a1.x * g1.x * bflo(ga.z), a1.y * g1.y * bfhi(ga.z)); w.w = pk2(a1.z * g1.z * bflo(ga.w), a1.w * g1.w * bfhi(ga.w));
            *(v4u*)(MIX + (size_t)m * DMIX + hh * 128 + d8) = w;
        }
    }
}

constexpr int SC_W2 = 0, SC_A2 = 16384, SC_TLW = 32768, SC_LA = 40960, SC_WD = 49152, SC_NKK = 57344, SC_BB = 65536, SC_KD = 73728, SC_R = 81920, SC_V = 90112, SC_Y = 98304, SC_BON = 106496;
template <int CTRL> __device__ __forceinline__ float dppf(float x) { return __builtin_bit_cast(float, __builtin_amdgcn_update_dpp(0, __builtin_bit_cast(int, x), CTRL, 0xf, 0xf, true)); }
__device__ __forceinline__ float reduce8(float v) { v += dppf<0xB1>(v); v += dppf<0x4E>(v); v += dppf<0x141>(v); return v; }
__device__ __forceinline__ float shift_load(const bf16* ub, const float* mu, int t, int T, int col) {
    const float u = bf2f(ub[col]);
    const float p = t > 0 ? bf2f(ub[col - DSH]) : 0.f;
    const float n = t < T - 1 ? bf2f(ub[col + DSH]) : 0.f;
    return u + mu[col] * (p - u) + mu[DSH + col] * (n - u);
}
__device__ __forceinline__ void scan_unit(Frame& F, int b, int hh, bool lat) {
    const int T = lat ? LSEQ : SEQ, m0 = lat ? MC + b * LSEQ : b * SEQ;
    const bf16* UB = (const bf16*)(F.ws + WS_UB); const bf16* GB = (const bf16*)(F.ws + WS_GB); bf16* MIX = (bf16*)(F.ws + WS_MIX);
    float* YB = F.out + OUT_Y;
    const float* mu = F.in[I_MU];
    LAS float* W2s = (LAS float*)(F.lds + SC_W2); LAS float* A2s = (LAS float*)(F.lds + SC_A2); LAS float* TLW = (LAS float*)(F.lds + SC_TLW); LAS float* LAs = (LAS float*)(F.lds + SC_LA);
    LAS float* WD = (LAS float*)(F.lds + SC_WD); LAS float* NKK = (LAS float*)(F.lds + SC_NKK); LAS float* BB = (LAS float*)(F.lds + SC_BB); LAS float* KD = (LAS float*)(F.lds + SC_KD);
    LAS float* RR = (LAS float*)(F.lds + SC_R); LAS float* VV = (LAS float*)(F.lds + SC_V); LAS float* YC = (LAS float*)(F.lds + SC_Y); LAS float* BON = (LAS float*)(F.lds + SC_BON);
    const int c = F.lane, hc = hh * 64 + c, row = F.wave * 8 + (F.lane >> 3), kq = F.lane & 7;
    const float kkc = F.in[I_KK][hc], kac = F.in[I_KA][hc], rkc = F.in[I_RK][hc];
    for (int d = 0; d < 2; ++d) {
        __syncthreads();
        for (int i = F.tid; i < 4096; i += NTHR) { const int j = i >> 6, cc = i & 63; W2s[i] = F.in[I_W2][(size_t)(d * 64 + j) * D + hh * 64 + cc]; A2s[i] = F.in[I_A2][(size_t)(d * 64 + j) * D + hh * 64 + cc]; }
        const float w0c = F.in[I_W0][d * D + hc], a0c = F.in[I_A0][d * D + hc];
        float S[8];
        if (lat) { const float* sp = F.in[I_ST] + ((size_t)((b * 2 + d) * NHB + hh) * 64 + row) * 64 + kq * 8;
            const f32x4 s0 = *(const f32x4*)sp, s1 = *(const f32x4*)(sp + 4); S[0] = s0.x; S[1] = s0.y; S[2] = s0.z; S[3] = s0.w; S[4] = s1.x; S[5] = s1.y; S[6] = s1.z; S[7] = s1.w; }
        else {
#pragma unroll
            for (int i = 0; i < 8; ++i) S[i] = 0.f; }
        const int nch = T / 32;
        for (int ch = 0; ch < nch; ++ch) {
            const int t0 = (d == 0 ? ch : nch - 1 - ch) * 32;
            __syncthreads();
            float r_[4], k_[4], v_[4];
#pragma unroll
            for (int i = 0; i < 4; ++i) {
                const int tt = F.wave * 4 + i, t = t0 + tt;
                const bf16* ub = UB + (size_t)(m0 + t) * DSH;
                r_[i] = shift_load(ub, mu, t, T, hc); k_[i] = shift_load(ub, mu, t, T, 1024 + hc); v_[i] = shift_load(ub, mu, t, T, 2048 + hc);
                const float lw = shift_load(ub, mu, t, T, 3072 + 64 * d + c), la = shift_load(ub, mu, t, T, 3200 + 64 * d + c);
                TLW[tt * 64 + c] = tanhf(lw); LAs[tt * 64 + c] = la;
            }
            __syncthreads();
            float zw[4], za[4];
#pragma unroll
            for (int i = 0; i < 4; ++i) { zw[i] = w0c; za[i] = a0c; }
            for (int j = 0; j < 64; j += 4) {
                f32x4 tw[4], ta[4];
#pragma unroll
                for (int i = 0; i < 4; ++i) { tw[i] = *(const LAS f32x4*)(TLW + (F.wave * 4 + i) * 64 + j); ta[i] = *(const LAS f32x4*)(LAs + (F.wave * 4 + i) * 64 + j); }
#pragma unroll
                for (int jj = 0; jj < 4; ++jj) { const float w2 = W2s[(j + jj) * 64 + c], a2 = A2s[(j + jj) * 64 + c];
#pragma unroll
                    for (int i = 0; i < 4; ++i) { zw[i] += tw[i][jj] * w2; za[i] += ta[i][jj] * a2; } }
            }
#pragma unroll
            for (int i = 0; i < 4; ++i) {
                const int tt = F.wave * 4 + i;
                const float dec = __expf(-0.60653065971f * sigmoidf_(zw[i])), a = sigmoidf_(za[i]);
                float kk = k_[i] * kkc; const float n2 = wave_sum(kk * kk); kk *= 1.f / sqrtf(n2 + 1e-12f);
                WD[tt * 64 + c] = dec; NKK[tt * 64 + c] = -kk; BB[tt * 64 + c] = kk * a; KD[tt * 64 + c] = k_[i] * (1.f + (a - 1.f) * kac); RR[tt * 64 + c] = r_[i]; VV[tt * 64 + c] = v_[i];
                if (d == 1) { const float bo = wave_sum(r_[i] * k_[i] * rkc); if (c == 0) BON[tt] = bo; }
            }
            __syncthreads();
            for (int s = 0; s < 32; ++s) {
                const int tt = d == 0 ? s : 31 - s; const int o = tt * 64 + kq * 8;
                const f32x4 w0 = *(const LAS f32x4*)(WD + o), w1 = *(const LAS f32x4*)(WD + o + 4), n0 = *(const LAS f32x4*)(NKK + o), n1 = *(const LAS f32x4*)(NKK + o + 4);
                const f32x4 b0 = *(const LAS f32x4*)(BB + o), b1 = *(const LAS f32x4*)(BB + o + 4), k0 = *(const LAS f32x4*)(KD + o), k1 = *(const LAS f32x4*)(KD + o + 4);
                const f32x4 r0 = *(const LAS f32x4*)(RR + o), r1 = *(const LAS f32x4*)(RR + o + 4);
                const float vv = VV[tt * 64 + row];
                float sa = (S[0] * n0.x + S[1] * n0.y) + (S[2] * n0.z + S[3] * n0.w) + (S[4] * n1.x + S[5] * n1.y) + (S[6] * n1.z + S[7] * n1.w);
                sa = reduce8(sa);
                S[0] = S[0] * w0.x + sa * b0.x + vv * k0.x; S[1] = S[1] * w0.y + sa * b0.y + vv * k0.y; S[2] = S[2] * w0.z + sa * b0.z + vv * k0.z; S[3] = S[3] * w0.w + sa * b0.w + vv * k0.w;
                S[4] = S[4] * w1.x + sa * b1.x + vv * k1.x; S[5] = S[5] * w1.y + sa * b1.y + vv * k1.y; S[6] = S[6] * w1.z + sa * b1.z + vv * k1.z; S[7] = S[7] * w1.w + sa * b1.w + vv * k1.w;
                float y = (S[0] * r0.x + S[1] * r0.y) + (S[2] * r0.z + S[3] * r0.w) + (S[4] * r1.x + S[5] * r1.y) + (S[6] * r1.z + S[7] * r1.w);
                y = reduce8(y);
                if (kq == 0) YC[tt * 64 + row] = y;
            }
            __syncthreads();
            {
                const int tt = F.tid >> 4, c4 = (F.tid & 15) * 4, m = m0 + t0 + tt;
                f32x4 y4 = *(const LAS f32x4*)(YC + tt * 64 + c4);
                float* gp = YB + (size_t)m * D + hh * 64 + c4;
                if (d == 0) *(f32x4*)gp = y4;
                else {
                    y4 += *(const f32x4*)gp;
                    float s1 = (y4.x + y4.y) + (y4.z + y4.w);
                    s1 += __shfl_xor(s1, 1); s1 += __shfl_xor(s1, 2); s1 += __shfl_xor(s1, 4); s1 += __shfl_xor(s1, 8);
                    const float mean = s1 * (1.f / 64.f);
                    const f32x4 dy = y4 - mean;
                    float s2 = (dy.x * dy.x + dy.y * dy.y) + (dy.z * dy.z + dy.w * dy.w);
                    s2 += __shfl_xor(s2, 1); s2 += __shfl_xor(s2, 2); s2 += __shfl_xor(s2, 4); s2 += __shfl_xor(s2, 8);
                    const float rstd = 1.f / sqrtf(s2 * (1.f / 64.f) + 64e-5f);
                    const f32x4 lg = *(const f32x4*)(F.in[I_LNG] + hh * 64 + c4), lb = *(const f32x4*)(F.in[I_LNB] + hh * 64 + c4);
                    const f32x4 vt = *(const LAS f32x4*)(VV + tt * 64 + c4);
                    const float bo = BON[tt];
                    const v2u gb = *(const v2u*)(GB + (size_t)m * D + hh * 64 + c4);
                    const f32x4 yn = dy * rstd * lg + lb + vt * bo;
                    v2u w; w.x = pk2(yn.x * bflo(gb.x), yn.y * bfhi(gb.x)); w.y = pk2(yn.z * bflo(gb.y), yn.w * bfhi(gb.y));
                    *(v2u*)(MIX + (size_t)m * DMIX + 1024 + hh * 64 + c4) = w;
                }
            }
        }
        if (!lat) { float* sp = F.out + OUT_ST + ((size_t)((b * 2 + d) * NHB + hh) * 64 + row) * 64 + kq * 8;
            *(f32x4*)sp = (f32x4){S[0], S[1], S[2], S[3]}; *(f32x4*)(sp + 4) = (f32x4){S[4], S[5], S[6], S[7]}; }
    }
}


constexpr int SG_ST = 144;
constexpr int G_AT = 0, G_RT = 9216, G_BH = 18432, G_KH = 26624, G_LAK = 34816, G_LBR = 36864, G_LKR = 38912, G_TM = 40960, G_GAM = 43008, G_PRIV = 44032;
constexpr int PW_TLW = 0, PW_LAB = 2304, PW_ZS = 4608, PW_LF = PW_ZS, PW_VT = PW_ZS + 1024, PW_SIZE = 8768, G_SIZE = G_PRIV + 4 * PW_SIZE;
constexpr int ZS_ST = 65, VT_ST = 40;
static_assert(2 * G_SIZE <= LDSCTL_OFF, "scan LDS map");
__device__ __forceinline__ bf16x8 mk8(v2u lo, v2u hi) { const v4u t = {lo.x, lo.y, hi.x, hi.y}; return __builtin_bit_cast(bf16x8, t); }
__device__ __forceinline__ bf16x8 pk8(f32x4 a, f32x4 b) { const v4u t = {pk2(a[0], a[1]), pk2(a[2], a[3]), pk2(b[0], b[1]), pk2(b[2], b[3])}; return __builtin_bit_cast(bf16x8, t); }
#define MFMA16(a, b, c) __builtin_amdgcn_mfma_f32_16x16x32_bf16(a, b, c, 0, 0, 0)
template <int CTRL> __device__ __forceinline__ float dpp_mov(float x) { return __builtin_bit_cast(float, __builtin_amdgcn_update_dpp(0, __builtin_bit_cast(int, x), CTRL, 0xf, 0xf, true)); }
__device__ __forceinline__ void wave_sum16(float (&v)[16], int lane) {
    float a8[8], a4[4], a2[2];
    { const bool bit = lane & 4;
#pragma unroll
      for (int m = 0; m < 8; ++m) { const float send = bit ? v[2 * m] : v[2 * m + 1], keep = bit ? v[2 * m + 1] : v[2 * m]; a8[m] = keep + dpp_mov<0x141>(send); } }
    { const bool bit = lane & 1;
#pragma unroll
      for (int m = 0; m < 4; ++m) { const float send = bit ? a8[2 * m] : a8[2 * m + 1], keep = bit ? a8[2 * m + 1] : a8[2 * m]; a4[m] = keep + dpp_mov<0xB1>(send); } }
    { const bool bit = lane & 2;
#pragma unroll
      for (int m = 0; m < 2; ++m) { const float send = bit ? a4[2 * m] : a4[2 * m + 1], keep = bit ? a4[2 * m + 1] : a4[2 * m]; a2[m] = keep + dpp_mov<0x4E>(send); } }
    float t;
    { const bool bit = lane & 8; const float send = bit ? a2[0] : a2[1], keep = bit ? a2[1] : a2[0]; t = keep + dpp_mov<0x128>(send); }
    t += __shfl_xor(t, 16); t += __shfl_xor(t, 32);
#pragma unroll
    for (int i = 0; i < 16; ++i) { constexpr int dummy = 0; const int src = ((i >> 1) & 1) + 2 * ((i >> 2) & 1) + 4 * (i & 1) + 8 * ((i >> 3) & 1);
        v[i] = __builtin_bit_cast(float, __builtin_amdgcn_readlane(__builtin_bit_cast(int, t), src)); }
}
__device__ __forceinline__ void load_shift16(const bf16* ubase, int T, int p0, int d, int col, float mA, float mB, float (&out)[16]) {
    float u[18];
#pragma unroll
    for (int j = 0; j < 18; ++j) { const int tj = d ? (T - p0 - j) : (p0 - 1 + j);
        if (j == 0 || j == 17) u[j] = (tj >= 0 && tj < T) ? bf2f(ubase[(size_t)tj * DSH + col]) : 0.f;
        else u[j] = bf2f(ubase[(size_t)tj * DSH + col]); }
#pragma unroll
    for (int i = 0; i < 16; ++i) out[i] = u[i + 1] + mA * (u[i] - u[i + 1]) + mB * (u[i + 2] - u[i + 1]);
}
__device__ __forceinline__ void scan_unit2(Frame& F, int b, int hh, bool lat) {
    const int T = lat ? LSEQ : SEQ, m0 = lat ? MC + b * LSEQ : b * SEQ, nch = T / 64;
    const int lane0 = F.lane, d = F.wave >> 2, w = F.wave & 3;
    int lane = lane0, c16 = lane & 15, g = lane >> 4, hc = hh * 64 + lane;
    LAS unsigned char* GB_ = F.lds + d * G_SIZE;
    LAS unsigned char* PW = GB_ + G_PRIV + w * PW_SIZE;
    const bf16* UB = (const bf16*)(F.ws + WS_UB) + (size_t)m0 * DSH; const bf16* GBp = (const bf16*)(F.ws + WS_GB); bf16* MIX = (bf16*)(F.ws + WS_MIX);
    float* YB = F.out + OUT_Y;
    const float* mu = F.in[I_MU];
    int cR = hc, cK = 1024 + hc, cV = 2048 + hc, cW = 3072 + 64 * d + lane, cA = 3200 + 64 * d + lane;
    const int oA = d ? DSH : 0, oB = d ? 0 : DSH;
    const float kkc = F.in[I_KK][hc], kac = F.in[I_KA][hc], rkc = F.in[I_RK][hc], w0c = F.in[I_W0][d * D + hc], a0c = F.in[I_A0][d * D + hc];
    const float lng = F.in[I_LNG][hc], lnb = F.in[I_LNB][hc];
    const v4u* wop0 = (const v4u*)(F.ws + WS_WOP) + (size_t)((d * 16 + hh) * 2) * 8 * 64;
    f32x4 S[4];
    const size_t st_off = ((size_t)((b * 2 + d) * NHB + hh) * 64 + 16 * w + c16) * 64 + 4 * g;
#pragma unroll
    for (int kt = 0; kt < 4; ++kt) S[kt] = lat ? *(const f32x4*)(F.in[I_ST] + st_off + 16 * kt) : (f32x4){0.f, 0.f, 0.f, 0.f};
    const v2u z2 = {0u, 0u};
    __syncthreads();
    for (int it = 0; it < nch; ++it) {
        const int p0 = it * 64 + w * 16;
        lane = lane0; asm volatile("" : "+v"(lane));
        c16 = lane & 15; g = lane >> 4; hc = hh * 64 + lane; cR = hc; cK = 1024 + hc; cV = 2048 + hc; cW = 3072 + 64 * d + lane; cA = 3200 + 64 * d + lane;
        const v4u* wop = wop0 + lane;
        float bon[16], v_[16];
        {
            float x_[16];
            load_shift16(UB, T, p0, d, cW, mu[oA + cW], mu[oB + cW], x_);
#pragma unroll
            for (int i = 0; i < 16; ++i) { const float e = __expf(2.f * x_[i]); *(LAS bf16*)(PW + PW_TLW + i * SG_ST + lane * 2) = (bf16)f2bf(1.f - 2.f / (e + 1.f)); }
            load_shift16(UB, T, p0, d, cA, mu[oA + cA], mu[oB + cA], x_);
#pragma unroll
            for (int i = 0; i < 16; ++i) *(LAS bf16*)(PW + PW_LAB + i * SG_ST + lane * 2) = (bf16)f2bf(x_[i]);
        }
        float lam[16], aa[16];
        {
            LAS float* Zs = (LAS float*)(PW + PW_ZS);
            {
                bf16x8 ta[2];
#pragma unroll
                for (int ks = 0; ks < 2; ++ks) ta[ks] = *(const LAS bf16x8*)(PW + PW_TLW + c16 * SG_ST + (32 * ks + 8 * g) * 2);
#pragma unroll
                for (int ct = 0; ct < 4; ++ct) { f32x4 z = {0.f, 0.f, 0.f, 0.f};
#pragma unroll
                    for (int ks = 0; ks < 2; ++ks) z = MFMA16(ta[ks], __builtin_bit_cast(bf16x8, wop[(ct * 2 + ks) * 64]), z);
#pragma unroll
                    for (int rg = 0; rg < 4; ++rg) Zs[(4 * g + rg) * ZS_ST + 16 * ct + c16] = z[rg]; }
                float l = 0.f;
#pragma unroll
                for (int i = 0; i < 16; ++i) { l += -0.60653065971f * sigmoidf_(w0c + Zs[i * ZS_ST + lane]); lam[i] = l; }
            }
            {
                bf16x8 tb[2];
#pragma unroll
                for (int ks = 0; ks < 2; ++ks) tb[ks] = *(const LAS bf16x8*)(PW + PW_LAB + c16 * SG_ST + (32 * ks + 8 * g) * 2);
#pragma unroll
                for (int ct = 0; ct < 4; ++ct) { f32x4 z = {0.f, 0.f, 0.f, 0.f};
#pragma unroll
                    for (int ks = 0; ks < 2; ++ks) z = MFMA16(tb[ks], __builtin_bit_cast(bf16x8, wop[512 + (ct * 2 + ks) * 64]), z);
#pragma unroll
                    for (int rg = 0; rg < 4; ++rg) Zs[(4 * g + rg) * ZS_ST + 16 * ct + c16] = z[rg]; }
#pragma unroll
                for (int i = 0; i < 16; ++i) aa[i] = sigmoidf_(a0c + Zs[i * ZS_ST + lane]);
            }
        }
        {
            float k_[16];
            load_shift16(UB, T, p0, d, cK, mu[oA + cK], mu[oB + cK], k_);
            {
                float n2[16];
#pragma unroll
                for (int i = 0; i < 16; ++i) { const float kk = k_[i] * kkc; n2[i] = kk * kk; }
                wave_sum16(n2, lane);
                unsigned bh[8], kh[8];
#pragma unroll
                for (int i = 0; i < 16; ++i) {
                    const float kk = k_[i] * kkc * (1.f / sqrtf(n2[i] + 1e-12f)), kd = k_[i] * (1.f + (aa[i] - 1.f) * kac), bb = kk * aa[i];
                    const float e1 = i ? __expf(lam[i - 1]) : 1.f, e2 = __expf(-lam[i]);
                    *(LAS bf16*)(GB_ + G_AT + (16 * w + i) * SG_ST + lane * 2) = (bf16)f2bf(-kk * e1);
                    const unsigned btb = f2bf(bb * e2), ktb = f2bf(kd * e2);
                    *(LAS bf16*)(PW + PW_TLW + i * SG_ST + lane * 2) = (bf16)btb;
                    *(LAS bf16*)(PW + PW_LAB + i * SG_ST + lane * 2) = (bf16)ktb;
                    if (i & 1) { bh[i >> 1] |= btb << 16; kh[i >> 1] |= ktb << 16; } else { bh[i >> 1] = btb; kh[i >> 1] = ktb; }
                }
#pragma unroll
                for (int q = 0; q < 4; ++q) {
                    *(LAS v2u*)(GB_ + G_BH + (w * 64 + lane) * 32 + 8 * q) = (v2u){bh[2 * q], bh[2 * q + 1]};
                    *(LAS v2u*)(GB_ + G_KH + (w * 64 + lane) * 32 + 8 * q) = (v2u){kh[2 * q], kh[2 * q + 1]};
                }
            }
            float r_[16];
            load_shift16(UB, T, p0, d, cR, mu[oA + cR], mu[oB + cR], r_);
#pragma unroll
            for (int i = 0; i < 16; ++i) { bon[i] = r_[i] * k_[i] * rkc; *(LAS bf16*)(GB_ + G_RT + (16 * w + i) * SG_ST + lane * 2) = (bf16)f2bf(r_[i] * __expf(lam[i])); }
            wave_sum16(bon, lane);
        }
        ((LAS float*)(GB_ + G_GAM))[w * 64 + lane] = __expf(lam[15]);
        {
            load_shift16(UB, T, p0, d, cV, mu[oA + cV], mu[oB + cV], v_);
            unsigned vt[8];
#pragma unroll
            for (int i = 0; i < 16; ++i) { const unsigned vtb = f2bf(v_[i]); if (i & 1) vt[i >> 1] |= vtb << 16; else vt[i >> 1] = vtb; v_[i] *= bon[i]; }
#pragma unroll
            for (int q = 0; q < 4; ++q) *(LAS v2u*)(PW + PW_VT + lane * VT_ST + 8 * q) = (v2u){vt[2 * q], vt[2 * q + 1]};
        }
        {
            bf16x8 fa[2], fr[2], fb[2], fk[2];
#pragma unroll
            for (int ks = 0; ks < 2; ++ks) {
                fa[ks] = *(const LAS bf16x8*)(GB_ + G_AT + (16 * w + c16) * SG_ST + (32 * ks + 8 * g) * 2); fr[ks] = *(const LAS bf16x8*)(GB_ + G_RT + (16 * w + c16) * SG_ST + (32 * ks + 8 * g) * 2);
                fb[ks] = *(const LAS bf16x8*)(PW + PW_TLW + c16 * SG_ST + (32 * ks + 8 * g) * 2); fk[ks] = *(const LAS bf16x8*)(PW + PW_LAB + c16 * SG_ST + (32 * ks + 8 * g) * 2);
            }
            f32x4 lab = {0.f, 0.f, 0.f, 0.f}, lak = lab, lbr = lab, lkr = lab;
#pragma unroll
            for (int ks = 0; ks < 2; ++ks) { lab = MFMA16(fa[ks], fb[ks], lab); lak = MFMA16(fa[ks], fk[ks], lak); lbr = MFMA16(fr[ks], fb[ks], lbr); lkr = MFMA16(fr[ks], fk[ks], lkr); }
            LAS float* Lf = (LAS float*)(PW + PW_LF);
#pragma unroll
            for (int rg = 0; rg < 4; ++rg) { const int i = 4 * g + rg, j = c16;
                Lf[i * 16 + j] = j < i ? lab[rg] : 0.f;
                *(LAS bf16*)(GB_ + G_LAK + (w * 16 + i) * 32 + j * 2) = (bf16)f2bf(j < i ? lak[rg] : 0.f);
                *(LAS bf16*)(GB_ + G_LBR + (w * 16 + i) * 32 + j * 2) = (bf16)f2bf(j <= i ? lbr[rg] : 0.f);
                *(LAS bf16*)(GB_ + G_LKR + (w * 16 + i) * 32 + j * 2) = (bf16)f2bf(j <= i ? lkr[rg] : 0.f); }
            float tm[16];
#pragma unroll
            for (int i = 0; i < 16; ++i) { float a = (i == c16) ? 1.f : 0.f;
#pragma unroll
                for (int j = 0; j < i; ++j) a += Lf[i * 16 + j] * tm[j];
                tm[i] = a; }
            if (lane < 16) {
#pragma unroll
                for (int i = 0; i < 16; ++i) *(LAS bf16*)(GB_ + G_TM + (w * 16 + i) * 32 + lane * 2) = (bf16)f2bf(tm[i]); }
        }
        __syncthreads();
        const bool first = it < nch / 2;
#pragma unroll 1
        for (int sc = 0; sc < 4; ++sc) {
            lane = lane0; asm volatile("" : "+v"(lane)); c16 = lane & 15; g = lane >> 4;
            const LAS unsigned char* at_p = GB_ + G_AT + (16 * sc + c16) * SG_ST + 8 * g;
            const LAS unsigned char* rt_p = GB_ + G_RT + (16 * sc + c16) * SG_ST + 8 * g;
            const LAS unsigned char* vt_p = GB_ + G_PRIV + sc * PW_SIZE + PW_VT + (16 * w + c16) * VT_ST + 8 * g;
            const bf16x8 sop0 = pk8(S[0], S[1]), sop1 = pk8(S[2], S[3]);
            const bf16x8 at0 = mk8(*(const LAS v2u*)(at_p), *(const LAS v2u*)(at_p + 32)), at1 = mk8(*(const LAS v2u*)(at_p + 64), *(const LAS v2u*)(at_p + 96));
            const bf16x8 rt0 = mk8(*(const LAS v2u*)(rt_p), *(const LAS v2u*)(rt_p + 32)), rt1 = mk8(*(const LAS v2u*)(rt_p + 64), *(const LAS v2u*)(rt_p + 96));
            const v2u vt2 = *(const LAS v2u*)vt_p;
            const bf16x8 alak = mk8(*(const LAS v2u*)(GB_ + G_LAK + (sc * 16 + c16) * 32 + 8 * g), z2);
            const bf16x8 atm = mk8(*(const LAS v2u*)(GB_ + G_TM + (sc * 16 + c16) * 32 + 8 * g), z2);
            const bf16x8 albk = mk8(*(const LAS v2u*)(GB_ + G_LBR + (sc * 16 + c16) * 32 + 8 * g), *(const LAS v2u*)(GB_ + G_LKR + (sc * 16 + c16) * 32 + 8 * g));
            f32x4 X = {0.f, 0.f, 0.f, 0.f};
            X = MFMA16(at0, sop0, X); X = MFMA16(at1, sop1, X); X = MFMA16(alak, mk8(vt2, z2), X);
            const v4u xo = {pk2(X[0], X[1]), pk2(X[2], X[3]), 0u, 0u};
            f32x4 U = {0.f, 0.f, 0.f, 0.f};
            U = MFMA16(atm, __builtin_bit_cast(bf16x8, xo), U);
            const v4u uo = {pk2(U[0], U[1]), pk2(U[2], U[3]), vt2.x, vt2.y};
            const bf16x8 uvop = __builtin_bit_cast(bf16x8, uo);
            float* yp[4];
#pragma unroll
            for (int rg = 0; rg < 4; ++rg) { const int p = it * 64 + sc * 16 + 4 * g + rg, t = d ? T - 1 - p : p; yp[rg] = YB + (size_t)(m0 + t) * D + hh * 64 + 16 * w + c16; }
            f32x4 Y = {0.f, 0.f, 0.f, 0.f};
            if (!first) {
#pragma unroll
                for (int rg = 0; rg < 4; ++rg) Y[rg] = *yp[rg]; }
            Y = MFMA16(rt0, sop0, Y); Y = MFMA16(rt1, sop1, Y); Y = MFMA16(albk, uvop, Y);
#pragma unroll
            for (int rg = 0; rg < 4; ++rg) *yp[rg] = Y[rg];
#pragma unroll
            for (int kt = 0; kt < 4; ++kt) {
                const bf16x8 abk = mk8(*(const LAS v2u*)(GB_ + G_BH + (sc * 64 + 16 * kt + c16) * 32 + 8 * g), *(const LAS v2u*)(GB_ + G_KH + (sc * 64 + 16 * kt + c16) * 32 + 8 * g));
                const f32x4 gm = *(const LAS f32x4*)(GB_ + G_GAM + (sc * 64 + 16 * kt + 4 * g) * 4);
                S[kt] = MFMA16(abk, uvop, S[kt]) * gm;
            }
        }
        __syncthreads();
        if (!first) {
            lane = lane0; asm volatile("" : "+v"(lane)); hc = hh * 64 + lane;
            float y_[16], s1[16];
#pragma unroll
            for (int i = 0; i < 16; ++i) { const int p = p0 + i, t = d ? T - 1 - p : p; y_[i] = YB[(size_t)(m0 + t) * D + hc]; s1[i] = y_[i]; }
            wave_sum16(s1, lane);
#pragma unroll
            for (int i = 0; i < 16; ++i) { y_[i] -= s1[i] * (1.f / 64.f); s1[i] = y_[i] * y_[i]; }
            wave_sum16(s1, lane);
#pragma unroll
            for (int i = 0; i < 16; ++i) { const int p = p0 + i, t = d ? T - 1 - p : p; const size_t m = (size_t)(m0 + t);
                const float yn = y_[i] * (1.f / sqrtf(s1[i] * (1.f / 64.f) + 64e-5f)) * lng + lnb + v_[i];
                MIX[m * DMIX + 1024 + hc] = (bf16)f2bf(yn * bf2f(GBp[m * D + hc])); }
        }
    }
    if (!lat) {
        float* sp = F.out + OUT_ST + st_off;
#pragma unroll
        for (int kt = 0; kt < 4; ++kt) *(f32x4*)(sp + 16 * kt) = S[kt];
    }
}


__device__ __forceinline__ void st_bf16(LAS unsigned char* p, float v) { *(LAS bf16*)p = (bf16)f2bf_hw(v); }
struct PfRows { unsigned off[3]; bool ok[3]; };
__device__ __forceinline__ PfRows pf_rows(int T, int p0, int d, int lane) {
    PfRows R;
#pragma unroll
    for (int q = 0; q < 3; ++q) { const int j = 8 * q + (lane >> 3), jj = j > 17 ? 17 : j, pj = p0 - 1 + jj; int tj = d ? T - 1 - pj : pj; R.ok[q] = tj >= 0 && tj < T; tj = R.ok[q] ? tj : 0;
        R.off[q] = (unsigned)tj * (unsigned)DSH + (unsigned)(lane & 7) * 8u; }
    return R;
}
__device__ __forceinline__ void pf_issue(const bf16* ubase, const PfRows& R, int colb, v4u (&r)[3]) {
#pragma unroll
    for (int q = 0; q < 3; ++q) r[q] = *(const v4u*)(ubase + colb + R.off[q]);
}
__device__ __forceinline__ void pf_consume(LAS unsigned char* stg, const v4u (&r)[3], int lane, float mA, float mB, float (&out)[16], int edge_lo, int edge_hi, float scale = 1.f) {
    if (edge_lo > 0 || edge_hi < 17) {
#pragma unroll
        for (int q = 0; q < 3; ++q) { const int j = 8 * q + (lane >> 3); v4u x = r[q]; if (j < edge_lo || j > edge_hi) x = (v4u){0u, 0u, 0u, 0u};
            *(LAS v4u*)(stg + j * SG_ST + (lane & 7) * 16) = x; }
    } else {
#pragma unroll
        for (int q = 0; q < 3; ++q) *(LAS v4u*)(stg + (8 * q + (lane >> 3)) * SG_ST + (lane & 7) * 16) = r[q];
    }
    asm volatile("" ::: "memory");
    float u[18];
#pragma unroll
    for (int j = 0; j < 18; ++j) u[j] = bf2f(*(const LAS bf16*)(stg + j * SG_ST + lane * 2));
    asm volatile("" ::: "memory");
    const float m0_ = (1.f - mA - mB) * scale, mA_ = mA * scale, mB_ = mB * scale;
#pragma unroll
    for (int i = 0; i < 16; ++i) out[i] = m0_ * u[i + 1] + mA_ * u[i] + mB_ * u[i + 2];
}
__device__ __forceinline__ void scan_unit3(Frame& F, int b, int hh, bool lat, const XcdBarrier* gbar = nullptr, int gbar_it = -1) {
    const int T = lat ? LSEQ : SEQ, m0 = lat ? MC + b * LSEQ : b * SEQ, nch = T / 64;
    int lane0 = F.lane; asm volatile("" : "+v"(lane0));
    const int d = F.wave >> 2, w = F.wave & 3;
    int lane = lane0, c16 = lane & 15, g = lane >> 4, hc = hh * 64 + lane;
    LAS unsigned char* GB_ = F.lds + d * G_SIZE;
    LAS unsigned char* PW = GB_ + G_PRIV + w * PW_SIZE;
    const bf16* UB = (const bf16*)(F.ws + WS_UB) + (size_t)m0 * DSH; const bf16* GBp = (const bf16*)(F.ws + WS_GB); bf16* MIX = (bf16*)(F.ws + WS_MIX);
    float* YB = F.out + OUT_Y;
    const float* mu = F.in[I_MU];
    const int cR = hh * 64, cK = 1024 + hh * 64, cV = 2048 + hh * 64, cW = 3072 + 64 * d, cA = 3200 + 64 * d;
    const int oA = d ? DSH : 0, oB = d ? 0 : DSH;
    const float kkc = F.in[I_KK][hc], kac = F.in[I_KA][hc], rkc = F.in[I_RK][hc], w0c = F.in[I_W0][d * D + hc] * 1.44269504088896f, a0c = F.in[I_A0][d * D + hc] * 1.44269504088896f;
    const float mWA = mu[oA + cW + lane], mWB = mu[oB + cW + lane], mAA = mu[oA + cA + lane], mAB = mu[oB + cA + lane], mKA = mu[oA + cK + lane], mKB = mu[oB + cK + lane];
    const float mRA = mu[oA + cR + lane], mRB = mu[oB + cR + lane], mVA = mu[oA + cV + lane], mVB = mu[oB + cV + lane];
    const v4u* wop0 = (const v4u*)(F.ws + WS_WOP) + (size_t)((d * 16 + hh) * 2) * 8 * 64;
    f32x4 S[4];
    { const size_t st_off = ((size_t)((b * 2 + d) * NHB + hh) * 64 + 16 * w + c16) * 64 + 4 * g;
#pragma unroll
    for (int kt = 0; kt < 4; ++kt) S[kt] = lat ? *(const f32x4*)(F.in[I_ST] + st_off + 16 * kt) : (f32x4){0.f, 0.f, 0.f, 0.f}; }
    const v2u z2 = {0u, 0u};
    v4u pW[3], pA[3], pK[3], pR[3], pV[3];
    { const PfRows R = pf_rows(T, w * 16, d, lane); pf_issue(UB, R, cW, pW); pf_issue(UB, R, cA, pA); pf_issue(UB, R, cK, pK); pf_issue(UB, R, cR, pR); pf_issue(UB, R, cV, pV); }
    __syncthreads();
    for (int it = 0; it < nch; ++it) {
        if (it == gbar_it) xcd_barrier(*gbar);
        const int p0 = it * 64 + w * 16;
        const bool first = it < nch / 2;
        lane = lane0; asm volatile("" : "+v"(lane));
        c16 = lane & 15; g = lane >> 4; hc = hh * 64 + lane;
        const v4u* wop = wop0 + lane;
        LAS unsigned char* stg = PW + PW_ZS;
        const int elo = p0 == 0 ? 1 : 0, ehi = (T - p0) < 17 ? (T - p0) : 17;
        float bon[16], v_[16];
#ifndef SREP_PREP
#define SREP_PREP 1
#endif
#ifndef SREP_POST
#define SREP_POST 1
#endif
#ifndef SREP_B
#define SREP_B 1
#endif
#pragma unroll 1
        for (int rep_ = 0; rep_ < SREP_PREP; ++rep_) {
        {
            float x_[16];
            pf_consume(stg, pW, lane, mWA, mWB, x_, elo, ehi, 2.f * 1.44269504088896f);
#pragma unroll
            for (int i = 0; i < 16; ++i) { const float e = __builtin_amdgcn_exp2f(x_[i]); st_bf16(PW + PW_TLW + i * SG_ST + lane * 2, 1.f - 2.f * __builtin_amdgcn_rcpf(e + 1.f)); }
            pf_consume(stg, pA, lane, mAA, mAB, x_, elo, ehi);
#pragma unroll
            for (int i = 0; i < 16; ++i) st_bf16(PW + PW_LAB + i * SG_ST + lane * 2, x_[i]);
        }
        float k_[16];
        pf_consume(stg, pK, lane, mKA, mKB, k_, elo, ehi);
        asm volatile("" ::: "memory");
        float lam[16], aa[16];
        {
            LAS float* Zs = (LAS float*)(PW + PW_ZS);
            {
                bf16x8 ta[2];
#pragma unroll
                for (int ks = 0; ks < 2; ++ks) ta[ks] = *(const LAS bf16x8*)(PW + PW_TLW + c16 * SG_ST + (32 * ks + 8 * g) * 2);
#pragma unroll
                for (int ct = 0; ct < 4; ++ct) { f32x4 z = {0.f, 0.f, 0.f, 0.f};
#pragma unroll
                    for (int ks = 0; ks < 2; ++ks) z = MFMA16(ta[ks], __builtin_bit_cast(bf16x8, wop[(ct * 2 + ks) * 64]), z);
#pragma unroll
                    for (int rg = 0; rg < 4; ++rg) Zs[(4 * g + rg) * ZS_ST + 16 * ct + c16] = z[rg]; }
                float l = 0.f;
#pragma unroll
                for (int i = 0; i < 16; ++i) { l += (-0.60653065971f * 1.44269504088896f) * sigmoid2_(w0c + Zs[i * ZS_ST + lane]); lam[i] = l; }
            }
            asm volatile("" ::: "memory");
            {
                bf16x8 tb[2];
#pragma unroll
                for (int ks = 0; ks < 2; ++ks) tb[ks] = *(const LAS bf16x8*)(PW + PW_LAB + c16 * SG_ST + (32 * ks + 8 * g) * 2);
#pragma unroll
                for (int ct = 0; ct < 4; ++ct) { f32x4 z = {0.f, 0.f, 0.f, 0.f};
#pragma unroll
                    for (int ks = 0; ks < 2; ++ks) z = MFMA16(tb[ks], __builtin_bit_cast(bf16x8, wop[512 + (ct * 2 + ks) * 64]), z);
#pragma unroll
                    for (int rg = 0; rg < 4; ++rg) Zs[(4 * g + rg) * ZS_ST + 16 * ct + c16] = z[rg]; }
#pragma unroll
                for (int i = 0; i < 16; ++i) aa[i] = sigmoid2_(a0c + Zs[i * ZS_ST + lane]);
            }
        }
        {
            {
                float n2[16];
#pragma unroll
                for (int i = 0; i < 16; ++i) { const float kk = k_[i] * kkc; n2[i] = kk * kk; }
                wave_sum16(n2, lane);
                unsigned bh[8], kh[8];
                float e1 = 1.f;
#pragma unroll
                for (int i = 0; i < 16; i += 2) {
                    float bt2[2], kt2[2];
#pragma unroll
                    for (int e = 0; e < 2; ++e) {
                        const float kk = k_[i + e] * kkc * __builtin_amdgcn_rsqf(n2[i + e] + 1e-12f), kd = k_[i + e] * (1.f + (aa[i + e] - 1.f) * kac), bb = kk * aa[i + e];
                        const float e3 = __builtin_amdgcn_exp2f(lam[i + e]), e2 = __builtin_amdgcn_rcpf(e3);
                        lam[i + e] = e3;
                        st_bf16(GB_ + G_AT + (16 * w + i + e) * SG_ST + lane * 2, -kk * e1);
                        bt2[e] = bb * e2; kt2[e] = kd * e2; e1 = e3;
                    }
                    const unsigned bp = pk2(bt2[0], bt2[1]), kp = pk2(kt2[0], kt2[1]);
                    bh[i >> 1] = bp; kh[i >> 1] = kp;
                    *(LAS bf16*)(PW + PW_TLW + i * SG_ST + lane * 2) = (bf16)bp; *(LAS bf16*)(PW + PW_TLW + (i + 1) * SG_ST + lane * 2) = (bf16)(bp >> 16);
                    *(LAS bf16*)(PW + PW_LAB + i * SG_ST + lane * 2) = (bf16)kp; *(LAS bf16*)(PW + PW_LAB + (i + 1) * SG_ST + lane * 2) = (bf16)(kp >> 16);
                }
#pragma unroll
                for (int q = 0; q < 4; ++q) {
                    *(LAS v2u*)(GB_ + G_BH + (w * 64 + lane) * 32 + 8 * q) = (v2u){bh[2 * q], bh[2 * q + 1]};
                    *(LAS v2u*)(GB_ + G_KH + (w * 64 + lane) * 32 + 8 * q) = (v2u){kh[2 * q], kh[2 * q + 1]};
                }
            }
            float r_[16];
            pf_consume(stg, pR, lane, mRA, mRB, r_, elo, ehi);
#pragma unroll
            for (int i = 0; i < 16; ++i) { bon[i] = r_[i] * k_[i] * rkc; st_bf16(GB_ + G_RT + (16 * w + i) * SG_ST + lane * 2, r_[i] * lam[i]); }
            wave_sum16(bon, lane);
        }
        ((LAS float*)(GB_ + G_GAM))[w * 64 + lane] = lam[15];
        {
            pf_consume(stg, pV, lane, mVA, mVB, v_, elo, ehi);
            unsigned vt[8];
#pragma unroll
            for (int i = 0; i < 16; i += 2) { vt[i >> 1] = pk2(v_[i], v_[i + 1]); v_[i] *= bon[i]; v_[i + 1] *= bon[i + 1]; }
            asm volatile("" ::: "memory");
#pragma unroll
            for (int q = 0; q < 4; ++q) *(LAS v2u*)(PW + PW_VT + lane * VT_ST + 8 * q) = (v2u){vt[2 * q], vt[2 * q + 1]};
        }
        asm volatile("" ::: "memory");
        {
            bf16x8 fa[2], fr[2], fb[2], fk[2];
#pragma unroll
            for (int ks = 0; ks < 2; ++ks) {
                fa[ks] = *(const LAS bf16x8*)(GB_ + G_AT + (16 * w + c16) * SG_ST + (32 * ks + 8 * g) * 2); fr[ks] = *(const LAS bf16x8*)(GB_ + G_RT + (16 * w + c16) * SG_ST + (32 * ks + 8 * g) * 2);
                fb[ks] = *(const LAS bf16x8*)(PW + PW_TLW + c16 * SG_ST + (32 * ks + 8 * g) * 2); fk[ks] = *(const LAS bf16x8*)(PW + PW_LAB + c16 * SG_ST + (32 * ks + 8 * g) * 2);
            }
            f32x4 lab = {0.f, 0.f, 0.f, 0.f}, lak = lab, lbr = lab, lkr = lab;
#pragma unroll
            for (int ks = 0; ks < 2; ++ks) { lab = MFMA16(fa[ks], fb[ks], lab); lak = MFMA16(fa[ks], fk[ks], lak); lbr = MFMA16(fr[ks], fb[ks], lbr); lkr = MFMA16(fr[ks], fk[ks], lkr); }
            LAS float* Lf = (LAS float*)(PW + PW_LF);
#pragma unroll
            for (int rg = 0; rg < 4; ++rg) { const int i = 4 * g + rg, j = c16;
                Lf[i * 16 + j] = j < i ? lab[rg] : 0.f;
                st_bf16(GB_ + G_LAK + (w * 16 + i) * 32 + j * 2, j < i ? lak[rg] : 0.f);
                st_bf16(GB_ + G_LBR + (w * 16 + i) * 32 + j * 2, j <= i ? lbr[rg] : 0.f);
                st_bf16(GB_ + G_LKR + (w * 16 + i) * 32 + j * 2, j <= i ? lkr[rg] : 0.f); }
            float tm[16];
#pragma unroll
            for (int i = 0; i < 16; ++i) { float a = (i == c16) ? 1.f : 0.f;
#pragma unroll
                for (int j = 0; j < i; ++j) a += Lf[i * 16 + j] * tm[j];
                tm[i] = a; }
            if (lane < 16) {
#pragma unroll
                for (int i = 0; i < 16; ++i) st_bf16(GB_ + G_TM + (w * 16 + i) * 32 + lane * 2, tm[i]); }
        }
        }
        __syncthreads();
        const PfRows PR = pf_rows(T, p0 + 64, d, lane);
        const float* yop = YB + (size_t)(m0 + (d ? T - 1 - p0 : p0)) * D + hc; const long ystep = d ? -(long)D : (long)D;
        float yo[16];
        {
            lane = lane0; asm volatile("" : "+v"(lane)); c16 = lane & 15; g = lane >> 4;
            const LAS unsigned char* at_b = GB_ + G_AT + c16 * SG_ST + 8 * g;
            const LAS unsigned char* rt_b = GB_ + G_RT + c16 * SG_ST + 8 * g;
            const LAS unsigned char* vt_b = GB_ + G_PRIV + PW_VT + (16 * w + c16) * VT_ST + 8 * g;
            const LAS unsigned char* l_b = GB_ + c16 * 32 + 8 * g;
            const LAS unsigned char* gm_b = GB_ + G_GAM + 16 * g;
            LAS float* yc_b = (LAS float*)(GB_ + G_PRIV + PW_TLW) + (4 * g) * ZS_ST + 16 * w + c16;
#pragma unroll
            for (int sc = 0; sc < 4; ++sc) {
                if (sc == 0) { pf_issue(UB, PR, cW, pW); pf_issue(UB, PR, cA, pA); }
                if (sc == 1) { pf_issue(UB, PR, cK, pK); pf_issue(UB, PR, cR, pR); }
                if (sc == 2) { pf_issue(UB, PR, cV, pV);
#pragma unroll
                    for (int i = 0; i < 6; ++i) yo[i] = yop[i * ystep]; }
                if (sc == 3) {
#pragma unroll
                    for (int i = 6; i < 16; ++i) yo[i] = yop[i * ystep]; }
                const LAS unsigned char* at_p = at_b + sc * 16 * SG_ST; const LAS unsigned char* rt_p = rt_b + sc * 16 * SG_ST;
                const bf16x8 sop0 = pk8(S[0], S[1]), sop1 = pk8(S[2], S[3]);
                const bf16x8 at0 = mk8(*(const LAS v2u*)(at_p), *(const LAS v2u*)(at_p + 32)), at1 = mk8(*(const LAS v2u*)(at_p + 64), *(const LAS v2u*)(at_p + 96));
                const bf16x8 rt0 = mk8(*(const LAS v2u*)(rt_p), *(const LAS v2u*)(rt_p + 32)), rt1 = mk8(*(const LAS v2u*)(rt_p + 64), *(const LAS v2u*)(rt_p + 96));
                const v2u vt2 = *(const LAS v2u*)(vt_b + sc * PW_SIZE);
                const bf16x8 alak = mk8(*(const LAS v2u*)(l_b + G_LAK + sc * 512), z2);
                const bf16x8 atm = mk8(*(const LAS v2u*)(l_b + G_TM + sc * 512), z2);
                const bf16x8 albk = mk8(*(const LAS v2u*)(l_b + G_LBR + sc * 512), *(const LAS v2u*)(l_b + G_LKR + sc * 512));
                f32x4 X = {0.f, 0.f, 0.f, 0.f}, Y = X;
                X = MFMA16(at0, sop0, X); Y = MFMA16(rt0, sop0, Y); X = MFMA16(at1, sop1, X); Y = MFMA16(rt1, sop1, Y); X = MFMA16(alak, mk8(vt2, z2), X);
                const v4u xo = {pk2(X[0], X[1]), pk2(X[2], X[3]), 0u, 0u};
                f32x4 U = {0.f, 0.f, 0.f, 0.f};
                U = MFMA16(atm, __builtin_bit_cast(bf16x8, xo), U);
                const v4u uo = {pk2(U[0], U[1]), pk2(U[2], U[3]), vt2.x, vt2.y};
                const bf16x8 uvop = __builtin_bit_cast(bf16x8, uo);
                Y = MFMA16(albk, uvop, Y);
#pragma unroll
                for (int kt = 0; kt < 4; ++kt) {
                    const bf16x8 abk = mk8(*(const LAS v2u*)(l_b + G_BH + (sc * 64 + 16 * kt) * 32), *(const LAS v2u*)(l_b + G_KH + (sc * 64 + 16 * kt) * 32));
                    const f32x4 gm = *(const LAS f32x4*)(gm_b + (sc * 64 + 16 * kt) * 4);
                    S[kt] = MFMA16(abk, uvop, S[kt]) * gm;
                }
                LAS float* yc = yc_b + sc * (PW_SIZE / 4);
#pragma unroll
                for (int rg = 0; rg < 4; ++rg) yc[rg * ZS_ST] = Y[rg];
            }
        }
        __syncthreads();
#pragma unroll 1
        for (int rep_ = 0; rep_ < SREP_POST; ++rep_)
        {
            lane = lane0; asm volatile("" : "+v"(lane)); hc = hh * 64 + lane;
            const LAS float* yc = (const LAS float*)(PW + PW_TLW);
            float y_[16];
#pragma unroll
            for (int i = 0; i < 16; ++i) y_[i] = yc[i * ZS_ST + lane];
            if (first) {
#pragma unroll
                for (int i = 0; i < 16; ++i) { const int p = p0 + i, t = d ? T - 1 - p : p; YB[(size_t)(m0 + t) * D + hc] = y_[i]; }
            } else {
                const float lng = F.in[I_LNG][hc], lnb = F.in[I_LNB][hc];
                unsigned short gb_[16];
#pragma unroll
                for (int i = 0; i < 16; ++i) { const int p = p0 + i, t = d ? T - 1 - p : p; gb_[i] = *(const unsigned short*)(GBp + (size_t)(m0 + t) * D + hc); }
                float s1[16];
#pragma unroll
                for (int i = 0; i < 16; ++i) { y_[i] += yo[i]; s1[i] = y_[i]; }
                wave_sum16(s1, lane);
#pragma unroll
                for (int i = 0; i < 16; ++i) { y_[i] -= s1[i] * (1.f / 64.f); s1[i] = y_[i] * y_[i]; }
                wave_sum16(s1, lane);
#pragma unroll
                for (int i = 0; i < 16; ++i) { const int p = p0 + i, t = d ? T - 1 - p : p; const size_t m = (size_t)(m0 + t);
                    const float yn = y_[i] * __builtin_amdgcn_rsqf(s1[i] * (1.f / 64.f) + 64e-5f) * lng + lnb + v_[i];
                    MIX[m * DMIX + 1024 + hc] = (bf16)f2bf_hw(yn * bf2f((bf16)gb_[i])); }
            }
        }
    }
    if (!lat) {
        lane = lane0; asm volatile("" : "+v"(lane)); c16 = lane & 15; g = lane >> 4;
        float* sp = F.out + OUT_ST + ((size_t)((b * 2 + d) * NHB + hh) * 64 + 16 * w + c16) * 64 + 4 * g;
#pragma unroll
        for (int kt = 0; kt < 4; ++kt) *(f32x4*)(sp + 16 * kt) = S[kt];
    }
}

template <int QW, int MASK> __device__ __forceinline__ void p3_mixers(Frame& F, const XcdBarrier& gbar) {
    float lam;
    { const float a = F.in[I_LQ1][F.lane] * F.in[I_LK1][F.lane], bq = F.in[I_LQ2][F.lane] * F.in[I_LK2][F.lane];
      lam = __expf(wave_sum(a)) - __expf(wave_sum(bq)) + 0.2f; }
    constexpr int N_SC = NBC * NHB, N_AL = NBL * NH * (LSEQ / 128), N_AC = NBC * NH * (SEQ / 128);
    constexpr int NU = N_AL + N_SC + N_AC;
    volatile LAS int* slot = (volatile LAS int*)(F.lds + MISC_OFF + 64);
    bool chain_first = (int)blockIdx.x < NLATB;
    for (;;) {
        int u, sb, sh, git = -1; bool slat = false, is_scan;
        if (chain_first) { chain_first = false; is_scan = true; slat = true; sb = (int)blockIdx.x / NHB; sh = (int)blockIdx.x % NHB; git = LAT_BAR_IT; u = 0; }
        else {
            __syncthreads();
            if (F.tid == 0) *slot = (int)__hip_atomic_fetch_add((unsigned*)(F.ctl + CW_Q3 + 64 * QW), 1u, RLX_AGENT);
            __syncthreads();
            u = *slot;
            if (u >= NU) break;
            is_scan = u < N_SC;
            sb = u / NHB; sh = u % NHB;
        }
        if (is_scan) { scan_unit3(F, sb, sh, slat, &gbar, git); continue; }
        { u -= N_SC; const bool lt = u < N_AL; if (!lt) u -= N_AL; attn_unit(F, u, lt, lam); }
    }
}

template <bool DUMMY> __device__ __forceinline__ void p5_final(Frame& F) {
    int ln = F.lane; asm volatile("" : "+v"(ln));
    const float* ssq = (const float*)(F.ws + WS_SSQ);
    const int gw = blockIdx.x * NWAVES + F.wave, NGW = F.G * NWAVES;
    for (int m = gw; m < M; m += NGW) {
        float s = ln < 16 ? ssq[(size_t)m * 16 + ln] : 0.f;
        s = wave_sum(s);
        const float rstd = 1.f / sqrtf(s * (1.f / D) + 1e-6f);
        float* yr = F.out + OUT_Y + (size_t)m * D;
#pragma unroll
        for (int j = 0; j < 4; ++j) { const int c = 4 * ln + 256 * j; const f32x4 v = *(const f32x4*)(yr + c), g = *(const f32x4*)(F.in[I_FG] + c); *(f32x4*)(yr + c) = DUMMY ? v : v * rstd * g; }
    }
}

__global__ void __launch_bounds__(NTHR, 2) hymba_fwd(Args args) {
    extern __shared__ __attribute__((aligned(16))) unsigned char lds[];
    Frame F;
    F.lds = (LAS unsigned char*)lds;
    F.MISC = (volatile LAS unsigned*)(F.lds + MISC_OFF);
    F.tid = threadIdx.x; F.lane = F.tid & 63; F.wave = __builtin_amdgcn_readfirstlane(F.tid >> 6);
    F.G = gridDim.x; F.in = args.in; F.out = args.out; F.ws = args.ws;
    F.ctl = (gu32*)(args.ws + WS_CTL);
    for (int u = F.tid; u < (LDS_BYTES - LDSCTL_OFF) / 4; u += NTHR) ((LAS unsigned*)(F.lds + LDSCTL_OFF))[u] = 0u;
    __syncthreads();
    XcdBarrier bar; bar.bar = (unsigned*)(F.ctl + CW_BAR); bar.x = 0; bar.st = nullptr;
    if (N_LAUNCHES != PER_PHASE) bar = xcd_barrier_post((unsigned*)(F.ctl + CW_BAR), F.MISC + 8);
#define GRID_BAR() do { if (N_LAUNCHES != PER_PHASE) xcd_barrier(bar); } while (0)
    const int lo = args.ph_lo, hi = args.ph_hi;
#define IN(k) (lo <= (k) && (k) < hi)
#define BOTH(k) (IN(k) && IN((k) + 1))
#ifndef REP0
#define REP0 1
#endif
#ifndef REP2
#define REP2 1
#endif
#ifndef REP3MASK
#define REP3MASK 0
#endif
#ifndef REP4
#define REP4 1
#endif
#define RELANE() do { int t_ = threadIdx.x; asm volatile("" : "+v"(t_)); F.tid = t_; F.lane = t_ & 63; } while (0)
    {
        f32x4 xv[5][4];
        p0_prologue(F); RELANE(); p1_load<0, 3>(F, xv); GRID_BAR();
        p1_load<3, 5>(F, xv); p1_norm(F, xv); GRID_BAR();
    }
    RELANE();
    if (IN(2)) {
        const pg8::Gemm g{(const bf16*)(F.ws + WS_XN), (const bf16*)(F.ws + WS_WIN), M, DIN, D};
        {
            const f32x4 rv = *(const f32x4*)((const float*)(F.ws + WS_ROPE) + 4 * F.tid);
            *(LAS f32x4*)(F.lds + ROPE_LDS + 16 * F.tid) = rv;
            __syncthreads();
        }
        const EpiIn E{F.ws, F.out, (const LAS float*)(F.lds + ROPE_LDS)};
        const bool chain = (int)blockIdx.x < NLATB;
#pragma unroll 1
        for (int part = 0; part < 2; ++part) {
            if (part == 1 && chain) break;
            ListOrder S;
            if (part == 0) S.init(F.G, (int)blockIdx.x, 0, P2A_UNITS); else S.init(F.G - NLATB, (int)blockIdx.x - NLATB, P2A_UNITS, P2_UNITS);
            pg8::gemm_phase<EpiIn, ListOrder, true, true>(F.lds + RING_OFF, g, S, E);
            GRID_BAR();
        }
    }
    RELANE();
    if (IN(3)) { p3_mixers<0, 15>(F, bar); if (BOTH(3)) GRID_BAR(); }
    RELANE();
    if (IN(4)) {
        pg8::Gemm g{(const bf16*)(F.ws + WS_MIX), (const bf16*)(F.ws + WS_WOUT), M, D, DMIX}; pg8::StaticOrder S; S.init(M, D, F.G, (int)blockIdx.x);
        EpiOutFused E{F.ws, F.out, F.in[I_XP], F.in[I_XS], F.in[I_FG], F.ctl};
        pg8::gemm_phase<EpiOutFused, pg8::StaticOrder, false, true>(F.lds + RING_OFF, g, S, E);
    }
#undef IN
#undef BOTH
}

extern "C" void kernel_launch(void* const* d_in, const int* in_sizes, int n_in, void* d_out, int out_size, void* d_ws, size_t ws_size, hipStream_t stream) {
    static int grid = 0;
    if (grid == 0) {
        if (n_in != N_IN || out_size != OUT_END || ws_size < WS_END) { fprintf(stderr, "kernel_launch: unexpected sizes n_in %d out %d ws %zu\n", n_in, out_size, ws_size); grid = -1; return; }
        int dev = 0, cus = 0, per_cu = 0;
        if (hipGetDevice(&dev) != hipSuccess || hipDeviceGetAttribute(&cus, hipDeviceAttributeMultiprocessorCount, dev) != hipSuccess) { grid = -1; return; }
        if (hipFuncSetAttribute((const void*)hymba_fwd, hipFuncAttributeMaxDynamicSharedMemorySize, LDS_BYTES) != hipSuccess) { fprintf(stderr, "kernel_launch: hipFuncSetAttribute failed\n"); grid = -1; return; }
        if (hipOccupancyMaxActiveBlocksPerMultiprocessor(&per_cu, (const void*)hymba_fwd, NTHR, LDS_BYTES) != hipSuccess || per_cu < 1) { fprintf(stderr, "kernel_launch: occupancy query says %d\n", per_cu); per_cu = 1; }
        (void)hipGetLastError();
        grid = cus;
        if (grid != 256) { fprintf(stderr, "kernel_launch: built for a 256-CU device (got %d CUs)\n", cus); grid = -1; return; }
    }
    if (grid < 0) return;
    if (hipMemsetAsync((char*)d_ws + WS_CTL, 0, CTL_ZERO_BYTES, stream) != hipSuccess) return;
    Args a{};
    for (int i = 0; i < N_IN; ++i) a.in[i] = (const float*)d_in[i];
    a.out = (float*)d_out; a.ws = (unsigned char*)d_ws;
    a.ph_lo = 0; a.ph_hi = PER_PHASE; a.li = 0;
    hipLaunchKernelGGL(hymba_fwd, dim3(grid), dim3(NTHR), LDS_BYTES, stream, a);
}
```

```cpp
#include <hip/hip_runtime.h>
#include <cstdio>
#include <cstdint>

#ifndef MK_N_LAUNCHES
#define MK_N_LAUNCHES 1
#endif

namespace pg8 {
#define PG8_LAS __attribute__((address_space(3)))
typedef unsigned short bf16_t;
typedef short bf16x8 __attribute__((ext_vector_type(8)));
typedef float f32x4 __attribute__((ext_vector_type(4)));
typedef unsigned u32x4 __attribute__((ext_vector_type(4)));
constexpr int BM = 256, BK = 64, HALF = 128, HTB = HALF * BK * 2, STAGE_BYTES = 8 * HTB, NXCD = 8, WGM = 8;

__host__ __device__ __forceinline__ int lds_byte(int r, int c) { const int st = (r >> 4) * 2 + (c >> 5), rr = r & 15, cc = c & 31, ob = rr * 64 + cc * 2; return st * 1024 + (ob ^ (((ob >> 9) & 1) << 5)); }
__host__ __device__ __forceinline__ void stage_rc(int b, int& R, int& C) { const int st = b / 1024, sb = b % 1024, swz = sb ^ (((sb >> 9) & 1) << 5); R = (st >> 1) * 16 + swz / 64; C = (st & 1) * 32 + (swz % 64) / 2; }
__host__ __device__ __forceinline__ int perm32(int rho) { const int n = rho >> 4, i = rho & 15; return 8 * (i >> 2) + 4 * n + (i & 3); }

struct Unit { int pm, pn; };
struct Gemm { const bf16_t* A; const bf16_t* Bt; int M, N, K; };

struct StaticOrder {
    int nM, nN, nwg, G, c;
    __host__ __device__ void init(int M, int N, int G_, int c_) { nM = M / BM; nN = N / BM; nwg = nM * nN; G = G_; c = c_; }
    __host__ __device__ bool next(int i, Unit& u) const {
        const long L = (long)i * G + c; if (L >= nwg) return false;
        int wgid = (int)L; { const int q = nwg / NXCD, r = nwg % NXCD, xcd = wgid % NXCD, off = wgid / NXCD; wgid = (xcd < r ? xcd * (q + 1) : r * (q + 1) + (xcd - r) * q) + off; }
        const int nig = WGM * nN, gid = wgid / nig, fm = gid * WGM, gsz = (nM - fm) < WGM ? (nM - fm) : WGM;
        u.pm = fm + ((wgid % nig) % gsz); u.pn = (wgid % nig) / gsz; return true;
    }
    __device__ __forceinline__ void a_ready(const Unit&) const {}
    __device__ __forceinline__ void done(const Unit&) const {}
};

__device__ __forceinline__ unsigned cvt_pk_bf16(float lo, float hi) { unsigned r; asm volatile("v_cvt_pk_bf16_f32 %0, %1, %2" : "=v"(r) : "v"(lo), "v"(hi)); return r; }

template <class Epi, class Sched, bool ALIGN_EPI = false, bool SP2 = false>
__device__ __forceinline__ void gemm_phase(PG8_LAS unsigned char* lds, const Gemm g, const Sched& S, const Epi& E) {
    int tid = threadIdx.x; asm volatile("" : "+v"(tid));
    const int wid = __builtin_amdgcn_readfirstlane(tid >> 6), lane = tid & 63, wr = wid >> 2, wc = wid & 3, fr = lane & 15, fq = lane >> 4;
    const int K = g.K, nt = K / BK;
    unsigned voffA[2], voffB[2];
#pragma unroll
    for (int i = 0; i < 2; ++i) { int R, C; stage_rc(tid * 16 + i * 8192, R, C); const int Rb = Epi::PERM ? ((R & ~31) + perm32(R & 31)) : R;
        voffA[i] = (unsigned)(R * K + C) * 2u; voffB[i] = (unsigned)(Rb * K + C) * 2u; }
    const size_t kstep = (size_t)(BK * 2);
    const size_t hstep = (size_t)HALF * K * 2;
    const size_t tstep = 2 * hstep;
    const unsigned ldsw = (unsigned)wid * 1024u;
    const int aoff = lds_byte(wr * 64 + fr, fq * 8), boff = lds_byte(wc * 32 + fr, fq * 8);
#define PG8_SA(b, h) (((b) * 2 + (h)) * HTB)
#define PG8_SB(b, h) ((4 + (b) * 2 + (h)) * HTB)
#define PG8_STAGE(bufoff, gbase, voff) do { _Pragma("unroll") for (int _i = 0; _i < 2; ++_i) \
        __builtin_amdgcn_global_load_lds((const unsigned*)((const char*)(gbase) + (voff)[_i]), (PG8_LAS unsigned*)(lds + (bufoff) + ldsw + _i * 8192), 16, 0, 0); } while (0)
#define PG8_LDA(dst, b, h) do { _Pragma("unroll") for (int m = 0; m < 4; ++m) _Pragma("unroll") for (int k = 0; k < 2; ++k) dst[m][k] = *(const PG8_LAS bf16x8*)(lds + PG8_SA(b, h) + aoff + m * 2048 + k * 1024); } while (0)
#define PG8_LDB(dst, b, h) do { _Pragma("unroll") for (int n = 0; n < 2; ++n) _Pragma("unroll") for (int k = 0; k < 2; ++k) dst[n][k] = *(const PG8_LAS bf16x8*)(lds + PG8_SB(b, h) + boff + n * 2048 + k * 1024); } while (0)
#define PG8_MMA(ai, bj, At, Bt) do { __builtin_amdgcn_s_setprio(1); _Pragma("unroll") for (int m = 0; m < 4; ++m) _Pragma("unroll") for (int n = 0; n < 2; ++n) _Pragma("unroll") for (int k = 0; k < 2; ++k) \
        acc[ai][bj][m][n] = __builtin_amdgcn_mfma_f32_16x16x32_bf16(Bt[n][k], At[m][k], acc[ai][bj][m][n], 0, 0, 0); __builtin_amdgcn_s_setprio(0); } while (0)
#define PG8_WAIT_V(n) asm volatile("s_waitcnt vmcnt(" #n ")" ::: "memory")
#define PG8_WAIT_L(n) asm volatile("s_waitcnt lgkmcnt(" #n ")" ::: "memory")
#define PG8_BAR __builtin_amdgcn_s_barrier()
#define PG8_SCHED __builtin_amdgcn_sched_barrier(0)
    Unit cur, nxt; int ui = 0;
    if (!S.next(0, cur)) return;
    f32x4 acc[2][2][4][2];
#pragma unroll
    for (int a = 0; a < 2; ++a)
#pragma unroll
        for (int b = 0; b < 2; ++b)
#pragma unroll
            for (int m = 0; m < 4; ++m)
#pragma unroll
                for (int n = 0; n < 2; ++n) acc[a][b][m][n] = (f32x4){0.f, 0.f, 0.f, 0.f};
    bf16x8 At[4][2], B0[2][2], B1[2][2];
    const char* cA = (const char*)g.A + (size_t)cur.pm * tstep; const char* cB = (const char*)g.Bt + (size_t)cur.pn * tstep;
    S.a_ready(cur);
    if constexpr (SP2) {
        PG8_STAGE(PG8_SB(0, 0), cB, voffB); PG8_STAGE(PG8_SB(0, 1), cB + hstep, voffB); PG8_STAGE(PG8_SA(0, 0), cA, voffA); PG8_STAGE(PG8_SA(0, 1), cA + hstep, voffA);
        if (wr == 1) PG8_BAR;
        PG8_WAIT_V(2); PG8_BAR;
        PG8_STAGE(PG8_SB(1, 0), cB + kstep, voffB); PG8_STAGE(PG8_SA(1, 0), cA + kstep, voffA); PG8_STAGE(PG8_SB(1, 1), cB + hstep + kstep, voffB);
        PG8_WAIT_V(6); PG8_BAR;
    } else {
        PG8_STAGE(PG8_SB(0, 0), cB, voffB); PG8_STAGE(PG8_SA(0, 0), cA, voffA); PG8_STAGE(PG8_SB(0, 1), cB + hstep, voffB); PG8_STAGE(PG8_SA(0, 1), cA + hstep, voffA);
        if (wr == 1) PG8_BAR;
        PG8_WAIT_V(4); PG8_BAR;
        PG8_STAGE(PG8_SB(1, 0), cB + kstep, voffB); PG8_STAGE(PG8_SA(1, 0), cA + kstep, voffA); PG8_STAGE(PG8_SB(1, 1), cB + hstep + kstep, voffB);
        PG8_WAIT_V(6); PG8_BAR;
    }
    for (;;) {
        const bool has_next = S.next(ui + 1, nxt);
        const char* nA = has_next ? (const char*)g.A + (size_t)nxt.pm * tstep : cA; const char* nB = has_next ? (const char*)g.Bt + (size_t)nxt.pn * tstep : cB;
        for (int t = 0; t < nt; t += 2) {
            const bool last = (t == nt - 2);
            const char* a1 = cA + (size_t)(t + 1) * kstep;
            const char* a2 = last ? nA : cA + (size_t)(t + 2) * kstep; const char* b2 = last ? nB : cB + (size_t)(t + 2) * kstep;
            const char* a3 = a2 + kstep; const char* b3 = b2 + kstep;
            if (last && has_next) S.a_ready(nxt);
            if constexpr (SP2) {
            PG8_LDB(B0, 0, 0); PG8_LDB(B1, 0, 1); PG8_SCHED; PG8_LDA(At, 0, 0); PG8_STAGE(PG8_SA(1, 1), a1 + hstep, voffA);
            PG8_WAIT_V(8); PG8_WAIT_L(0); PG8_BAR; PG8_MMA(0, 0, At, B0); PG8_MMA(0, 1, At, B1); PG8_BAR; PG8_SCHED;
            PG8_LDA(At, 0, 1); PG8_STAGE(PG8_SB(0, 0), b2, voffB); PG8_STAGE(PG8_SB(0, 1), b2 + hstep, voffB); PG8_STAGE(PG8_SA(0, 0), a2, voffA);
            PG8_WAIT_V(8); PG8_WAIT_L(0); PG8_BAR; PG8_MMA(1, 0, At, B0); PG8_MMA(1, 1, At, B1); PG8_BAR; PG8_SCHED;
            PG8_LDB(B0, 1, 0); PG8_LDB(B1, 1, 1); PG8_SCHED; PG8_LDA(At, 1, 0); PG8_STAGE(PG8_SA(0, 1), a2 + hstep, voffA);
            PG8_WAIT_V(8); PG8_WAIT_L(0); PG8_BAR; PG8_MMA(0, 0, At, B0); PG8_MMA(0, 1, At, B1); PG8_BAR; PG8_SCHED;
            PG8_LDA(At, 1, 1); PG8_STAGE(PG8_SB(1, 0), b3, voffB); PG8_STAGE(PG8_SB(1, 1), b3 + hstep, voffB); PG8_STAGE(PG8_SA(1, 0), a3, voffA);
            PG8_WAIT_V(8); PG8_WAIT_L(0); PG8_BAR; PG8_MMA(1, 0, At, B0); PG8_MMA(1, 1, At, B1); PG8_BAR; PG8_SCHED;
            } else {
            PG8_LDB(B0, 0, 0); PG8_SCHED; PG8_LDA(At, 0, 0); PG8_STAGE(PG8_SA(1, 1), a1 + hstep, voffA);
            PG8_WAIT_L(8); PG8_BAR; PG8_WAIT_L(0); PG8_MMA(0, 0, At, B0); PG8_BAR; PG8_SCHED;
            PG8_LDB(B1, 0, 1); PG8_STAGE(PG8_SB(0, 0), b2, voffB);
            PG8_BAR; PG8_WAIT_L(0); PG8_MMA(0, 1, At, B1); PG8_BAR;
            PG8_LDA(At, 0, 1); PG8_STAGE(PG8_SA(0, 0), a2, voffA);
            PG8_BAR; PG8_WAIT_L(0); PG8_MMA(1, 0, At, B0); PG8_BAR; PG8_SCHED;
            PG8_STAGE(PG8_SB(0, 1), b2 + hstep, voffB);
            PG8_WAIT_V(6); PG8_BAR; PG8_MMA(1, 1, At, B1); PG8_BAR;
            PG8_LDB(B0, 1, 0); PG8_SCHED; PG8_LDA(At, 1, 0); PG8_STAGE(PG8_SA(0, 1), a2 + hstep, voffA);
            PG8_WAIT_L(8); PG8_BAR; PG8_WAIT_L(0); PG8_MMA(0, 0, At, B0); PG8_BAR; PG8_SCHED;
            PG8_LDB(B1, 1, 1); PG8_STAGE(PG8_SB(1, 0), b3, voffB);
            PG8_BAR; PG8_WAIT_L(0); PG8_MMA(0, 1, At, B1); PG8_BAR;
            PG8_LDA(At, 1, 1); PG8_STAGE(PG8_SA(1, 0), a3, voffA);
            PG8_BAR; PG8_WAIT_L(0); PG8_MMA(1, 0, At, B0); PG8_BAR; PG8_SCHED;
            PG8_STAGE(PG8_SB(1, 1), b3 + hstep, voffB);
            PG8_WAIT_V(6); PG8_BAR; PG8_MMA(1, 1, At, B1); PG8_BAR;
            }
        }
        if constexpr (ALIGN_EPI) { if (wr == 0) PG8_BAR; }
        if constexpr (!Epi::AFTER_DRAIN) { E(acc, cur, wr, wc, fr, fq); S.done(cur); }
        if (!has_next) break;
#pragma unroll
        for (int a = 0; a < 2; ++a)
#pragma unroll
            for (int b = 0; b < 2; ++b)
#pragma unroll
                for (int m = 0; m < 4; ++m)
#pragma unroll
                    for (int n = 0; n < 2; ++n) acc[a][b][m][n] = (f32x4){0.f, 0.f, 0.f, 0.f};
        cur = nxt; cA = nA; cB = nB; ++ui;
        if constexpr (ALIGN_EPI) { if (wr == 1) PG8_BAR; }
    }
    PG8_WAIT_V(0);
    if constexpr (!ALIGN_EPI) { if (wr == 0) PG8_BAR; }
    PG8_BAR;
    if constexpr (Epi::AFTER_DRAIN) { E.fused(acc, cur, wr, wc, fr, fq, lds, wid, lane); S.done(cur); }
#undef PG8_SA
#undef PG8_SB
#undef PG8_STAGE
#undef PG8_LDA
#undef PG8_LDB
#undef PG8_MMA
#undef PG8_WAIT_V
#undef PG8_WAIT_L
#undef PG8_BAR
#undef PG8_SCHED
}
}

constexpr int NWAVES = 8, NTHR = 512;
constexpr int N_LAUNCHES = MK_N_LAUNCHES;
constexpr int PER_PHASE = 6;
constexpr int D = 1024, NBC = 32, SEQ = 256, NBL = 2, LSEQ = 1024, PAST = 512, KLAT = PAST + LSEQ;
constexpr int MC = NBC * SEQ, ML = NBL * LSEQ, M = MC + ML;
constexpr int DIN = 8448, DMIX = 2048, DSH = 3328, NH = 8, NHB = 16;
constexpr int OUT_Y = 0, OUT_CK = M * D, OUT_CV = OUT_CK + MC * D, OUT_ST = OUT_CV + MC * D, OUT_END = OUT_ST + NBC * 2 * NHB * 64 * 64;

enum { I_XP = 0, I_XS, I_CK, I_CV, I_ST, I_C, I_CCTX, I_NG, I_WADA, I_BADA, I_WIN, I_LQ1, I_LK1, I_LQ2, I_LK2, I_SUBG, I_MU, I_W0, I_W2, I_A0, I_A2, I_KK, I_KA, I_RK, I_LNG, I_LNB, I_WOUT, I_FG, N_IN };

constexpr size_t MiB = 1u << 20;
constexpr size_t WS_CTL = 0, CTL_ZERO_BYTES = 64 * 1024;
constexpr size_t WS_MODP = 1 * MiB;
constexpr size_t WS_MODF = WS_MODP + 640 * 1024;
constexpr size_t WS_ROPE = WS_MODF + 64 * 1024;
constexpr size_t WS_SSQ = 2 * MiB;
constexpr size_t WS_WOP = 3 * MiB;
constexpr size_t WS_WIN = 4 * MiB;
constexpr size_t WS_WOUT = 21 * MiB;
constexpr size_t WS_XN = 25 * MiB;
constexpr size_t WS_Q = 45 * MiB;
constexpr size_t WS_KC = 65 * MiB;
constexpr size_t WS_KL = 81 * MiB;
constexpr size_t WS_VTC = 87 * MiB;
constexpr size_t WS_VTL = 103 * MiB;
constexpr size_t WS_GA = 109 * MiB;
constexpr size_t WS_GB = 129 * MiB;
constexpr size_t WS_UB = 149 * MiB;
constexpr size_t WS_MIX = 214 * MiB;
constexpr size_t WS_END = 254 * MiB;
constexpr int CW_BAR = 4096;
constexpr int CW_BAR2 = 11264;
constexpr int CW_P2A = 2176;
constexpr int CW_P2DONE = 2112;
constexpr int CW_Q3 = 64;

constexpr int RING_OFF = 0, RING_BYTES = 131072, ROPE_LDS = RING_OFF + RING_BYTES;
constexpr int LDS_BYTES = 163840;
constexpr int LDSCTL_OFF = LDS_BYTES - 1024, MISC_OFF = LDSCTL_OFF + 320;

#define GAS __attribute__((address_space(1)))
#define LAS __attribute__((address_space(3)))
typedef unsigned short bf16;
typedef unsigned v4u __attribute__((ext_vector_type(4)));
typedef unsigned v2u __attribute__((ext_vector_type(2)));
typedef float f32x4 __attribute__((ext_vector_type(4)));
typedef float f32x16 __attribute__((ext_vector_type(16)));
typedef short bf16x8 __attribute__((ext_vector_type(8)));
typedef GAS unsigned gu32;
#define RLX_AGENT __ATOMIC_RELAXED, __HIP_MEMORY_SCOPE_AGENT
#define LDS_WAIT() asm volatile("s_waitcnt lgkmcnt(0)" ::: "memory")
#define VM_WAIT() asm volatile("s_waitcnt vmcnt(0)" ::: "memory")
__device__ __forceinline__ unsigned f2bf(float f) { unsigned u = __builtin_bit_cast(unsigned, f); return (u + 0x7fffu + ((u >> 16) & 1u)) >> 16; }
typedef float f32x2_t __attribute__((ext_vector_type(2)));
typedef __bf16 bf16x2_t __attribute__((ext_vector_type(2)));
__device__ __forceinline__ unsigned pk2(float lo, float hi) { const f32x2_t f = {lo, hi}; return __builtin_bit_cast(unsigned, __builtin_convertvector(f, bf16x2_t)); }
__device__ __forceinline__ unsigned f2bf_hw(float f) { return pk2(f, f); }
__device__ __forceinline__ float bf2f(unsigned b) { return __builtin_bit_cast(float, b << 16); }
__device__ __forceinline__ float bflo(unsigned w) { return __builtin_bit_cast(float, w << 16); }
__device__ __forceinline__ float bfhi(unsigned w) { return __builtin_bit_cast(float, w & 0xffff0000u); }
__device__ __forceinline__ float sigmoidf_(float x) { return __builtin_amdgcn_rcpf(1.f + __expf(-x)); }
__device__ __forceinline__ float sigmoid2_(float x2) { return __builtin_amdgcn_rcpf(1.f + __builtin_amdgcn_exp2f(-x2)); }
__device__ __forceinline__ float siluf_(float x) { return x * __builtin_amdgcn_rcpf(1.f + __expf(-x)); }

#define XB_TMO      128
#define XB_XCNT(j)  (256  + 64 * (j))
#define XB_XSUB(j)  (1280 + 64 * (j))
#define XB_XGEN(j)  (2304 + 64 * (j))
#define XB_TOP      3328
#define XB_TOPGEN   3392
#define XCD_BAR_WORDS 3456
#define XB_SPIN_CAP (1u << 18)
__device__ __forceinline__ unsigned xb_ld(unsigned* p)              { return __hip_atomic_load(p, __ATOMIC_RELAXED, __HIP_MEMORY_SCOPE_AGENT); }
__device__ __forceinline__ unsigned xb_add(unsigned* p, unsigned v) { return __hip_atomic_fetch_add(p, v, __ATOMIC_RELAXED, __HIP_MEMORY_SCOPE_AGENT); }
__device__ __forceinline__ unsigned xb_xcc_id() { return (unsigned)__builtin_amdgcn_s_getreg((3 << 11) | 20) & 0xFu; }
#define XB_SPIN(cond, bar) do { unsigned _sp = 0; while (cond) { __builtin_amdgcn_s_sleep(1); \
    if ((++_sp & 255u) == 0u) { if (xb_ld(&(bar)[XB_TMO])) break; if (_sp > XB_SPIN_CAP) { atomicAdd(&(bar)[XB_TMO], 1u); break; } } } } while (0)
struct XcdBarrier { unsigned* bar; unsigned x; volatile LAS unsigned* st; unsigned expect; };
__device__ __forceinline__ XcdBarrier xcd_barrier_post(unsigned* bar, volatile LAS unsigned* st, unsigned expect = 0u) {
    XcdBarrier b; b.bar = bar; b.x = xb_xcc_id(); b.st = st; b.expect = expect;
    if (threadIdx.x == 0) (void)xb_add(&bar[XB_XCNT(b.x)], 1u);
    return b;
}
__device__ __forceinline__ void xcd_barrier_complete(unsigned* bar, unsigned x, unsigned& nloc, unsigned& nx, unsigned expect) {
    const unsigned G = expect ? expect : gridDim.x * gridDim.y * gridDim.z;
    unsigned sum, cnt, mine, sp = 0u;
    for (;;) {
        sum = 0u; cnt = 0u; mine = 0u;
#pragma unroll
        for (unsigned j = 0; j < 16; ++j) { const unsigned c = xb_ld(&bar[XB_XCNT(j)]); sum += c; cnt += (c > 0u) ? 1u : 0u; mine = (j == x) ? c : mine; }
        if (sum == G) break;
        __builtin_amdgcn_s_sleep(1);
        if ((++sp & 255u) == 0u) { if (xb_ld(&bar[XB_TMO])) break; if (sp > XB_SPIN_CAP) { atomicAdd(&bar[XB_TMO], 1u); break; } }
    }
    nloc = mine > 0u ? mine : 1u; nx = cnt > 0u ? cnt : 1u;
}
__device__ __forceinline__ void xcd_barrier(const XcdBarrier& b) {
    asm volatile("s_waitcnt vmcnt(0)" ::: "memory");
    __syncthreads();
    if (threadIdx.x == 0) {
        unsigned* bar = b.bar;
        __builtin_amdgcn_s_waitcnt(0);
        unsigned nloc = b.st[0], nx = b.st[1];
        if (nloc == 0u) { xcd_barrier_complete(bar, b.x, nloc, nx, b.expect); b.st[0] = nloc; b.st[1] = nx; }
        const unsigned old = xb_add(&bar[XB_XSUB(b.x)], 1u);
        const unsigned gen = old / nloc;
        if (old + 1u == (gen + 1u) * nloc) {
            __builtin_amdgcn_fence(__ATOMIC_RELEASE, "agent");
            asm volatile("s_waitcnt vmcnt(0)" ::: "memory");
            const unsigned og = xb_add(&bar[XB_TOP], 1u);
            const unsigned tg = og / nx;
            if (og + 1u == (tg + 1u) * nx) xb_add(&bar[XB_TOPGEN], 1u);
            else XB_SPIN(xb_ld(&bar[XB_TOPGEN]) == tg, bar);
            __builtin_amdgcn_fence(__ATOMIC_ACQUIRE, "agent");
            xb_add(&bar[XB_XGEN(b.x)], 1u);
            asm volatile("s_waitcnt vmcnt(0)" ::: "memory");
        } else {
            XB_SPIN(xb_ld(&bar[XB_XGEN(b.x)]) == gen, bar);
            __builtin_amdgcn_fence(__ATOMIC_ACQUIRE, "agent");
            asm volatile("s_waitcnt vmcnt(0)" ::: "memory");
        }
    }
    __syncthreads();
}

struct Args { const float* in[N_IN]; float* out; unsigned char* ws; int ph_lo, ph_hi, li, pad; };
struct Frame {
    LAS unsigned char* lds;
    volatile LAS unsigned* MISC;
    gu32* ctl;
    int tid, lane, wave, G;
    const float* const* in;
    float* out; unsigned char* ws;
};
__device__ __forceinline__ float wave_sum(float v) {
#pragma unroll
    for (int o = 1; o < 64; o <<= 1) v += __shfl_xor(v, o);
    return v;
}
__device__ __forceinline__ const float* xrow_ptr(const Frame& F, int m) { return m < MC ? F.in[I_XP] + (size_t)m * D : F.in[I_XS] + (size_t)(m - MC) * D; }

__device__ __forceinline__ void p0_transpose_item(const float* W, int K, int N, bf16* WT, LAS float* scr, int item, int lane) {
    const int nblk = N / 32, kb = item / nblk, nb = item % nblk, k0 = 64 * kb, n0 = 32 * nb;
#pragma unroll 4
    for (int i = 0; i < 32; ++i) { const int kk = 2 * i + (lane >> 5); scr[kk * 33 + (lane & 31)] = __builtin_nontemporal_load(W + (size_t)(k0 + kk) * N + n0 + (lane & 31)); }
    LDS_WAIT(); asm volatile("" ::: "memory");
    const int c = lane & 7;
#pragma unroll
    for (int j = 0; j < 4; ++j) { const int n = (lane >> 3) + 8 * j; const LAS float* s = scr + (8 * c) * 33 + n;
        v4u o; o.x = pk2(s[0 * 33], s[1 * 33]); o.y = pk2(s[2 * 33], s[3 * 33]); o.z = pk2(s[4 * 33], s[5 * 33]); o.w = pk2(s[6 * 33], s[7 * 33]);
        __builtin_amdgcn_raw_buffer_store_b128(o, __builtin_amdgcn_make_buffer_rsrc((void*)WT, (short)0, 0x04000000, 0x00020000), (unsigned)(((size_t)(n0 + n) * K + k0 + 8 * c) * 2), 0, 16); }
    LDS_WAIT(); asm volatile("" ::: "memory");
}
__device__ __forceinline__ void p0_prologue(Frame& F) {
    LAS float* scr = (LAS float*)(F.lds + RING_OFF + F.wave * 16384);
    const int gw = blockIdx.x * NWAVES + F.wave, NGW = F.G * NWAVES;
    bf16* WinT = (bf16*)(F.ws + WS_WIN);
    constexpr int I_IN = (D / 64) * (DIN / 32), I_OUT = (DMIX / 64) * (D / 32), I_MOD = 16 * 12, I_CV_ = NBL * NH * (PAST / 64);
    {
        const int e = ((int)blockIdx.x - (F.G - 2)) * NTHR + F.tid;
        if (e >= 0 && e < 1024) { float* rp = (float*)(F.ws + WS_ROPE); const int pos = e >> 4, i = e & 15; const double inv = pow(10000.0, -(double)i / 16.0), ang = (double)pos * inv; rp[e] = (float)cos(ang); rp[1024 + e] = (float)sin(ang); }
    }
    {
        const int r = NGW - 1 - gw;
        if (r < I_MOD) {
            const int kc = r / 12, nb = r % 12, n0 = nb * 256 + 4 * F.lane;
            const float* wa = F.in[I_WADA] + (size_t)(kc * 64) * 3072 + n0;
            f32x4 a0 = {0.f, 0.f, 0.f, 0.f}, a1 = a0, a2 = a0;
#pragma unroll 16
            for (int k = 0; k < 64; ++k) {
                const f32x4 w = __builtin_nontemporal_load((const f32x4*)(wa + (size_t)k * 3072));
                const float s0 = siluf_(F.in[I_CCTX][kc * 64 + k]), s1 = siluf_(F.in[I_C][kc * 64 + k]), s2 = siluf_(F.in[I_C][D + kc * 64 + k]);
                a0 += w * s0; a1 += w * s1; a2 += w * s2;
            }
            float* mp = (float*)(F.ws + WS_MODP) + (size_t)kc * 3 * 3072 + n0;
            *(f32x4*)(mp) = a0; *(f32x4*)(mp + 3072) = a1; *(f32x4*)(mp + 2 * 3072) = a2;
        } else if (r < I_MOD + I_CV_) {
            const int q_ = r - I_MOD, tb = q_ % (PAST / 64), hh = (q_ / (PAST / 64)) % NH, b = q_ / (NH * (PAST / 64));
            const float* src = F.in[I_CV] + ((size_t)(b * PAST + tb * 64 + F.lane) * NH + hh) * 128;
            bf16* dst = (bf16*)(F.ws + WS_VTL) + (size_t)((b * NH + hh) * 128) * KLAT + tb * 64 + F.lane;
#pragma unroll 1
            for (int dv0 = 0; dv0 < 128; dv0 += 32) {
                f32x4 v[8];
#pragma unroll
                for (int q = 0; q < 8; ++q) v[q] = *(const f32x4*)(src + dv0 + 4 * q);
#pragma unroll
                for (int q = 0; q < 8; ++q) { const int dv = dv0 + 4 * q;
                    dst[(size_t)(dv + 0) * KLAT] = (bf16)f2bf(v[q].x); dst[(size_t)(dv + 1) * KLAT] = (bf16)f2bf(v[q].y); dst[(size_t)(dv + 2) * KLAT] = (bf16)f2bf(v[q].z); dst[(size_t)(dv + 3) * KLAT] = (bf16)f2bf(v[q].w); }
            }
        }
    }
    {
        const int NW1 = NGW - (I_MOD + I_CV_);
        if (gw < NW1) for (int it = gw; it < I_IN; it += NW1) p0_transpose_item(F.in[I_WIN], D, DIN, WinT, scr, it, F.lane);
    }
    for (int idx = blockIdx.x * NTHR + F.tid; idx < 2 * 16 * 2 * 4 * 2 * 64; idx += F.G * NTHR) {
        const int ln = idx & 63, ks = (idx >> 6) & 1, ct = (idx >> 7) & 3, mat = (idx >> 9) & 1, hh = (idx >> 10) & 15, dd = idx >> 14;
        const float* src = F.in[mat ? I_A2 : I_W2] + (size_t)(dd * 64 + 32 * ks + 8 * (ln >> 4)) * D + hh * 64 + 16 * ct + (ln & 15);
        constexpr float L2E = 1.44269504088896f;
        v4u o; o.x = pk2(src[0] * L2E, src[D] * L2E); o.y = pk2(src[2 * D] * L2E, src[3 * D] * L2E); o.z = pk2(src[4 * D] * L2E, src[5 * D] * L2E); o.w = pk2(src[6 * D] * L2E, src[7 * D] * L2E);
        ((v4u*)(F.ws + WS_WOP))[idx] = o;
    }
    bf16* KL = (bf16*)(F.ws + WS_KL);
    for (int i = blockIdx.x * NTHR + F.tid; i < NBL * PAST * D / 8; i += F.G * NTHR) {
        const int e = i * 8, b = e / (PAST * D), rem = e % (PAST * D);
        const f32x4 v0 = *(const f32x4*)(F.in[I_CK] + e), v1 = *(const f32x4*)(F.in[I_CK] + e + 4);
        v4u o; o.x = pk2(v0.x, v0.y); o.y = pk2(v0.z, v0.w); o.z = pk2(v1.x, v1.y); o.w = pk2(v1.z, v1.w);
        *(v4u*)(KL + (size_t)b * KLAT * D + rem) = o;
    }
}

template <int I0, int I1> __device__ __forceinline__ void p1_load(Frame& F, f32x4 (&v)[5][4]) {
#pragma unroll
    for (int i = I0; i < I1; ++i) { const float* xr = xrow_ptr(F, ((int)blockIdx.x + 256 * i) * 8 + F.wave);
#pragma unroll
        for (int j = 0; j < 4; ++j) v[i][j] = __builtin_nontemporal_load((const f32x4*)(xr + 4 * F.lane + 256 * j)); }
}
__device__ __forceinline__ void p1_norm(Frame& F, f32x4 (&v)[5][4]) {
    LAS float* modL = (LAS float*)(F.lds + RING_OFF);
    const float* modp = (const float*)(F.ws + WS_MODP);
    const float* bada = F.in[I_BADA];
    int mrow[5];
#pragma unroll
    for (int i = 0; i < 5; ++i) mrow[i] = ((int)blockIdx.x + 256 * i) * 8 + F.wave;
    if (blockIdx.x < 36 && F.tid < 256) {
        const int idx = blockIdx.x * 256 + F.tid, ci = idx / 3072, n = idx % 3072;
        float pt[16];
#pragma unroll
        for (int kc = 0; kc < 16; ++kc) pt[kc] = modp[(size_t)(kc * 3 + ci) * 3072 + n];
#pragma unroll
        for (int kc = 0; kc < 16; ++kc) asm volatile("" : "+v"(pt[kc]));
        float s = bada[n];
#pragma unroll
        for (int kc = 0; kc < 16; ++kc) s += pt[kc];
        ((float*)(F.ws + WS_MODF))[idx] = s;
    }
    {
        const int cil = 1 + (int)blockIdx.x / 128;
#pragma unroll 1
        for (int e = F.tid; e < 4096; e += 2 * NTHR) {
            float pt[2][16], s[2];
#pragma unroll
            for (int h = 0; h < 2; ++h) { const int e2 = e + h * NTHR, n = e2 & 2047, ci = e2 < 2048 ? 0 : cil; s[h] = bada[n];
#pragma unroll
                for (int kc = 0; kc < 16; ++kc) pt[h][kc] = modp[(size_t)(kc * 3 + ci) * 3072 + n]; }
#pragma unroll
            for (int h = 0; h < 2; ++h)
#pragma unroll
                for (int kc = 0; kc < 16; ++kc) asm volatile("" : "+v"(pt[h][kc]));
#pragma unroll
            for (int h = 0; h < 2; ++h) {
#pragma unroll
                for (int kc = 0; kc < 16; ++kc) s[h] += pt[h][kc];
                modL[e + h * NTHR] = s[h]; }
        }
    }
    __syncthreads();
    bf16* XN = (bf16*)(F.ws + WS_XN);
    const __amdgpu_buffer_rsrc_t rsx_ = __builtin_amdgcn_make_buffer_rsrc((void*)F.ws, (short)0, 0x10000000, 0x00020000);
    f32x4 gn[4];
#pragma unroll
    for (int j = 0; j < 4; ++j) gn[j] = *(const f32x4*)(F.in[I_NG] + 4 * F.lane + 256 * j);
#pragma unroll
    for (int i = 0; i < 5; ++i) {
        float ss = 0.f;
#pragma unroll
        for (int j = 0; j < 4; ++j) ss += (v[i][j].x * v[i][j].x + v[i][j].y * v[i][j].y) + (v[i][j].z * v[i][j].z + v[i][j].w * v[i][j].w);
        const float rstd = __builtin_amdgcn_rsqf(wave_sum(ss) * (1.f / D) + 1e-6f);
        const LAS float* ml = modL + (i == 4 ? 2048 : 0);
#pragma unroll
        for (int j = 0; j < 4; ++j) {
            const int c = 4 * F.lane + 256 * j;
            const f32x4 sh = *(const LAS f32x4*)(ml + c), sc = *(const LAS f32x4*)(ml + 1024 + c);
            const f32x4 h = (v[i][j] * rstd) * gn[j] * (sc + 1.0f) + sh;
            v2u o; o.x = pk2(h.x, h.y); o.y = pk2(h.z, h.w);
            __builtin_amdgcn_raw_buffer_store_b64(o, rsx_, (unsigned)((const char*)(XN + (size_t)mrow[i] * D + c) - (const char*)F.ws), 0, 16);
        }
    }
}

__device__ __forceinline__ __amdgpu_buffer_rsrc_t ws_rsrc(unsigned char* ws) { return __builtin_amdgcn_make_buffer_rsrc((void*)ws, (short)0, 0x10000000, 0x00020000); }
__device__ __forceinline__ void st_wt16(__amdgpu_buffer_rsrc_t rs, const void* base, const void* p, v4u v) { __builtin_amdgcn_raw_buffer_store_b128(v, rs, (unsigned)((const char*)p - (const char*)base), 0, 16); }
__device__ __forceinline__ void st_wt2(__amdgpu_buffer_rsrc_t rs, const void* base, const void* p, unsigned short v) { __builtin_amdgcn_raw_buffer_store_b16(v, rs, (unsigned)((const char*)p - (const char*)base), 0, 16); }
struct EpiIn {
    static constexpr bool PERM = true, AFTER_DRAIN = false;
    unsigned char* ws; float* out; const LAS float* rope;
    __device__ __forceinline__ void operator()(const f32x4 (&acc)[2][2][4][2], const pg8::Unit& u, int wr, int wc, int fr, int fq) const {
        const int pn = u.pn; const bool lat = u.pm >= MC / 256;
        const __amdgpu_buffer_rsrc_t rs_ = ws_rsrc(ws);
        constexpr float QS = 0.125f * 1.44269504088896f;
#pragma unroll
        for (int ai = 0; ai < 2; ++ai)
#pragma unroll
            for (int m = 0; m < 4; ++m) {
                const int r = u.pm * 256 + ai * 128 + wr * 64 + m * 16 + fr;
#pragma unroll
                for (int bj = 0; bj < 2; ++bj) {
                    const int c = pn * 256 + bj * 128 + wc * 32 + 8 * fq;
                    f32x4 v0 = acc[ai][bj][m][0], v1 = acc[ai][bj][m][1];
                    if (pn < 8) {
                        const bool isq = pn < 4; const int cc = isq ? c : c - 1024;
                        if (lat) {
                            const int t = (r - MC) & (LSEQ - 1), pos = (wc & 1) ? (t & 63) : (t >> 6);
                            const LAS float* cp = rope + pos * 16 + 8 * (fq & 1);
                            const f32x4 c0 = *(const LAS f32x4*)cp, c1 = *(const LAS f32x4*)(cp + 4), s0 = *(const LAS f32x4*)(cp + 1024), s1 = *(const LAS f32x4*)(cp + 1028);
                            f32x4 p0, p1;
#pragma unroll
                            for (int j = 0; j < 4; ++j) { p0[j] = __shfl_xor(v0[j], 32); p1[j] = __shfl_xor(v1[j], 32); }
                            const float sg = (fq & 2) ? 1.f : -1.f;
                            v0 = v0 * c0 + (p0 * s0) * sg; v1 = v1 * c1 + (p1 * s1) * sg;
                        }
                        if (isq) { v0 = v0 * QS; v1 = v1 * QS; }
                        else if (!lat) { float* o = out + OUT_CK + (size_t)r * D + cc; *(f32x4*)o = v0; *(f32x4*)(o + 4) = v1; }
                        v4u w; w.x = pk2(v0[0], v0[1]); w.y = pk2(v0[2], v0[3]); w.z = pk2(v1[0], v1[1]); w.w = pk2(v1[2], v1[3]);
                        bf16* dst;
                        if (isq) dst = (bf16*)(ws + WS_Q) + (size_t)r * D + cc;
                        else if (!lat) dst = (bf16*)(ws + WS_KC) + (size_t)r * D + cc;
                        else { const int b = (r - MC) >> 10, t = (r - MC) & (LSEQ - 1); dst = (bf16*)(ws + WS_KL) + ((size_t)b * KLAT + PAST + t) * D + cc; }
                        st_wt16(rs_, ws, dst, w);
                    } else if (pn < 12) {
                        const int cc = c - 2048, hh = cc >> 7, dv = cc & 127;
                        bf16* dst;
                        if (!lat) { float* o = out + OUT_CV + (size_t)r * D + cc; *(f32x4*)o = v0; *(f32x4*)(o + 4) = v1;
                            const int b = r >> 8, t = r & 255; dst = (bf16*)(ws + WS_VTC) + (size_t)((b * NH + hh) * 128 + dv) * SEQ + t;
#pragma unroll
                            for (int j = 0; j < 4; ++j) { dst[(size_t)j * SEQ] = (bf16)f2bf(v0[j]); dst[(size_t)(4 + j) * SEQ] = (bf16)f2bf(v1[j]); }
                        } else { const int b = (r - MC) >> 10, t = (r - MC) & (LSEQ - 1); dst = (bf16*)(ws + WS_VTL) + (size_t)((b * NH + hh) * 128 + dv) * KLAT + PAST + t;
#pragma unroll
                            for (int j = 0; j < 4; ++j) { dst[(size_t)j * KLAT] = (bf16)f2bf(v0[j]); dst[(size_t)(4 + j) * KLAT] = (bf16)f2bf(v1[j]); }
                        }
                    } else if (pn < 16 || pn >= 29) {
                        bf16* dst = pn < 16 ? (bf16*)(ws + WS_GA) + (size_t)r * D + (c - 3072) : (bf16*)(ws + WS_GB) + (size_t)r * D + (c - 7424);
                        v4u w; w.x = pk2(siluf_(v0[0]), siluf_(v0[1])); w.y = pk2(siluf_(v0[2]), siluf_(v0[3])); w.z = pk2(siluf_(v1[0]), siluf_(v1[1])); w.w = pk2(siluf_(v1[2]), siluf_(v1[3]));
                        st_wt16(rs_, ws, dst, w);
                    } else {
                        v4u w; w.x = pk2(v0[0], v0[1]); w.y = pk2(v0[2], v0[3]); w.z = pk2(v1[0], v1[1]); w.w = pk2(v1[2], v1[3]);
                        st_wt16(rs_, ws, (bf16*)(ws + WS_UB) + (size_t)r * DSH + (c - 4096), w);
                    }
                }
            }
    }
};

#ifndef NIDLE
#define NIDLE 8
#endif
constexpr int NOFF = 32 + NIDLE;
constexpr int NLATB = 32;
constexpr int LAT_UNITS = (ML / 256) * (DIN / 256);
constexpr int LAT_CHAIN = (ML / 256) * (DIN / 256 - 16);
constexpr int P2A_UNITS = 256, P2_UNITS = (M / 256) * (DIN / 256);
struct ListOrder {
    int G, v, lo, hi;
    __device__ void init(int G_, int c_, int lo_, int hi_) { G = G_; v = (G_ % 8 == 0) ? (c_ % 8) * (G_ / 8) + c_ / 8 : c_; lo = lo_; hi = hi_; }
    __device__ bool next(int i, pg8::Unit& u) const {
        int L = lo + i * G + v; if (L >= hi) return false;
        if (L < LAT_CHAIN) { u.pn = 16 + (L >> 3); u.pm = MC / 256 + (L & 7); return true; }
        if (L < LAT_UNITS) { const int L2 = L - LAT_CHAIN; u.pn = L2 >> 3; u.pm = MC / 256 + (L2 & 7); return true; }
        L -= LAT_UNITS;
        const int grp = L / (8 * (DIN / 256)), r = L % (8 * (DIN / 256)); u.pn = r >> 3; u.pm = grp * 8 + (r & 7); return true;
    }
    __device__ __forceinline__ void a_ready(const pg8::Unit&) const {}
    __device__ __forceinline__ void done(const pg8::Unit&) const {}
};

constexpr size_t WS_XCH = WS_SSQ;
constexpr int CW_PANEL = 8192;
struct EpiOutFused {
    static constexpr bool PERM = false, AFTER_DRAIN = true;
    unsigned char* ws; float* out; const float* xp; const float* xs; const float* fg; gu32* ctl;
    __device__ __forceinline__ void fused(f32x4 (&acc)[2][2][4][2], const pg8::Unit& u, int wr, int wc, int fr, int fq, PG8_LAS unsigned char* lds, int wid, int lane) const {
        const float* modf = (const float*)(ws + WS_MODF);
        PG8_LAS float* P = (PG8_LAS float*)lds;
        PG8_LAS float* R = (PG8_LAS float*)(lds + 4096);
        const int col0 = u.pn * 256 + wc * 32 + 4 * fq;
#pragma unroll
        for (int ai = 0; ai < 2; ++ai)
#pragma unroll
            for (int m = 0; m < 4; ++m) {
                const int rl = ai * 128 + wr * 64 + m * 16 + fr, r = u.pm * 256 + rl;
                const int ci = r < MC ? 0 : 1 + ((r - MC) >> 10);
                const float* xr = (r < MC ? xp + (size_t)r * D : xs + (size_t)(r - MC) * D) + col0;
                const float* gt = modf + ci * 3072 + 2048 + col0;
                float ss = 0.f;
#pragma unroll
                for (int bj = 0; bj < 2; ++bj)
#pragma unroll
                    for (int n = 0; n < 2; ++n) {
                        const int off = bj * 128 + n * 16;
                        const f32x4 y = *(const f32x4*)(xr + off) + *(const f32x4*)(gt + off) * acc[ai][bj][m][n];
                        acc[ai][bj][m][n] = y;
                        ss += (y.x * y.x + y.y * y.y) + (y.z * y.z + y.w * y.w);
                    }
                ss += __shfl_xor(ss, 16); ss += __shfl_xor(ss, 32);
                if (fq == 0) P[rl * 4 + wc] = ss;
            }
        asm volatile("s_waitcnt lgkmcnt(0)" ::: "memory"); __builtin_amdgcn_s_barrier(); asm volatile("" ::: "memory");
        const int row = wid * 32 + (lane & 31);
        float* xbuf = (float*)(ws + WS_XCH) + ((size_t)(u.pm * 256 + row) * 4);
        if (lane < 32) {
            const f32x4 p = *(const PG8_LAS f32x4*)(P + row * 4);
            __hip_atomic_store(xbuf + u.pn, (p.x + p.y) + (p.z + p.w), __ATOMIC_RELAXED, __HIP_MEMORY_SCOPE_AGENT);
        }
        asm volatile("s_waitcnt vmcnt(0)" ::: "memory");
        unsigned* cnt = (unsigned*)(ctl + CW_PANEL + 64 * u.pm);
        if (lane == 0) __hip_atomic_fetch_add(cnt, 1u, __ATOMIC_RELAXED, __HIP_MEMORY_SCOPE_AGENT);
        if (wid == 0) {
            unsigned sp = 0;
            while ((unsigned)__builtin_amdgcn_readfirstlane(__hip_atomic_load(cnt, __ATOMIC_RELAXED, __HIP_MEMORY_SCOPE_AGENT)) < 32u) { __builtin_amdgcn_s_sleep(2); if (++sp > (1u << 20)) break; }
            __builtin_amdgcn_fence(__ATOMIC_ACQUIRE, "agent");
        }
        asm volatile("s_waitcnt vmcnt(0) lgkmcnt(0)" ::: "memory"); __builtin_amdgcn_s_barrier(); asm volatile("" ::: "memory");
        if (lane < 32) {
            float t = 0.f;
#pragma unroll
            for (int q = 0; q < 4; ++q) t += __hip_atomic_load(xbuf + q, __ATOMIC_RELAXED, __HIP_MEMORY_SCOPE_AGENT);
            R[row] = __builtin_amdgcn_rsqf(t * (1.f / D) + 1e-6f);
        }
        asm volatile("s_waitcnt lgkmcnt(0)" ::: "memory"); __builtin_amdgcn_s_barrier(); asm volatile("" ::: "memory");
        f32x4 fgv[2][2];
#pragma unroll
        for (int bj = 0; bj < 2; ++bj)
#pragma unroll
            for (int n = 0; n < 2; ++n) fgv[bj][n] = *(const f32x4*)(fg + col0 + bj * 128 + n * 16);
#pragma unroll
        for (int ai = 0; ai < 2; ++ai)
#pragma unroll
            for (int m = 0; m < 4; ++m) {
                const int rl = ai * 128 + wr * 64 + m * 16 + fr; const float rs = R[rl];
                float* o = out + OUT_Y + (size_t)(u.pm * 256 + rl) * D + col0;
#pragma unroll
                for (int bj = 0; bj < 2; ++bj)
#pragma unroll
                    for (int n = 0; n < 2; ++n) { const int off = bj * 128 + n * 16; *(f32x4*)(o + off) = acc[ai][bj][m][n] * rs * fgv[bj][n]; }
            }
    }
};

constexpr int AT_KS = 0, AT_KSTRIDE = 272, AT_VS = 64 * AT_KSTRIDE, AT_VSTRIDE = 144, AT_BUF = AT_VS + 128 * AT_VSTRIDE, AT_X = 2 * AT_BUF, AT_XSTRIDE = 132;
static_assert(AT_X + 4 * 32 * AT_XSTRIDE * 4 <= LDSCTL_OFF && (AT_X % 16) == 0, "attention LDS map");
constexpr int Q_NSC = NBC * NHB, Q_NAL = NBL * NH * (LSEQ / 128), Q_NAC = NBC * NH * (SEQ / 128), Q_NU = Q_NSC + Q_NAL + Q_NAC;
struct AttnGeo { int hh, m0, nkeys, vlen; const bf16* Kb; const bf16* VT; };
__device__ __forceinline__ AttnGeo attn_geo(const Frame& F, int idx, bool lat) {
    AttnGeo g; int b, qb;
    if (!lat) { b = idx >> 4; g.hh = (idx >> 1) & 7; qb = idx & 1; g.m0 = b * SEQ + qb * 128; g.nkeys = SEQ; g.vlen = SEQ;
        g.Kb = (const bf16*)(F.ws + WS_KC) + (size_t)b * SEQ * D + g.hh * 128; g.VT = (const bf16*)(F.ws + WS_VTC) + (size_t)((b * NH + g.hh) * 128) * SEQ; }
    else { b = idx >> 6; g.hh = (idx >> 3) & 7; qb = idx & 7; g.m0 = MC + b * LSEQ + qb * 128; g.nkeys = KLAT; g.vlen = KLAT;
        g.Kb = (const bf16*)(F.ws + WS_KL) + (size_t)b * KLAT * D + g.hh * 128; g.VT = (const bf16*)(F.ws + WS_VTL) + (size_t)((b * NH + g.hh) * 128) * KLAT; }
    return g;
}
__device__ __forceinline__ void attn_unit(Frame& F, int idx, bool lat, float lam, unsigned* nq, bool& Pvalid, int& Pu, v4u& Pk0, v4u& Pk1, v4u& Pv0, v4u& Pv1, bf16x8& Pq0, bf16x8& Pq1, bf16x8& Pq2, bf16x8& Pq3) {
    int tid_ = F.tid; asm volatile("" : "+v"(tid_)); const int lane_ = tid_ & 63;
    const AttnGeo G_ = attn_geo(F, idx, lat);
    const int hh = G_.hh, m0 = G_.m0, nkeys = G_.nkeys, vlen = G_.vlen; const bf16* Kb = G_.Kb; const bf16* VT = G_.VT;
    const int w = F.wave, qs = w >> 1, mp = w & 1, l31 = lane_ & 31, h5 = lane_ >> 5;
    const int kperm = (l31 & 3) + 4 * ((l31 >> 3) & 1) + 8 * ((l31 >> 2) & 1) + 16 * (l31 >> 4);
    LAS float* X = (LAS float*)(F.lds + AT_X);
    bf16x8 qf[4];
    if (Pvalid) { qf[0] = Pq0; qf[1] = Pq1; qf[2] = Pq2; qf[3] = Pq3; }
    else { const bf16* qrow = (const bf16*)(F.ws + WS_Q) + (size_t)(m0 + qs * 32 + l31) * D + hh * 128 + mp * 64 + 8 * h5;
#pragma unroll
      for (int ks = 0; ks < 4; ++ks) qf[ks] = *(const bf16x8*)(qrow + 16 * ks); }
    f32x16 o[4];
#pragma unroll
    for (int i = 0; i < 4; ++i)
#pragma unroll
        for (int j = 0; j < 16; ++j) o[i][j] = 0.f;
    float mrun = -1e30f, lrun = 0.f;
    const int krow = tid_ >> 3, kch = tid_ & 7, vrow = tid_ >> 2, vch = tid_ & 3;
    const int ntile = nkeys / 64;
    const bf16* kp = Kb + (size_t)krow * D + kch * 8;
    const bf16* vp = VT + (size_t)vrow * vlen + vch * 8;
    LAS unsigned char* kd = F.lds + AT_KS + krow * AT_KSTRIDE + kch * 16;
    LAS unsigned char* vd = F.lds + AT_VS + vrow * AT_VSTRIDE + vch * 16;
    v4u k0, k1, v0, v1;
    if (Pvalid) { k0 = Pk0; k1 = Pk1; v0 = Pv0; v1 = Pv1; }
    else { k0 = *(const v4u*)kp; k1 = *(const v4u*)(kp + 64); v0 = *(const v4u*)vp; v1 = *(const v4u*)(vp + 32); }
    volatile LAS int* slot2 = (volatile LAS int*)(F.lds + MISC_OFF + 72);
    int claim = 0;
    __syncthreads();
    *(LAS v4u*)(kd) = k0; *(LAS v4u*)(kd + 128) = k1;
    *(LAS v4u*)(vd) = v0; *(LAS v4u*)(vd + 64) = v1;
    if (ntile > 1) { k0 = *(const v4u*)(kp + (size_t)64 * D); k1 = *(const v4u*)(kp + (size_t)64 * D + 64); v0 = *(const v4u*)(vp + 64); v1 = *(const v4u*)(vp + 96); }
    __syncthreads();
    for (int kt = 0; kt < ntile; ++kt) {
        if (kt == ntile - 1 && tid_ == 0) claim = (int)__hip_atomic_fetch_add(nq, 1u, RLX_AGENT);
        const int bo = (kt & 1) * AT_BUF;
        LAS unsigned char* Ks = F.lds + AT_KS + bo; LAS unsigned char* Vs = F.lds + AT_VS + bo;
        if (kt + 1 < ntile) {
            const int bn = AT_BUF - bo;
            *(LAS v4u*)(kd + bn) = k0; *(LAS v4u*)(kd + bn + 128) = k1;
            *(LAS v4u*)(vd + bn) = v0; *(LAS v4u*)(vd + bn + 64) = v1;
            if (kt + 2 < ntile) { const bf16* kq = kp + (size_t)(kt + 2) * 64 * D; const bf16* vq = vp + (kt + 2) * 64;
                k0 = *(const v4u*)kq; k1 = *(const v4u*)(kq + 64); v0 = *(const v4u*)vq; v1 = *(const v4u*)(vq + 32); }
        }
        f32x16 s[2];
#pragma unroll
        for (int st = 0; st < 2; ++st) {
#pragma unroll
            for (int j = 0; j < 16; ++j) s[st][j] = 0.f;
#pragma unroll
            for (int ks = 0; ks < 4; ++ks) {
                const bf16x8 kf = *(const LAS bf16x8*)(Ks + (st * 32 + kperm) * AT_KSTRIDE + (mp * 64 + 16 * ks + 8 * h5) * 2);
                s[st] = __builtin_amdgcn_mfma_f32_32x32x16_bf16(kf, qf[ks], s[st], 0, 0, 0);
            }
        }
        float mx = s[0][0];
#pragma unroll
        for (int j = 0; j < 16; ++j) { mx = fmaxf(mx, s[0][j]); mx = fmaxf(mx, s[1][j]); }
        mx = fmaxf(mx, __shfl_xor(mx, 32));
        if (!__all(mx - mrun <= 8.f)) {
            const float mnew_ = fmaxf(mrun, mx), alpha = __builtin_amdgcn_exp2f(mrun - mnew_);
            mrun = mnew_; lrun *= alpha;
#pragma unroll
            for (int i = 0; i < 4; ++i) o[i] = o[i] * alpha;
        }
        const float mnew = mrun;
        float ps = 0.f;
#pragma unroll
        for (int st = 0; st < 2; ++st)
#pragma unroll
            for (int j = 0; j < 16; ++j) { const float p = __builtin_amdgcn_exp2f(s[st][j] - mnew); s[st][j] = p; ps += p; }
        lrun += ps;
        bf16x8 pf[2][2];
#pragma unroll
        for (int st = 0; st < 2; ++st)
#pragma unroll
            for (int s2 = 0; s2 < 2; ++s2) {
                v4u t; t.x = pk2(s[st][8 * s2 + 0], s[st][8 * s2 + 1]); t.y = pk2(s[st][8 * s2 + 2], s[st][8 * s2 + 3]); t.z = pk2(s[st][8 * s2 + 4], s[st][8 * s2 + 5]); t.w = pk2(s[st][8 * s2 + 6], s[st][8 * s2 + 7]);
                pf[st][s2] = __builtin_bit_cast(bf16x8, t);
            }
#pragma unroll
        for (int dvt = 0; dvt < 4; ++dvt)
#pragma unroll
            for (int st = 0; st < 2; ++st)
#pragma unroll
                for (int s2 = 0; s2 < 2; ++s2) {
                    const bf16x8 vf = *(const LAS bf16x8*)(Vs + (dvt * 32 + l31) * AT_VSTRIDE + (st * 32 + 16 * s2 + 8 * h5) * 2);
                    o[dvt] = __builtin_amdgcn_mfma_f32_32x32x16_bf16(vf, pf[st][s2], o[dvt], 0, 0, 0);
                }
        if (kt == ntile - 1 && tid_ == 0) *slot2 = claim;
        __syncthreads();
    }
    {
        const int nu = __builtin_amdgcn_readfirstlane(*slot2);
        Pu = nu; Pvalid = false;
        if (nu >= Q_NSC && nu < Q_NU) {
            const int a_ = nu - Q_NSC; const bool lt2 = a_ < Q_NAL; const AttnGeo G2 = attn_geo(F, lt2 ? a_ : a_ - Q_NAL, lt2);
            const bf16* kp2 = G2.Kb + (size_t)krow * D + kch * 8; const bf16* vp2 = G2.VT + (size_t)vrow * G2.vlen + vch * 8;
            Pk0 = *(const v4u*)kp2; Pk1 = *(const v4u*)(kp2 + 64); Pv0 = *(const v4u*)vp2; Pv1 = *(const v4u*)(vp2 + 32);
            const bf16* qrow2 = (const bf16*)(F.ws + WS_Q) + (size_t)(G2.m0 + qs * 32 + l31) * D + G2.hh * 128 + mp * 64 + 8 * h5;
            Pq0 = *(const bf16x8*)(qrow2); Pq1 = *(const bf16x8*)(qrow2 + 16); Pq2 = *(const bf16x8*)(qrow2 + 32); Pq3 = *(const bf16x8*)(qrow2 + 48);
            Pvalid = true;
        }
    }
    v4u gav[4];
    {
        const bf16* GA = (const bf16*)(F.ws + WS_GA);
#pragma unroll
        for (int p = 0; p < 4; ++p) gav[p] = *(const v4u*)(GA + (size_t)(m0 + p * 32 + (tid_ >> 4)) * D + hh * 128 + (tid_ & 15) * 8);
    }
    const float ltot = lrun + __shfl_xor(lrun, 32), inv = 1.f / ltot;
    LAS float* Xq = X + (qs * 32 + l31) * AT_XSTRIDE;
    if (mp == 1) {
#pragma unroll
        for (int dvt = 0; dvt < 4; ++dvt)
#pragma unroll
            for (int j = 0; j < 16; ++j) Xq[dvt * 32 + (j & 3) + 8 * (j >> 2) + 4 * h5] = o[dvt][j] * inv;
    }
    __syncthreads();
    if (mp == 0) {
        float ss = 0.f;
#pragma unroll
        for (int dvt = 0; dvt < 4; ++dvt)
#pragma unroll
            for (int j = 0; j < 16; ++j) { const float a = o[dvt][j] * inv - lam * Xq[dvt * 32 + (j & 3) + 8 * (j >> 2) + 4 * h5]; o[dvt][j] = a; ss += a * a; }
        ss += __shfl_xor(ss, 32);
        const float rstd = 0.8f / sqrtf(ss * (1.f / 128.f) + 1e-5f);
#pragma unroll
        for (int dvt = 0; dvt < 4; ++dvt)
#pragma unroll
            for (int j = 0; j < 16; ++j) Xq[dvt * 32 + (j & 3) + 8 * (j >> 2) + 4 * h5] = o[dvt][j] * rstd;
    }
    __syncthreads();
    {
        const float* sg = F.in[I_SUBG];
        bf16* MIX = (bf16*)(F.ws + WS_MIX);
        const int d8 = (tid_ & 15) * 8;
        const f32x4 g0 = *(const f32x4*)(sg + d8), g1 = *(const f32x4*)(sg + d8 + 4);
#pragma unroll
        for (int p = 0; p < 4; ++p) {
            const int q = p * 32 + (tid_ >> 4), m = m0 + q;
            const LAS float* xr = X + q * AT_XSTRIDE + d8;
            const f32x4 a0 = *(const LAS f32x4*)xr, a1 = *(const LAS f32x4*)(xr + 4);
            const v4u ga = gav[p];
            v4u w;
            w.x = pk2(a0.x * g0.x * bflo(ga.x), a0.y * g0.y * bfhi(ga.x)); w.y = pk2(a0.z * g0.z * bflo(ga.y), a0.w * g0.w * bfhi(ga.y));
            w.z = pk2(a1.x * g1.x * bflo(ga.z), a1.y * g1.y * bfhi(ga.z)); w.w = pk2(a1.z * g1.z * bflo(ga.w), a1.w * g1.w * bfhi(ga.w));
            st_wt16(ws_rsrc(F.ws), F.ws, MIX + (size_t)m * DMIX + hh * 128 + d8, w);
        }
    }
}

constexpr int SC_W2 = 0, SC_A2 = 16384, SC_TLW = 32768, SC_LA = 40960, SC_WD = 49152, SC_NKK = 57344, SC_BB = 65536, SC_KD = 73728, SC_R = 81920, SC_V = 90112, SC_Y = 98304, SC_BON = 106496;
template <int CTRL> __device__ __forceinline__ float dppf(float x) { return __builtin_bit_cast(float, __builtin_amdgcn_update_dpp(0, __builtin_bit_cast(int, x), CTRL, 0xf, 0xf, true)); }
__device__ __forceinline__ float reduce8(float v) { v += dppf<0xB1>(v); v += dppf<0x4E>(v); v += dppf<0x141>(v); return v; }
__device__ __forceinline__ float shift_load(const bf16* ub, const float* mu, int t, int T, int col) {
    const float u = bf2f(ub[col]);
    const float p = t > 0 ? bf2f(ub[col - DSH]) : 0.f;
    const float n = t < T - 1 ? bf2f(ub[col + DSH]) : 0.f;
    return u + mu[col] * (p - u) + mu[DSH + col] * (n - u);
}
__device__ __forceinline__ void scan_unit(Frame& F, int b, int hh, bool lat) {
    const int T = lat ? LSEQ : SEQ, m0 = lat ? MC + b * LSEQ : b * SEQ;
    const bf16* UB = (const bf16*)(F.ws + WS_UB); const bf16* GB = (const bf16*)(F.ws + WS_GB); bf16* MIX = (bf16*)(F.ws + WS_MIX);
    float* YB = F.out + OUT_Y;
    const float* mu = F.in[I_MU];
    LAS float* W2s = (LAS float*)(F.lds + SC_W2); LAS float* A2s = (LAS float*)(F.lds + SC_A2); LAS float* TLW = (LAS float*)(F.lds + SC_TLW); LAS float* LAs = (LAS float*)(F.lds + SC_LA);
    LAS float* WD = (LAS float*)(F.lds + SC_WD); LAS float* NKK = (LAS float*)(F.lds + SC_NKK); LAS float* BB = (LAS float*)(F.lds + SC_BB); LAS float* KD = (LAS float*)(F.lds + SC_KD);
    LAS float* RR = (LAS float*)(F.lds + SC_R); LAS float* VV = (LAS float*)(F.lds + SC_V); LAS float* YC = (LAS float*)(F.lds + SC_Y); LAS float* BON = (LAS float*)(F.lds + SC_BON);
    const int c = F.lane, hc = hh * 64 + c, row = F.wave * 8 + (F.lane >> 3), kq = F.lane & 7;
    const float kkc = F.in[I_KK][hc], kac = F.in[I_KA][hc], rkc = F.in[I_RK][hc];
    for (int d = 0; d < 2; ++d) {
        __syncthreads();
        for (int i = F.tid; i < 4096; i += NTHR) { const int j = i >> 6, cc = i & 63; W2s[i] = F.in[I_W2][(size_t)(d * 64 + j) * D + hh * 64 + cc]; A2s[i] = F.in[I_A2][(size_t)(d * 64 + j) * D + hh * 64 + cc]; }
        const float w0c = F.in[I_W0][d * D + hc], a0c = F.in[I_A0][d * D + hc];
        float S[8];
        if (lat) { const float* sp = F.in[I_ST] + ((size_t)((b * 2 + d) * NHB + hh) * 64 + row) * 64 + kq * 8;
            const f32x4 s0 = *(const f32x4*)sp, s1 = *(const f32x4*)(sp + 4); S[0] = s0.x; S[1] = s0.y; S[2] = s0.z; S[3] = s0.w; S[4] = s1.x; S[5] = s1.y; S[6] = s1.z; S[7] = s1.w; }
        else {
#pragma unroll
            for (int i = 0; i < 8; ++i) S[i] = 0.f; }
        const int nch = T / 32;
        for (int ch = 0; ch < nch; ++ch) {
            const int t0 = (d == 0 ? ch : nch - 1 - ch) * 32;
            __syncthreads();
            float r_[4], k_[4], v_[4];
#pragma unroll
            for (int i = 0; i < 4; ++i) {
                const int tt = F.wave * 4 + i, t = t0 + tt;
                const bf16* ub = UB + (size_t)(m0 + t) * DSH;
                r_[i] = shift_load(ub, mu, t, T, hc); k_[i] = shift_load(ub, mu, t, T, 1024 + hc); v_[i] = shift_load(ub, mu, t, T, 2048 + hc);
                const float lw = shift_load(ub, mu, t, T, 3072 + 64 * d + c), la = shift_load(ub, mu, t, T, 3200 + 64 * d + c);
                TLW[tt * 64 + c] = tanhf(lw); LAs[tt * 64 + c] = la;
            }
            __syncthreads();
            float zw[4], za[4];
#pragma unroll
            for (int i = 0; i < 4; ++i) { zw[i] = w0c; za[i] = a0c; }
            for (int j = 0; j < 64; j += 4) {
                f32x4 tw[4], ta[4];
#pragma unroll
                for (int i = 0; i < 4; ++i) { tw[i] = *(const LAS f32x4*)(TLW + (F.wave * 4 + i) * 64 + j); ta[i] = *(const LAS f32x4*)(LAs + (F.wave * 4 + i) * 64 + j); }
#pragma unroll
                for (int jj = 0; jj < 4; ++jj) { const float w2 = W2s[(j + jj) * 64 + c], a2 = A2s[(j + jj) * 64 + c];
#pragma unroll
                    for (int i = 0; i < 4; ++i) { zw[i] += tw[i][jj] * w2; za[i] += ta[i][jj] * a2; } }
            }
#pragma unroll
            for (int i = 0; i < 4; ++i) {
                const int tt = F.wave * 4 + i;
                const float dec = __expf(-0.60653065971f * sigmoidf_(zw[i])), a = sigmoidf_(za[i]);
                float kk = k_[i] * kkc; const float n2 = wave_sum(kk * kk); kk *= 1.f / sqrtf(n2 + 1e-12f);
                WD[tt * 64 + c] = dec; NKK[tt * 64 + c] = -kk; BB[tt * 64 + c] = kk * a; KD[tt * 64 + c] = k_[i] * (1.f + (a - 1.f) * kac); RR[tt * 64 + c] = r_[i]; VV[tt * 64 + c] = v_[i];
                if (d == 1) { const float bo = wave_sum(r_[i] * k_[i] * rkc); if (c == 0) BON[tt] = bo; }
            }
            __syncthreads();
            for (int s = 0; s < 32; ++s) {
                const int tt = d == 0 ? s : 31 - s; const int o = tt * 64 + kq * 8;
                const f32x4 w0 = *(const LAS f32x4*)(WD + o), w1 = *(const LAS f32x4*)(WD + o + 4), n0 = *(const LAS f32x4*)(NKK + o), n1 = *(const LAS f32x4*)(NKK + o + 4);
                const f32x4 b0 = *(const LAS f32x4*)(BB + o), b1 = *(const LAS f32x4*)(BB + o + 4), k0 = *(const LAS f32x4*)(KD + o), k1 = *(const LAS f32x4*)(KD + o + 4);
                const f32x4 r0 = *(const LAS f32x4*)(RR + o), r1 = *(const LAS f32x4*)(RR + o + 4);
                const float vv = VV[tt * 64 + row];
                float sa = (S[0] * n0.x + S[1] * n0.y) + (S[2] * n0.z + S[3] * n0.w) + (S[4] * n1.x + S[5] * n1.y) + (S[6] * n1.z + S[7] * n1.w);
                sa = reduce8(sa);
                S[0] = S[0] * w0.x + sa * b0.x + vv * k0.x; S[1] = S[1] * w0.y + sa * b0.y + vv * k0.y; S[2] = S[2] * w0.z + sa * b0.z + vv * k0.z; S[3] = S[3] * w0.w + sa * b0.w + vv * k0.w;
                S[4] = S[4] * w1.x + sa * b1.x + vv * k1.x; S[5] = S[5] * w1.y + sa * b1.y + vv * k1.y; S[6] = S[6] * w1.z + sa * b1.z + vv * k1.z; S[7] = S[7] * w1.w + sa * b1.w + vv * k1.w;
                float y = (S[0] * r0.x + S[1] * r0.y) + (S[2] * r0.z + S[3] * r0.w) + (S[4] * r1.x + S[5] * r1.y) + (S[6] * r1.z + S[7] * r1.w);
                y = reduce8(y);
                if (kq == 0) YC[tt * 64 + row] = y;
            }
            __syncthreads();
            {
                const int tt = F.tid >> 4, c4 = (F.tid & 15) * 4, m = m0 + t0 + tt;
                f32x4 y4 = *(const LAS f32x4*)(YC + tt * 64 + c4);
                float* gp = YB + (size_t)m * D + hh * 64 + c4;
                if (d == 0) *(f32x4*)gp = y4;
                else {
                    y4 += *(const f32x4*)gp;
                    float s1 = (y4.x + y4.y) + (y4.z + y4.w);
                    s1 += __shfl_xor(s1, 1); s1 += __shfl_xor(s1, 2); s1 += __shfl_xor(s1, 4); s1 += __shfl_xor(s1, 8);
                    const float mean = s1 * (1.f / 64.f);
                    const f32x4 dy = y4 - mean;
                    float s2 = (dy.x * dy.x + dy.y * dy.y) + (dy.z * dy.z + dy.w * dy.w);
                    s2 += __shfl_xor(s2, 1); s2 += __shfl_xor(s2, 2); s2 += __shfl_xor(s2, 4); s2 += __shfl_xor(s2, 8);
                    const float rstd = 1.f / sqrtf(s2 * (1.f / 64.f) + 64e-5f);
                    const f32x4 lg = *(const f32x4*)(F.in[I_LNG] + hh * 64 + c4), lb = *(const f32x4*)(F.in[I_LNB] + hh * 64 + c4);
                    const f32x4 vt = *(const LAS f32x4*)(VV + tt * 64 + c4);
                    const float bo = BON[tt];
                    const v2u gb = *(const v2u*)(GB + (size_t)m * D + hh * 64 + c4);
                    const f32x4 yn = dy * rstd * lg + lb + vt * bo;
                    v2u w; w.x = pk2(yn.x * bflo(gb.x), yn.y * bfhi(gb.x)); w.y = pk2(yn.z * bflo(gb.y), yn.w * bfhi(gb.y));
                    *(v2u*)(MIX + (size_t)m * DMIX + 1024 + hh * 64 + c4) = w;
                }
            }
        }
        if (!lat) { float* sp = F.out + OUT_ST + ((size_t)((b * 2 + d) * NHB + hh) * 64 + row) * 64 + kq * 8;
            *(f32x4*)sp = (f32x4){S[0], S[1], S[2], S[3]}; *(f32x4*)(sp + 4) = (f32x4){S[4], S[5], S[6], S[7]}; }
    }
}


constexpr int SG_ST = 144;
constexpr int G_AT = 0, G_RT = 9216, G_BH = 18432, G_KH = 26624, G_LAK = 34816, G_LBR = 36864, G_LKR = 38912, G_TM = 40960, G_GAM = 43008, G_PRIV = 44032;
constexpr int PW_TLW = 0, PW_LAB = 2304, PW_ZS = 4608, PW_LF = PW_ZS, PW_VT = PW_ZS + 1024, PW_SIZE = 8768, G_SIZE = G_PRIV + 4 * PW_SIZE;
constexpr int ZS_ST = 65, VT_ST = 40;
static_assert(2 * G_SIZE <= LDSCTL_OFF, "scan LDS map");
__device__ __forceinline__ bf16x8 mk8(v2u lo, v2u hi) { const v4u t = {lo.x, lo.y, hi.x, hi.y}; return __builtin_bit_cast(bf16x8, t); }
__device__ __forceinline__ bf16x8 pk8(f32x4 a, f32x4 b) { const v4u t = {pk2(a[0], a[1]), pk2(a[2], a[3]), pk2(b[0], b[1]), pk2(b[2], b[3])}; return __builtin_bit_cast(bf16x8, t); }
#define MFMA16(a, b, c) __builtin_amdgcn_mfma_f32_16x16x32_bf16(a, b, c, 0, 0, 0)
template <int CTRL> __device__ __forceinline__ float dpp_mov(float x) { return __builtin_bit_cast(float, __builtin_amdgcn_update_dpp(0, __builtin_bit_cast(int, x), CTRL, 0xf, 0xf, true)); }
__device__ __forceinline__ void wave_sum16(float (&v)[16], int lane) {
    float a8[8], a4[4], a2[2];
    { const bool bit = lane & 4;
#pragma unroll
      for (int m = 0; m < 8; ++m) { const float send = bit ? v[2 * m] : v[2 * m + 1], keep = bit ? v[2 * m + 1] : v[2 * m]; a8[m] = keep + dpp_mov<0x141>(send); } }
    { const bool bit = lane & 1;
#pragma unroll
      for (int m = 0; m < 4; ++m) { const float send = bit ? a8[2 * m] : a8[2 * m + 1], keep = bit ? a8[2 * m + 1] : a8[2 * m]; a4[m] = keep + dpp_mov<0xB1>(send); } }
    { const bool bit = lane & 2;
#pragma unroll
      for (int m = 0; m < 2; ++m) { const float send = bit ? a4[2 * m] : a4[2 * m + 1], keep = bit ? a4[2 * m + 1] : a4[2 * m]; a2[m] = keep + dpp_mov<0x4E>(send); } }
    float t;
    { const bool bit = lane & 8; const float send = bit ? a2[0] : a2[1], keep = bit ? a2[1] : a2[0]; t = keep + dpp_mov<0x128>(send); }
    t += __shfl_xor(t, 16); t += __shfl_xor(t, 32);
#pragma unroll
    for (int i = 0; i < 16; ++i) { constexpr int dummy = 0; const int src = ((i >> 1) & 1) + 2 * ((i >> 2) & 1) + 4 * (i & 1) + 8 * ((i >> 3) & 1);
        v[i] = __builtin_bit_cast(float, __builtin_amdgcn_readlane(__builtin_bit_cast(int, t), src)); }
}
__device__ __forceinline__ void load_shift16(const bf16* ubase, int T, int p0, int d, int col, float mA, float mB, float (&out)[16]) {
    float u[18];
#pragma unroll
    for (int j = 0; j < 18; ++j) { const int tj = d ? (T - p0 - j) : (p0 - 1 + j);
        if (j == 0 || j == 17) u[j] = (tj >= 0 && tj < T) ? bf2f(ubase[(size_t)tj * DSH + col]) : 0.f;
        else u[j] = bf2f(ubase[(size_t)tj * DSH + col]); }
#pragma unroll
    for (int i = 0; i < 16; ++i) out[i] = u[i + 1] + mA * (u[i] - u[i + 1]) + mB * (u[i + 2] - u[i + 1]);
}
__device__ __forceinline__ void scan_unit2(Frame& F, int b, int hh, bool lat) {
    const int T = lat ? LSEQ : SEQ, m0 = lat ? MC + b * LSEQ : b * SEQ, nch = T / 64;
    const int lane0 = F.lane, d = F.wave >> 2, w = F.wave & 3;
    int lane = lane0, c16 = lane & 15, g = lane >> 4, hc = hh * 64 + lane;
    LAS unsigned char* GB_ = F.lds + d * G_SIZE;
    LAS unsigned char* PW = GB_ + G_PRIV + w * PW_SIZE;
    const bf16* UB = (const bf16*)(F.ws + WS_UB) + (size_t)m0 * DSH; const bf16* GBp = (const bf16*)(F.ws + WS_GB); bf16* MIX = (bf16*)(F.ws + WS_MIX);
    float* YB = F.out + OUT_Y;
    const float* mu = F.in[I_MU];
    int cR = hc, cK = 1024 + hc, cV = 2048 + hc, cW = 3072 + 64 * d + lane, cA = 3200 + 64 * d + lane;
    const int oA = d ? DSH : 0, oB = d ? 0 : DSH;
    const float kkc = F.in[I_KK][hc], kac = F.in[I_KA][hc], rkc = F.in[I_RK][hc], w0c = F.in[I_W0][d * D + hc], a0c = F.in[I_A0][d * D + hc];
    const float lng = F.in[I_LNG][hc], lnb = F.in[I_LNB][hc];
    const v4u* wop0 = (const v4u*)(F.ws + WS_WOP) + (size_t)((d * 16 + hh) * 2) * 8 * 64;
    f32x4 S[4];
    const size_t st_off = ((size_t)((b * 2 + d) * NHB + hh) * 64 + 16 * w + c16) * 64 + 4 * g;
#pragma unroll
    for (int kt = 0; kt < 4; ++kt) S[kt] = lat ? *(const f32x4*)(F.in[I_ST] + st_off + 16 * kt) : (f32x4){0.f, 0.f, 0.f, 0.f};
    const v2u z2 = {0u, 0u};
    __syncthreads();
    for (int it = 0; it < nch; ++it) {
        const int p0 = it * 64 + w * 16;
        lane = lane0; asm volatile("" : "+v"(lane));
        c16 = lane & 15; g = lane >> 4; hc = hh * 64 + lane; cR = hc; cK = 1024 + hc; cV = 2048 + hc; cW = 3072 + 64 * d + lane; cA = 3200 + 64 * d + lane;
        const v4u* wop = wop0 + lane;
        float bon[16], v_[16];
        {
            float x_[16];
            load_shift16(UB, T, p0, d, cW, mu[oA + cW], mu[oB + cW], x_);
#pragma unroll
            for (int i = 0; i < 16; ++i) { const float e = __expf(2.f * x_[i]); *(LAS bf16*)(PW + PW_TLW + i * SG_ST + lane * 2) = (bf16)f2bf(1.f - 2.f / (e + 1.f)); }
            load_shift16(UB, T, p0, d, cA, mu[oA + cA], mu[oB + cA], x_);
#pragma unroll
            for (int i = 0; i < 16; ++i) *(LAS bf16*)(PW + PW_LAB + i * SG_ST + lane * 2) = (bf16)f2bf(x_[i]);
        }
        float lam[16], aa[16];
        {
            LAS float* Zs = (LAS float*)(PW + PW_ZS);
            {
                bf16x8 ta[2];
#pragma unroll
                for (int ks = 0; ks < 2; ++ks) ta[ks] = *(const LAS bf16x8*)(PW + PW_TLW + c16 * SG_ST + (32 * ks + 8 * g) * 2);
#pragma unroll
                for (int ct = 0; ct < 4; ++ct) { f32x4 z = {0.f, 0.f, 0.f, 0.f};
#pragma unroll
                    for (int ks = 0; ks < 2; ++ks) z = MFMA16(ta[ks], __builtin_bit_cast(bf16x8, wop[(ct * 2 + ks) * 64]), z);
#pragma unroll
                    for (int rg = 0; rg < 4; ++rg) Zs[(4 * g + rg) * ZS_ST + 16 * ct + c16] = z[rg]; }
                float l = 0.f;
#pragma unroll
                for (int i = 0; i < 16; ++i) { l += -0.60653065971f * sigmoidf_(w0c + Zs[i * ZS_ST + lane]); lam[i] = l; }
            }
            {
                bf16x8 tb[2];
#pragma unroll
                for (int ks = 0; ks < 2; ++ks) tb[ks] = *(const LAS bf16x8*)(PW + PW_LAB + c16 * SG_ST + (32 * ks + 8 * g) * 2);
#pragma unroll
                for (int ct = 0; ct < 4; ++ct) { f32x4 z = {0.f, 0.f, 0.f, 0.f};
#pragma unroll
                    for (int ks = 0; ks < 2; ++ks) z = MFMA16(tb[ks], __builtin_bit_cast(bf16x8, wop[512 + (ct * 2 + ks) * 64]), z);
#pragma unroll
                    for (int rg = 0; rg < 4; ++rg) Zs[(4 * g + rg) * ZS_ST + 16 * ct + c16] = z[rg]; }
#pragma unroll
                for (int i = 0; i < 16; ++i) aa[i] = sigmoidf_(a0c + Zs[i * ZS_ST + lane]);
            }
        }
        {
            float k_[16];
            load_shift16(UB, T, p0, d, cK, mu[oA + cK], mu[oB + cK], k_);
            {
                float n2[16];
#pragma unroll
                for (int i = 0; i < 16; ++i) { const float kk = k_[i] * kkc; n2[i] = kk * kk; }
                wave_sum16(n2, lane);
                unsigned bh[8], kh[8];
#pragma unroll
                for (int i = 0; i < 16; ++i) {
                    const float kk = k_[i] * kkc * (1.f / sqrtf(n2[i] + 1e-12f)), kd = k_[i] * (1.f + (aa[i] - 1.f) * kac), bb = kk * aa[i];
                    const float e1 = i ? __expf(lam[i - 1]) : 1.f, e2 = __expf(-lam[i]);
                    *(LAS bf16*)(GB_ + G_AT + (16 * w + i) * SG_ST + lane * 2) = (bf16)f2bf(-kk * e1);
                    const unsigned btb = f2bf(bb * e2), ktb = f2bf(kd * e2);
                    *(LAS bf16*)(PW + PW_TLW + i * SG_ST + lane * 2) = (bf16)btb;
                    *(LAS bf16*)(PW + PW_LAB + i * SG_ST + lane * 2) = (bf16)ktb;
                    if (i & 1) { bh[i >> 1] |= btb << 16; kh[i >> 1] |= ktb << 16; } else { bh[i >> 1] = btb; kh[i >> 1] = ktb; }
                }
#pragma unroll
                for (int q = 0; q < 4; ++q) {
                    *(LAS v2u*)(GB_ + G_BH + (w * 64 + lane) * 32 + 8 * q) = (v2u){bh[2 * q], bh[2 * q + 1]};
                    *(LAS v2u*)(GB_ + G_KH + (w * 64 + lane) * 32 + 8 * q) = (v2u){kh[2 * q], kh[2 * q + 1]};
                }
            }
            float r_[16];
            load_shift16(UB, T, p0, d, cR, mu[oA + cR], mu[oB + cR], r_);
#pragma unroll
            for (int i = 0; i < 16; ++i) { bon[i] = r_[i] * k_[i] * rkc; *(LAS bf16*)(GB_ + G_RT + (16 * w + i) * SG_ST + lane * 2) = (bf16)f2bf(r_[i] * __expf(lam[i])); }
            wave_sum16(bon, lane);
        }
        ((LAS float*)(GB_ + G_GAM))[w * 64 + lane] = __expf(lam[15]);
        {
            load_shift16(UB, T, p0, d, cV, mu[oA + cV], mu[oB + cV], v_);
            unsigned vt[8];
#pragma unroll
            for (int i = 0; i < 16; ++i) { const unsigned vtb = f2bf(v_[i]); if (i & 1) vt[i >> 1] |= vtb << 16; else vt[i >> 1] = vtb; v_[i] *= bon[i]; }
#pragma unroll
            for (int q = 0; q < 4; ++q) *(LAS v2u*)(PW + PW_VT + lane * VT_ST + 8 * q) = (v2u){vt[2 * q], vt[2 * q + 1]};
        }
        {
            bf16x8 fa[2], fr[2], fb[2], fk[2];
#pragma unroll
            for (int ks = 0; ks < 2; ++ks) {
                fa[ks] = *(const LAS bf16x8*)(GB_ + G_AT + (16 * w + c16) * SG_ST + (32 * ks + 8 * g) * 2); fr[ks] = *(const LAS bf16x8*)(GB_ + G_RT + (16 * w + c16) * SG_ST + (32 * ks + 8 * g) * 2);
                fb[ks] = *(const LAS bf16x8*)(PW + PW_TLW + c16 * SG_ST + (32 * ks + 8 * g) * 2); fk[ks] = *(const LAS bf16x8*)(PW + PW_LAB + c16 * SG_ST + (32 * ks + 8 * g) * 2);
            }
            f32x4 lab = {0.f, 0.f, 0.f, 0.f}, lak = lab, lbr = lab, lkr = lab;
#pragma unroll
            for (int ks = 0; ks < 2; ++ks) { lab = MFMA16(fa[ks], fb[ks], lab); lak = MFMA16(fa[ks], fk[ks], lak); lbr = MFMA16(fr[ks], fb[ks], lbr); lkr = MFMA16(fr[ks], fk[ks], lkr); }
            LAS float* Lf = (LAS float*)(PW + PW_LF);
#pragma unroll
            for (int rg = 0; rg < 4; ++rg) { const int i = 4 * g + rg, j = c16;
                Lf[i * 16 + j] = j < i ? lab[rg] : 0.f;
                *(LAS bf16*)(GB_ + G_LAK + (w * 16 + i) * 32 + j * 2) = (bf16)f2bf(j < i ? lak[rg] : 0.f);
                *(LAS bf16*)(GB_ + G_LBR + (w * 16 + i) * 32 + j * 2) = (bf16)f2bf(j <= i ? lbr[rg] : 0.f);
                *(LAS bf16*)(GB_ + G_LKR + (w * 16 + i) * 32 + j * 2) = (bf16)f2bf(j <= i ? lkr[rg] : 0.f); }
            float tm[16];
#pragma unroll
            for (int i = 0; i < 16; ++i) { float a = (i == c16) ? 1.f : 0.f;
#pragma unroll
                for (int j = 0; j < i; ++j) a += Lf[i * 16 + j] * tm[j];
                tm[i] = a; }
            if (lane < 16) {
#pragma unroll
                for (int i = 0; i < 16; ++i) *(LAS bf16*)(GB_ + G_TM + (w * 16 + i) * 32 + lane * 2) = (bf16)f2bf(tm[i]); }
        }
        __syncthreads();
        const bool first = it < nch / 2;
#pragma unroll 1
        for (int sc = 0; sc < 4; ++sc) {
            lane = lane0; asm volatile("" : "+v"(lane)); c16 = lane & 15; g = lane >> 4;
            const LAS unsigned char* at_p = GB_ + G_AT + (16 * sc + c16) * SG_ST + 8 * g;
            const LAS unsigned char* rt_p = GB_ + G_RT + (16 * sc + c16) * SG_ST + 8 * g;
            const LAS unsigned char* vt_p = GB_ + G_PRIV + sc * PW_SIZE + PW_VT + (16 * w + c16) * VT_ST + 8 * g;
            const bf16x8 sop0 = pk8(S[0], S[1]), sop1 = pk8(S[2], S[3]);
            const bf16x8 at0 = mk8(*(const LAS v2u*)(at_p), *(const LAS v2u*)(at_p + 32)), at1 = mk8(*(const LAS v2u*)(at_p + 64), *(const LAS v2u*)(at_p + 96));
            const bf16x8 rt0 = mk8(*(const LAS v2u*)(rt_p), *(const LAS v2u*)(rt_p + 32)), rt1 = mk8(*(const LAS v2u*)(rt_p + 64), *(const LAS v2u*)(rt_p + 96));
            const v2u vt2 = *(const LAS v2u*)vt_p;
            const bf16x8 alak = mk8(*(const LAS v2u*)(GB_ + G_LAK + (sc * 16 + c16) * 32 + 8 * g), z2);
            const bf16x8 atm = mk8(*(const LAS v2u*)(GB_ + G_TM + (sc * 16 + c16) * 32 + 8 * g), z2);
            const bf16x8 albk = mk8(*(const LAS v2u*)(GB_ + G_LBR + (sc * 16 + c16) * 32 + 8 * g), *(const LAS v2u*)(GB_ + G_LKR + (sc * 16 + c16) * 32 + 8 * g));
            f32x4 X = {0.f, 0.f, 0.f, 0.f};
            X = MFMA16(at0, sop0, X); X = MFMA16(at1, sop1, X); X = MFMA16(alak, mk8(vt2, z2), X);
            const v4u xo = {pk2(X[0], X[1]), pk2(X[2], X[3]), 0u, 0u};
            f32x4 U = {0.f, 0.f, 0.f, 0.f};
            U = MFMA16(atm, __builtin_bit_cast(bf16x8, xo), U);
            const v4u uo = {pk2(U[0], U[1]), pk2(U[2], U[3]), vt2.x, vt2.y};
            const bf16x8 uvop = __builtin_bit_cast(bf16x8, uo);
            float* yp[4];
#pragma unroll
            for (int rg = 0; rg < 4; ++rg) { const int p = it * 64 + sc * 16 + 4 * g + rg, t = d ? T - 1 - p : p; yp[rg] = YB + (size_t)(m0 + t) * D + hh * 64 + 16 * w + c16; }
            f32x4 Y = {0.f, 0.f, 0.f, 0.f};
            if (!first) {
#pragma unroll
                for (int rg = 0; rg < 4; ++rg) Y[rg] = *yp[rg]; }
            Y = MFMA16(rt0, sop0, Y); Y = MFMA16(rt1, sop1, Y); Y = MFMA16(albk, uvop, Y);
#pragma unroll
            for (int rg = 0; rg < 4; ++rg) *yp[rg] = Y[rg];
#pragma unroll
            for (int kt = 0; kt < 4; ++kt) {
                const bf16x8 abk = mk8(*(const LAS v2u*)(GB_ + G_BH + (sc * 64 + 16 * kt + c16) * 32 + 8 * g), *(const LAS v2u*)(GB_ + G_KH + (sc * 64 + 16 * kt + c16) * 32 + 8 * g));
                const f32x4 gm = *(const LAS f32x4*)(GB_ + G_GAM + (sc * 64 + 16 * kt + 4 * g) * 4);
                S[kt] = MFMA16(abk, uvop, S[kt]) * gm;
            }
        }
        __syncthreads();
        if (!first) {
            lane = lane0; asm volatile("" : "+v"(lane)); hc = hh * 64 + lane;
            float y_[16], s1[16];
#pragma unroll
            for (int i = 0; i < 16; ++i) { const int p = p0 + i, t = d ? T - 1 - p : p; y_[i] = YB[(size_t)(m0 + t) * D + hc]; s1[i] = y_[i]; }
            wave_sum16(s1, lane);
#pragma unroll
            for (int i = 0; i < 16; ++i) { y_[i] -= s1[i] * (1.f / 64.f); s1[i] = y_[i] * y_[i]; }
            wave_sum16(s1, lane);
#pragma unroll
            for (int i = 0; i < 16; ++i) { const int p = p0 + i, t = d ? T - 1 - p : p; const size_t m = (size_t)(m0 + t);
                const float yn = y_[i] * (1.f / sqrtf(s1[i] * (1.f / 64.f) + 64e-5f)) * lng + lnb + v_[i];
                MIX[m * DMIX + 1024 + hc] = (bf16)f2bf(yn * bf2f(GBp[m * D + hc])); }
        }
    }
    if (!lat) {
        float* sp = F.out + OUT_ST + st_off;
#pragma unroll
        for (int kt = 0; kt < 4; ++kt) *(f32x4*)(sp + 16 * kt) = S[kt];
    }
}


__device__ __forceinline__ void st_bf16(LAS unsigned char* p, float v) { *(LAS bf16*)p = (bf16)f2bf_hw(v); }
struct PfRows { unsigned off[3]; bool ok[3]; };
__device__ __forceinline__ PfRows pf_rows(int T, int p0, int d, int lane) {
    PfRows R;
#pragma unroll
    for (int q = 0; q < 3; ++q) { const int j = 8 * q + (lane >> 3), jj = j > 17 ? 17 : j, pj = p0 - 1 + jj; int tj = d ? T - 1 - pj : pj; R.ok[q] = tj >= 0 && tj < T; tj = R.ok[q] ? tj : 0;
        R.off[q] = (unsigned)tj * (unsigned)DSH + (unsigned)(lane & 7) * 8u; }
    return R;
}
__device__ __forceinline__ void pf_issue(const bf16* ubase, const PfRows& R, int colb, v4u (&r)[3]) {
#pragma unroll
    for (int q = 0; q < 3; ++q) r[q] = *(const v4u*)(ubase + colb + R.off[q]);
}
__device__ __forceinline__ void pf_consume(LAS unsigned char* stg, const v4u (&r)[3], int lane, float mA, float mB, float (&out)[16], int edge_lo, int edge_hi, float scale = 1.f) {
    if (edge_lo > 0 || edge_hi < 17) {
#pragma unroll
        for (int q = 0; q < 3; ++q) { const int j = 8 * q + (lane >> 3); v4u x = r[q]; if (j < edge_lo || j > edge_hi) x = (v4u){0u, 0u, 0u, 0u};
            *(LAS v4u*)(stg + j * SG_ST + (lane & 7) * 16) = x; }
    } else {
#pragma unroll
        for (int q = 0; q < 3; ++q) *(LAS v4u*)(stg + (8 * q + (lane >> 3)) * SG_ST + (lane & 7) * 16) = r[q];
    }
    asm volatile("" ::: "memory");
    float u[18];
#pragma unroll
    for (int j = 0; j < 18; ++j) u[j] = bf2f(*(const LAS bf16*)(stg + j * SG_ST + lane * 2));
    asm volatile("" ::: "memory");
    const float m0_ = (1.f - mA - mB) * scale, mA_ = mA * scale, mB_ = mB * scale;
#pragma unroll
    for (int i = 0; i < 16; ++i) out[i] = m0_ * u[i + 1] + mA_ * u[i] + mB_ * u[i + 2];
}
__device__ __forceinline__ void scan_unit3(Frame& F, int b, int hh, bool lat, const XcdBarrier* gbar = nullptr, int gbar_it = -1) {
    const int T = lat ? LSEQ : SEQ, m0 = lat ? MC + b * LSEQ : b * SEQ, nch = T / 64;
    int lane0 = F.lane; asm volatile("" : "+v"(lane0));
    const int d = F.wave >> 2, w = F.wave & 3;
    int lane = lane0, c16 = lane & 15, g = lane >> 4, hc = hh * 64 + lane;
    LAS unsigned char* GB_ = F.lds + d * G_SIZE;
    LAS unsigned char* PW = GB_ + G_PRIV + w * PW_SIZE;
    const bf16* UB = (const bf16*)(F.ws + WS_UB) + (size_t)m0 * DSH; const bf16* GBp = (const bf16*)(F.ws + WS_GB); bf16* MIX = (bf16*)(F.ws + WS_MIX);
    float* YB = F.out + OUT_Y;
    const float* mu = F.in[I_MU];
    const int cR = hh * 64, cK = 1024 + hh * 64, cV = 2048 + hh * 64, cW = 3072 + 64 * d, cA = 3200 + 64 * d;
    const int oA = d ? DSH : 0, oB = d ? 0 : DSH;
    const float kkc = F.in[I_KK][hc], kac = F.in[I_KA][hc], rkc = F.in[I_RK][hc], w0c = F.in[I_W0][d * D + hc] * 1.44269504088896f, a0c = F.in[I_A0][d * D + hc] * 1.44269504088896f;
    const float mWA = mu[oA + cW + lane], mWB = mu[oB + cW + lane], mAA = mu[oA + cA + lane], mAB = mu[oB + cA + lane], mKA = mu[oA + cK + lane], mKB = mu[oB + cK + lane];
    const float mRA = mu[oA + cR + lane], mRB = mu[oB + cR + lane], mVA = mu[oA + cV + lane], mVB = mu[oB + cV + lane];
    const v4u* wop0 = (const v4u*)(F.ws + WS_WOP) + (size_t)((d * 16 + hh) * 2) * 8 * 64;
    f32x4 S[4];
    { const size_t st_off = ((size_t)((b * 2 + d) * NHB + hh) * 64 + 16 * w + c16) * 64 + 4 * g;
#pragma unroll
    for (int kt = 0; kt < 4; ++kt) S[kt] = lat ? *(const f32x4*)(F.in[I_ST] + st_off + 16 * kt) : (f32x4){0.f, 0.f, 0.f, 0.f}; }
    const v2u z2 = {0u, 0u};
    v4u pW[3], pA[3], pK[3], pR[3], pV[3];
    { const PfRows R = pf_rows(T, w * 16, d, lane); pf_issue(UB, R, cW, pW); pf_issue(UB, R, cA, pA); pf_issue(UB, R, cK, pK); pf_issue(UB, R, cR, pR); pf_issue(UB, R, cV, pV); }
    __syncthreads();
    for (int it = 0; it < nch; ++it) {
        if (it == gbar_it) xcd_barrier(*gbar);
        const int p0 = it * 64 + w * 16;
        const bool first = it < nch / 2;
        lane = lane0; asm volatile("" : "+v"(lane));
        c16 = lane & 15; g = lane >> 4; hc = hh * 64 + lane;
        const v4u* wop = wop0 + lane;
        LAS unsigned char* stg = PW + PW_ZS;
        const int elo = p0 == 0 ? 1 : 0, ehi = (T - p0) < 17 ? (T - p0) : 17;
        float bon[16], v_[16];
#ifndef SREP_PREP
#define SREP_PREP 1
#endif
#ifndef SREP_POST
#define SREP_POST 1
#endif
#ifndef SREP_B
#define SREP_B 1
#endif
#pragma unroll 1
        for (int rep_ = 0; rep_ < SREP_PREP; ++rep_) {
        {
            float x_[16];
            pf_consume(stg, pW, lane, mWA, mWB, x_, elo, ehi, 2.f * 1.44269504088896f);
#pragma unroll
            for (int i = 0; i < 16; ++i) { const float e = __builtin_amdgcn_exp2f(x_[i]); st_bf16(PW + PW_TLW + i * SG_ST + lane * 2, 1.f - 2.f * __builtin_amdgcn_rcpf(e + 1.f)); }
            pf_consume(stg, pA, lane, mAA, mAB, x_, elo, ehi);
#pragma unroll
            for (int i = 0; i < 16; ++i) st_bf16(PW + PW_LAB + i * SG_ST + lane * 2, x_[i]);
        }
        float k_[16];
        pf_consume(stg, pK, lane, mKA, mKB, k_, elo, ehi);
        asm volatile("" ::: "memory");
        float lam[16], aa[16];
        {
            LAS float* Zs = (LAS float*)(PW + PW_ZS);
            {
                bf16x8 ta[2];
#pragma unroll
                for (int ks = 0; ks < 2; ++ks) ta[ks] = *(const LAS bf16x8*)(PW + PW_TLW + c16 * SG_ST + (32 * ks + 8 * g) * 2);
#pragma unroll
                for (int ct = 0; ct < 4; ++ct) { f32x4 z = {0.f, 0.f, 0.f, 0.f};
#pragma unroll
                    for (int ks = 0; ks < 2; ++ks) z = MFMA16(ta[ks], __builtin_bit_cast(bf16x8, wop[(ct * 2 + ks) * 64]), z);
#pragma unroll
                    for (int rg = 0; rg < 4; ++rg) Zs[(4 * g + rg) * ZS_ST + 16 * ct + c16] = z[rg]; }
                float l = 0.f;
#pragma unroll
                for (int i = 0; i < 16; ++i) { l += (-0.60653065971f * 1.44269504088896f) * sigmoid2_(w0c + Zs[i * ZS_ST + lane]); lam[i] = l; }
            }
            asm volatile("" ::: "memory");
            {
                bf16x8 tb[2];
#pragma unroll
                for (int ks = 0; ks < 2; ++ks) tb[ks] = *(const LAS bf16x8*)(PW + PW_LAB + c16 * SG_ST + (32 * ks + 8 * g) * 2);
#pragma unroll
                for (int ct = 0; ct < 4; ++ct) { f32x4 z = {0.f, 0.f, 0.f, 0.f};
#pragma unroll
                    for (int ks = 0; ks < 2; ++ks) z = MFMA16(tb[ks], __builtin_bit_cast(bf16x8, wop[512 + (ct * 2 + ks) * 64]), z);
#pragma unroll
                    for (int rg = 0; rg < 4; ++rg) Zs[(4 * g + rg) * ZS_ST + 16 * ct + c16] = z[rg]; }
#pragma unroll
                for (int i = 0; i < 16; ++i) aa[i] = sigmoid2_(a0c + Zs[i * ZS_ST + lane]);
            }
        }
        {
            {
                float n2[16];
#pragma unroll
                for (int i = 0; i < 16; ++i) { const float kk = k_[i] * kkc; n2[i] = kk * kk; }
                wave_sum16(n2, lane);
                unsigned bh[8], kh[8];
                float e1 = 1.f;
#pragma unroll
                for (int i = 0; i < 16; i += 2) {
                    float bt2[2], kt2[2];
#pragma unroll
                    for (int e = 0; e < 2; ++e) {
                        const float kk = k_[i + e] * kkc * __builtin_amdgcn_rsqf(n2[i + e] + 1e-12f), kd = k_[i + e] * (1.f + (aa[i + e] - 1.f) * kac), bb = kk * aa[i + e];
                        const float e3 = __builtin_amdgcn_exp2f(lam[i + e]), e2 = __builtin_amdgcn_rcpf(e3);
                        lam[i + e] = e3;
                        st_bf16(GB_ + G_AT + (16 * w + i + e) * SG_ST + lane * 2, -kk * e1);
                        bt2[e] = bb * e2; kt2[e] = kd * e2; e1 = e3;
                    }
                    const unsigned bp = pk2(bt2[0], bt2[1]), kp = pk2(kt2[0], kt2[1]);
                    bh[i >> 1] = bp; kh[i >> 1] = kp;
                    *(LAS bf16*)(PW + PW_TLW + i * SG_ST + lane * 2) = (bf16)bp; *(LAS bf16*)(PW + PW_TLW + (i + 1) * SG_ST + lane * 2) = (bf16)(bp >> 16);
                    *(LAS bf16*)(PW + PW_LAB + i * SG_ST + lane * 2) = (bf16)kp; *(LAS bf16*)(PW + PW_LAB + (i + 1) * SG_ST + lane * 2) = (bf16)(kp >> 16);
                }
#pragma unroll
                for (int q = 0; q < 4; ++q) {
                    *(LAS v2u*)(GB_ + G_BH + (w * 64 + lane) * 32 + 8 * q) = (v2u){bh[2 * q], bh[2 * q + 1]};
                    *(LAS v2u*)(GB_ + G_KH + (w * 64 + lane) * 32 + 8 * q) = (v2u){kh[2 * q], kh[2 * q + 1]};
                }
            }
            float r_[16];
            pf_consume(stg, pR, lane, mRA, mRB, r_, elo, ehi);
#pragma unroll
            for (int i = 0; i < 16; ++i) { bon[i] = r_[i] * k_[i] * rkc; st_bf16(GB_ + G_RT + (16 * w + i) * SG_ST + lane * 2, r_[i] * lam[i]); }
            wave_sum16(bon, lane);
        }
        ((LAS float*)(GB_ + G_GAM))[w * 64 + lane] = lam[15];
        {
            pf_consume(stg, pV, lane, mVA, mVB, v_, elo, ehi);
            unsigned vt[8];
#pragma unroll
            for (int i = 0; i < 16; i += 2) { vt[i >> 1] = pk2(v_[i], v_[i + 1]); v_[i] *= bon[i]; v_[i + 1] *= bon[i + 1]; }
            asm volatile("" ::: "memory");
#pragma unroll
            for (int q = 0; q < 4; ++q) *(LAS v2u*)(PW + PW_VT + lane * VT_ST + 8 * q) = (v2u){vt[2 * q], vt[2 * q + 1]};
        }
        asm volatile("" ::: "memory");
        {
            bf16x8 fa[2], fr[2], fb[2], fk[2];
#pragma unroll
            for (int ks = 0; ks < 2; ++ks) {
                fa[ks] = *(const LAS bf16x8*)(GB_ + G_AT + (16 * w + c16) * SG_ST + (32 * ks + 8 * g) * 2); fr[ks] = *(const LAS bf16x8*)(GB_ + G_RT + (16 * w + c16) * SG_ST + (32 * ks + 8 * g) * 2);
                fb[ks] = *(const LAS bf16x8*)(PW + PW_TLW + c16 * SG_ST + (32 * ks + 8 * g) * 2); fk[ks] = *(const LAS bf16x8*)(PW + PW_LAB + c16 * SG_ST + (32 * ks + 8 * g) * 2);
            }
            f32x4 lab = {0.f, 0.f, 0.f, 0.f}, lak = lab, lbr = lab, lkr = lab;
#pragma unroll
            for (int ks = 0; ks < 2; ++ks) { lab = MFMA16(fa[ks], fb[ks], lab); lak = MFMA16(fa[ks], fk[ks], lak); lbr = MFMA16(fr[ks], fb[ks], lbr); lkr = MFMA16(fr[ks], fk[ks], lkr); }
            LAS float* Lf = (LAS float*)(PW + PW_LF);
#pragma unroll
            for (int rg = 0; rg < 4; ++rg) { const int i = 4 * g + rg, j = c16;
                Lf[i * 16 + j] = j < i ? lab[rg] : 0.f;
                st_bf16(GB_ + G_LAK + (w * 16 + i) * 32 + j * 2, j < i ? lak[rg] : 0.f);
                st_bf16(GB_ + G_LBR + (w * 16 + i) * 32 + j * 2, j <= i ? lbr[rg] : 0.f);
                st_bf16(GB_ + G_LKR + (w * 16 + i) * 32 + j * 2, j <= i ? lkr[rg] : 0.f); }
            float tm[16];
#pragma unroll
            for (int i = 0; i < 16; ++i) { float a = (i == c16) ? 1.f : 0.f;
#pragma unroll
                for (int j = 0; j < i; ++j) a += Lf[i * 16 + j] * tm[j];
                tm[i] = a; }
            if (lane < 16) {
#pragma unroll
                for (int i = 0; i < 16; ++i) st_bf16(GB_ + G_TM + (w * 16 + i) * 32 + lane * 2, tm[i]); }
        }
        }
        __syncthreads();
        const PfRows PR = pf_rows(T, p0 + 64, d, lane);
        const float* yop = YB + (size_t)(m0 + (d ? T - 1 - p0 : p0)) * D + hc; const long ystep = d ? -(long)D : (long)D;
        float yo[16];
        {
            lane = lane0; asm volatile("" : "+v"(lane)); c16 = lane & 15; g = lane >> 4;
            const LAS unsigned char* at_b = GB_ + G_AT + c16 * SG_ST + 8 * g;
            const LAS unsigned char* rt_b = GB_ + G_RT + c16 * SG_ST + 8 * g;
            const LAS unsigned char* vt_b = GB_ + G_PRIV + PW_VT + (16 * w + c16) * VT_ST + 8 * g;
            const LAS unsigned char* l_b = GB_ + c16 * 32 + 8 * g;
            const LAS unsigned char* gm_b = GB_ + G_GAM + 16 * g;
            LAS float* yc_b = (LAS float*)(GB_ + G_PRIV + PW_TLW) + (4 * g) * ZS_ST + 16 * w + c16;
#pragma unroll
            for (int sc = 0; sc < 4; ++sc) {
                if (sc == 0) { pf_issue(UB, PR, cW, pW); pf_issue(UB, PR, cA, pA); }
                if (sc == 1) { pf_issue(UB, PR, cK, pK); pf_issue(UB, PR, cR, pR); }
                if (sc == 2) { pf_issue(UB, PR, cV, pV);
#pragma unroll
                    for (int i = 0; i < 6; ++i) yo[i] = yop[i * ystep]; }
                if (sc == 3) {
#pragma unroll
                    for (int i = 6; i < 16; ++i) yo[i] = yop[i * ystep]; }
                const LAS unsigned char* at_p = at_b + sc * 16 * SG_ST; const LAS unsigned char* rt_p = rt_b + sc * 16 * SG_ST;
                const bf16x8 sop0 = pk8(S[0], S[1]), sop1 = pk8(S[2], S[3]);
                const bf16x8 at0 = mk8(*(const LAS v2u*)(at_p), *(const LAS v2u*)(at_p + 32)), at1 = mk8(*(const LAS v2u*)(at_p + 64), *(const LAS v2u*)(at_p + 96));
                const bf16x8 rt0 = mk8(*(const LAS v2u*)(rt_p), *(const LAS v2u*)(rt_p + 32)), rt1 = mk8(*(const LAS v2u*)(rt_p + 64), *(const LAS v2u*)(rt_p + 96));
                const v2u vt2 = *(const LAS v2u*)(vt_b + sc * PW_SIZE);
                const bf16x8 alak = mk8(*(const LAS v2u*)(l_b + G_LAK + sc * 512), z2);
                const bf16x8 atm = mk8(*(const LAS v2u*)(l_b + G_TM + sc * 512), z2);
                const bf16x8 albk = mk8(*(const LAS v2u*)(l_b + G_LBR + sc * 512), *(const LAS v2u*)(l_b + G_LKR + sc * 512));
                f32x4 X = {0.f, 0.f, 0.f, 0.f}, Y = X;
                X = MFMA16(at0, sop0, X); Y = MFMA16(rt0, sop0, Y); X = MFMA16(at1, sop1, X); Y = MFMA16(rt1, sop1, Y); X = MFMA16(alak, mk8(vt2, z2), X);
                const v4u xo = {pk2(X[0], X[1]), pk2(X[2], X[3]), 0u, 0u};
                f32x4 U = {0.f, 0.f, 0.f, 0.f};
                U = MFMA16(atm, __builtin_bit_cast(bf16x8, xo), U);
                const v4u uo = {pk2(U[0], U[1]), pk2(U[2], U[3]), vt2.x, vt2.y};
                const bf16x8 uvop = __builtin_bit_cast(bf16x8, uo);
                Y = MFMA16(albk, uvop, Y);
#pragma unroll
                for (int kt = 0; kt < 4; ++kt) {
                    const bf16x8 abk = mk8(*(const LAS v2u*)(l_b + G_BH + (sc * 64 + 16 * kt) * 32), *(const LAS v2u*)(l_b + G_KH + (sc * 64 + 16 * kt) * 32));
                    const f32x4 gm = *(const LAS f32x4*)(gm_b + (sc * 64 + 16 * kt) * 4);
                    S[kt] = MFMA16(abk, uvop, S[kt]) * gm;
                }
                LAS float* yc = yc_b + sc * (PW_SIZE / 4);
#pragma unroll
                for (int rg = 0; rg < 4; ++rg) yc[rg * ZS_ST] = Y[rg];
            }
        }
        __syncthreads();
#pragma unroll 1
        for (int rep_ = 0; rep_ < SREP_POST; ++rep_)
        {
            lane = lane0; asm volatile("" : "+v"(lane)); hc = hh * 64 + lane;
            const LAS float* yc = (const LAS float*)(PW + PW_TLW);
            float y_[16];
#pragma unroll
            for (int i = 0; i < 16; ++i) y_[i] = yc[i * ZS_ST + lane];
            if (first) {
#pragma unroll
                for (int i = 0; i < 16; ++i) { const int p = p0 + i, t = d ? T - 1 - p : p; YB[(size_t)(m0 + t) * D + hc] = y_[i]; }
            } else {
                const float lng = F.in[I_LNG][hc], lnb = F.in[I_LNB][hc];
                unsigned short gb_[16];
#pragma unroll
                for (int i = 0; i < 16; ++i) { const int p = p0 + i, t = d ? T - 1 - p : p; gb_[i] = *(const unsigned short*)(GBp + (size_t)(m0 + t) * D + hc); }
                float s1[16];
#pragma unroll
                for (int i = 0; i < 16; ++i) { y_[i] += yo[i]; s1[i] = y_[i]; }
                wave_sum16(s1, lane);
#pragma unroll
                for (int i = 0; i < 16; ++i) { y_[i] -= s1[i] * (1.f / 64.f); s1[i] = y_[i] * y_[i]; }
                wave_sum16(s1, lane);
#pragma unroll
                for (int i = 0; i < 16; ++i) { const int p = p0 + i, t = d ? T - 1 - p : p; const size_t m = (size_t)(m0 + t);
                    const float yn = y_[i] * __builtin_amdgcn_rsqf(s1[i] * (1.f / 64.f) + 64e-5f) * lng + lnb + v_[i];
                    st_wt2(ws_rsrc(F.ws), F.ws, MIX + m * DMIX + 1024 + hc, (unsigned short)f2bf_hw(yn * bf2f((bf16)gb_[i]))); }
            }
        }
    }
    if (!lat) {
        lane = lane0; asm volatile("" : "+v"(lane)); c16 = lane & 15; g = lane >> 4;
        float* sp = F.out + OUT_ST + ((size_t)((b * 2 + d) * NHB + hh) * 64 + 16 * w + c16) * 64 + 4 * g;
#pragma unroll
        for (int kt = 0; kt < 4; ++kt) *(f32x4*)(sp + 16 * kt) = S[kt];
    }
}

template <int QW, int MASK> __device__ __forceinline__ void p3_mixers(Frame& F) {
    float lam;
    { const float a = F.in[I_LQ1][F.lane] * F.in[I_LK1][F.lane], bq = F.in[I_LQ2][F.lane] * F.in[I_LK2][F.lane];
      lam = __expf(wave_sum(a)) - __expf(wave_sum(bq)) + 0.2f; }
    constexpr int N_SC = Q_NSC, N_AL = Q_NAL, NU = Q_NU;
    unsigned* const nq = (unsigned*)(F.ctl + CW_Q3 + 64 * QW);
    volatile LAS int* slot = (volatile LAS int*)(F.lds + MISC_OFF + 64);
    bool chain_first = (int)blockIdx.x < NLATB;
    if (!chain_first && (int)blockIdx.x < NOFF) {
        if (F.tid == 0) { unsigned sp = 0; while (__hip_atomic_load((unsigned*)(F.ctl + CW_P2DONE), RLX_AGENT) == 0u) { __builtin_amdgcn_s_sleep(4); if (++sp > (1u << 22)) break; } }
        __syncthreads();
        __builtin_amdgcn_fence(__ATOMIC_ACQUIRE, "agent");
    }
    int u = 0;
    for (;;) {
        int sb, sh; bool slat = false;
        if (chain_first) { chain_first = false; slat = true; sb = (int)blockIdx.x / NHB; sh = (int)blockIdx.x % NHB; }
        else {
            __syncthreads();
            if (F.tid == 0) *slot = (int)__hip_atomic_fetch_add(nq, 1u, RLX_AGENT);
            __syncthreads();
            u = *slot;
            if (u >= N_SC) break;
            sb = u / NHB; sh = u % NHB;
        }
        scan_unit3(F, sb, sh, slat);
        if (slat) {
            if (F.tid == 0) { unsigned sp = 0; while (__hip_atomic_load((unsigned*)(F.ctl + CW_P2DONE), RLX_AGENT) == 0u) { __builtin_amdgcn_s_sleep(4); if (++sp > (1u << 22)) break; } }
            __syncthreads();
            __builtin_amdgcn_fence(__ATOMIC_ACQUIRE, "agent");
        }
    }
    bool Pvalid = false; int Pu = 0;
    v4u Pk0 = {0u, 0u, 0u, 0u}, Pk1 = Pk0, Pv0 = Pk0, Pv1 = Pk0; bf16x8 Pq0 = {0, 0, 0, 0, 0, 0, 0, 0}, Pq1 = Pq0, Pq2 = Pq0, Pq3 = Pq0;
    while (u < NU) {
        int a_ = u - N_SC; const bool lt = a_ < N_AL; if (!lt) a_ -= N_AL;
        attn_unit(F, a_, lt, lam, nq, Pvalid, Pu, Pk0, Pk1, Pv0, Pv1, Pq0, Pq1, Pq2, Pq3);
        u = Pu;
    }
}

template <bool DUMMY> __device__ __forceinline__ void p5_final(Frame& F) {
    int ln = F.lane; asm volatile("" : "+v"(ln));
    const float* ssq = (const float*)(F.ws + WS_SSQ);
    const int gw = blockIdx.x * NWAVES + F.wave, NGW = F.G * NWAVES;
    for (int m = gw; m < M; m += NGW) {
        float s = ln < 16 ? ssq[(size_t)m * 16 + ln] : 0.f;
        s = wave_sum(s);
        const float rstd = 1.f / sqrtf(s * (1.f / D) + 1e-6f);
        float* yr = F.out + OUT_Y + (size_t)m * D;
#pragma unroll
        for (int j = 0; j < 4; ++j) { const int c = 4 * ln + 256 * j; const f32x4 v = *(const f32x4*)(yr + c), g = *(const f32x4*)(F.in[I_FG] + c); *(f32x4*)(yr + c) = DUMMY ? v : v * rstd * g; }
    }
}

__global__ void __launch_bounds__(NTHR, 2) hymba_fwd(Args args) {
    extern __shared__ __attribute__((aligned(16))) unsigned char lds[];
    Frame F;
    F.lds = (LAS unsigned char*)lds;
    F.MISC = (volatile LAS unsigned*)(F.lds + MISC_OFF);
    F.tid = threadIdx.x; F.lane = F.tid & 63; F.wave = __builtin_amdgcn_readfirstlane(F.tid >> 6);
    F.G = gridDim.x; F.in = args.in; F.out = args.out; F.ws = args.ws;
    F.ctl = (gu32*)(args.ws + WS_CTL);
    for (int u = F.tid; u < (LDS_BYTES - LDSCTL_OFF) / 4; u += NTHR) ((LAS unsigned*)(F.lds + LDSCTL_OFF))[u] = 0u;
    __syncthreads();
    XcdBarrier bar; bar.bar = (unsigned*)(F.ctl + CW_BAR); bar.x = 0; bar.st = nullptr; bar.expect = 0u;
    XcdBarrier bar2 = bar;
    if (N_LAUNCHES != PER_PHASE) bar = xcd_barrier_post((unsigned*)(F.ctl + CW_BAR), F.MISC + 8);
    if (N_LAUNCHES != PER_PHASE && (int)blockIdx.x >= NOFF) bar2 = xcd_barrier_post((unsigned*)(F.ctl + CW_BAR2), F.MISC + 12, (unsigned)(gridDim.x - NOFF));
#define GRID_BAR() do { if (N_LAUNCHES != PER_PHASE) xcd_barrier(bar); } while (0)
    {
        unsigned long long pc_;
        asm volatile("s_getpc_b64 %0" : "=s"(pc_));
        if (threadIdx.x == 0) *(volatile LAS unsigned long long*)(F.lds + MISC_OFF + 80) = pc_ & ~63ull;
        __syncthreads();
    }
#define CODE_PREFETCH(first_block) do { if ((unsigned)((int)blockIdx.x - (first_block)) < 8u) { const char* cb_ = (const char*)*(volatile LAS unsigned long long*)(F.lds + MISC_OFF + 80); int acc_ = 0; \
        _Pragma("unroll") for (int q_ = 0; q_ < 4; ++q_) { const int off_ = ((int)threadIdx.x + q_ * NTHR) * 64; if (off_ < 100 * 1024) acc_ += *(const volatile int*)(cb_ + off_); } asm volatile("" :: "v"(acc_)); } } while (0)
    CODE_PREFETCH(0);
    const int lo = args.ph_lo, hi = args.ph_hi;
#define IN(k) (lo <= (k) && (k) < hi)
#define BOTH(k) (IN(k) && IN((k) + 1))
#ifndef REP0
#define REP0 1
#endif
#ifndef REP2
#define REP2 1
#endif
#ifndef REP3MASK
#define REP3MASK 0
#endif
#ifndef REP4
#define REP4 1
#endif
#define RELANE() do { int t_ = threadIdx.x; asm volatile("" : "+v"(t_)); F.tid = t_; F.lane = t_ & 63; } while (0)
    {
        f32x4 xv[5][4];
        p0_prologue(F); RELANE(); p1_load<0, 3>(F, xv); GRID_BAR();
        p1_load<3, 5>(F, xv); p1_norm(F, xv); CODE_PREFETCH(0); GRID_BAR();
    }
    RELANE();
    if (IN(2)) {
        const pg8::Gemm g{(const bf16*)(F.ws + WS_XN), (const bf16*)(F.ws + WS_WIN), M, DIN, D};
        {
            const f32x4 rv = *(const f32x4*)((const float*)(F.ws + WS_ROPE) + 4 * F.tid);
            *(LAS f32x4*)(F.lds + ROPE_LDS + 16 * F.tid) = rv;
            __syncthreads();
        }
        const EpiIn E{F.ws, F.out, (const LAS float*)(F.lds + ROPE_LDS)};
        const bool chain = (int)blockIdx.x < NLATB;
#pragma unroll 1
        for (int part = 0; part < 2; ++part) {
            if (part == 1 && (int)blockIdx.x < NOFF) {
                if (!chain) {
                    LAS float* scr = (LAS float*)(F.lds + RING_OFF + F.wave * 16384);
                    for (int it = ((int)blockIdx.x - NLATB) * NWAVES + F.wave; it < (DMIX / 64) * (D / 32); it += NIDLE * NWAVES)
                        p0_transpose_item(F.in[I_WOUT], DMIX, D, (bf16*)(F.ws + WS_WOUT), scr, it, F.lane);
                }
                break;
            }
            ListOrder S;
            if (part == 0) S.init(F.G, (int)blockIdx.x, 0, P2A_UNITS); else S.init(F.G - NOFF, (int)blockIdx.x - NOFF, P2A_UNITS, P2_UNITS);
            pg8::gemm_phase<EpiIn, ListOrder, true, true>(F.lds + RING_OFF, g, S, E);
            if (part == 0) {
                if (N_LAUNCHES != PER_PHASE) {
                    asm volatile("s_waitcnt vmcnt(0)" ::: "memory");
                    __syncthreads();
                    if (F.tid == 0) {
                        __hip_atomic_fetch_add((unsigned*)(F.ctl + CW_P2A), 1u, RLX_AGENT);
                        if (chain) { unsigned sp = 0; while (__hip_atomic_load((unsigned*)(F.ctl + CW_P2A), RLX_AGENT) < (unsigned)F.G) { __builtin_amdgcn_s_sleep(2); if (++sp > (1u << 22)) break; } }
                    }
                    if (chain) { __syncthreads(); __builtin_amdgcn_fence(__ATOMIC_ACQUIRE, "agent"); }
                }
                continue;
            }
            if (N_LAUNCHES != PER_PHASE) {
                CODE_PREFETCH(NOFF); xcd_barrier(bar2);
                if ((int)blockIdx.x == NOFF && F.tid == 0) { __builtin_amdgcn_fence(__ATOMIC_RELEASE, "agent"); __hip_atomic_store((unsigned*)(F.ctl + CW_P2DONE), 1u, RLX_AGENT); }
            }
        }
    }
    RELANE();
    if (IN(3)) { p3_mixers<0, 15>(F); CODE_PREFETCH(0); if (BOTH(3)) GRID_BAR(); }
    RELANE();
    if (IN(4)) {
        pg8::Gemm g{(const bf16*)(F.ws + WS_MIX), (const bf16*)(F.ws + WS_WOUT), M, D, DMIX}; pg8::StaticOrder S; S.init(M, D, F.G, (int)blockIdx.x);
        EpiOutFused E{F.ws, F.out, F.in[I_XP], F.in[I_XS], F.in[I_FG], F.ctl};
        pg8::gemm_phase<EpiOutFused, pg8::StaticOrder, false, true>(F.lds + RING_OFF, g, S, E);
    }
#undef IN
#undef BOTH
}

extern "C" void kernel_launch(void* const* d_in, const int* in_sizes, int n_in, void* d_out, int out_size, void* d_ws, size_t ws_size, hipStream_t stream) {
    static int grid = 0;
    if (grid == 0) {
        if (n_in != N_IN || out_size != OUT_END || ws_size < WS_END) { fprintf(stderr, "kernel_launch: unexpected sizes n_in %d out %d ws %zu\n", n_in, out_size, ws_size); grid = -1; return; }
        int dev = 0, cus = 0, per_cu = 0;
        if (hipGetDevice(&dev) != hipSuccess || hipDeviceGetAttribute(&cus, hipDeviceAttributeMultiprocessorCount, dev) != hipSuccess) { grid = -1; return; }
        if (hipFuncSetAttribute((const void*)hymba_fwd, hipFuncAttributeMaxDynamicSharedMemorySize, LDS_BYTES) != hipSuccess) { fprintf(stderr, "kernel_launch: hipFuncSetAttribute failed\n"); grid = -1; return; }
        if (hipOccupancyMaxActiveBlocksPerMultiprocessor(&per_cu, (const void*)hymba_fwd, NTHR, LDS_BYTES) != hipSuccess || per_cu < 1) { fprintf(stderr, "kernel_launch: occupancy query says %d\n", per_cu); per_cu = 1; }
        (void)hipGetLastError();
        grid = cus;
        if (grid != 256) { fprintf(stderr, "kernel_launch: built for a 256-CU device (got %d CUs)\n", cus); grid = -1; return; }
    }
    if (grid < 0) return;
    if (hipMemsetAsync((char*)d_ws + WS_CTL, 0, CTL_ZERO_BYTES, stream) != hipSuccess) return;
    Args a{};
    for (int i = 0; i < N_IN; ++i) a.in[i] = (const float*)d_in[i];
    a.out = (float*)d_out; a.ws = (unsigned char*)d_ws;
    a.ph_lo = 0; a.ph_hi = PER_PHASE; a.li = 0;
    hipLaunchKernelGGL(hymba_fwd, dim3(grid), dim3(NTHR), LDS_BYTES, stream, a);
}
```
